# Optimizing an MI355X kernel written in HIP

```python
import jax
import jax.numpy as jnp
from jax import lax
import numpy as np


D_MODEL = 2048
BATCH = 4
SEQ = 4096
DEPTH = 2

N_EVEN = (DEPTH + 1) // 2
N_ODD = DEPTH // 2
ALPHA = (2 * DEPTH) ** 0.25
BETA = (8 * DEPTH) ** -0.25
GRID_W = 64
PLE_DIM = 256
LN_EPS = 1e-5
RMS_EPS = 1e-6

MLSTM_HEADS = 4
MLSTM_DV = D_MODEL // 2 // MLSTM_HEADS
MLSTM_DK = MLSTM_DV // 2
MLSTM_CHUNK = 64
GATE_CAP = 15.0

HGRN_DK = 128
HGRN_HEADS = D_MODEL // 2 // HGRN_DK
HGRN_DV = HGRN_DK
HGRN_CHUNK = 16

A_WIDTH = MLSTM_HEADS * MLSTM_DV
B_WIDTH = HGRN_HEADS * HGRN_DV
REC_SPLITS = (MLSTM_HEADS * MLSTM_DK, MLSTM_HEADS * MLSTM_DK, A_WIDTH, A_WIDTH, 4 * MLSTM_HEADS, HGRN_HEADS * HGRN_DK, HGRN_HEADS * HGRN_DK, HGRN_HEADS * HGRN_DK, B_WIDTH, B_WIDTH)
REC_IN = sum(REC_SPLITS)

NA_DH = 128
NA_HEADS = D_MODEL // NA_DH
NA_WIDTH = NA_HEADS * NA_DH
NA_KH = 8
NA_KW = 16

FFN_DIM = ((8 * D_MODEL // 3 + 255) // 256) * 256
N_EXPERTS = 8
TOP_K = 2
MOE_DIM = 7 * D_MODEL // 2
MOE_BLOCK = 512

kernel_name = 'hybrid_mlstm_hgrn2_natten_moe_encoder'


def layer_norm(x, w, b):
    xf = x.astype(jnp.float32)
    mu = jnp.mean(xf, axis=-1, keepdims=True)
    xc = xf - mu
    var = jnp.mean(xc * xc, axis=-1, keepdims=True)
    return (xc * lax.rsqrt(var + LN_EPS) * w.astype(jnp.float32) + b.astype(jnp.float32)).astype(x.dtype)


def head_rms_norm(h, w):
    wh = w.astype(jnp.float32).reshape(h.shape[1], 1, h.shape[-1])
    return h * lax.rsqrt(jnp.mean(h * h, axis=-1, keepdims=True) + RMS_EPS) * wh


def to_heads(z, nh):
    bsz, t, _ = z.shape
    return z.reshape(bsz, t, nh, -1).transpose(0, 2, 1, 3).astype(jnp.float32)


def from_heads(h):
    bsz, nh, t, d = h.shape
    return h.transpose(0, 2, 1, 3).reshape(bsz, t, nh * d)


def flip_t(z):
    return jnp.flip(z, axis=2)


def mlstm_chunkwise(q, k, v, log_i, log_f):
    bsz, nh, t, dk = q.shape
    dv = v.shape[-1]
    L = MLSTM_CHUNK
    nc = t // L
    q = q.reshape(bsz, nh, nc, L, dk)
    k = k.reshape(bsz, nh, nc, L, dk)
    v = v.reshape(bsz, nh, nc, L, dv)
    log_i = log_i.reshape(bsz, nh, nc, L)
    b = jnp.cumsum(log_f.reshape(bsz, nh, nc, L), axis=-1)
    g = b[..., -1]
    a = g[..., None] - b + log_i
    m_loc = jnp.max(a, axis=-1)
    kw = k * jnp.exp(a - m_loc[..., None])[..., None]
    c_loc = jnp.einsum('bhcsd,bhcse->bhcde', kw, v)
    n_loc = jnp.sum(kw, axis=-2)

    def step(carry, inp):
        c, n, m = carry
        c_l, n_l, m_l, g_c, q_c = inp
        y = jnp.einsum('bhtd,bhde->bhte', q_c, c)
        d = jnp.einsum('bhtd,bhd->bht', q_c, n)
        m_new = jnp.maximum(g_c + m, m_l)
        decay = jnp.exp(g_c + m - m_new)
        inj = jnp.exp(m_l - m_new)
        c = decay[..., None, None] * c + inj[..., None, None] * c_l
        n = decay[..., None] * n + inj[..., None] * n_l
        return (c, n, m_new), (y, d, m)

    init = (jnp.zeros((bsz, nh, dk, dv), jnp.float32), jnp.zeros((bsz, nh, dk), jnp.float32), jnp.zeros((bsz, nh), jnp.float32))
    xs = (jnp.moveaxis(c_loc, 2, 0), jnp.moveaxis(n_loc, 2, 0), jnp.moveaxis(m_loc, 2, 0), jnp.moveaxis(g, 2, 0), jnp.moveaxis(q, 2, 0))
    _, (y_inter, d_inter, m_prev) = lax.scan(step, init, xs)
    y_inter = jnp.moveaxis(y_inter, 0, 2)
    d_inter = jnp.moveaxis(d_inter, 0, 2)
    m_prev = jnp.moveaxis(m_prev, 0, 2)

    causal = jnp.tril(jnp.ones((L, L), dtype=bool))
    log_d = jnp.where(causal, b[..., :, None] - b[..., None, :] + log_i[..., None, :], -jnp.inf)
    inter_log = b + m_prev[..., None]
    m_t = jnp.maximum(jnp.max(log_d, axis=-1), inter_log)
    s = jnp.einsum('bhctd,bhcsd->bhcts', q, k) * jnp.exp(log_d - m_t[..., None])
    inter_w = jnp.exp(inter_log - m_t)
    num = jnp.einsum('bhcts,bhcse->bhcte', s, v) + inter_w[..., None] * y_inter
    den = jnp.sum(s, axis=-1) + inter_w * d_inter
    h = num / jnp.maximum(jnp.abs(den), jnp.exp(-m_t))[..., None]
    return h.reshape(bsz, nh, t, dv)


def hgrn2_chunkwise(q, k, v, log_f):
    bsz, nh, t, dk = q.shape
    dv = v.shape[-1]
    L = HGRN_CHUNK
    nc = t // L
    q = q.reshape(bsz, nh, nc, L, dk)
    k = k.reshape(bsz, nh, nc, L, dk)
    v = v.reshape(bsz, nh, nc, L, dv)
    b = jnp.cumsum(log_f.reshape(bsz, nh, nc, L, dk), axis=-2)
    g = b[..., -1, :]
    q_in = q * jnp.exp(b)
    k_in = k * jnp.exp(-b)
    k_end = k * jnp.exp(g[..., None, :] - b)
    causal = jnp.tril(jnp.ones((L, L), dtype=bool))
    a = jnp.where(causal, jnp.einsum('bhctd,bhcsd->bhcts', q_in, k_in), 0.0)
    o_intra = jnp.einsum('bhcts,bhcse->bhcte', a, v)

    def step(s, inp):
        k_c, v_c, g_c, q_c = inp
        y = jnp.einsum('bhtd,bhde->bhte', q_c, s)
        s = jnp.exp(g_c)[..., None] * s + jnp.einsum('bhsd,bhse->bhde', k_c, v_c)
        return s, y

    xs = (jnp.moveaxis(k_end, 2, 0), jnp.moveaxis(v, 2, 0), jnp.moveaxis(g, 2, 0), jnp.moveaxis(q_in, 2, 0))
    _, y = lax.scan(step, jnp.zeros((bsz, nh, dk, dv), jnp.float32), xs)
    o = o_intra + jnp.moveaxis(y, 0, 2)
    return o.reshape(bsz, nh, t, dv)


def recurrent_mixer(x, w_in, gate_bias, mlstm_norm_w, lower_bound, hgrn_norm_w, w_out):
    bsz, t, _ = x.shape
    u = x @ w_in
    q_a, k_a, v_a, o_a, gates_a, q_b, f_fw, f_bw, i_b, g_b = jnp.split(u, [int(c) for c in np.cumsum(REC_SPLITS)[:-1]], axis=-1)

    qa = to_heads(q_a, MLSTM_HEADS) * (MLSTM_DK ** -0.5)
    ka = to_heads(k_a, MLSTM_HEADS)
    va = to_heads(v_a, MLSTM_HEADS)
    gates = gates_a.astype(jnp.float32).reshape(bsz, t, 4, MLSTM_HEADS) + gate_bias.astype(jnp.float32)
    gates = (GATE_CAP * jnp.tanh(gates / GATE_CAP)).transpose(2, 0, 3, 1)
    h_fw = mlstm_chunkwise(qa, ka, va, gates[0], jax.nn.log_sigmoid(gates[1]))
    h_bw = flip_t(mlstm_chunkwise(flip_t(qa), flip_t(ka), flip_t(va), flip_t(gates[2]), flip_t(jax.nn.log_sigmoid(gates[3]))))
    h_a = from_heads(head_rms_norm(h_fw + h_bw, mlstm_norm_w))
    y_a = h_a * jax.nn.sigmoid(o_a.astype(jnp.float32))

    qb = jax.nn.silu(to_heads(q_b, HGRN_HEADS))
    vb = to_heads(i_b, HGRN_HEADS)
    lb = lower_bound.astype(jnp.float32).reshape(2, HGRN_HEADS, 1, HGRN_DK)
    f_f = lb[0] + (1.0 - lb[0]) * jax.nn.sigmoid(to_heads(f_fw, HGRN_HEADS))
    f_b = lb[1] + (1.0 - lb[1]) * jax.nn.sigmoid(to_heads(f_bw, HGRN_HEADS))
    o_fw = hgrn2_chunkwise(qb, 1.0 - f_f, vb, jnp.log(f_f))
    o_bw = flip_t(hgrn2_chunkwise(flip_t(qb), flip_t(1.0 - f_b), flip_t(vb), flip_t(jnp.log(f_b))))
    h_b = from_heads(head_rms_norm(o_fw + o_bw, hgrn_norm_w))
    y_b = h_b * jax.nn.silu(g_b.astype(jnp.float32))

    y = jnp.concatenate([y_a, y_b], axis=-1).astype(x.dtype)
    return y @ w_out


def neighborhood_attention(x, w_qkv, rpb, w_out):
    bsz, t, _ = x.shape
    rows = t // GRID_W
    kh = min(NA_KH, rows)
    qkv = (x @ w_qkv).reshape(bsz, rows, GRID_W, 3, NA_HEADS, NA_DH)
    q = qkv[:, :, :, 0].transpose(1, 0, 3, 2, 4)
    k = qkv[:, :, :, 1].transpose(0, 3, 1, 2, 4)
    v = qkv[:, :, :, 2].transpose(0, 3, 1, 2, 4)
    row_start = jnp.clip(jnp.arange(rows) - kh // 2, 0, rows - kh)
    col = jnp.arange(GRID_W)
    col_start = jnp.clip(col - NA_KW // 2, 0, GRID_W - NA_KW)
    col_mask = (col[None, :] >= col_start[:, None]) & (col[None, :] < col_start[:, None] + NA_KW)
    dc_idx = jnp.clip(col[None, :] - col[:, None] + NA_KW - 1, 0, 2 * NA_KW - 2)
    rpb_cols = rpb[:, :, dc_idx]
    scale = NA_DH ** -0.5

    def attend_row(args):
        q_r, r, rs = args
        k_r = lax.dynamic_slice_in_dim(k, rs, kh, axis=2)
        v_r = lax.dynamic_slice_in_dim(v, rs, kh, axis=2)
        dr_idx = rs + jnp.arange(kh) - r + NA_KH - 1
        bias = rpb_cols[:, dr_idx].transpose(0, 2, 1, 3).astype(jnp.float32)
        s = jnp.einsum('bhqd,bhjkd->bhqjk', q_r, k_r).astype(jnp.float32) * scale + bias[None]
        s = jnp.where(col_mask[None, None, :, None, :], s, -jnp.inf)
        pr = jax.nn.softmax(s.reshape(bsz, NA_HEADS, GRID_W, kh * GRID_W), axis=-1).reshape(s.shape).astype(v.dtype)
        return jnp.einsum('bhqjk,bhjkd->bhqd', pr, v_r)

    out = lax.map(attend_row, (q, jnp.arange(rows), row_start))
    out = out.transpose(1, 0, 3, 2, 4).reshape(bsz, t, NA_WIDTH)
    return out @ w_out


def swiglu(x, w_gate, w_up, w_down):
    return (jax.nn.silu(x @ w_gate) * (x @ w_up)) @ w_down


def moe_swiglu(x, w_router, b_router, w_gate, w_up, w_down):
    bsz, t, d = x.shape
    xt = x.reshape(-1, d)
    n = xt.shape[0]
    nk = n * TOP_K
    logits = (xt @ w_router).astype(jnp.float32) + b_router.astype(jnp.float32)
    top_logit, top_e = lax.top_k(logits, TOP_K)
    gate = jax.nn.softmax(top_logit, axis=-1)
    e_flat = top_e.reshape(-1).astype(jnp.int32)
    slot = jnp.arange(nk, dtype=jnp.int32)
    order = jnp.argsort(e_flat * nk + slot)
    e_sorted = e_flat[order]
    tok_sorted = order // TOP_K
    g_sorted = gate.reshape(-1)[order]
    counts = jnp.bincount(e_flat, length=N_EXPERTS)
    padded = (counts + MOE_BLOCK - 1) // MOE_BLOCK * MOE_BLOCK
    pad_end = jnp.cumsum(padded)
    pad_start = pad_end - padded
    start = jnp.cumsum(counts) - counts
    dest = pad_start[e_sorted] + slot - start[e_sorted]
    n_blocks = -(-(nk + N_EXPERTS * (MOE_BLOCK - 1)) // MOE_BLOCK)
    xs = jnp.zeros((n_blocks * MOE_BLOCK, d), x.dtype).at[dest].set(xt[tok_sorted])
    block_e = jnp.minimum(jnp.searchsorted(pad_end, jnp.arange(n_blocks) * MOE_BLOCK, side='right'), N_EXPERTS - 1)

    def run_block(args):
        xb, e = args
        return swiglu(xb, w_gate[e], w_up[e], w_down[e])

    ys = lax.map(run_block, (xs.reshape(n_blocks, MOE_BLOCK, d), block_e)).reshape(-1, d)
    out = jnp.zeros_like(xt).at[tok_sorted].add(ys[dest] * g_sorted[:, None].astype(x.dtype))
    return out.reshape(bsz, t, d)


def setup_inputs(seed: int = 0) -> dict:
    key = jax.random.key(seed)
    ks = jax.random.split(key, 24)
    f32 = jnp.float32

    def nrm(k, shape, scale):
        return jax.random.normal(k, shape, f32) * scale

    gate_offset = jnp.stack([jnp.full((MLSTM_HEADS,), -1.0, f32), jnp.linspace(3.0, 6.0, MLSTM_HEADS, dtype=f32), jnp.full((MLSTM_HEADS,), -1.0, f32), jnp.linspace(3.0, 6.0, MLSTM_HEADS, dtype=f32)])
    return {
        'x': nrm(ks[0], (BATCH, SEQ, D_MODEL), 1.0),
        'p': nrm(ks[1], (DEPTH, BATCH, SEQ, PLE_DIM), 1.0),
        'ln_w': 1.0 + nrm(ks[2], (DEPTH, 2, D_MODEL), 0.02),
        'ln_b': nrm(ks[3], (DEPTH, 2, D_MODEL), 0.02),
        'rec_w_in': nrm(ks[4], (N_EVEN, D_MODEL, REC_IN), D_MODEL ** -0.5),
        'mlstm_gate_bias': gate_offset[None] + nrm(ks[5], (N_EVEN, 4, MLSTM_HEADS), 0.1),
        'mlstm_norm_w': 1.0 + nrm(ks[6], (N_EVEN, A_WIDTH), 0.02),
        'hgrn_lb_logits': nrm(ks[7], (2, N_EVEN + 1, HGRN_HEADS * HGRN_DK), 0.1),
        'hgrn_norm_w': 1.0 + nrm(ks[8], (N_EVEN, B_WIDTH), 0.02),
        'rec_w_out': nrm(ks[9], (N_EVEN, A_WIDTH + B_WIDTH, D_MODEL), BETA * (A_WIDTH + B_WIDTH) ** -0.5),
        'ffn_w_gate': nrm(ks[10], (N_EVEN, D_MODEL, FFN_DIM), D_MODEL ** -0.5),
        'ffn_w_up': nrm(ks[11], (N_EVEN, D_MODEL, FFN_DIM), D_MODEL ** -0.5),
        'ffn_w_down': nrm(ks[12], (N_EVEN, FFN_DIM, D_MODEL), BETA * FFN_DIM ** -0.5),
        'na_w_qkv': nrm(ks[13], (N_ODD, D_MODEL, 3 * NA_WIDTH), D_MODEL ** -0.5),
        'na_rpb': nrm(ks[14], (N_ODD, NA_HEADS, 2 * NA_KH - 1, 2 * NA_KW - 1), 0.1),
        'na_w_out': nrm(ks[15], (N_ODD, NA_WIDTH, D_MODEL), BETA * NA_WIDTH ** -0.5),
        'moe_w_router': nrm(ks[16], (N_ODD, D_MODEL, N_EXPERTS), D_MODEL ** -0.5),
        'moe_b_router': nrm(ks[17], (N_ODD, N_EXPERTS), 0.01),
        'moe_w_gate': nrm(ks[18], (N_ODD, N_EXPERTS, D_MODEL, MOE_DIM), D_MODEL ** -0.5),
        'moe_w_up': nrm(ks[19], (N_ODD, N_EXPERTS, D_MODEL, MOE_DIM), D_MODEL ** -0.5),
        'moe_w_down': nrm(ks[20], (N_ODD, N_EXPERTS, MOE_DIM, D_MODEL), BETA * MOE_DIM ** -0.5),
        'ple_w_gate': nrm(ks[21], (DEPTH, D_MODEL, D_MODEL), D_MODEL ** -0.5),
        'ple_w_proj': nrm(ks[22], (DEPTH, PLE_DIM, D_MODEL), PLE_DIM ** -0.5),
    }


def reference(x, p, ln_w, ln_b, rec_w_in, mlstm_gate_bias, mlstm_norm_w, hgrn_lb_logits, hgrn_norm_w, rec_w_out, ffn_w_gate, ffn_w_up, ffn_w_down, na_w_qkv, na_rpb, na_w_out, moe_w_router, moe_b_router, moe_w_gate, moe_w_up, moe_w_down, ple_w_gate, ple_w_proj):
    lower_bounds = jnp.cumsum(jax.nn.softmax(hgrn_lb_logits.astype(jnp.float32), axis=1), axis=1)
    for i in range(DEPTH):
        j = i // 2
        if i % 2 == 0:
            mix = recurrent_mixer(x, rec_w_in[j], mlstm_gate_bias[j], mlstm_norm_w[j], lower_bounds[:, j], hgrn_norm_w[j], rec_w_out[j])
        else:
            mix = neighborhood_attention(x, na_w_qkv[j], na_rpb[j], na_w_out[j])
        x = layer_norm(ALPHA * x + mix, ln_w[i, 0], ln_b[i, 0])
        if i % 2 == 0:
            ffn = swiglu(x, ffn_w_gate[j], ffn_w_up[j], ffn_w_down[j])
        else:
            ffn = moe_swiglu(x, moe_w_router[j], moe_b_router[j], moe_w_gate[j], moe_w_up[j], moe_w_down[j])
        x = layer_norm(ALPHA * x + ffn, ln_w[i, 1], ln_b[i, 1])
        x = x + jax.nn.sigmoid(x @ ple_w_gate[i]) * (p[i] @ ple_w_proj[i])
    return x
```

```cpp
#include <hip/hip_runtime.h>
#include <cstdio>
#include <cstdint>
__device__ __forceinline__ int lane_now() { int l; asm volatile("v_mbcnt_lo_u32_b32 %0, -1, 0\n\tv_mbcnt_hi_u32_b32 %0, -1, %0" : "=v"(l)); return l; }
namespace pg8 {
#define PG8_LAS __attribute__((address_space(3)))
typedef unsigned short bf16_t;
typedef short bf16x8 __attribute__((ext_vector_type(8)));
typedef float f32x4 __attribute__((ext_vector_type(4)));
typedef unsigned u32x4 __attribute__((ext_vector_type(4)));
constexpr int BM = 256, BK = 64, HALF = 128, HTB = HALF * BK * 2  , STAGE_BYTES = 8 * HTB, NXCD = 8, WGM = 8;

__host__ __device__ __forceinline__ int lds_byte(int r, int c) { const int st = (r >> 4) * 2 + (c >> 5), rr = r & 15, cc = c & 31, ob = rr * 64 + cc * 2; return st * 1024 + (ob ^ (((ob >> 9) & 1) << 5)); }
__host__ __device__ __forceinline__ void stage_rc(int b, int& R, int& C) { const int st = b / 1024, sb = b % 1024, swz = sb ^ (((sb >> 9) & 1) << 5); R = (st >> 1) * 16 + swz / 64; C = (st & 1) * 32 + (swz % 64) / 2; }
__host__ __device__ __forceinline__ int perm32(int rho) { const int n = rho >> 4, i = rho & 15; return 8 * (i >> 2) + 4 * n + (i & 3); }

struct Unit { int pm, pn; };
struct Gemm { const bf16_t* A; const bf16_t* Bt; int M, N, K; };

struct StaticOrder {
    int nM, nN, nwg, G, c;
    __host__ __device__ void init(int M, int N, int G_, int c_) { nM = M / BM; nN = N / BM; nwg = nM * nN; G = G_; c = c_; }
    __host__ __device__ bool next(int i, Unit& u) const {
        const long L = (long)i * G + c; if (L >= nwg) return false;
        int wgid = (int)L; { const int q = nwg / NXCD, r = nwg % NXCD, xcd = wgid % NXCD, off = wgid / NXCD; wgid = (xcd < r ? xcd * (q + 1) : r * (q + 1) + (xcd - r) * q) + off; }
        const int nig = WGM * nN, gid = wgid / nig, fm = gid * WGM, gsz = (nM - fm) < WGM ? (nM - fm) : WGM;
        u.pm = fm + ((wgid % nig) % gsz); u.pn = (wgid % nig) / gsz; return true;
    }
    __device__ __forceinline__ void a_ready(const Unit&) const {}
    __device__ __forceinline__ void done(const Unit&) const {}
};

__device__ __forceinline__ unsigned cvt_pk_bf16(float lo, float hi) { unsigned r; asm volatile("v_cvt_pk_bf16_f32 %0, %1, %2" : "=v"(r) : "v"(lo), "v"(hi)); return r; }
__device__ __forceinline__ float fsigmoid(float x) { return __builtin_amdgcn_rcpf(1.0f + __expf(-x)); }
__device__ __forceinline__ float fsilu(float x) { return x * fsigmoid(x); }


struct EpiBf16G {
    static constexpr bool PERM = true, AFTER_DRAIN = false;
    bf16_t* O; int ldc; int gate_pn; float* Gt;
    __device__ __forceinline__ void operator()(const f32x4 (&acc)[2][2][4][2], const Unit& u, int wr, int wc, int fr, int fq) const {
        const int row0 = u.pm * BM + wr * 64 + fr;
        if (u.pn == gate_pn) {
            if (wc == 0 && fq < 2) {
#pragma unroll
                for (int ai = 0; ai < 2; ++ai)
#pragma unroll
                    for (int m = 0; m < 4; ++m) { float* gp = Gt + (size_t)(row0 + ai * HALF + m * 16) * 16 + 8 * fq;
                        *(f32x4*)(gp) = acc[ai][0][m][0]; *(f32x4*)(gp + 4) = acc[ai][0][m][1]; }
            }
            return;
        }
        const int col0 = u.pn * BM + wc * 32 + 8 * fq;
#pragma unroll
        for (int ai = 0; ai < 2; ++ai)
#pragma unroll
            for (int m = 0; m < 4; ++m) { bf16_t* rowp = O + (size_t)(row0 + ai * HALF + m * 16) * ldc + col0;
#pragma unroll
                for (int bj = 0; bj < 2; ++bj) { const f32x4 v0 = acc[ai][bj][m][0], v1 = acc[ai][bj][m][1];
                    u32x4 w; w.x = cvt_pk_bf16(v0[0], v0[1]); w.y = cvt_pk_bf16(v0[2], v0[3]); w.z = cvt_pk_bf16(v1[0], v1[1]); w.w = cvt_pk_bf16(v1[2], v1[3]);
                    *(u32x4*)(rowp + bj * HALF) = w; } }
    }
};
struct EpiSwiglu {
    static constexpr bool PERM = true, AFTER_DRAIN = false;
    bf16_t* H; int ldh; int npn;
    __device__ __forceinline__ void operator()(const f32x4 (&acc)[2][2][4][2], const Unit& u, int wr, int wc, int fr, int fq) const {
        const int row0 = u.pm * BM + wr * 64 + fr; const int pl = u.pn % npn; const int col0 = pl * HALF + wc * 32 + 8 * fq;
#pragma unroll
        for (int ai = 0; ai < 2; ++ai)
#pragma unroll
            for (int m = 0; m < 4; ++m) { bf16_t* rowp = H + (size_t)(row0 + ai * HALF + m * 16) * ldh + col0;
                const f32x4 g0 = acc[ai][0][m][0], g1 = acc[ai][0][m][1], u0 = acc[ai][1][m][0], u1 = acc[ai][1][m][1];
                float o[8];
#pragma unroll
                for (int i = 0; i < 4; ++i) { o[i] = fsilu(g0[i]) * u0[i]; o[4 + i] = fsilu(g1[i]) * u1[i]; }
                u32x4 w; w.x = cvt_pk_bf16(o[0], o[1]); w.y = cvt_pk_bf16(o[2], o[3]); w.z = cvt_pk_bf16(o[4], o[5]); w.w = cvt_pk_bf16(o[6], o[7]);
                *(u32x4*)rowp = w; }
    }
};
struct EpiResF32 {
    static constexpr bool PERM = true, AFTER_DRAIN = false;
    const float* SRC; float* DST; int ldc; float alpha;
    __device__ __forceinline__ void operator()(const f32x4 (&acc)[2][2][4][2], const Unit& u, int wr, int wc, int fr, int fq) const {
        const int row0 = u.pm * BM + wr * 64 + fr; const int col0 = u.pn * BM + wc * 32 + 8 * fq;
#pragma unroll
        for (int ai = 0; ai < 2; ++ai)
#pragma unroll
            for (int m = 0; m < 4; ++m) { const size_t ro = (size_t)(row0 + ai * HALF + m * 16) * ldc + col0;
#pragma unroll
                for (int bj = 0; bj < 2; ++bj)
#pragma unroll
                    for (int n = 0; n < 2; ++n) { const size_t o = ro + bj * HALF + 4 * n; const f32x4 s = *(const f32x4*)(SRC + o); *(f32x4*)(DST + o) = s * alpha + acc[ai][bj][m][n]; } }
    }
};
struct EpiStoreF32 {
    static constexpr bool PERM = true, AFTER_DRAIN = false;
    float* O; int ldc; int npn;
    __device__ __forceinline__ void operator()(const f32x4 (&acc)[2][2][4][2], const Unit& u, int wr, int wc, int fr, int fq) const {
        const int row0 = u.pm * BM + wr * 64 + fr; const int col0 = (u.pn % npn) * BM + wc * 32 + 8 * fq;
#pragma unroll
        for (int ai = 0; ai < 2; ++ai)
#pragma unroll
            for (int m = 0; m < 4; ++m) { float* ro = O + (size_t)(row0 + ai * HALF + m * 16) * ldc + col0;
#pragma unroll
                for (int bj = 0; bj < 2; ++bj)
#pragma unroll
                    for (int n = 0; n < 2; ++n) *(f32x4*)(ro + bj * HALF + 4 * n) = acc[ai][bj][m][n]; }
    }
};
struct EpiPle {
    static constexpr bool PERM = true, AFTER_DRAIN = false;
    float* XF; const float* PP; bf16_t* XB; int ldc;
    __device__ __forceinline__ void operator()(const f32x4 (&acc)[2][2][4][2], const Unit& u, int wr, int wc, int fr, int fq) const {
        const int row0 = u.pm * BM + wr * 64 + fr; const int col0 = u.pn * BM + wc * 32 + 8 * fq;
#pragma unroll
        for (int ai = 0; ai < 2; ++ai)
#pragma unroll
            for (int m = 0; m < 4; ++m) { const size_t ro = (size_t)(row0 + ai * HALF + m * 16) * ldc + col0;
#pragma unroll
                for (int bj = 0; bj < 2; ++bj) { f32x4 o[2];
#pragma unroll
                    for (int n = 0; n < 2; ++n) { const size_t of = ro + bj * HALF + 4 * n; const f32x4 x = *(const f32x4*)(XF + of), pp = *(const f32x4*)(PP + of); const f32x4 a = acc[ai][bj][m][n];
                        f32x4 r; r[0] = x[0] + fsigmoid(a[0]) * pp[0]; r[1] = x[1] + fsigmoid(a[1]) * pp[1]; r[2] = x[2] + fsigmoid(a[2]) * pp[2]; r[3] = x[3] + fsigmoid(a[3]) * pp[3];
                        *(f32x4*)(XF + of) = r; o[n] = r; }
                    u32x4 w; w.x = cvt_pk_bf16(o[0][0], o[0][1]); w.y = cvt_pk_bf16(o[0][2], o[0][3]); w.z = cvt_pk_bf16(o[1][0], o[1][1]); w.w = cvt_pk_bf16(o[1][2], o[1][3]);
                    if (XB) *(u32x4*)(XB + ro + bj * HALF) = w; } }
    }
};
struct MoeOrder {
    StaticOrder base; const int* tile_e; int nN;
    __device__ __forceinline__ bool next(int i, Unit& u) const { if (!base.next(i, u)) return false; u.pn += tile_e[u.pm] * nN; return true; }
    __device__ __forceinline__ void a_ready(const Unit&) const {}
    __device__ __forceinline__ void done(const Unit&) const {}
};

template <class Epi, class Sched, bool ALIGN_EPI = false, bool SP2 = false>
__device__ __forceinline__ void gemm_phase(PG8_LAS unsigned char* lds, const Gemm g, const Sched& S, const Epi& E, int wave_s) {
    const int lane = lane_now(), wid = wave_s, tid = wave_s * 64 + lane, wr = wid >> 2, wc = wid & 3, fr = lane & 15, fq = lane >> 4;
    const int K = g.K, nt = K / BK;
    unsigned voffA[2], voffB[2];
#pragma unroll
    for (int i = 0; i < 2; ++i) { int R, C; stage_rc(tid * 16 + i * 8192, R, C); const int Rb = Epi::PERM ? ((R & ~31) + perm32(R & 31)) : R;
        voffA[i] = (unsigned)(R * K + C) * 2u; voffB[i] = (unsigned)(Rb * K + C) * 2u; }
    const size_t kstep = (size_t)(BK * 2);
    const size_t hstep = (size_t)HALF * K * 2;
    const size_t tstep = 2 * hstep;
    const unsigned ldsw = (unsigned)wid * 1024u;
    const int aoff = lds_byte(wr * 64 + fr, fq * 8), boff = lds_byte(wc * 32 + fr, fq * 8);
#define PG8_SA(b, h) (((b) * 2 + (h)) * HTB)
#define PG8_SB(b, h) ((4 + (b) * 2 + (h)) * HTB)
#define PG8_STAGE(bufoff, gbase, voff) do { _Pragma("unroll") for (int _i = 0; _i < 2; ++_i) \
        __builtin_amdgcn_global_load_lds((const unsigned*)((const char*)(gbase) + (voff)[_i]), (PG8_LAS unsigned*)(lds + (bufoff) + ldsw + _i * 8192), 16, 0, 0); } while (0)
#define PG8_LDA(dst, b, h) do { _Pragma("unroll") for (int m = 0; m < 4; ++m) _Pragma("unroll") for (int k = 0; k < 2; ++k) dst[m][k] = *(const PG8_LAS bf16x8*)(lds + PG8_SA(b, h) + aoff + m * 2048 + k * 1024); } while (0)
#define PG8_LDB(dst, b, h) do { _Pragma("unroll") for (int n = 0; n < 2; ++n) _Pragma("unroll") for (int k = 0; k < 2; ++k) dst[n][k] = *(const PG8_LAS bf16x8*)(lds + PG8_SB(b, h) + boff + n * 2048 + k * 1024); } while (0)
#define PG8_MMA(ai, bj, At, Bt) do { __builtin_amdgcn_s_setprio(1); _Pragma("unroll") for (int m = 0; m < 4; ++m) _Pragma("unroll") for (int n = 0; n < 2; ++n) _Pragma("unroll") for (int k = 0; k < 2; ++k) \
        acc[ai][bj][m][n] = __builtin_amdgcn_mfma_f32_16x16x32_bf16(Bt[n][k], At[m][k], acc[ai][bj][m][n], 0, 0, 0); __builtin_amdgcn_s_setprio(0); } while (0)
#define PG8_WAIT_V(n) asm volatile("s_waitcnt vmcnt(" #n ")" ::: "memory")
#define PG8_WAIT_L(n) asm volatile("s_waitcnt lgkmcnt(" #n ")" ::: "memory")
#define PG8_BAR __builtin_amdgcn_s_barrier()
#define PG8_SCHED __builtin_amdgcn_sched_barrier(0)
    Unit cur, nxt; int ui = 0;
    if (!S.next(0, cur)) return;
    f32x4 acc[2][2][4][2];
#pragma unroll
    for (int a = 0; a < 2; ++a)
#pragma unroll
        for (int b = 0; b < 2; ++b)
#pragma unroll
            for (int m = 0; m < 4; ++m)
#pragma unroll
                for (int n = 0; n < 2; ++n) acc[a][b][m][n] = (f32x4){0.f, 0.f, 0.f, 0.f};
    bf16x8 At[4][2], B0[2][2], B1[2][2];
    const char* cA = (const char*)g.A + (size_t)cur.pm * tstep; const char* cB = (const char*)g.Bt + (size_t)cur.pn * tstep;
    S.a_ready(cur);
    if constexpr (SP2) {
        PG8_STAGE(PG8_SB(0, 0), cB, voffB); PG8_STAGE(PG8_SB(0, 1), cB + hstep, voffB); PG8_STAGE(PG8_SA(0, 0), cA, voffA); PG8_STAGE(PG8_SA(0, 1), cA + hstep, voffA);
        if (wr == 1) PG8_BAR;
        PG8_WAIT_V(2); PG8_BAR;
        PG8_STAGE(PG8_SB(1, 0), cB + kstep, voffB); PG8_STAGE(PG8_SA(1, 0), cA + kstep, voffA); PG8_STAGE(PG8_SB(1, 1), cB + hstep + kstep, voffB);
        PG8_WAIT_V(6); PG8_BAR;
    } else {
        PG8_STAGE(PG8_SB(0, 0), cB, voffB); PG8_STAGE(PG8_SA(0, 0), cA, voffA); PG8_STAGE(PG8_SB(0, 1), cB + hstep, voffB); PG8_STAGE(PG8_SA(0, 1), cA + hstep, voffA);
        if (wr == 1) PG8_BAR;
        PG8_WAIT_V(4); PG8_BAR;
        PG8_STAGE(PG8_SB(1, 0), cB + kstep, voffB); PG8_STAGE(PG8_SA(1, 0), cA + kstep, voffA); PG8_STAGE(PG8_SB(1, 1), cB + hstep + kstep, voffB);
        PG8_WAIT_V(6); PG8_BAR;
    }
    for (;;) {
        const bool has_next = S.next(ui + 1, nxt);
        const char* nA = has_next ? (const char*)g.A + (size_t)nxt.pm * tstep : cA; const char* nB = has_next ? (const char*)g.Bt + (size_t)nxt.pn * tstep : cB;
        for (int t = 0; t < nt; t += 2) {
            const bool last = (t == nt - 2);
            const char* a1 = cA + (size_t)(t + 1) * kstep;
            const char* a2 = last ? nA : cA + (size_t)(t + 2) * kstep; const char* b2 = last ? nB : cB + (size_t)(t + 2) * kstep;
            const char* a3 = a2 + kstep; const char* b3 = b2 + kstep;
            if (last && has_next) S.a_ready(nxt);
            if constexpr (SP2) {
            PG8_LDB(B0, 0, 0); PG8_LDB(B1, 0, 1); PG8_SCHED; PG8_LDA(At, 0, 0); PG8_STAGE(PG8_SA(1, 1), a1 + hstep, voffA);
            PG8_WAIT_V(8); PG8_WAIT_L(0); PG8_BAR; PG8_MMA(0, 0, At, B0); PG8_MMA(0, 1, At, B1); PG8_BAR; PG8_SCHED;
            PG8_LDA(At, 0, 1); PG8_STAGE(PG8_SB(0, 0), b2, voffB); PG8_STAGE(PG8_SB(0, 1), b2 + hstep, voffB); PG8_STAGE(PG8_SA(0, 0), a2, voffA);
            PG8_WAIT_V(8); PG8_WAIT_L(0); PG8_BAR; PG8_MMA(1, 0, At, B0); PG8_MMA(1, 1, At, B1); PG8_BAR; PG8_SCHED;
            PG8_LDB(B0, 1, 0); PG8_LDB(B1, 1, 1); PG8_SCHED; PG8_LDA(At, 1, 0); PG8_STAGE(PG8_SA(0, 1), a2 + hstep, voffA);
            PG8_WAIT_V(8); PG8_WAIT_L(0); PG8_BAR; PG8_MMA(0, 0, At, B0); PG8_MMA(0, 1, At, B1); PG8_BAR; PG8_SCHED;
            PG8_LDA(At, 1, 1); PG8_STAGE(PG8_SB(1, 0), b3, voffB); PG8_STAGE(PG8_SB(1, 1), b3 + hstep, voffB); PG8_STAGE(PG8_SA(1, 0), a3, voffA);
            PG8_WAIT_V(8); PG8_WAIT_L(0); PG8_BAR; PG8_MMA(1, 0, At, B0); PG8_MMA(1, 1, At, B1); PG8_BAR; PG8_SCHED;
            } else {
            PG8_LDB(B0, 0, 0); PG8_SCHED; PG8_LDA(At, 0, 0); PG8_STAGE(PG8_SA(1, 1), a1 + hstep, voffA);
            PG8_WAIT_L(8); PG8_BAR; PG8_WAIT_L(0); PG8_MMA(0, 0, At, B0); PG8_BAR; PG8_SCHED;
            PG8_LDB(B1, 0, 1); PG8_STAGE(PG8_SB(0, 0), b2, voffB);
            PG8_BAR; PG8_WAIT_L(0); PG8_MMA(0, 1, At, B1); PG8_BAR;
            PG8_LDA(At, 0, 1); PG8_STAGE(PG8_SA(0, 0), a2, voffA);
            PG8_BAR; PG8_WAIT_L(0); PG8_MMA(1, 0, At, B0); PG8_BAR; PG8_SCHED;
            PG8_STAGE(PG8_SB(0, 1), b2 + hstep, voffB);
            PG8_WAIT_V(6); PG8_BAR; PG8_MMA(1, 1, At, B1); PG8_BAR;
            PG8_LDB(B0, 1, 0); PG8_SCHED; PG8_LDA(At, 1, 0); PG8_STAGE(PG8_SA(0, 1), a2 + hstep, voffA);
            PG8_WAIT_L(8); PG8_BAR; PG8_WAIT_L(0); PG8_MMA(0, 0, At, B0); PG8_BAR; PG8_SCHED;
            PG8_LDB(B1, 1, 1); PG8_STAGE(PG8_SB(1, 0), b3, voffB);
            PG8_BAR; PG8_WAIT_L(0); PG8_MMA(0, 1, At, B1); PG8_BAR;
            PG8_LDA(At, 1, 1); PG8_STAGE(PG8_SA(1, 0), a3, voffA);
            PG8_BAR; PG8_WAIT_L(0); PG8_MMA(1, 0, At, B0); PG8_BAR; PG8_SCHED;
            PG8_STAGE(PG8_SB(1, 1), b3 + hstep, voffB);
            PG8_WAIT_V(6); PG8_BAR; PG8_MMA(1, 1, At, B1); PG8_BAR;
            }
        }
        if constexpr (ALIGN_EPI) { if (wr == 0) PG8_BAR; }
        if constexpr (!Epi::AFTER_DRAIN) { E(acc, cur, wr, wc, fr, fq); S.done(cur); }
        if (!has_next) break;
#pragma unroll
        for (int a = 0; a < 2; ++a)
#pragma unroll
            for (int b = 0; b < 2; ++b)
#pragma unroll
                for (int m = 0; m < 4; ++m)
#pragma unroll
                    for (int n = 0; n < 2; ++n) acc[a][b][m][n] = (f32x4){0.f, 0.f, 0.f, 0.f};
        cur = nxt; cA = nA; cB = nB; ++ui;
        if constexpr (ALIGN_EPI) { if (wr == 1) PG8_BAR; }
    }
    PG8_WAIT_V(0);
    if constexpr (!ALIGN_EPI) { if (wr == 0) PG8_BAR; }
    PG8_BAR;
    if constexpr (Epi::AFTER_DRAIN) { E.fused(acc, cur, wr, wc, fr, fq, lds, wid, lane); S.done(cur); }
#undef PG8_SA
#undef PG8_SB
#undef PG8_STAGE
#undef PG8_LDA
#undef PG8_LDB
#undef PG8_MMA
#undef PG8_WAIT_V
#undef PG8_WAIT_L
#undef PG8_BAR
#undef PG8_SCHED
}
}
constexpr int NWAVES = 8;
constexpr int BATCH = 4, T = 4096, D = 2048, M = BATCH * T;
constexpr int PLE_DIM = 256, FFN = 5632, MOE = 7168, NE = 8;
constexpr int REC_IN = 8208, UW = 8192, NREC = 8448;
constexpr int U_QA = 0, U_KA = 512, U_VA = 1024, U_OA = 2048, U_QB = 3072, U_FF = 4096, U_FB = 5120, U_IB = 6144, U_GB = 7168;
constexpr int NQKV = 6144;
constexpr int XS_ROWS = 34816;
constexpr float LN_EPS = 1e-5f, RMS_EPS = 1e-6f, ALPHA = 1.41421356237f, GATE_CAP = 15.0f;

constexpr size_t MiB = 1u << 20;
constexpr size_t WS_CTL = 0, CTL_ZERO_BYTES = 1 * MiB;
constexpr size_t WS_TOKE = 1 * MiB, WS_TOKG = WS_TOKE + 256 * 1024, WS_DEST = WS_TOKG + 256 * 1024, WS_WGCNT = WS_DEST + 256 * 1024, WS_TILEE = WS_WGCNT + 64 * 1024;
constexpr size_t WS_WQKV = 4 * MiB, WS_WNAO = 28 * MiB, WS_WPG1 = 36 * MiB, WS_WPP1 = 44 * MiB, WS_WMGU = 48 * MiB, WS_WMDN = 496 * MiB;
constexpr size_t WS_XB0 = 720 * MiB, WS_XB1 = 784 * MiB, WS_PB = 848 * MiB, WS_G = 864 * MiB;
constexpr size_t WS_WRIN = 872 * MiB, WS_WROUT = 905 * MiB, WS_WFGU = 913 * MiB, WS_WFDN = 957 * MiB, WS_WPG0 = 979 * MiB, WS_WPP0 = 987 * MiB;
constexpr size_t WS_U = 992 * MiB, WS_HA = 1248 * MiB, WS_HB = 1376 * MiB, WS_Y = 1504 * MiB;
constexpr size_t WS_H = 992 * MiB;
constexpr size_t WS_PP = 1248 * MiB;
constexpr size_t WS_QKV = 992 * MiB;
constexpr size_t WS_AO = WS_Y;
constexpr size_t WS_HM = 872 * MiB;
constexpr size_t WS_YS = 1348 * MiB;
constexpr size_t WS_XS = 1348 * MiB;
constexpr size_t WS_PP1 = 872 * MiB;
constexpr size_t WS_END = 1620 * MiB;
static_assert(WS_WMGU + (size_t)NE * 2 * MOE * D * 2 <= WS_WMDN && WS_WMDN + (size_t)NE * D * MOE * 2 <= WS_XB0, "ws map 1");
static_assert(WS_WRIN + (size_t)NREC * D * 2 <= WS_WROUT && WS_WFGU + (size_t)2 * FFN * D * 2 <= WS_WFDN && WS_WFDN + (size_t)D * FFN * 2 <= WS_WPG0 && WS_WPP0 + (size_t)D * PLE_DIM * 2 <= WS_U, "ws map 2");
static_assert(WS_U + (size_t)M * UW * 2 <= WS_HA && WS_H + (size_t)M * FFN * 2 <= WS_HA && WS_QKV + (size_t)M * NQKV * 2 <= WS_HA, "ws map 3");
static_assert(WS_HM + (size_t)XS_ROWS * MOE * 2 <= WS_YS && WS_YS + (size_t)XS_ROWS * D * 4 <= WS_END && WS_XS + (size_t)XS_ROWS * D * 2 <= WS_Y, "ws map 4");
constexpr int CW_BAR = 4096;

constexpr int RING_OFF = 0, RING_BYTES = 131072;
constexpr int LDSCTL_OFF = RING_BYTES, MISC_OFF = LDSCTL_OFF + 320;
constexpr int LDS_BYTES = 147456;
static_assert(MISC_OFF + 128 <= LDS_BYTES, "LDS map");

#define GAS __attribute__((address_space(1)))
#define LAS __attribute__((address_space(3)))
typedef unsigned short bf16;
typedef unsigned v4u __attribute__((ext_vector_type(4)));
typedef unsigned v2u __attribute__((ext_vector_type(2)));
typedef float f32x4 __attribute__((ext_vector_type(4)));
typedef float f32x2 __attribute__((ext_vector_type(2)));
typedef GAS unsigned gu32;
#define RLX_AGENT __ATOMIC_RELAXED, __HIP_MEMORY_SCOPE_AGENT
#define LDS_WAIT() asm volatile("s_waitcnt lgkmcnt(0)" ::: "memory")
#define VM_WAIT() asm volatile("s_waitcnt vmcnt(0)" ::: "memory")
__device__ __forceinline__ unsigned f2bf(float f) { unsigned u = __builtin_bit_cast(unsigned, f); return (u + 0x7fffu + ((u >> 16) & 1u)) >> 16; }
__device__ __forceinline__ unsigned pk2(float lo, float hi) { return f2bf(lo) | (f2bf(hi) << 16); }
__device__ __forceinline__ float bflo(unsigned w) { return __builtin_bit_cast(float, w << 16); }
__device__ __forceinline__ float bfhi(unsigned w) { return __builtin_bit_cast(float, w & 0xffff0000u); }
__device__ __forceinline__ float bf1(bf16 h) { return __builtin_bit_cast(float, (unsigned)h << 16); }
__device__ __forceinline__ float sigm(float x) { return 1.0f / (1.0f + __expf(-x)); }
#define XB_TMO      128
#define XB_XCNT(j)  (256  + 64 * (j))
#define XB_XSUB(j)  (1280 + 64 * (j))
#define XB_XGEN(j)  (2304 + 64 * (j))
#define XB_TOP      3328
#define XB_TOPGEN   3392
#define XCD_BAR_WORDS 3456
#define XB_SPIN_CAP (1u << 18)

__device__ __forceinline__ unsigned xb_ld(unsigned* p)              { return __hip_atomic_load(p, __ATOMIC_RELAXED, __HIP_MEMORY_SCOPE_AGENT); }
__device__ __forceinline__ unsigned xb_add(unsigned* p, unsigned v) { return __hip_atomic_fetch_add(p, v, __ATOMIC_RELAXED, __HIP_MEMORY_SCOPE_AGENT); }
__device__ __forceinline__ unsigned xb_xcc_id() { return (unsigned)__builtin_amdgcn_s_getreg((3 << 11) | 20) & 0xFu; }
#define XB_SPIN(cond, bar) do { unsigned _sp = 0; while (cond) { __builtin_amdgcn_s_sleep(1); \
    if ((++_sp & 255u) == 0u) { if (xb_ld(&(bar)[XB_TMO])) break; if (_sp > XB_SPIN_CAP) { atomicAdd(&(bar)[XB_TMO], 1u); break; } } } } while (0)

struct XcdBarrier {
    unsigned* bar; unsigned x;
    volatile LAS unsigned* st;
};

__device__ __forceinline__ XcdBarrier xcd_barrier_post(unsigned* bar, volatile LAS unsigned* st, int wave_s) {
    XcdBarrier b; b.bar = bar; b.x = xb_xcc_id(); b.st = st;
    if (wave_s == 0 && lane_now() == 0) (void)xb_add(&bar[XB_XCNT(b.x)], 1u);
    return b;
}
__device__ __forceinline__ void xcd_barrier_complete(unsigned* bar, unsigned x, unsigned& nloc, unsigned& nx) {
    const unsigned G = gridDim.x * gridDim.y * gridDim.z;
    unsigned sum, cnt, mine, sp = 0u;
    for (;;) {
        sum = 0u; cnt = 0u; mine = 0u;
#pragma unroll
        for (unsigned j = 0; j < 16; ++j) { const unsigned c = xb_ld(&bar[XB_XCNT(j)]); sum += c; cnt += (c > 0u) ? 1u : 0u; mine = (j == x) ? c : mine; }
        if (sum == G) break;
        __builtin_amdgcn_s_sleep(1);
        if ((++sp & 255u) == 0u) { if (xb_ld(&bar[XB_TMO])) break; if (sp > XB_SPIN_CAP) { atomicAdd(&bar[XB_TMO], 1u); break; } }
    }
    nloc = mine > 0u ? mine : 1u; nx = cnt > 0u ? cnt : 1u;
}

__device__ __forceinline__ void xcd_barrier(const XcdBarrier& b, int wave_s) {
    asm volatile("s_waitcnt vmcnt(0)" ::: "memory");
    __syncthreads();
    if (wave_s == 0 && lane_now() == 0) {
        unsigned* bar = b.bar;
        __builtin_amdgcn_s_waitcnt(0);
        unsigned nloc = b.st[0], nx = b.st[1];
        if (nloc == 0u) { xcd_barrier_complete(bar, b.x, nloc, nx); b.st[0] = nloc; b.st[1] = nx; }
        const unsigned old = xb_add(&bar[XB_XSUB(b.x)], 1u);
        const unsigned gen = old / nloc;
        if (old + 1u == (gen + 1u) * nloc) {
            __builtin_amdgcn_fence(__ATOMIC_RELEASE, "agent");
            asm volatile("s_waitcnt vmcnt(0)" ::: "memory");
            const unsigned og = xb_add(&bar[XB_TOP], 1u);
            const unsigned tg = og / nx;
            if (og + 1u == (tg + 1u) * nx) xb_add(&bar[XB_TOPGEN], 1u);
            else XB_SPIN(xb_ld(&bar[XB_TOPGEN]) == tg, bar);
            __builtin_amdgcn_fence(__ATOMIC_ACQUIRE, "agent");
            xb_add(&bar[XB_XGEN(b.x)], 1u);
            asm volatile("s_waitcnt vmcnt(0)" ::: "memory");
        } else {
            XB_SPIN(xb_ld(&bar[XB_XGEN(b.x)]) == gen, bar);
            __builtin_amdgcn_fence(__ATOMIC_ACQUIRE, "agent");
            asm volatile("s_waitcnt vmcnt(0)" ::: "memory");
        }
    }
    __syncthreads();
}

struct Frame {
    LAS unsigned char* lds;
    int wave, G;
};
struct Args { const float* in[23]; float* out; unsigned char* ws; int ph_lo, ph_hi; };
enum { I_X = 0, I_P, I_LNW, I_LNB, I_RECWIN, I_GBIAS, I_MNORM, I_LBLOG, I_HNORM, I_RECWOUT, I_FWG, I_FWU, I_FWD, I_NAQKV, I_RPB, I_NAOUT, I_WR, I_BR, I_MWG, I_MWU, I_MWD, I_PLEG, I_PLEP };

__device__ __forceinline__ float wave_sum(float v) {
#pragma unroll
    for (int o = 1; o < 64; o <<= 1) v += __shfl_xor(v, o);
    return v;
}
__device__ __forceinline__ float wave_max(float v) {
#pragma unroll
    for (int o = 1; o < 64; o <<= 1) v = fmaxf(v, __shfl_xor(v, o));
    return v;
}

__device__ __forceinline__ void tr_item(const float* W, int ldn, int K, int srcc, int nvalid, bf16* WT, size_t drow, int k0, LAS float* scr, int lane) {
    const int c = lane & 31;
#pragma unroll 8
    for (int i = 0; i < 32; ++i) { const int kk = 2 * i + (lane >> 5); scr[kk * 33 + c] = (c < nvalid) ? W[(size_t)(k0 + kk) * ldn + srcc + c] : 0.f; }
    LDS_WAIT(); asm volatile("" ::: "memory");
    const int c8 = lane & 7;
#pragma unroll
    for (int j = 0; j < 4; ++j) { const int n = (lane >> 3) + 8 * j; const LAS float* s = scr + (8 * c8) * 33 + n;
        v4u o; o.x = pk2(s[0 * 33], s[1 * 33]); o.y = pk2(s[2 * 33], s[3 * 33]); o.z = pk2(s[4 * 33], s[5 * 33]); o.w = pk2(s[6 * 33], s[7 * 33]);
        *(GAS v4u*)(WT + (drow + n) * (size_t)K + k0 + 8 * c8) = o; }
    LDS_WAIT(); asm volatile("" ::: "memory");
}
__device__ __forceinline__ void p0_prologue(const Frame& F, const Args& A) {
    const int lane = lane_now(), tid = F.wave * 64 + lane; (void)tid;
    LAS float* scr = (LAS float*)(F.lds + RING_OFF + F.wave * 16384);
    const int gw = blockIdx.x * NWAVES + F.wave, NGW = F.G * NWAVES;
    unsigned char* ws = A.ws;
    constexpr int N_RIN = 32 * (NREC / 32), N_ROUT = 32 * 64, N_FGU = 32 * (2 * FFN / 32), N_FDN = (FFN / 64) * 64, N_PG = 32 * 64, N_PP = 4 * 64, N_QKV = 32 * (NQKV / 32), N_NAO = 32 * 64;
    constexpr int N_MGU = 32 * (NE * 2 * MOE / 32), N_MDN = (MOE / 64) * (NE * D / 32);
    constexpr int NITEMS = N_RIN + N_ROUT + N_FGU + N_FDN + 2 * N_PG + 2 * N_PP + N_QKV + N_NAO + N_MGU + N_MDN;
    for (int it = gw; it < NITEMS; it += NGW) {
        int r = it; const float* W; bf16* WT; int ldn, K, nblk;
        int srcc, nvalid = 32; size_t drow; int kb, nb;
        if (r < N_RIN) { W = A.in[I_RECWIN]; WT = (bf16*)(ws + WS_WRIN); ldn = REC_IN; K = D; nblk = NREC / 32; kb = r / nblk; nb = r % nblk; drow = (size_t)nb * 32;
            if (nb < 96) srcc = nb * 32; else if (nb < 256) srcc = nb * 32 + 16; else { srcc = 3072; nvalid = (nb == 256) ? 16 : 0; } }
        else if ((r -= N_RIN) < N_ROUT) { W = A.in[I_RECWOUT]; WT = (bf16*)(ws + WS_WROUT); ldn = D; K = D; nblk = 64; kb = r / nblk; nb = r % nblk; drow = (size_t)nb * 32; srcc = nb * 32; }
        else if ((r -= N_ROUT) < N_FGU) { WT = (bf16*)(ws + WS_WFGU); ldn = FFN; K = D; nblk = 2 * FFN / 32; kb = r / nblk; nb = r % nblk; drow = (size_t)nb * 32;
            const int tile = nb >> 3, w = nb & 7; W = (w < 4) ? A.in[I_FWG] : A.in[I_FWU]; srcc = tile * 128 + (w & 3) * 32; }
        else if ((r -= N_FGU) < N_FDN) { W = A.in[I_FWD]; WT = (bf16*)(ws + WS_WFDN); ldn = D; K = FFN; nblk = 64; kb = r / nblk; nb = r % nblk; drow = (size_t)nb * 32; srcc = nb * 32; }
        else if ((r -= N_FDN) < 2 * N_PG) { const int l = r / N_PG; r -= l * N_PG; W = A.in[I_PLEG] + (size_t)l * D * D; WT = (bf16*)(ws + (l ? WS_WPG1 : WS_WPG0)); ldn = D; K = D; nblk = 64; kb = r / nblk; nb = r % nblk; drow = (size_t)nb * 32; srcc = nb * 32; }
        else if ((r -= 2 * N_PG) < 2 * N_PP) { const int l = r / N_PP; r -= l * N_PP; W = A.in[I_PLEP] + (size_t)l * PLE_DIM * D; WT = (bf16*)(ws + (l ? WS_WPP1 : WS_WPP0)); ldn = D; K = PLE_DIM; nblk = 64; kb = r / nblk; nb = r % nblk; drow = (size_t)nb * 32; srcc = nb * 32; }
        else if ((r -= 2 * N_PP) < N_QKV) { W = A.in[I_NAQKV]; WT = (bf16*)(ws + WS_WQKV); ldn = NQKV; K = D; nblk = NQKV / 32; kb = r / nblk; nb = r % nblk; drow = (size_t)nb * 32; srcc = nb * 32; }
        else if ((r -= N_QKV) < N_NAO) { W = A.in[I_NAOUT]; WT = (bf16*)(ws + WS_WNAO); ldn = D; K = D; nblk = 64; kb = r / nblk; nb = r % nblk; drow = (size_t)nb * 32; srcc = nb * 32; }
        else if ((r -= N_NAO) < N_MGU) { WT = (bf16*)(ws + WS_WMGU); ldn = MOE; K = D; nblk = NE * 2 * MOE / 32; kb = r / nblk; nb = r % nblk; drow = (size_t)nb * 32;
            const int e = nb / (2 * MOE / 32), nl = nb % (2 * MOE / 32), tile = nl >> 3, w = nl & 7; W = ((w < 4) ? A.in[I_MWG] : A.in[I_MWU]) + (size_t)e * D * MOE; srcc = tile * 128 + (w & 3) * 32; }
        else { r -= N_MGU; WT = (bf16*)(ws + WS_WMDN); ldn = D; K = MOE; nblk = NE * D / 32; kb = r / nblk; nb = r % nblk; drow = (size_t)nb * 32;
            const int e = nb / (D / 32), nl = nb % (D / 32); W = A.in[I_MWD] + (size_t)e * MOE * D; srcc = nl * 32; }
        tr_item(W, ldn, K, srcc, nvalid, WT, drow, kb * 64, scr, lane);
    }
    const size_t gt = (size_t)blockIdx.x * (NWAVES * 64) + tid, NGT = (size_t)F.G * NWAVES * 64;
    { const GAS f32x4* src = (const GAS f32x4*)A.in[I_X]; GAS v4u* dst = (GAS v4u*)(ws + WS_XB0);
      for (size_t i = gt; i < (size_t)M * D / 8; i += NGT) { const f32x4 a = src[2 * i], b = src[2 * i + 1]; v4u o; o.x = pk2(a[0], a[1]); o.y = pk2(a[2], a[3]); o.z = pk2(b[0], b[1]); o.w = pk2(b[2], b[3]); dst[i] = o; } }
    { const GAS f32x4* src = (const GAS f32x4*)A.in[I_P]; GAS v4u* dst = (GAS v4u*)(ws + WS_PB);
      for (size_t i = gt; i < (size_t)2 * M * PLE_DIM / 8; i += NGT) { const f32x4 a = src[2 * i], b = src[2 * i + 1]; v4u o; o.x = pk2(a[0], a[1]); o.y = pk2(a[2], a[3]); o.z = pk2(b[0], b[1]); o.w = pk2(b[2], b[3]); dst[i] = o; } }
}

constexpr int RB = 32;
#define T0_OF(blk) (dir ? (T - RB - (blk) * RB) : (blk) * RB)
__device__ __forceinline__ void mlstm_unit(const Frame& F, const Args& A, int unit) {
    const int lane = lane_now(), tid = F.wave * 64 + lane; (void)tid;
    const int cg = unit & 3, dir = (unit >> 2) & 1, h = (unit >> 3) & 3, b = unit >> 5;
    LAS float* qs = (LAS float*)(F.lds + RING_OFF);
    LAS float* ks = qs + RB * 128;
    LAS float* vs = ks + RB * 128;
    LAS float* fi = vs + RB * 64;
    LAS float* ob = fi + RB * 2;
    const bf16* U = (const bf16*)(A.ws + WS_U); const float* Gt = (const float*)(A.ws + WS_G);
    float* HA = (float*)(A.ws + WS_HA) + (size_t)dir * M * 1024;
    const int e = lane & 7, dg = lane >> 3, colw = F.wave * 8 + e;
    const int srow = tid >> 4, sc = tid & 15;
    const float bias_i = A.in[I_GBIAS][(dir ? 2 : 0) * 4 + h], bias_f = A.in[I_GBIAS][(dir ? 3 : 1) * 4 + h];
    float C[16], n[16];
#pragma unroll
    for (int j = 0; j < 16; ++j) { C[j] = 0.f; n[j] = 0.f; }
    v4u rq, rk; v2u rv; float rgi = 0.f, rgf = 0.f;
    {   const size_t row = (size_t)b * T + T0_OF(0) + srow; const bf16* ur = U + row * UW;
        rq = *(const GAS v4u*)(ur + U_QA + h * 128 + sc * 8); rk = *(const GAS v4u*)(ur + U_KA + h * 128 + sc * 8); rv = *(const GAS v2u*)(ur + U_VA + h * 256 + cg * 64 + sc * 4);
        if (tid < RB) { const size_t r2 = (size_t)b * T + T0_OF(0) + tid; rgi = Gt[r2 * 16 + (dir ? 2 : 0) * 4 + h]; rgf = Gt[r2 * 16 + (dir ? 3 : 1) * 4 + h]; } }
    for (int blk = 0; blk < T / RB; ++blk) {
        const int t0 = T0_OF(blk);
        {   const float qsc = 0.08838834764831845f;
            LAS float* qd = qs + srow * 128 + sc * 8; LAS float* kd = ks + srow * 128 + sc * 8;
            *(LAS f32x4*)qd = (f32x4){bflo(rq.x) * qsc, bfhi(rq.x) * qsc, bflo(rq.y) * qsc, bfhi(rq.y) * qsc}; *(LAS f32x4*)(qd + 4) = (f32x4){bflo(rq.z) * qsc, bfhi(rq.z) * qsc, bflo(rq.w) * qsc, bfhi(rq.w) * qsc};
            *(LAS f32x4*)kd = (f32x4){bflo(rk.x), bfhi(rk.x), bflo(rk.y), bfhi(rk.y)}; *(LAS f32x4*)(kd + 4) = (f32x4){bflo(rk.z), bfhi(rk.z), bflo(rk.w), bfhi(rk.w)};
            *(LAS f32x4*)(vs + srow * 64 + sc * 4) = (f32x4){bflo(rv.x), bfhi(rv.x), bflo(rv.y), bfhi(rv.y)};
            if (tid < RB) { const float gi = GATE_CAP * tanhf((rgi + bias_i) * (1.0f / GATE_CAP)), gf = GATE_CAP * tanhf((rgf + bias_f) * (1.0f / GATE_CAP));
                fi[tid * 2] = sigm(gf); fi[tid * 2 + 1] = __expf(gi); } }
        __syncthreads();
        if (blk + 1 < T / RB) { const size_t row = (size_t)b * T + T0_OF(blk + 1) + srow; const bf16* ur = U + row * UW;
            rq = *(const GAS v4u*)(ur + U_QA + h * 128 + sc * 8); rk = *(const GAS v4u*)(ur + U_KA + h * 128 + sc * 8); rv = *(const GAS v2u*)(ur + U_VA + h * 256 + cg * 64 + sc * 4);
            if (tid < RB) { const size_t r2 = (size_t)b * T + T0_OF(blk + 1) + tid; rgi = Gt[r2 * 16 + (dir ? 2 : 0) * 4 + h]; rgf = Gt[r2 * 16 + (dir ? 3 : 1) * 4 + h]; } }
        for (int s = 0; s < RB; ++s) {
            const int tl = dir ? (RB - 1 - s) : s;
            const float f = fi[tl * 2], ii = fi[tl * 2 + 1], v = vs[tl * 64 + colw];
            const LAS f32x4* qp = (const LAS f32x4*)(qs + tl * 128 + dg * 16); const LAS f32x4* kp = (const LAS f32x4*)(ks + tl * 128 + dg * 16);
            float num = 0.f, den = 0.f;
#pragma unroll
            for (int j4 = 0; j4 < 4; ++j4) { const f32x4 q4 = qp[j4], k4 = kp[j4];
#pragma unroll
                for (int i = 0; i < 4; ++i) { const int j = j4 * 4 + i; const float kk = ii * k4[i]; C[j] = f * C[j] + kk * v; n[j] = f * n[j] + kk; num += C[j] * q4[i]; den += n[j] * q4[i]; } }
            num += __shfl_xor(num, 8); den += __shfl_xor(den, 8); num += __shfl_xor(num, 16); den += __shfl_xor(den, 16); num += __shfl_xor(num, 32); den += __shfl_xor(den, 32);
            if (dg == 0) ob[tl * 64 + colw] = num / fmaxf(fabsf(den), 1.0f);
        }
        __syncthreads();
        *(GAS f32x4*)(HA + ((size_t)b * T + t0 + srow) * 1024 + h * 256 + cg * 64 + sc * 4) = *(const LAS f32x4*)(ob + srow * 64 + sc * 4);
    }
    __syncthreads();
}
__device__ __forceinline__ void hgrn_unit(const Frame& F, const Args& A, int unit) {
    const int lane = lane_now(), tid = F.wave * 64 + lane; (void)tid;
    const int cg = unit & 1, dir = (unit >> 1) & 1, h = (unit >> 2) & 7, b = unit >> 5;
    LAS float* qs = (LAS float*)(F.lds + RING_OFF);
    LAS float* fs = qs + RB * 128;
    LAS float* vs = fs + RB * 128;
    LAS float* ob = vs + RB * 64;
    const bf16* U = (const bf16*)(A.ws + WS_U);
    float* HB = (float*)(A.ws + WS_HB) + (size_t)dir * M * 1024;
    const int e = lane & 7, dg = lane >> 3, colw = F.wave * 8 + e;
    const int srow = tid >> 4, sc = tid & 15;
    float lb[8];
#pragma unroll
    for (int i = 0; i < 8; ++i) { const float l0 = A.in[I_LBLOG][(dir * 2 + 0) * 1024 + h * 128 + sc * 8 + i], l1 = A.in[I_LBLOG][(dir * 2 + 1) * 1024 + h * 128 + sc * 8 + i]; lb[i] = 1.0f / (1.0f + __expf(l1 - l0)); }
    float S[16];
#pragma unroll
    for (int j = 0; j < 16; ++j) S[j] = 0.f;
    v4u rq, rf; v2u rv;
    {   const size_t row = (size_t)b * T + T0_OF(0) + srow; const bf16* ur = U + row * UW;
        rq = *(const GAS v4u*)(ur + U_QB + h * 128 + sc * 8); rf = *(const GAS v4u*)(ur + (dir ? U_FB : U_FF) + h * 128 + sc * 8); rv = *(const GAS v2u*)(ur + U_IB + h * 128 + cg * 64 + sc * 4); }
    for (int blk = 0; blk < T / RB; ++blk) {
        const int t0 = T0_OF(blk);
        {   LAS float* qd = qs + srow * 128 + sc * 8; LAS float* fd = fs + srow * 128 + sc * 8;
            float qv[8] = {bflo(rq.x), bfhi(rq.x), bflo(rq.y), bfhi(rq.y), bflo(rq.z), bfhi(rq.z), bflo(rq.w), bfhi(rq.w)};
            float fv[8] = {bflo(rf.x), bfhi(rf.x), bflo(rf.y), bfhi(rf.y), bflo(rf.z), bfhi(rf.z), bflo(rf.w), bfhi(rf.w)};
#pragma unroll
            for (int i = 0; i < 8; ++i) { qv[i] = qv[i] * sigm(qv[i]); fv[i] = lb[i] + (1.0f - lb[i]) * sigm(fv[i]); }
            *(LAS f32x4*)qd = (f32x4){qv[0], qv[1], qv[2], qv[3]}; *(LAS f32x4*)(qd + 4) = (f32x4){qv[4], qv[5], qv[6], qv[7]};
            *(LAS f32x4*)fd = (f32x4){fv[0], fv[1], fv[2], fv[3]}; *(LAS f32x4*)(fd + 4) = (f32x4){fv[4], fv[5], fv[6], fv[7]};
            *(LAS f32x4*)(vs + srow * 64 + sc * 4) = (f32x4){bflo(rv.x), bfhi(rv.x), bflo(rv.y), bfhi(rv.y)}; }
        __syncthreads();
        if (blk + 1 < T / RB) { const size_t row = (size_t)b * T + T0_OF(blk + 1) + srow; const bf16* ur = U + row * UW;
            rq = *(const GAS v4u*)(ur + U_QB + h * 128 + sc * 8); rf = *(const GAS v4u*)(ur + (dir ? U_FB : U_FF) + h * 128 + sc * 8); rv = *(const GAS v2u*)(ur + U_IB + h * 128 + cg * 64 + sc * 4); }
        for (int s = 0; s < RB; ++s) {
            const int tl = dir ? (RB - 1 - s) : s;
            const float v = vs[tl * 64 + colw];
            const LAS f32x4* qp = (const LAS f32x4*)(qs + tl * 128 + dg * 16); const LAS f32x4* fp = (const LAS f32x4*)(fs + tl * 128 + dg * 16);
            float o = 0.f;
#pragma unroll
            for (int j4 = 0; j4 < 4; ++j4) { const f32x4 q4 = qp[j4], f4 = fp[j4];
#pragma unroll
                for (int i = 0; i < 4; ++i) { const int j = j4 * 4 + i; S[j] = f4[i] * S[j] + (1.0f - f4[i]) * v; o += S[j] * q4[i]; } }
            o += __shfl_xor(o, 8); o += __shfl_xor(o, 16); o += __shfl_xor(o, 32);
            if (dg == 0) ob[tl * 64 + colw] = o;
        }
        __syncthreads();
        *(GAS f32x4*)(HB + ((size_t)b * T + t0 + srow) * 1024 + h * 128 + cg * 64 + sc * 4) = *(const LAS f32x4*)(ob + srow * 64 + sc * 4);
    }
    __syncthreads();
}
__device__ __forceinline__ void p3_finalize(const Frame& F, const Args& A) {
    const int lane = lane_now(), tid = F.wave * 64 + lane; (void)tid;
    const int gw = blockIdx.x * NWAVES + F.wave, NGW = F.G * NWAVES;
    const bf16* U = (const bf16*)(A.ws + WS_U); bf16* Y = (bf16*)(A.ws + WS_Y);
    const float* HA = (const float*)(A.ws + WS_HA); const float* HB = (const float*)(A.ws + WS_HB);
    for (int row = gw; row < M; row += NGW) {
        const bf16* ur = U + (size_t)row * UW; bf16* yr = Y + (size_t)row * D;
#pragma unroll
        for (int h = 0; h < 4; ++h) { const int c = h * 256 + lane * 4;
            const f32x4 a = *(const GAS f32x4*)(HA + (size_t)row * 1024 + c), bq = *(const GAS f32x4*)(HA + (size_t)M * 1024 + (size_t)row * 1024 + c);
            const f32x4 s = a + bq; float ss = (s[0] * s[0] + s[1] * s[1]) + (s[2] * s[2] + s[3] * s[3]); ss = wave_sum(ss);
            const float r = 1.0f / sqrtf(ss * (1.0f / 256.0f) + RMS_EPS);
            const f32x4 w = *(const GAS f32x4*)(A.in[I_MNORM] + c); const v2u og = *(const GAS v2u*)(ur + U_OA + c);
            const float o0 = s[0] * r * w[0] * sigm(bflo(og.x)), o1 = s[1] * r * w[1] * sigm(bfhi(og.x)), o2 = s[2] * r * w[2] * sigm(bflo(og.y)), o3 = s[3] * r * w[3] * sigm(bfhi(og.y));
            v2u o; o.x = pk2(o0, o1); o.y = pk2(o2, o3); *(GAS v2u*)(yr + c) = o; }
#pragma unroll
        for (int hp = 0; hp < 4; ++hp) { const int c = hp * 256 + lane * 4;
            const f32x4 a = *(const GAS f32x4*)(HB + (size_t)row * 1024 + c), bq = *(const GAS f32x4*)(HB + (size_t)M * 1024 + (size_t)row * 1024 + c);
            const f32x4 s = a + bq; float ss = (s[0] * s[0] + s[1] * s[1]) + (s[2] * s[2] + s[3] * s[3]);
#pragma unroll
            for (int o = 1; o < 32; o <<= 1) ss += __shfl_xor(ss, o);
            const float r = 1.0f / sqrtf(ss * (1.0f / 128.0f) + RMS_EPS);
            const f32x4 w = *(const GAS f32x4*)(A.in[I_HNORM] + c); const v2u gg = *(const GAS v2u*)(ur + U_GB + c);
            const float g0 = bflo(gg.x), g1 = bfhi(gg.x), g2 = bflo(gg.y), g3 = bfhi(gg.y);
            const float o0 = s[0] * r * w[0] * g0 * sigm(g0), o1 = s[1] * r * w[1] * g1 * sigm(g1), o2 = s[2] * r * w[2] * g2 * sigm(g2), o3 = s[3] * r * w[3] * g3 * sigm(g3);
            v2u o; o.x = pk2(o0, o1); o.y = pk2(o2, o3); *(GAS v2u*)(yr + 1024 + c) = o; }
    }
}

__device__ __forceinline__ void ln_row_regs(f32x4 (&v)[8], const float* w, const float* bvec, int lane) {
    float s = 0.f;
#pragma unroll
    for (int j = 0; j < 8; ++j) s += (v[j][0] + v[j][1]) + (v[j][2] + v[j][3]);
    const float mean = wave_sum(s) * (1.0f / D); float s2 = 0.f;
#pragma unroll
    for (int j = 0; j < 8; ++j) { v[j] = v[j] - mean; s2 += (v[j][0] * v[j][0] + v[j][1] * v[j][1]) + (v[j][2] * v[j][2] + v[j][3] * v[j][3]); }
    const float rstd = 1.0f / sqrtf(wave_sum(s2) * (1.0f / D) + LN_EPS);
#pragma unroll
    for (int j = 0; j < 8; ++j) { const f32x4 ww = *(const GAS f32x4*)(w + 256 * j + 4 * lane), bb = *(const GAS f32x4*)(bvec + 256 * j + 4 * lane); v[j] = v[j] * rstd * ww + bb; }
}
__device__ __forceinline__ void store_row(const f32x4 (&v)[8], float* xf, bf16* xb, int lane) {
#pragma unroll
    for (int j = 0; j < 8; ++j) { *(GAS f32x4*)(xf + 256 * j + 4 * lane) = v[j]; v2u o; o.x = pk2(v[j][0], v[j][1]); o.y = pk2(v[j][2], v[j][3]); *(GAS v2u*)(xb + 256 * j + 4 * lane) = o; }
}
__device__ __forceinline__ void ln_phase(const Frame& F, const Args& A, const float* w, const float* bvec, bf16* XB) {
    const int lane = lane_now(), tid = F.wave * 64 + lane; (void)tid;
    const int gw = blockIdx.x * NWAVES + F.wave, NGW = F.G * NWAVES;
    for (int row = gw; row < M; row += NGW) { float* xr = A.out + (size_t)row * D; f32x4 v[8];
#pragma unroll
        for (int j = 0; j < 8; ++j) v[j] = *(const GAS f32x4*)(xr + 256 * j + 4 * lane);
        ln_row_regs(v, w, bvec, lane); store_row(v, xr, XB + (size_t)row * D, lane); }
}
__device__ __forceinline__ void ln_router_phase(const Frame& F, const Args& A, const float* w, const float* bvec, bf16* XB) {
    const int lane = lane_now(), tid = F.wave * 64 + lane; (void)tid;
    LAS int* cnt = (LAS int*)(F.lds + RING_OFF);
    int* TOKE = (int*)(A.ws + WS_TOKE); float* TOKG = (float*)(A.ws + WS_TOKG); int* WGCNT = (int*)(A.ws + WS_WGCNT);
    const float* wr = A.in[I_WR]; const float* br = A.in[I_BR];
    for (int vb = blockIdx.x; vb < M / 64; vb += F.G) {
        if (tid < 8) cnt[tid] = 0;
        __syncthreads();
        for (int k = 0; k < 8; ++k) { const int row = vb * 64 + F.wave * 8 + k; float* xr = A.out + (size_t)row * D; f32x4 v[8];
#pragma unroll
            for (int j = 0; j < 8; ++j) v[j] = *(const GAS f32x4*)(xr + 256 * j + 4 * lane);
            ln_row_regs(v, w, bvec, lane); store_row(v, xr, XB + (size_t)row * D, lane);
            float lg[8];
#pragma unroll
            for (int e = 0; e < 8; ++e) lg[e] = 0.f;
#pragma unroll
            for (int j = 0; j < 8; ++j)
#pragma unroll
                for (int i = 0; i < 4; ++i) { const float* wp = wr + (size_t)(256 * j + 4 * lane + i) * NE; const f32x4 w0 = *(const GAS f32x4*)wp, w1 = *(const GAS f32x4*)(wp + 4); const float xv = v[j][i];
                    lg[0] += xv * w0[0]; lg[1] += xv * w0[1]; lg[2] += xv * w0[2]; lg[3] += xv * w0[3]; lg[4] += xv * w1[0]; lg[5] += xv * w1[1]; lg[6] += xv * w1[2]; lg[7] += xv * w1[3]; }
#pragma unroll
            for (int e = 0; e < 8; ++e) lg[e] = wave_sum(lg[e]) + br[e];
            int e1 = 0; float l1 = lg[0];
#pragma unroll
            for (int e = 1; e < 8; ++e) if (lg[e] > l1) { l1 = lg[e]; e1 = e; }
            int e2 = -1; float l2 = -3.0e38f;
#pragma unroll
            for (int e = 0; e < 8; ++e) if (e != e1 && lg[e] > l2) { l2 = lg[e]; e2 = e; }
            const float g2 = 1.0f / (1.0f + __expf(l1 - l2)), g1 = 1.0f - g2;
            if (lane == 0) { TOKE[2 * row] = e1; TOKE[2 * row + 1] = e2; TOKG[2 * row] = g1; TOKG[2 * row + 1] = g2; __hip_atomic_fetch_add(&cnt[e1], 1, __ATOMIC_RELAXED, __HIP_MEMORY_SCOPE_WORKGROUP); __hip_atomic_fetch_add(&cnt[e2], 1, __ATOMIC_RELAXED, __HIP_MEMORY_SCOPE_WORKGROUP); }
        }
        __syncthreads();
        if (tid < 8) WGCNT[vb * 8 + tid] = cnt[tid];
        __syncthreads();
    }
}
__device__ __forceinline__ void moe_scatter_phase(const Frame& F, const Args& A, const bf16* XB) {
    const int lane = lane_now(), tid = F.wave * 64 + lane; (void)tid;
    LAS int* sm = (LAS int*)(F.lds + RING_OFF);
    const int* TOKE = (const int*)(A.ws + WS_TOKE); int* DEST = (int*)(A.ws + WS_DEST); const int* WGCNT = (const int*)(A.ws + WS_WGCNT); int* TILEE = (int*)(A.ws + WS_TILEE);
    bf16* XS = (bf16*)(A.ws + WS_XS);
    for (int vb = blockIdx.x; vb < M / 64; vb += F.G) {
        if (tid < 16) sm[tid] = 0;
        if (tid >= 64 && tid < 192) sm[32 + tid - 64] = TOKE[vb * 128 + tid - 64];
        __syncthreads();
        {   const int e = tid & 7, wq = tid >> 3; int tot = 0, pre = 0;
#pragma unroll
            for (int i = 0; i < 4; ++i) { const int w = wq * 4 + i; const int c = WGCNT[w * 8 + e]; tot += c; pre += (w < vb) ? c : 0; }
            __hip_atomic_fetch_add(&sm[e], tot, __ATOMIC_RELAXED, __HIP_MEMORY_SCOPE_WORKGROUP); __hip_atomic_fetch_add(&sm[8 + e], pre, __ATOMIC_RELAXED, __HIP_MEMORY_SCOPE_WORKGROUP); }
        __syncthreads();
        if (tid == 0) { int base = 0; for (int e = 0; e < 8; ++e) { sm[16 + e] = base; base += ((sm[e] + 255) >> 8) << 8; }
            if (vb == 0) { int rt = 0; for (int e = 0; e < 8; ++e) { const int nt = (sm[e] + 255) >> 8; for (int i = 0; i < nt; ++i) TILEE[1 + rt++] = e; } TILEE[0] = rt; } }
        __syncthreads();
        if (tid < 128) { const int e = sm[32 + tid]; int rank = 0; for (int s = 0; s < tid; ++s) rank += (sm[32 + s] == e) ? 1 : 0; const int d = sm[16 + e] + sm[8 + e] + rank; sm[160 + tid] = d; DEST[vb * 128 + tid] = d; }
        __syncthreads();
        for (int s = F.wave; s < 128; s += NWAVES) { const int tok = vb * 64 + (s >> 1); const int d = sm[160 + s];
            const GAS v4u* src = (const GAS v4u*)(XB + (size_t)tok * D); GAS v4u* dst = (GAS v4u*)(XS + (size_t)d * D);
#pragma unroll
            for (int j = 0; j < 4; ++j) dst[64 * j + lane] = src[64 * j + lane]; }
        __syncthreads();
    }
}
__device__ __forceinline__ void ln_moe_phase(const Frame& F, const Args& A, const float* w, const float* bvec, bf16* XB) {
    const int lane = lane_now(), tid = F.wave * 64 + lane; (void)tid;
    const int gw = blockIdx.x * NWAVES + F.wave, NGW = F.G * NWAVES;
    const float* TOKG = (const float*)(A.ws + WS_TOKG); const int* DEST = (const int*)(A.ws + WS_DEST); const float* YS = (const float*)(A.ws + WS_YS);
    for (int row = gw; row < M; row += NGW) { float* xr = A.out + (size_t)row * D; f32x4 v[8];
        const int d1 = DEST[2 * row], d2 = DEST[2 * row + 1]; const float g1 = TOKG[2 * row], g2 = TOKG[2 * row + 1];
        const float* y1 = YS + (size_t)d1 * D; const float* y2 = YS + (size_t)d2 * D;
#pragma unroll
        for (int j = 0; j < 8; ++j) { const int c = 256 * j + 4 * lane; v[j] = *(const GAS f32x4*)(xr + c) * ALPHA + *(const GAS f32x4*)(y1 + c) * g1 + *(const GAS f32x4*)(y2 + c) * g2; }
        ln_row_regs(v, w, bvec, lane); store_row(v, xr, XB + (size_t)row * D, lane); }
}

__device__ __forceinline__ void na_phase_simple(const Frame& F, const Args& A) {
    const int lane = lane_now(), tid = F.wave * 64 + lane; (void)tid;
    const int gw = blockIdx.x * NWAVES + F.wave, NGW = F.G * NWAVES;
    const bf16* QKV = (const bf16*)(A.ws + WS_QKV); bf16* AO = (bf16*)(A.ws + WS_AO); const float* rpb = A.in[I_RPB];
    const float scale = 0.08838834764831845f;
    for (int task = gw; task < M * 16; task += NGW) {
        const int tok = task >> 4, h = task & 15, b = tok >> 12, r = (tok >> 6) & 63, c = tok & 63;
        const int rs = min(max(r - 4, 0), 56), cs = min(max(c - 8, 0), 48);
        const GAS v4u* qp = (const GAS v4u*)(QKV + (size_t)tok * NQKV + h * 128);
        float sc[2];
#pragma unroll
        for (int i = 0; i < 2; ++i) { const int kk = lane + 64 * i, jr = kk >> 4, jc = kk & 15; const int ktok = b * T + (rs + jr) * 64 + cs + jc;
            const GAS v4u* kp = (const GAS v4u*)(QKV + (size_t)ktok * NQKV + D + h * 128); float acc = 0.f;
#pragma unroll 4
            for (int j = 0; j < 16; ++j) { const v4u q = qp[j], k = kp[j];
                acc += bflo(q.x) * bflo(k.x) + bfhi(q.x) * bfhi(k.x) + bflo(q.y) * bflo(k.y) + bfhi(q.y) * bfhi(k.y) + bflo(q.z) * bflo(k.z) + bfhi(q.z) * bfhi(k.z) + bflo(q.w) * bflo(k.w) + bfhi(q.w) * bfhi(k.w); }
            sc[i] = acc * scale + rpb[(h * 15 + (rs + jr - r + 7)) * 31 + (cs + jc - c + 15)]; }
        const float mx = wave_max(fmaxf(sc[0], sc[1]));
        const float p0 = __expf(sc[0] - mx), p1 = __expf(sc[1] - mx);
        const float inv = 1.0f / wave_sum(p0 + p1);
        float a0 = 0.f, a1 = 0.f;
        const bf16* vbase = QKV + 2 * D + h * 128 + 2 * lane;
#pragma unroll
        for (int i = 0; i < 2; ++i) { const float pi = i ? p1 : p0;
#pragma unroll 8
            for (int l = 0; l < 64; ++l) { const int kk = l + 64 * i, jr = kk >> 4, jc = kk & 15; const int ktok = b * T + (rs + jr) * 64 + cs + jc;
                const float pk = __builtin_bit_cast(float, __builtin_amdgcn_readlane(__builtin_bit_cast(int, pi), l));
                const unsigned vv = *(const GAS unsigned*)(vbase + (size_t)ktok * NQKV); a0 += pk * bflo(vv); a1 += pk * bfhi(vv); } }
        *(GAS unsigned*)(AO + (size_t)tok * D + h * 128 + 2 * lane) = pk2(a0 * inv, a1 * inv);
    }
}
#ifndef MK_ONE_LAUNCH
#define MK_ONE_LAUNCH 0
#endif
constexpr int N_PHASES = 21;
__global__ void __launch_bounds__(NWAVES * 64, 2) trunk_fwd(Args args) {
    extern __shared__ __attribute__((aligned(16))) unsigned char lds[];
    Frame F;
    F.lds = (LAS unsigned char*)lds;
    F.wave = __builtin_amdgcn_readfirstlane(threadIdx.x >> 6);
    F.G = gridDim.x;
    const Args& A = args;
    { const int tid0 = F.wave * 64 + lane_now(); for (int u = tid0; u < (LDS_BYTES - LDSCTL_OFF) / 4; u += NWAVES * 64) ((LAS unsigned*)(F.lds + LDSCTL_OFF))[u] = 0u; }
    __syncthreads();
    gu32* ctl = (gu32*)(args.ws + WS_CTL);
    const int lo = args.ph_lo, hi = args.ph_hi;
    XcdBarrier bar; bar.bar = (unsigned*)(ctl + CW_BAR); bar.x = 0; bar.st = nullptr;
    if (hi - lo > 1) bar = xcd_barrier_post((unsigned*)(ctl + CW_BAR), (volatile LAS unsigned*)(F.lds + MISC_OFF) + 8, F.wave);
#define IN(k) (lo <= (k) && (k) < hi)
#define SEAM(k) do { if (IN(k) && IN((k) + 1)) xcd_barrier(bar, F.wave); } while (0)
    unsigned char* ws = args.ws;
    bf16* XB0 = (bf16*)(ws + WS_XB0); bf16* XB1 = (bf16*)(ws + WS_XB1);
    const int bid = (int)blockIdx.x;

    if (IN(0)) { p0_prologue(F, A); } SEAM(0);
    if (IN(1)) {
        pg8::Gemm g{XB0, (const bf16*)(ws + WS_WRIN), M, NREC, D}; pg8::StaticOrder S; S.init(M, NREC, F.G, bid);
        pg8::EpiBf16G E{(bf16*)(ws + WS_U), UW, 32, (float*)(ws + WS_G)};
        pg8::gemm_phase<pg8::EpiBf16G, pg8::StaticOrder, true, true>(F.lds + RING_OFF, g, S, E, F.wave);
    } SEAM(1);
    if (IN(2)) { for (int unit = bid; unit < 256; unit += F.G) { if (unit < 128) mlstm_unit(F, A, unit); else hgrn_unit(F, A, unit - 128); } } SEAM(2);
    if (IN(3)) { p3_finalize(F, A); } SEAM(3);
    if (IN(4)) {
        pg8::Gemm g{(const bf16*)(ws + WS_Y), (const bf16*)(ws + WS_WROUT), M, D, D}; pg8::StaticOrder S; S.init(M, D, F.G, bid);
        pg8::EpiResF32 E{A.in[I_X], A.out, D, ALPHA};
        pg8::gemm_phase<pg8::EpiResF32, pg8::StaticOrder, true, true>(F.lds + RING_OFF, g, S, E, F.wave);
    } SEAM(4);
    if (IN(5)) { ln_phase(F, A, A.in[I_LNW] + 0 * D, A.in[I_LNB] + 0 * D, XB1); } SEAM(5);
    if (IN(6)) {
        pg8::Gemm g{XB1, (const bf16*)(ws + WS_WFGU), M, 2 * FFN, D}; pg8::StaticOrder S; S.init(M, 2 * FFN, F.G, bid);
        pg8::EpiSwiglu E{(bf16*)(ws + WS_H), FFN, 2 * FFN / 256};
        pg8::gemm_phase<pg8::EpiSwiglu, pg8::StaticOrder, true, true>(F.lds + RING_OFF, g, S, E, F.wave);
    } SEAM(6);
    if (IN(7)) {
        pg8::Gemm g{(const bf16*)(ws + WS_H), (const bf16*)(ws + WS_WFDN), M, D, FFN}; pg8::StaticOrder S; S.init(M, D, F.G, bid);
        pg8::EpiResF32 E{A.out, A.out, D, ALPHA};
        pg8::gemm_phase<pg8::EpiResF32, pg8::StaticOrder, true, true>(F.lds + RING_OFF, g, S, E, F.wave);
    } SEAM(7);
    if (IN(8)) { ln_phase(F, A, A.in[I_LNW] + 1 * D, A.in[I_LNB] + 1 * D, XB0); } SEAM(8);
    if (IN(9)) {
        pg8::Gemm g{(const bf16*)(ws + WS_PB), (const bf16*)(ws + WS_WPP0), M, D, PLE_DIM}; pg8::StaticOrder S; S.init(M, D, F.G, bid);
        pg8::EpiStoreF32 E{(float*)(ws + WS_PP), D, D / 256};
        pg8::gemm_phase<pg8::EpiStoreF32, pg8::StaticOrder, true, true>(F.lds + RING_OFF, g, S, E, F.wave);
    } SEAM(9);
    if (IN(10)) {
        pg8::Gemm g{XB0, (const bf16*)(ws + WS_WPG0), M, D, D}; pg8::StaticOrder S; S.init(M, D, F.G, bid);
        pg8::EpiPle E{A.out, (const float*)(ws + WS_PP), XB1, D};
        pg8::gemm_phase<pg8::EpiPle, pg8::StaticOrder, true, true>(F.lds + RING_OFF, g, S, E, F.wave);
    } SEAM(10);
    if (IN(11)) {
        pg8::Gemm g{XB1, (const bf16*)(ws + WS_WQKV), M, NQKV, D}; pg8::StaticOrder S; S.init(M, NQKV, F.G, bid);
        pg8::EpiBf16G E{(bf16*)(ws + WS_QKV), NQKV, -1, nullptr};
        pg8::gemm_phase<pg8::EpiBf16G, pg8::StaticOrder, true, true>(F.lds + RING_OFF, g, S, E, F.wave);
    } SEAM(11);
    if (IN(12)) { na_phase_simple(F, A); } SEAM(12);
    if (IN(13)) {
        pg8::Gemm g{(const bf16*)(ws + WS_AO), (const bf16*)(ws + WS_WNAO), M, D, D}; pg8::StaticOrder S; S.init(M, D, F.G, bid);
        pg8::EpiResF32 E{A.out, A.out, D, ALPHA};
        pg8::gemm_phase<pg8::EpiResF32, pg8::StaticOrder, true, true>(F.lds + RING_OFF, g, S, E, F.wave);
    } SEAM(13);
    if (IN(14)) { ln_router_phase(F, A, A.in[I_LNW] + 2 * D, A.in[I_LNB] + 2 * D, XB0); } SEAM(14);
    if (IN(15)) { moe_scatter_phase(F, A, XB0); } SEAM(15);
    if (IN(16)) {
        const int* TILEE = (const int*)(ws + WS_TILEE); const int nrt = __builtin_amdgcn_readfirstlane(TILEE[0]);
        pg8::Gemm g{(const bf16*)(ws + WS_XS), (const bf16*)(ws + WS_WMGU), nrt * 256, 2 * MOE, D}; pg8::MoeOrder S; S.base.init(nrt * 256, 2 * MOE, F.G, bid); S.tile_e = TILEE + 1; S.nN = 2 * MOE / 256;
        pg8::EpiSwiglu E{(bf16*)(ws + WS_HM), MOE, 2 * MOE / 256};
        pg8::gemm_phase<pg8::EpiSwiglu, pg8::MoeOrder, true, true>(F.lds + RING_OFF, g, S, E, F.wave);
    } SEAM(16);
    if (IN(17)) {
        const int* TILEE = (const int*)(ws + WS_TILEE); const int nrt = __builtin_amdgcn_readfirstlane(TILEE[0]);
        pg8::Gemm g{(const bf16*)(ws + WS_HM), (const bf16*)(ws + WS_WMDN), nrt * 256, D, MOE}; pg8::MoeOrder S; S.base.init(nrt * 256, D, F.G, bid); S.tile_e = TILEE + 1; S.nN = D / 256;
        pg8::EpiStoreF32 E{(float*)(ws + WS_YS), D, D / 256};
        pg8::gemm_phase<pg8::EpiStoreF32, pg8::MoeOrder, true, true>(F.lds + RING_OFF, g, S, E, F.wave);
    } SEAM(17);
    if (IN(18)) { ln_moe_phase(F, A, A.in[I_LNW] + 3 * D, A.in[I_LNB] + 3 * D, XB1); } SEAM(18);
    if (IN(19)) {
        pg8::Gemm g{(const bf16*)(ws + WS_PB) + (size_t)M * PLE_DIM, (const bf16*)(ws + WS_WPP1), M, D, PLE_DIM}; pg8::StaticOrder S; S.init(M, D, F.G, bid);
        pg8::EpiStoreF32 E{(float*)(ws + WS_PP1), D, D / 256};
        pg8::gemm_phase<pg8::EpiStoreF32, pg8::StaticOrder, true, true>(F.lds + RING_OFF, g, S, E, F.wave);
    } SEAM(19);
    if (IN(20)) {
        pg8::Gemm g{XB1, (const bf16*)(ws + WS_WPG1), M, D, D}; pg8::StaticOrder S; S.init(M, D, F.G, bid);
        pg8::EpiPle E{A.out, (const float*)(ws + WS_PP1), nullptr, D};
        pg8::gemm_phase<pg8::EpiPle, pg8::StaticOrder, true, true>(F.lds + RING_OFF, g, S, E, F.wave);
    }
#undef IN
#undef SEAM
}

extern "C" void kernel_launch(void* const* d_in, const int* in_sizes, int n_in, void* d_out, int out_size, void* d_ws, size_t ws_size, hipStream_t stream) {
    static int grid = 0;
    if (grid == 0) {
        if (n_in != 23 || in_sizes[0] != M * D || out_size != M * D || ws_size < WS_END) { fprintf(stderr, "kernel_launch: unexpected shapes (n_in %d, in0 %d, out %d, ws %zu, need %zu)\n", n_in, n_in > 0 ? in_sizes[0] : -1, out_size, ws_size, (size_t)WS_END); grid = -1; return; }
        int dev = 0, cus = 0, per_cu = 0;
        if (hipGetDevice(&dev) != hipSuccess || hipDeviceGetAttribute(&cus, hipDeviceAttributeMultiprocessorCount, dev) != hipSuccess) { grid = -1; return; }
        if (hipFuncSetAttribute((const void*)trunk_fwd, hipFuncAttributeMaxDynamicSharedMemorySize, LDS_BYTES) != hipSuccess) { fprintf(stderr, "kernel_launch: hipFuncSetAttribute failed\n"); grid = -1; return; }
        if (hipOccupancyMaxActiveBlocksPerMultiprocessor(&per_cu, (const void*)trunk_fwd, NWAVES * 64, LDS_BYTES) != hipSuccess || per_cu < 1) { fprintf(stderr, "kernel_launch: occupancy query reports %d\n", per_cu); }
        (void)hipGetLastError();
        grid = cus;
    }
    if (grid < 0) return;
    (void)hipMemsetAsync((char*)d_ws + WS_CTL, 0, CTL_ZERO_BYTES, stream);
    Args a{};
    for (int i = 0; i < 23; ++i) a.in[i] = (const float*)d_in[i];
    a.out = (float*)d_out; a.ws = (unsigned char*)d_ws;
#if MK_ONE_LAUNCH
    a.ph_lo = 0; a.ph_hi = N_PHASES;
    hipLaunchKernelGGL(trunk_fwd, dim3(grid), dim3(NWAVES * 64), LDS_BYTES, stream, a);
#else
    for (int ph = 0; ph < N_PHASES; ++ph) { a.ph_lo = ph; a.ph_hi = ph + 1; hipLaunchKernelGGL(trunk_fwd, dim3(grid), dim3(NWAVES * 64), LDS_BYTES, stream, a); }
#endif
}
```

```cpp
#include <hip/hip_runtime.h>
#include <cstdio>
#include <cstdint>
__device__ __forceinline__ int lane_now() { int l; asm volatile("v_mbcnt_lo_u32_b32 %0, -1, 0\n\tv_mbcnt_hi_u32_b32 %0, -1, %0" : "=v"(l)); return l; }
namespace pg8 {
#define PG8_LAS __attribute__((address_space(3)))
typedef unsigned short bf16_t;
typedef short bf16x8 __attribute__((ext_vector_type(8)));
typedef float f32x4 __attribute__((ext_vector_type(4)));
typedef unsigned u32x4 __attribute__((ext_vector_type(4)));
constexpr int BM = 256, BK = 64, HALF = 128, HTB = HALF * BK * 2  , STAGE_BYTES = 8 * HTB, NXCD = 8, WGM = 8;

__host__ __device__ __forceinline__ int lds_byte(int r, int c) { const int st = (r >> 4) * 2 + (c >> 5), rr = r & 15, cc = c & 31, ob = rr * 64 + cc * 2; return st * 1024 + (ob ^ (((ob >> 9) & 1) << 5)); }
__host__ __device__ __forceinline__ void stage_rc(int b, int& R, int& C) { const int st = b / 1024, sb = b % 1024, swz = sb ^ (((sb >> 9) & 1) << 5); R = (st >> 1) * 16 + swz / 64; C = (st & 1) * 32 + (swz % 64) / 2; }
__host__ __device__ __forceinline__ int perm32(int rho) { const int n = rho >> 4, i = rho & 15; return 8 * (i >> 2) + 4 * n + (i & 3); }

struct Unit { int pm, pn; };
struct Gemm { const bf16_t* A; const bf16_t* Bt; int M, N, K; };

struct StaticOrder {
    int nM, nN, nwg, G, c;
    __host__ __device__ void init(int M, int N, int G_, int c_) { nM = M / BM; nN = N / BM; nwg = nM * nN; G = G_; c = c_; }
    __host__ __device__ bool next(int i, Unit& u) const {
        const long L = (long)i * G + c; if (L >= nwg) return false;
        int wgid = (int)L; { const int q = nwg / NXCD, r = nwg % NXCD, xcd = wgid % NXCD, off = wgid / NXCD; wgid = (xcd < r ? xcd * (q + 1) : r * (q + 1) + (xcd - r) * q) + off; }
        const int nig = WGM * nN, gid = wgid / nig, fm = gid * WGM, gsz = (nM - fm) < WGM ? (nM - fm) : WGM;
        u.pm = fm + ((wgid % nig) % gsz); u.pn = (wgid % nig) / gsz; return true;
    }
    __device__ __forceinline__ void a_ready(const Unit&) const {}
    __device__ __forceinline__ void done(const Unit&) const {}
};

__device__ __forceinline__ unsigned cvt_pk_bf16(float lo, float hi) { unsigned r; asm volatile("v_cvt_pk_bf16_f32 %0, %1, %2" : "=v"(r) : "v"(lo), "v"(hi)); return r; }
__device__ __forceinline__ float fsigmoid(float x) { return __builtin_amdgcn_rcpf(1.0f + __expf(-x)); }
__device__ __forceinline__ float fsilu(float x) { return x * fsigmoid(x); }


struct EpiBf16G {
    static constexpr bool PERM = true, AFTER_DRAIN = false;
    bf16_t* O; int ldc; int gate_pn; float* Gt;
    __device__ __forceinline__ void operator()(const f32x4 (&acc)[2][2][4][2], const Unit& u, int wr, int wc, int fr, int fq) const {
        const int row0 = u.pm * BM + wr * 64 + fr;
        if (u.pn == gate_pn) {
            if (wc == 0 && fq < 2) {
#pragma unroll
                for (int ai = 0; ai < 2; ++ai)
#pragma unroll
                    for (int m = 0; m < 4; ++m) { float* gp = Gt + (size_t)(row0 + ai * HALF + m * 16) * 16 + 8 * fq;
                        *(f32x4*)(gp) = acc[ai][0][m][0]; *(f32x4*)(gp + 4) = acc[ai][0][m][1]; }
            }
            return;
        }
        const int col0 = u.pn * BM + wc * 32 + 8 * fq;
#pragma unroll
        for (int ai = 0; ai < 2; ++ai)
#pragma unroll
            for (int m = 0; m < 4; ++m) { bf16_t* rowp = O + (size_t)(row0 + ai * HALF + m * 16) * ldc + col0;
#pragma unroll
                for (int bj = 0; bj < 2; ++bj) { const f32x4 v0 = acc[ai][bj][m][0], v1 = acc[ai][bj][m][1];
                    u32x4 w; w.x = cvt_pk_bf16(v0[0], v0[1]); w.y = cvt_pk_bf16(v0[2], v0[3]); w.z = cvt_pk_bf16(v1[0], v1[1]); w.w = cvt_pk_bf16(v1[2], v1[3]);
                    *(u32x4*)(rowp + bj * HALF) = w; } }
    }
};
struct EpiSwiglu {
    static constexpr bool PERM = true, AFTER_DRAIN = false;
    bf16_t* H; int ldh; int npn;
    __device__ __forceinline__ void operator()(const f32x4 (&acc)[2][2][4][2], const Unit& u, int wr, int wc, int fr, int fq) const {
        const int row0 = u.pm * BM + wr * 64 + fr; const int pl = u.pn % npn; const int col0 = pl * HALF + wc * 32 + 8 * fq;
#pragma unroll
        for (int ai = 0; ai < 2; ++ai)
#pragma unroll
            for (int m = 0; m < 4; ++m) { bf16_t* rowp = H + (size_t)(row0 + ai * HALF + m * 16) * ldh + col0;
                const f32x4 g0 = acc[ai][0][m][0], g1 = acc[ai][0][m][1], u0 = acc[ai][1][m][0], u1 = acc[ai][1][m][1];
                float o[8];
#pragma unroll
                for (int i = 0; i < 4; ++i) { o[i] = fsilu(g0[i]) * u0[i]; o[4 + i] = fsilu(g1[i]) * u1[i]; }
                u32x4 w; w.x = cvt_pk_bf16(o[0], o[1]); w.y = cvt_pk_bf16(o[2], o[3]); w.z = cvt_pk_bf16(o[4], o[5]); w.w = cvt_pk_bf16(o[6], o[7]);
                *(u32x4*)rowp = w; }
    }
};
struct EpiResF32 {
    static constexpr bool PERM = true, AFTER_DRAIN = false;
    const float* SRC; float* DST; int ldc; float alpha;
    __device__ __forceinline__ void operator()(const f32x4 (&acc)[2][2][4][2], const Unit& u, int wr, int wc, int fr, int fq) const {
        const int row0 = u.pm * BM + wr * 64 + fr; const int col0 = u.pn * BM + wc * 32 + 8 * fq;
#pragma unroll
        for (int ai = 0; ai < 2; ++ai)
#pragma unroll
            for (int m = 0; m < 4; ++m) { const size_t ro = (size_t)(row0 + ai * HALF + m * 16) * ldc + col0;
#pragma unroll
                for (int bj = 0; bj < 2; ++bj)
#pragma unroll
                    for (int n = 0; n < 2; ++n) { const size_t o = ro + bj * HALF + 4 * n; const f32x4 s = *(const f32x4*)(SRC + o); *(f32x4*)(DST + o) = s * alpha + acc[ai][bj][m][n]; } }
    }
};
struct EpiStoreF32 {
    static constexpr bool PERM = true, AFTER_DRAIN = false;
    float* O; int ldc; int npn;
    __device__ __forceinline__ void operator()(const f32x4 (&acc)[2][2][4][2], const Unit& u, int wr, int wc, int fr, int fq) const {
        const int row0 = u.pm * BM + wr * 64 + fr; const int col0 = (u.pn % npn) * BM + wc * 32 + 8 * fq;
#pragma unroll
        for (int ai = 0; ai < 2; ++ai)
#pragma unroll
            for (int m = 0; m < 4; ++m) { float* ro = O + (size_t)(row0 + ai * HALF + m * 16) * ldc + col0;
#pragma unroll
                for (int bj = 0; bj < 2; ++bj)
#pragma unroll
                    for (int n = 0; n < 2; ++n) *(f32x4*)(ro + bj * HALF + 4 * n) = acc[ai][bj][m][n]; }
    }
};
struct EpiPle {
    static constexpr bool PERM = true, AFTER_DRAIN = false;
    float* XF; const float* PP; bf16_t* XB; int ldc;
    __device__ __forceinline__ void operator()(const f32x4 (&acc)[2][2][4][2], const Unit& u, int wr, int wc, int fr, int fq) const {
        const int row0 = u.pm * BM + wr * 64 + fr; const int col0 = u.pn * BM + wc * 32 + 8 * fq;
#pragma unroll
        for (int ai = 0; ai < 2; ++ai)
#pragma unroll
            for (int m = 0; m < 4; ++m) { const size_t ro = (size_t)(row0 + ai * HALF + m * 16) * ldc + col0;
#pragma unroll
                for (int bj = 0; bj < 2; ++bj) { f32x4 o[2];
#pragma unroll
                    for (int n = 0; n < 2; ++n) { const size_t of = ro + bj * HALF + 4 * n; const f32x4 x = *(const f32x4*)(XF + of), pp = *(const f32x4*)(PP + of); const f32x4 a = acc[ai][bj][m][n];
                        f32x4 r; r[0] = x[0] + fsigmoid(a[0]) * pp[0]; r[1] = x[1] + fsigmoid(a[1]) * pp[1]; r[2] = x[2] + fsigmoid(a[2]) * pp[2]; r[3] = x[3] + fsigmoid(a[3]) * pp[3];
                        *(f32x4*)(XF + of) = r; o[n] = r; }
                    u32x4 w; w.x = cvt_pk_bf16(o[0][0], o[0][1]); w.y = cvt_pk_bf16(o[0][2], o[0][3]); w.z = cvt_pk_bf16(o[1][0], o[1][1]); w.w = cvt_pk_bf16(o[1][2], o[1][3]);
                    if (XB) *(u32x4*)(XB + ro + bj * HALF) = w; } }
    }
};
struct MoeOrder {
    StaticOrder base; const int* tile_e; int nN;
    __device__ __forceinline__ bool next(int i, Unit& u) const { if (!base.next(i, u)) return false; u.pn += tile_e[u.pm] * nN; return true; }
    __device__ __forceinline__ void a_ready(const Unit&) const {}
    __device__ __forceinline__ void done(const Unit&) const {}
};

template <class Epi, class Sched, bool ALIGN_EPI = false, bool SP2 = false>
__device__ __forceinline__ void gemm_phase(PG8_LAS unsigned char* lds, const Gemm g, const Sched& S, const Epi& E, int wave_s) {
    const int lane = lane_now(), wid = wave_s, tid = wave_s * 64 + lane, wr = wid >> 2, wc = wid & 3, fr = lane & 15, fq = lane >> 4;
    const int K = g.K, nt = K / BK;
    unsigned voffA[2], voffB[2];
#pragma unroll
    for (int i = 0; i < 2; ++i) { int R, C; stage_rc(tid * 16 + i * 8192, R, C); const int Rb = Epi::PERM ? ((R & ~31) + perm32(R & 31)) : R;
        voffA[i] = (unsigned)(R * K + C) * 2u; voffB[i] = (unsigned)(Rb * K + C) * 2u; }
    const size_t kstep = (size_t)(BK * 2);
    const size_t hstep = (size_t)HALF * K * 2;
    const size_t tstep = 2 * hstep;
    const unsigned ldsw = (unsigned)wid * 1024u;
    const int aoff = lds_byte(wr * 64 + fr, fq * 8), boff = lds_byte(wc * 32 + fr, fq * 8);
#define PG8_SA(b, h) (((b) * 2 + (h)) * HTB)
#define PG8_SB(b, h) ((4 + (b) * 2 + (h)) * HTB)
#define PG8_STAGE(bufoff, gbase, voff) do { _Pragma("unroll") for (int _i = 0; _i < 2; ++_i) \
        __builtin_amdgcn_global_load_lds((const unsigned*)((const char*)(gbase) + (voff)[_i]), (PG8_LAS unsigned*)(lds + (bufoff) + ldsw + _i * 8192), 16, 0, 0); } while (0)
#define PG8_LDA(dst, b, h) do { _Pragma("unroll") for (int m = 0; m < 4; ++m) _Pragma("unroll") for (int k = 0; k < 2; ++k) dst[m][k] = *(const PG8_LAS bf16x8*)(lds + PG8_SA(b, h) + aoff + m * 2048 + k * 1024); } while (0)
#define PG8_LDB(dst, b, h) do { _Pragma("unroll") for (int n = 0; n < 2; ++n) _Pragma("unroll") for (int k = 0; k < 2; ++k) dst[n][k] = *(const PG8_LAS bf16x8*)(lds + PG8_SB(b, h) + boff + n * 2048 + k * 1024); } while (0)
#define PG8_MMA(ai, bj, At, Bt) do { __builtin_amdgcn_s_setprio(1); _Pragma("unroll") for (int m = 0; m < 4; ++m) _Pragma("unroll") for (int n = 0; n < 2; ++n) _Pragma("unroll") for (int k = 0; k < 2; ++k) \
        acc[ai][bj][m][n] = __builtin_amdgcn_mfma_f32_16x16x32_bf16(Bt[n][k], At[m][k], acc[ai][bj][m][n], 0, 0, 0); __builtin_amdgcn_s_setprio(0); } while (0)
#define PG8_WAIT_V(n) asm volatile("s_waitcnt vmcnt(" #n ")" ::: "memory")
#define PG8_WAIT_L(n) asm volatile("s_waitcnt lgkmcnt(" #n ")" ::: "memory")
#define PG8_BAR __builtin_amdgcn_s_barrier()
#define PG8_SCHED __builtin_amdgcn_sched_barrier(0)
    Unit cur, nxt; int ui = 0;
    if (!S.next(0, cur)) return;
    f32x4 acc[2][2][4][2];
#pragma unroll
    for (int a = 0; a < 2; ++a)
#pragma unroll
        for (int b = 0; b < 2; ++b)
#pragma unroll
            for (int m = 0; m < 4; ++m)
#pragma unroll
                for (int n = 0; n < 2; ++n) acc[a][b][m][n] = (f32x4){0.f, 0.f, 0.f, 0.f};
    bf16x8 At[4][2], B0[2][2], B1[2][2];
    const char* cA = (const char*)g.A + (size_t)cur.pm * tstep; const char* cB = (const char*)g.Bt + (size_t)cur.pn * tstep;
    S.a_ready(cur);
    if constexpr (SP2) {
        PG8_STAGE(PG8_SB(0, 0), cB, voffB); PG8_STAGE(PG8_SB(0, 1), cB + hstep, voffB); PG8_STAGE(PG8_SA(0, 0), cA, voffA); PG8_STAGE(PG8_SA(0, 1), cA + hstep, voffA);
        if (wr == 1) PG8_BAR;
        PG8_WAIT_V(2); PG8_BAR;
        PG8_STAGE(PG8_SB(1, 0), cB + kstep, voffB); PG8_STAGE(PG8_SA(1, 0), cA + kstep, voffA); PG8_STAGE(PG8_SB(1, 1), cB + hstep + kstep, voffB);
        PG8_WAIT_V(6); PG8_BAR;
    } else {
        PG8_STAGE(PG8_SB(0, 0), cB, voffB); PG8_STAGE(PG8_SA(0, 0), cA, voffA); PG8_STAGE(PG8_SB(0, 1), cB + hstep, voffB); PG8_STAGE(PG8_SA(0, 1), cA + hstep, voffA);
        if (wr == 1) PG8_BAR;
        PG8_WAIT_V(4); PG8_BAR;
        PG8_STAGE(PG8_SB(1, 0), cB + kstep, voffB); PG8_STAGE(PG8_SA(1, 0), cA + kstep, voffA); PG8_STAGE(PG8_SB(1, 1), cB + hstep + kstep, voffB);
        PG8_WAIT_V(6); PG8_BAR;
    }
    for (;;) {
        const bool has_next = S.next(ui + 1, nxt);
        const char* nA = has_next ? (const char*)g.A + (size_t)nxt.pm * tstep : cA; const char* nB = has_next ? (const char*)g.Bt + (size_t)nxt.pn * tstep : cB;
        for (int t = 0; t < nt; t += 2) {
            const bool last = (t == nt - 2);
            const char* a1 = cA + (size_t)(t + 1) * kstep;
            const char* a2 = last ? nA : cA + (size_t)(t + 2) * kstep; const char* b2 = last ? nB : cB + (size_t)(t + 2) * kstep;
            const char* a3 = a2 + kstep; const char* b3 = b2 + kstep;
            if (last && has_next) S.a_ready(nxt);
            if constexpr (SP2) {
            PG8_LDB(B0, 0, 0); PG8_LDB(B1, 0, 1); PG8_SCHED; PG8_LDA(At, 0, 0); PG8_STAGE(PG8_SA(1, 1), a1 + hstep, voffA);
            PG8_WAIT_V(8); PG8_WAIT_L(0); PG8_BAR; PG8_MMA(0, 0, At, B0); PG8_MMA(0, 1, At, B1); PG8_BAR; PG8_SCHED;
            PG8_LDA(At, 0, 1); PG8_STAGE(PG8_SB(0, 0), b2, voffB); PG8_STAGE(PG8_SB(0, 1), b2 + hstep, voffB); PG8_STAGE(PG8_SA(0, 0), a2, voffA);
            PG8_WAIT_V(8); PG8_WAIT_L(0); PG8_BAR; PG8_MMA(1, 0, At, B0); PG8_MMA(1, 1, At, B1); PG8_BAR; PG8_SCHED;
            PG8_LDB(B0, 1, 0); PG8_LDB(B1, 1, 1); PG8_SCHED; PG8_LDA(At, 1, 0); PG8_STAGE(PG8_SA(0, 1), a2 + hstep, voffA);
            PG8_WAIT_V(8); PG8_WAIT_L(0); PG8_BAR; PG8_MMA(0, 0, At, B0); PG8_MMA(0, 1, At, B1); PG8_BAR; PG8_SCHED;
            PG8_LDA(At, 1, 1); PG8_STAGE(PG8_SB(1, 0), b3, voffB); PG8_STAGE(PG8_SB(1, 1), b3 + hstep, voffB); PG8_STAGE(PG8_SA(1, 0), a3, voffA);
            PG8_WAIT_V(8); PG8_WAIT_L(0); PG8_BAR; PG8_MMA(1, 0, At, B0); PG8_MMA(1, 1, At, B1); PG8_BAR; PG8_SCHED;
            } else {
            PG8_LDB(B0, 0, 0); PG8_SCHED; PG8_LDA(At, 0, 0); PG8_STAGE(PG8_SA(1, 1), a1 + hstep, voffA);
            PG8_WAIT_L(8); PG8_BAR; PG8_WAIT_L(0); PG8_MMA(0, 0, At, B0); PG8_BAR; PG8_SCHED;
            PG8_LDB(B1, 0, 1); PG8_STAGE(PG8_SB(0, 0), b2, voffB);
            PG8_BAR; PG8_WAIT_L(0); PG8_MMA(0, 1, At, B1); PG8_BAR;
            PG8_LDA(At, 0, 1); PG8_STAGE(PG8_SA(0, 0), a2, voffA);
            PG8_BAR; PG8_WAIT_L(0); PG8_MMA(1, 0, At, B0); PG8_BAR; PG8_SCHED;
            PG8_STAGE(PG8_SB(0, 1), b2 + hstep, voffB);
            PG8_WAIT_V(6); PG8_BAR; PG8_MMA(1, 1, At, B1); PG8_BAR;
            PG8_LDB(B0, 1, 0); PG8_SCHED; PG8_LDA(At, 1, 0); PG8_STAGE(PG8_SA(0, 1), a2 + hstep, voffA);
            PG8_WAIT_L(8); PG8_BAR; PG8_WAIT_L(0); PG8_MMA(0, 0, At, B0); PG8_BAR; PG8_SCHED;
            PG8_LDB(B1, 1, 1); PG8_STAGE(PG8_SB(1, 0), b3, voffB);
            PG8_BAR; PG8_WAIT_L(0); PG8_MMA(0, 1, At, B1); PG8_BAR;
            PG8_LDA(At, 1, 1); PG8_STAGE(PG8_SA(1, 0), a3, voffA);
            PG8_BAR; PG8_WAIT_L(0); PG8_MMA(1, 0, At, B0); PG8_BAR; PG8_SCHED;
            PG8_STAGE(PG8_SB(1, 1), b3 + hstep, voffB);
            PG8_WAIT_V(6); PG8_BAR; PG8_MMA(1, 1, At, B1); PG8_BAR;
            }
        }
        if constexpr (ALIGN_EPI) { if (wr == 0) PG8_BAR; }
        if constexpr (!Epi::AFTER_DRAIN) { E(acc, cur, wr, wc, fr, fq); S.done(cur); }
        if (!has_next) break;
#pragma unroll
        for (int a = 0; a < 2; ++a)
#pragma unroll
            for (int b = 0; b < 2; ++b)
#pragma unroll
                for (int m = 0; m < 4; ++m)
#pragma unroll
                    for (int n = 0; n < 2; ++n) acc[a][b][m][n] = (f32x4){0.f, 0.f, 0.f, 0.f};
        cur = nxt; cA = nA; cB = nB; ++ui;
        if constexpr (ALIGN_EPI) { if (wr == 1) PG8_BAR; }
    }
    PG8_WAIT_V(0);
    if constexpr (!ALIGN_EPI) { if (wr == 0) PG8_BAR; }
    PG8_BAR;
    if constexpr (Epi::AFTER_DRAIN) { E.fused(acc, cur, wr, wc, fr, fq, lds, wid, lane); S.done(cur); }
#undef PG8_SA
#undef PG8_SB
#undef PG8_STAGE
#undef PG8_LDA
#undef PG8_LDB
#undef PG8_MMA
#undef PG8_WAIT_V
#undef PG8_WAIT_L
#undef PG8_BAR
#undef PG8_SCHED
}
}
constexpr int NWAVES = 8;
constexpr int BATCH = 4, T = 4096, D = 2048, M = BATCH * T;
constexpr int PLE_DIM = 256, FFN = 5632, MOE = 7168, NE = 8;
constexpr int REC_IN = 8208, UW = 8192, NREC = 8448;
constexpr int U_QA = 0, U_KA = 512, U_VA = 1024, U_OA = 2048, U_QB = 3072, U_FF = 4096, U_FB = 5120, U_IB = 6144, U_GB = 7168;
constexpr int NQKV = 6144;
constexpr int XS_ROWS = 34816;
constexpr float LN_EPS = 1e-5f, RMS_EPS = 1e-6f, ALPHA = 1.41421356237f, GATE_CAP = 15.0f;

constexpr size_t MiB = 1u << 20;
constexpr size_t WS_CTL = 0, CTL_ZERO_BYTES = 1 * MiB;
constexpr size_t WS_TOKE = 1 * MiB, WS_TOKG = WS_TOKE + 256 * 1024, WS_DEST = WS_TOKG + 256 * 1024, WS_WGCNT = WS_DEST + 256 * 1024, WS_TILEE = WS_WGCNT + 64 * 1024;
constexpr size_t WS_WQKV = 4 * MiB, WS_WNAO = 28 * MiB, WS_WPG1 = 36 * MiB, WS_WPP1 = 44 * MiB, WS_WMGU = 48 * MiB, WS_WMDN = 496 * MiB;
constexpr size_t WS_XB0 = 720 * MiB, WS_XB1 = 784 * MiB, WS_PB = 848 * MiB, WS_G = 864 * MiB;
constexpr size_t WS_WRIN = 872 * MiB, WS_WROUT = 905 * MiB, WS_WFGU = 913 * MiB, WS_WFDN = 957 * MiB, WS_WPG0 = 979 * MiB, WS_WPP0 = 987 * MiB;
constexpr size_t WS_U = 992 * MiB, WS_HA = 1248 * MiB, WS_HB = 1376 * MiB, WS_Y = 1504 * MiB;
constexpr size_t WS_H = 992 * MiB;
constexpr size_t WS_PP = 1248 * MiB;
constexpr size_t WS_QKV = 992 * MiB;
constexpr size_t WS_AO = WS_Y;
constexpr size_t WS_HM = 872 * MiB;
constexpr size_t WS_YS = 1348 * MiB;
constexpr size_t WS_XS = 1348 * MiB;
constexpr size_t WS_PP1 = 872 * MiB;
constexpr size_t WS_END = 1620 * MiB;
static_assert(WS_WMGU + (size_t)NE * 2 * MOE * D * 2 <= WS_WMDN && WS_WMDN + (size_t)NE * D * MOE * 2 <= WS_XB0, "ws map 1");
static_assert(WS_WRIN + (size_t)NREC * D * 2 <= WS_WROUT && WS_WFGU + (size_t)2 * FFN * D * 2 <= WS_WFDN && WS_WFDN + (size_t)D * FFN * 2 <= WS_WPG0 && WS_WPP0 + (size_t)D * PLE_DIM * 2 <= WS_U, "ws map 2");
static_assert(WS_U + (size_t)M * UW * 2 <= WS_HA && WS_H + (size_t)M * FFN * 2 <= WS_HA && WS_QKV + (size_t)M * NQKV * 2 <= WS_HA, "ws map 3");
static_assert(WS_HM + (size_t)XS_ROWS * MOE * 2 <= WS_YS && WS_YS + (size_t)XS_ROWS * D * 4 <= WS_END && WS_XS + (size_t)XS_ROWS * D * 2 <= WS_Y, "ws map 4");
constexpr int CW_BAR = 4096;

constexpr int RING_OFF = 0, RING_BYTES = 131072;
constexpr int LDSCTL_OFF = RING_BYTES, MISC_OFF = LDSCTL_OFF + 320;
constexpr int LDS_BYTES = 147456;
static_assert(MISC_OFF + 128 <= LDS_BYTES, "LDS map");

#define GAS __attribute__((address_space(1)))
#define LAS __attribute__((address_space(3)))
typedef unsigned short bf16;
typedef unsigned v4u __attribute__((ext_vector_type(4)));
typedef unsigned v2u __attribute__((ext_vector_type(2)));
typedef float f32x4 __attribute__((ext_vector_type(4)));
typedef float f32x2 __attribute__((ext_vector_type(2)));
typedef GAS unsigned gu32;
#define RLX_AGENT __ATOMIC_RELAXED, __HIP_MEMORY_SCOPE_AGENT
#define LDS_WAIT() asm volatile("s_waitcnt lgkmcnt(0)" ::: "memory")
#define VM_WAIT() asm volatile("s_waitcnt vmcnt(0)" ::: "memory")
__device__ __forceinline__ unsigned f2bf(float f) { unsigned u = __builtin_bit_cast(unsigned, f); return (u + 0x7fffu + ((u >> 16) & 1u)) >> 16; }
__device__ __forceinline__ unsigned pk2(float lo, float hi) { return f2bf(lo) | (f2bf(hi) << 16); }
__device__ __forceinline__ float bflo(unsigned w) { return __builtin_bit_cast(float, w << 16); }
__device__ __forceinline__ float bfhi(unsigned w) { return __builtin_bit_cast(float, w & 0xffff0000u); }
__device__ __forceinline__ float bf1(bf16 h) { return __builtin_bit_cast(float, (unsigned)h << 16); }
__device__ __forceinline__ float sigm(float x) { return 1.0f / (1.0f + __expf(-x)); }
#define XB_TMO      128
#define XB_XCNT(j)  (256  + 64 * (j))
#define XB_XSUB(j)  (1280 + 64 * (j))
#define XB_XGEN(j)  (2304 + 64 * (j))
#define XB_TOP      3328
#define XB_TOPGEN   3392
#define XCD_BAR_WORDS 3456
#define XB_SPIN_CAP (1u << 18)

__device__ __forceinline__ unsigned xb_ld(unsigned* p)              { return __hip_atomic_load(p, __ATOMIC_RELAXED, __HIP_MEMORY_SCOPE_AGENT); }
__device__ __forceinline__ unsigned xb_add(unsigned* p, unsigned v) { return __hip_atomic_fetch_add(p, v, __ATOMIC_RELAXED, __HIP_MEMORY_SCOPE_AGENT); }
__device__ __forceinline__ unsigned xb_xcc_id() { return (unsigned)__builtin_amdgcn_s_getreg((3 << 11) | 20) & 0xFu; }
#define XB_SPIN(cond, bar) do { unsigned _sp = 0; while (cond) { __builtin_amdgcn_s_sleep(1); \
    if ((++_sp & 255u) == 0u) { if (xb_ld(&(bar)[XB_TMO])) break; if (_sp > XB_SPIN_CAP) { atomicAdd(&(bar)[XB_TMO], 1u); break; } } } } while (0)

struct XcdBarrier {
    unsigned* bar; unsigned x;
    volatile LAS unsigned* st;
};

__device__ __forceinline__ XcdBarrier xcd_barrier_post(unsigned* bar, volatile LAS unsigned* st, int wave_s) {
    XcdBarrier b; b.bar = bar; b.x = xb_xcc_id(); b.st = st;
    if (wave_s == 0 && lane_now() == 0) (void)xb_add(&bar[XB_XCNT(b.x)], 1u);
    return b;
}
__device__ __forceinline__ void xcd_barrier_complete(unsigned* bar, unsigned x, unsigned& nloc, unsigned& nx) {
    const unsigned G = gridDim.x * gridDim.y * gridDim.z;
    unsigned sum, cnt, mine, sp = 0u;
    for (;;) {
        sum = 0u; cnt = 0u; mine = 0u;
#pragma unroll
        for (unsigned j = 0; j < 16; ++j) { const unsigned c = xb_ld(&bar[XB_XCNT(j)]); sum += c; cnt += (c > 0u) ? 1u : 0u; mine = (j == x) ? c : mine; }
        if (sum == G) break;
        __builtin_amdgcn_s_sleep(1);
        if ((++sp & 255u) == 0u) { if (xb_ld(&bar[XB_TMO])) break; if (sp > XB_SPIN_CAP) { atomicAdd(&bar[XB_TMO], 1u); break; } }
    }
    nloc = mine > 0u ? mine : 1u; nx = cnt > 0u ? cnt : 1u;
}

__device__ __forceinline__ void xcd_barrier(const XcdBarrier& b, int wave_s) {
    asm volatile("s_waitcnt vmcnt(0)" ::: "memory");
    __syncthreads();
    if (wave_s == 0 && lane_now() == 0) {
        unsigned* bar = b.bar;
        __builtin_amdgcn_s_waitcnt(0);
        unsigned nloc = b.st[0], nx = b.st[1];
        if (nloc == 0u) { xcd_barrier_complete(bar, b.x, nloc, nx); b.st[0] = nloc; b.st[1] = nx; }
        const unsigned old = xb_add(&bar[XB_XSUB(b.x)], 1u);
        const unsigned gen = old / nloc;
        if (old + 1u == (gen + 1u) * nloc) {
            __builtin_amdgcn_fence(__ATOMIC_RELEASE, "agent");
            asm volatile("s_waitcnt vmcnt(0)" ::: "memory");
            const unsigned og = xb_add(&bar[XB_TOP], 1u);
            const unsigned tg = og / nx;
            if (og + 1u == (tg + 1u) * nx) xb_add(&bar[XB_TOPGEN], 1u);
            else XB_SPIN(xb_ld(&bar[XB_TOPGEN]) == tg, bar);
            __builtin_amdgcn_fence(__ATOMIC_ACQUIRE, "agent");
            xb_add(&bar[XB_XGEN(b.x)], 1u);
            asm volatile("s_waitcnt vmcnt(0)" ::: "memory");
        } else {
            XB_SPIN(xb_ld(&bar[XB_XGEN(b.x)]) == gen, bar);
            __builtin_amdgcn_fence(__ATOMIC_ACQUIRE, "agent");
            asm volatile("s_waitcnt vmcnt(0)" ::: "memory");
        }
    }
    __syncthreads();
}

struct Frame {
    LAS unsigned char* lds;
    int wave, G;
};
struct Args { const float* in[23]; float* out; unsigned char* ws; int ph_lo, ph_hi; };
enum { I_X = 0, I_P, I_LNW, I_LNB, I_RECWIN, I_GBIAS, I_MNORM, I_LBLOG, I_HNORM, I_RECWOUT, I_FWG, I_FWU, I_FWD, I_NAQKV, I_RPB, I_NAOUT, I_WR, I_BR, I_MWG, I_MWU, I_MWD, I_PLEG, I_PLEP };

__device__ __forceinline__ float wave_sum(float v) {
#pragma unroll
    for (int o = 1; o < 64; o <<= 1) v += __shfl_xor(v, o);
    return v;
}
__device__ __forceinline__ float wave_max(float v) {
#pragma unroll
    for (int o = 1; o < 64; o <<= 1) v = fmaxf(v, __shfl_xor(v, o));
    return v;
}

__device__ __forceinline__ void tr_item(const float* W, int ldn, int K, int srcc, int nvalid, bf16* WT, size_t drow, int k0, LAS float* scr, int lane) {
    const int c = lane & 31;
#pragma unroll 8
    for (int i = 0; i < 32; ++i) { const int kk = 2 * i + (lane >> 5); scr[kk * 33 + c] = (c < nvalid) ? W[(size_t)(k0 + kk) * ldn + srcc + c] : 0.f; }
    LDS_WAIT(); asm volatile("" ::: "memory");
    const int c8 = lane & 7;
#pragma unroll
    for (int j = 0; j < 4; ++j) { const int n = (lane >> 3) + 8 * j; const LAS float* s = scr + (8 * c8) * 33 + n;
        v4u o; o.x = pk2(s[0 * 33], s[1 * 33]); o.y = pk2(s[2 * 33], s[3 * 33]); o.z = pk2(s[4 * 33], s[5 * 33]); o.w = pk2(s[6 * 33], s[7 * 33]);
        *(GAS v4u*)(WT + (drow + n) * (size_t)K + k0 + 8 * c8) = o; }
    LDS_WAIT(); asm volatile("" ::: "memory");
}
__device__ __forceinline__ void p0_prologue(const Frame& F, const Args& A) {
    const int lane = lane_now(), tid = F.wave * 64 + lane; (void)tid;
    LAS float* scr = (LAS float*)(F.lds + RING_OFF + F.wave * 16384);
    const int gw = blockIdx.x * NWAVES + F.wave, NGW = F.G * NWAVES;
    unsigned char* ws = A.ws;
    constexpr int N_RIN = 32 * (NREC / 32), N_ROUT = 32 * 64, N_FGU = 32 * (2 * FFN / 32), N_FDN = (FFN / 64) * 64, N_PG = 32 * 64, N_PP = 4 * 64, N_QKV = 32 * (NQKV / 32), N_NAO = 32 * 64;
    constexpr int N_MGU = 32 * (NE * 2 * MOE / 32), N_MDN = (MOE / 64) * (NE * D / 32);
    constexpr int NITEMS = N_RIN + N_ROUT + N_FGU + N_FDN + 2 * N_PG + 2 * N_PP + N_QKV + N_NAO + N_MGU + N_MDN;
    for (int it = gw; it < NITEMS; it += NGW) {
        int r = it; const float* W; bf16* WT; int ldn, K, nblk;
        int srcc, nvalid = 32; size_t drow; int kb, nb;
        if (r < N_RIN) { W = A.in[I_RECWIN]; WT = (bf16*)(ws + WS_WRIN); ldn = REC_IN; K = D; nblk = NREC / 32; kb = r / nblk; nb = r % nblk; drow = (size_t)nb * 32;
            if (nb < 96) srcc = nb * 32; else if (nb < 256) srcc = nb * 32 + 16; else { srcc = 3072; nvalid = (nb == 256) ? 16 : 0; } }
        else if ((r -= N_RIN) < N_ROUT) { W = A.in[I_RECWOUT]; WT = (bf16*)(ws + WS_WROUT); ldn = D; K = D; nblk = 64; kb = r / nblk; nb = r % nblk; drow = (size_t)nb * 32; srcc = nb * 32; }
        else if ((r -= N_ROUT) < N_FGU) { WT = (bf16*)(ws + WS_WFGU); ldn = FFN; K = D; nblk = 2 * FFN / 32; kb = r / nblk; nb = r % nblk; drow = (size_t)nb * 32;
            const int tile = nb >> 3, w = nb & 7; W = (w < 4) ? A.in[I_FWG] : A.in[I_FWU]; srcc = tile * 128 + (w & 3) * 32; }
        else if ((r -= N_FGU) < N_FDN) { W = A.in[I_FWD]; WT = (bf16*)(ws + WS_WFDN); ldn = D; K = FFN; nblk = 64; kb = r / nblk; nb = r % nblk; drow = (size_t)nb * 32; srcc = nb * 32; }
        else if ((r -= N_FDN) < 2 * N_PG) { const int l = r / N_PG; r -= l * N_PG; W = A.in[I_PLEG] + (size_t)l * D * D; WT = (bf16*)(ws + (l ? WS_WPG1 : WS_WPG0)); ldn = D; K = D; nblk = 64; kb = r / nblk; nb = r % nblk; drow = (size_t)nb * 32; srcc = nb * 32; }
        else if ((r -= 2 * N_PG) < 2 * N_PP) { const int l = r / N_PP; r -= l * N_PP; W = A.in[I_PLEP] + (size_t)l * PLE_DIM * D; WT = (bf16*)(ws + (l ? WS_WPP1 : WS_WPP0)); ldn = D; K = PLE_DIM; nblk = 64; kb = r / nblk; nb = r % nblk; drow = (size_t)nb * 32; srcc = nb * 32; }
        else if ((r -= 2 * N_PP) < N_QKV) { W = A.in[I_NAQKV]; WT = (bf16*)(ws + WS_WQKV); ldn = NQKV; K = D; nblk = NQKV / 32; kb = r / nblk; nb = r % nblk; drow = (size_t)nb * 32; srcc = nb * 32; }
        else if ((r -= N_QKV) < N_NAO) { W = A.in[I_NAOUT]; WT = (bf16*)(ws + WS_WNAO); ldn = D; K = D; nblk = 64; kb = r / nblk; nb = r % nblk; drow = (size_t)nb * 32; srcc = nb * 32; }
        else if ((r -= N_NAO) < N_MGU) { WT = (bf16*)(ws + WS_WMGU); ldn = MOE; K = D; nblk = NE * 2 * MOE / 32; kb = r / nblk; nb = r % nblk; drow = (size_t)nb * 32;
            const int e = nb / (2 * MOE / 32), nl = nb % (2 * MOE / 32), tile = nl >> 3, w = nl & 7; W = ((w < 4) ? A.in[I_MWG] : A.in[I_MWU]) + (size_t)e * D * MOE; srcc = tile * 128 + (w & 3) * 32; }
        else { r -= N_MGU; WT = (bf16*)(ws + WS_WMDN); ldn = D; K = MOE; nblk = NE * D / 32; kb = r / nblk; nb = r % nblk; drow = (size_t)nb * 32;
            const int e = nb / (D / 32), nl = nb % (D / 32); W = A.in[I_MWD] + (size_t)e * MOE * D; srcc = nl * 32; }
        tr_item(W, ldn, K, srcc, nvalid, WT, drow, kb * 64, scr, lane);
    }
    const size_t gt = (size_t)blockIdx.x * (NWAVES * 64) + tid, NGT = (size_t)F.G * NWAVES * 64;
    { const GAS f32x4* src = (const GAS f32x4*)A.in[I_X]; GAS v4u* dst = (GAS v4u*)(ws + WS_XB0);
      for (size_t i = gt; i < (size_t)M * D / 8; i += NGT) { const f32x4 a = src[2 * i], b = src[2 * i + 1]; v4u o; o.x = pk2(a[0], a[1]); o.y = pk2(a[2], a[3]); o.z = pk2(b[0], b[1]); o.w = pk2(b[2], b[3]); dst[i] = o; } }
    { const GAS f32x4* src = (const GAS f32x4*)A.in[I_P]; GAS v4u* dst = (GAS v4u*)(ws + WS_PB);
      for (size_t i = gt; i < (size_t)2 * M * PLE_DIM / 8; i += NGT) { const f32x4 a = src[2 * i], b = src[2 * i + 1]; v4u o; o.x = pk2(a[0], a[1]); o.y = pk2(a[2], a[3]); o.z = pk2(b[0], b[1]); o.w = pk2(b[2], b[3]); dst[i] = o; } }
}

constexpr int RB = 32;
#define T0_OF(blk) (dir ? (T - RB - (blk) * RB) : (blk) * RB)
__device__ __forceinline__ void mlstm_unit(const Frame& F, const Args& A, int unit) {
    const int lane = lane_now(), tid = F.wave * 64 + lane; (void)tid;
    const int cg = unit & 3, dir = (unit >> 2) & 1, h = (unit >> 3) & 3, b = unit >> 5;
    LAS float* qs = (LAS float*)(F.lds + RING_OFF);
    LAS float* ks = qs + RB * 128;
    LAS float* vs = ks + RB * 128;
    LAS float* fi = vs + RB * 64;
    LAS float* ob = fi + RB * 2;
    const bf16* U = (const bf16*)(A.ws + WS_U); const float* Gt = (const float*)(A.ws + WS_G);
    float* HA = (float*)(A.ws + WS_HA) + (size_t)dir * M * 1024;
    const int e = lane & 7, dg = lane >> 3, colw = F.wave * 8 + e;
    const int srow = tid >> 4, sc = tid & 15;
    const float bias_i = A.in[I_GBIAS][(dir ? 2 : 0) * 4 + h], bias_f = A.in[I_GBIAS][(dir ? 3 : 1) * 4 + h];
    float C[16], n[16];
#pragma unroll
    for (int j = 0; j < 16; ++j) { C[j] = 0.f; n[j] = 0.f; }
    v4u rq, rk; v2u rv; float rgi = 0.f, rgf = 0.f;
    {   const size_t row = (size_t)b * T + T0_OF(0) + srow; const bf16* ur = U + row * UW;
        rq = *(const GAS v4u*)(ur + U_QA + h * 128 + sc * 8); rk = *(const GAS v4u*)(ur + U_KA + h * 128 + sc * 8); rv = *(const GAS v2u*)(ur + U_VA + h * 256 + cg * 64 + sc * 4);
        if (tid < RB) { const size_t r2 = (size_t)b * T + T0_OF(0) + tid; rgi = Gt[r2 * 16 + (dir ? 2 : 0) * 4 + h]; rgf = Gt[r2 * 16 + (dir ? 3 : 1) * 4 + h]; } }
    for (int blk = 0; blk < T / RB; ++blk) {
        const int t0 = T0_OF(blk);
        {   const float qsc = 0.08838834764831845f;
            LAS float* qd = qs + srow * 128 + sc * 8; LAS float* kd = ks + srow * 128 + sc * 8;
            *(LAS f32x4*)qd = (f32x4){bflo(rq.x) * qsc, bfhi(rq.x) * qsc, bflo(rq.y) * qsc, bfhi(rq.y) * qsc}; *(LAS f32x4*)(qd + 4) = (f32x4){bflo(rq.z) * qsc, bfhi(rq.z) * qsc, bflo(rq.w) * qsc, bfhi(rq.w) * qsc};
            *(LAS f32x4*)kd = (f32x4){bflo(rk.x), bfhi(rk.x), bflo(rk.y), bfhi(rk.y)}; *(LAS f32x4*)(kd + 4) = (f32x4){bflo(rk.z), bfhi(rk.z), bflo(rk.w), bfhi(rk.w)};
            *(LAS f32x4*)(vs + srow * 64 + sc * 4) = (f32x4){bflo(rv.x), bfhi(rv.x), bflo(rv.y), bfhi(rv.y)};
            if (tid < RB) { const float gi = GATE_CAP * tanhf((rgi + bias_i) * (1.0f / GATE_CAP)), gf = GATE_CAP * tanhf((rgf + bias_f) * (1.0f / GATE_CAP));
                fi[tid * 2] = sigm(gf); fi[tid * 2 + 1] = __expf(gi); } }
        __syncthreads();
        if (blk + 1 < T / RB) { const size_t row = (size_t)b * T + T0_OF(blk + 1) + srow; const bf16* ur = U + row * UW;
            rq = *(const GAS v4u*)(ur + U_QA + h * 128 + sc * 8); rk = *(const GAS v4u*)(ur + U_KA + h * 128 + sc * 8); rv = *(const GAS v2u*)(ur + U_VA + h * 256 + cg * 64 + sc * 4);
            if (tid < RB) { const size_t r2 = (size_t)b * T + T0_OF(blk + 1) + tid; rgi = Gt[r2 * 16 + (dir ? 2 : 0) * 4 + h]; rgf = Gt[r2 * 16 + (dir ? 3 : 1) * 4 + h]; } }
        for (int s = 0; s < RB; ++s) {
            const int tl = dir ? (RB - 1 - s) : s;
            const float f = fi[tl * 2], ii = fi[tl * 2 + 1], v = vs[tl * 64 + colw];
            const LAS f32x4* qp = (const LAS f32x4*)(qs + tl * 128 + dg * 16); const LAS f32x4* kp = (const LAS f32x4*)(ks + tl * 128 + dg * 16);
            float num = 0.f, den = 0.f;
#pragma unroll
            for (int j4 = 0; j4 < 4; ++j4) { const f32x4 q4 = qp[j4], k4 = kp[j4];
#pragma unroll
                for (int i = 0; i < 4; ++i) { const int j = j4 * 4 + i; const float kk = ii * k4[i]; C[j] = f * C[j] + kk * v; n[j] = f * n[j] + kk; num += C[j] * q4[i]; den += n[j] * q4[i]; } }
            num += __shfl_xor(num, 8); den += __shfl_xor(den, 8); num += __shfl_xor(num, 16); den += __shfl_xor(den, 16); num += __shfl_xor(num, 32); den += __shfl_xor(den, 32);
            if (dg == 0) ob[tl * 64 + colw] = num / fmaxf(fabsf(den), 1.0f);
        }
        __syncthreads();
        *(GAS f32x4*)(HA + ((size_t)b * T + t0 + srow) * 1024 + h * 256 + cg * 64 + sc * 4) = *(const LAS f32x4*)(ob + srow * 64 + sc * 4);
    }
    __syncthreads();
}
__device__ __forceinline__ void hgrn_unit(const Frame& F, const Args& A, int unit) {
    const int lane = lane_now(), tid = F.wave * 64 + lane; (void)tid;
    const int cg = unit & 1, dir = (unit >> 1) & 1, h = (unit >> 2) & 7, b = unit >> 5;
    LAS float* qs = (LAS float*)(F.lds + RING_OFF);
    LAS float* fs = qs + RB * 128;
    LAS float* vs = fs + RB * 128;
    LAS float* ob = vs + RB * 64;
    const bf16* U = (const bf16*)(A.ws + WS_U);
    float* HB = (float*)(A.ws + WS_HB) + (size_t)dir * M * 1024;
    const int e = lane & 7, dg = lane >> 3, colw = F.wave * 8 + e;
    const int srow = tid >> 4, sc = tid & 15;
    float lb[8];
#pragma unroll
    for (int i = 0; i < 8; ++i) { const float l0 = A.in[I_LBLOG][(dir * 2 + 0) * 1024 + h * 128 + sc * 8 + i], l1 = A.in[I_LBLOG][(dir * 2 + 1) * 1024 + h * 128 + sc * 8 + i]; lb[i] = 1.0f / (1.0f + __expf(l1 - l0)); }
    float S[16];
#pragma unroll
    for (int j = 0; j < 16; ++j) S[j] = 0.f;
    v4u rq, rf; v2u rv;
    {   const size_t row = (size_t)b * T + T0_OF(0) + srow; const bf16* ur = U + row * UW;
        rq = *(const GAS v4u*)(ur + U_QB + h * 128 + sc * 8); rf = *(const GAS v4u*)(ur + (dir ? U_FB : U_FF) + h * 128 + sc * 8); rv = *(const GAS v2u*)(ur + U_IB + h * 128 + cg * 64 + sc * 4); }
    for (int blk = 0; blk < T / RB; ++blk) {
        const int t0 = T0_OF(blk);
        {   LAS float* qd = qs + srow * 128 + sc * 8; LAS float* fd = fs + srow * 128 + sc * 8;
            float qv[8] = {bflo(rq.x), bfhi(rq.x), bflo(rq.y), bfhi(rq.y), bflo(rq.z), bfhi(rq.z), bflo(rq.w), bfhi(rq.w)};
            float fv[8] = {bflo(rf.x), bfhi(rf.x), bflo(rf.y), bfhi(rf.y), bflo(rf.z), bfhi(rf.z), bflo(rf.w), bfhi(rf.w)};
#pragma unroll
            for (int i = 0; i < 8; ++i) { qv[i] = qv[i] * sigm(qv[i]); fv[i] = lb[i] + (1.0f - lb[i]) * sigm(fv[i]); }
            *(LAS f32x4*)qd = (f32x4){qv[0], qv[1], qv[2], qv[3]}; *(LAS f32x4*)(qd + 4) = (f32x4){qv[4], qv[5], qv[6], qv[7]};
            *(LAS f32x4*)fd = (f32x4){fv[0], fv[1], fv[2], fv[3]}; *(LAS f32x4*)(fd + 4) = (f32x4){fv[4], fv[5], fv[6], fv[7]};
            *(LAS f32x4*)(vs + srow * 64 + sc * 4) = (f32x4){bflo(rv.x), bfhi(rv.x), bflo(rv.y), bfhi(rv.y)}; }
        __syncthreads();
        if (blk + 1 < T / RB) { const size_t row = (size_t)b * T + T0_OF(blk + 1) + srow; const bf16* ur = U + row * UW;
            rq = *(const GAS v4u*)(ur + U_QB + h * 128 + sc * 8); rf = *(const GAS v4u*)(ur + (dir ? U_FB : U_FF) + h * 128 + sc * 8); rv = *(const GAS v2u*)(ur + U_IB + h * 128 + cg * 64 + sc * 4); }
        for (int s = 0; s < RB; ++s) {
            const int tl = dir ? (RB - 1 - s) : s;
            const float v = vs[tl * 64 + colw];
            const LAS f32x4* qp = (const LAS f32x4*)(qs + tl * 128 + dg * 16); const LAS f32x4* fp = (const LAS f32x4*)(fs + tl * 128 + dg * 16);
            float o = 0.f;
#pragma unroll
            for (int j4 = 0; j4 < 4; ++j4) { const f32x4 q4 = qp[j4], f4 = fp[j4];
#pragma unroll
                for (int i = 0; i < 4; ++i) { const int j = j4 * 4 + i; S[j] = f4[i] * S[j] + (1.0f - f4[i]) * v; o += S[j] * q4[i]; } }
            o += __shfl_xor(o, 8); o += __shfl_xor(o, 16); o += __shfl_xor(o, 32);
            if (dg == 0) ob[tl * 64 + colw] = o;
        }
        __syncthreads();
        *(GAS f32x4*)(HB + ((size_t)b * T + t0 + srow) * 1024 + h * 128 + cg * 64 + sc * 4) = *(const LAS f32x4*)(ob + srow * 64 + sc * 4);
    }
    __syncthreads();
}
__device__ __forceinline__ void p3_finalize(const Frame& F, const Args& A) {
    const int lane = lane_now(), tid = F.wave * 64 + lane; (void)tid;
    const int gw = blockIdx.x * NWAVES + F.wave, NGW = F.G * NWAVES;
    const bf16* U = (const bf16*)(A.ws + WS_U); bf16* Y = (bf16*)(A.ws + WS_Y);
    const float* HA = (const float*)(A.ws + WS_HA); const float* HB = (const float*)(A.ws + WS_HB);
    for (int row = gw; row < M; row += NGW) {
        const bf16* ur = U + (size_t)row * UW; bf16* yr = Y + (size_t)row * D;
#pragma unroll
        for (int h = 0; h < 4; ++h) { const int c = h * 256 + lane * 4;
            const f32x4 a = *(const GAS f32x4*)(HA + (size_t)row * 1024 + c), bq = *(const GAS f32x4*)(HA + (size_t)M * 1024 + (size_t)row * 1024 + c);
            const f32x4 s = a + bq; float ss = (s[0] * s[0] + s[1] * s[1]) + (s[2] * s[2] + s[3] * s[3]); ss = wave_sum(ss);
            const float r = 1.0f / sqrtf(ss * (1.0f / 256.0f) + RMS_EPS);
            const f32x4 w = *(const GAS f32x4*)(A.in[I_MNORM] + c); const v2u og = *(const GAS v2u*)(ur + U_OA + c);
            const float o0 = s[0] * r * w[0] * sigm(bflo(og.x)), o1 = s[1] * r * w[1] * sigm(bfhi(og.x)), o2 = s[2] * r * w[2] * sigm(bflo(og.y)), o3 = s[3] * r * w[3] * sigm(bfhi(og.y));
            v2u o; o.x = pk2(o0, o1); o.y = pk2(o2, o3); *(GAS v2u*)(yr + c) = o; }
#pragma unroll
        for (int hp = 0; hp < 4; ++hp) { const int c = hp * 256 + lane * 4;
            const f32x4 a = *(const GAS f32x4*)(HB + (size_t)row * 1024 + c), bq = *(const GAS f32x4*)(HB + (size_t)M * 1024 + (size_t)row * 1024 + c);
            const f32x4 s = a + bq; float ss = (s[0] * s[0] + s[1] * s[1]) + (s[2] * s[2] + s[3] * s[3]);
#pragma unroll
            for (int o = 1; o < 32; o <<= 1) ss += __shfl_xor(ss, o);
            const float r = 1.0f / sqrtf(ss * (1.0f / 128.0f) + RMS_EPS);
            const f32x4 w = *(const GAS f32x4*)(A.in[I_HNORM] + c); const v2u gg = *(const GAS v2u*)(ur + U_GB + c);
            const float g0 = bflo(gg.x), g1 = bfhi(gg.x), g2 = bflo(gg.y), g3 = bfhi(gg.y);
            const float o0 = s[0] * r * w[0] * g0 * sigm(g0), o1 = s[1] * r * w[1] * g1 * sigm(g1), o2 = s[2] * r * w[2] * g2 * sigm(g2), o3 = s[3] * r * w[3] * g3 * sigm(g3);
            v2u o; o.x = pk2(o0, o1); o.y = pk2(o2, o3); *(GAS v2u*)(yr + 1024 + c) = o; }
    }
}

__device__ __forceinline__ void ln_row_regs(f32x4 (&v)[8], const float* w, const float* bvec, int lane) {
    float s = 0.f;
#pragma unroll
    for (int j = 0; j < 8; ++j) s += (v[j][0] + v[j][1]) + (v[j][2] + v[j][3]);
    const float mean = wave_sum(s) * (1.0f / D); float s2 = 0.f;
#pragma unroll
    for (int j = 0; j < 8; ++j) { v[j] = v[j] - mean; s2 += (v[j][0] * v[j][0] + v[j][1] * v[j][1]) + (v[j][2] * v[j][2] + v[j][3] * v[j][3]); }
    const float rstd = 1.0f / sqrtf(wave_sum(s2) * (1.0f / D) + LN_EPS);
#pragma unroll
    for (int j = 0; j < 8; ++j) { const f32x4 ww = *(const GAS f32x4*)(w + 256 * j + 4 * lane), bb = *(const GAS f32x4*)(bvec + 256 * j + 4 * lane); v[j] = v[j] * rstd * ww + bb; }
}
__device__ __forceinline__ void store_row(const f32x4 (&v)[8], float* xf, bf16* xb, int lane) {
#pragma unroll
    for (int j = 0; j < 8; ++j) { *(GAS f32x4*)(xf + 256 * j + 4 * lane) = v[j]; v2u o; o.x = pk2(v[j][0], v[j][1]); o.y = pk2(v[j][2], v[j][3]); *(GAS v2u*)(xb + 256 * j + 4 * lane) = o; }
}
__device__ __forceinline__ void ln_phase(const Frame& F, const Args& A, const float* w, const float* bvec, bf16* XB) {
    const int lane = lane_now(), tid = F.wave * 64 + lane; (void)tid;
    const int gw = blockIdx.x * NWAVES + F.wave, NGW = F.G * NWAVES;
    for (int row = gw; row < M; row += NGW) { float* xr = A.out + (size_t)row * D; f32x4 v[8];
#pragma unroll
        for (int j = 0; j < 8; ++j) v[j] = *(const GAS f32x4*)(xr + 256 * j + 4 * lane);
        ln_row_regs(v, w, bvec, lane); store_row(v, xr, XB + (size_t)row * D, lane); }
}
__device__ __forceinline__ void ln_router_phase(const Frame& F, const Args& A, const float* w, const float* bvec, bf16* XB) {
    const int lane = lane_now(), tid = F.wave * 64 + lane; (void)tid;
    LAS int* cnt = (LAS int*)(F.lds + RING_OFF);
    int* TOKE = (int*)(A.ws + WS_TOKE); float* TOKG = (float*)(A.ws + WS_TOKG); int* WGCNT = (int*)(A.ws + WS_WGCNT);
    const float* wr = A.in[I_WR]; const float* br = A.in[I_BR];
    for (int vb = blockIdx.x; vb < M / 64; vb += F.G) {
        if (tid < 8) cnt[tid] = 0;
        __syncthreads();
        for (int k = 0; k < 8; ++k) { const int row = vb * 64 + F.wave * 8 + k; float* xr = A.out + (size_t)row * D; f32x4 v[8];
#pragma unroll
            for (int j = 0; j < 8; ++j) v[j] = *(const GAS f32x4*)(xr + 256 * j + 4 * lane);
            ln_row_regs(v, w, bvec, lane); store_row(v, xr, XB + (size_t)row * D, lane);
            float lg[8];
#pragma unroll
            for (int e = 0; e < 8; ++e) lg[e] = 0.f;
#pragma unroll
            for (int j = 0; j < 8; ++j)
#pragma unroll
                for (int i = 0; i < 4; ++i) { const float* wp = wr + (size_t)(256 * j + 4 * lane + i) * NE; const f32x4 w0 = *(const GAS f32x4*)wp, w1 = *(const GAS f32x4*)(wp + 4); const float xv = v[j][i];
                    lg[0] += xv * w0[0]; lg[1] += xv * w0[1]; lg[2] += xv * w0[2]; lg[3] += xv * w0[3]; lg[4] += xv * w1[0]; lg[5] += xv * w1[1]; lg[6] += xv * w1[2]; lg[7] += xv * w1[3]; }
#pragma unroll
            for (int e = 0; e < 8; ++e) lg[e] = wave_sum(lg[e]) + br[e];
            int e1 = 0; float l1 = lg[0];
#pragma unroll
            for (int e = 1; e < 8; ++e) if (lg[e] > l1) { l1 = lg[e]; e1 = e; }
            int e2 = -1; float l2 = -3.0e38f;
#pragma unroll
            for (int e = 0; e < 8; ++e) if (e != e1 && lg[e] > l2) { l2 = lg[e]; e2 = e; }
            const float g2 = 1.0f / (1.0f + __expf(l1 - l2)), g1 = 1.0f - g2;
            if (lane == 0) { TOKE[2 * row] = e1; TOKE[2 * row + 1] = e2; TOKG[2 * row] = g1; TOKG[2 * row + 1] = g2; __hip_atomic_fetch_add(&cnt[e1], 1, __ATOMIC_RELAXED, __HIP_MEMORY_SCOPE_WORKGROUP); __hip_atomic_fetch_add(&cnt[e2], 1, __ATOMIC_RELAXED, __HIP_MEMORY_SCOPE_WORKGROUP); }
        }
        __syncthreads();
        if (tid < 8) WGCNT[vb * 8 + tid] = cnt[tid];
        __syncthreads();
    }
}
__device__ __forceinline__ void moe_scatter_phase(const Frame& F, const Args& A, const bf16* XB) {
    const int lane = lane_now(), tid = F.wave * 64 + lane; (void)tid;
    LAS int* sm = (LAS int*)(F.lds + RING_OFF);
    const int* TOKE = (const int*)(A.ws + WS_TOKE); int* DEST = (int*)(A.ws + WS_DEST); const int* WGCNT = (const int*)(A.ws + WS_WGCNT); int* TILEE = (int*)(A.ws + WS_TILEE);
    bf16* XS = (bf16*)(A.ws + WS_XS);
    for (int vb = blockIdx.x; vb < M / 64; vb += F.G) {
        if (tid < 16) sm[tid] = 0;
        if (tid >= 64 && tid < 192) sm[32 + tid - 64] = TOKE[vb * 128 + tid - 64];
        __syncthreads();
        {   const int e = tid & 7, wq = tid >> 3; int tot = 0, pre = 0;
#pragma unroll
            for (int i = 0; i < 4; ++i) { const int w = wq * 4 + i; const int c = WGCNT[w * 8 + e]; tot += c; pre += (w < vb) ? c : 0; }
            __hip_atomic_fetch_add(&sm[e], tot, __ATOMIC_RELAXED, __HIP_MEMORY_SCOPE_WORKGROUP); __hip_atomic_fetch_add(&sm[8 + e], pre, __ATOMIC_RELAXED, __HIP_MEMORY_SCOPE_WORKGROUP); }
        __syncthreads();
        if (tid == 0) { int base = 0; for (int e = 0; e < 8; ++e) { sm[16 + e] = base; base += ((sm[e] + 255) >> 8) << 8; }
            if (vb == 0) { int rt = 0; for (int e = 0; e < 8; ++e) { const int nt = (sm[e] + 255) >> 8; for (int i = 0; i < nt; ++i) TILEE[1 + rt++] = e; } TILEE[0] = rt; } }
        __syncthreads();
        if (tid < 128) { const int e = sm[32 + tid]; int rank = 0; for (int s = 0; s < tid; ++s) rank += (sm[32 + s] == e) ? 1 : 0; const int d = sm[16 + e] + sm[8 + e] + rank; sm[160 + tid] = d; DEST[vb * 128 + tid] = d; }
        __syncthreads();
        for (int s = F.wave; s < 128; s += NWAVES) { const int tok = vb * 64 + (s >> 1); const int d = sm[160 + s];
            const GAS v4u* src = (const GAS v4u*)(XB + (size_t)tok * D); GAS v4u* dst = (GAS v4u*)(XS + (size_t)d * D);
#pragma unroll
            for (int j = 0; j < 4; ++j) dst[64 * j + lane] = src[64 * j + lane]; }
        __syncthreads();
    }
}
__device__ __forceinline__ void ln_moe_phase(const Frame& F, const Args& A, const float* w, const float* bvec, bf16* XB) {
    const int lane = lane_now(), tid = F.wave * 64 + lane; (void)tid;
    const int gw = blockIdx.x * NWAVES + F.wave, NGW = F.G * NWAVES;
    const float* TOKG = (const float*)(A.ws + WS_TOKG); const int* DEST = (const int*)(A.ws + WS_DEST); const float* YS = (const float*)(A.ws + WS_YS);
    for (int row = gw; row < M; row += NGW) { float* xr = A.out + (size_t)row * D; f32x4 v[8];
        const int d1 = DEST[2 * row], d2 = DEST[2 * row + 1]; const float g1 = TOKG[2 * row], g2 = TOKG[2 * row + 1];
        const float* y1 = YS + (size_t)d1 * D; const float* y2 = YS + (size_t)d2 * D;
#pragma unroll
        for (int j = 0; j < 8; ++j) { const int c = 256 * j + 4 * lane; v[j] = *(const GAS f32x4*)(xr + c) * ALPHA + *(const GAS f32x4*)(y1 + c) * g1 + *(const GAS f32x4*)(y2 + c) * g2; }
        ln_row_regs(v, w, bvec, lane); store_row(v, xr, XB + (size_t)row * D, lane); }
}

__device__ __forceinline__ void na_phase_simple(const Frame& F, const Args& A) {
    const int lane = lane_now(), tid = F.wave * 64 + lane; (void)tid;
    const int gw = blockIdx.x * NWAVES + F.wave, NGW = F.G * NWAVES;
    const bf16* QKV = (const bf16*)(A.ws + WS_QKV); bf16* AO = (bf16*)(A.ws + WS_AO); const float* rpb = A.in[I_RPB];
    const float scale = 0.08838834764831845f;
    for (int task = gw; task < M * 16; task += NGW) {
        const int tok = task >> 4, h = task & 15, b = tok >> 12, r = (tok >> 6) & 63, c = tok & 63;
        const int rs = min(max(r - 4, 0), 56), cs = min(max(c - 8, 0), 48);
        const GAS v4u* qp = (const GAS v4u*)(QKV + (size_t)tok * NQKV + h * 128);
        float sc[2];
#pragma unroll
        for (int i = 0; i < 2; ++i) { const int kk = lane + 64 * i, jr = kk >> 4, jc = kk & 15; const int ktok = b * T + (rs + jr) * 64 + cs + jc;
            const GAS v4u* kp = (const GAS v4u*)(QKV + (size_t)ktok * NQKV + D + h * 128); float acc = 0.f;
#pragma unroll 4
            for (int j = 0; j < 16; ++j) { const v4u q = qp[j], k = kp[j];
                acc += bflo(q.x) * bflo(k.x) + bfhi(q.x) * bfhi(k.x) + bflo(q.y) * bflo(k.y) + bfhi(q.y) * bfhi(k.y) + bflo(q.z) * bflo(k.z) + bfhi(q.z) * bfhi(k.z) + bflo(q.w) * bflo(k.w) + bfhi(q.w) * bfhi(k.w); }
            sc[i] = acc * scale + rpb[(h * 15 + (rs + jr - r + 7)) * 31 + (cs + jc - c + 15)]; }
        const float mx = wave_max(fmaxf(sc[0], sc[1]));
        const float p0 = __expf(sc[0] - mx), p1 = __expf(sc[1] - mx);
        const float inv = 1.0f / wave_sum(p0 + p1);
        float a0 = 0.f, a1 = 0.f;
        const bf16* vbase = QKV + 2 * D + h * 128 + 2 * lane;
#pragma unroll
        for (int i = 0; i < 2; ++i) { const float pi = i ? p1 : p0;
#pragma unroll 8
            for (int l = 0; l < 64; ++l) { const int kk = l + 64 * i, jr = kk >> 4, jc = kk & 15; const int ktok = b * T + (rs + jr) * 64 + cs + jc;
                const float pk = __builtin_bit_cast(float, __builtin_amdgcn_readlane(__builtin_bit_cast(int, pi), l));
                const unsigned vv = *(const GAS unsigned*)(vbase + (size_t)ktok * NQKV); a0 += pk * bflo(vv); a1 += pk * bfhi(vv); } }
        *(GAS unsigned*)(AO + (size_t)tok * D + h * 128 + 2 * lane) = pk2(a0 * inv, a1 * inv);
    }
}
#ifndef MK_ONE_LAUNCH
#define MK_ONE_LAUNCH 1
#endif
constexpr int N_PHASES = 21;
__global__ void __launch_bounds__(NWAVES * 64, 2) trunk_fwd(Args args) {
    extern __shared__ __attribute__((aligned(16))) unsigned char lds[];
    Frame F;
    F.lds = (LAS unsigned char*)lds;
    F.wave = __builtin_amdgcn_readfirstlane(threadIdx.x >> 6);
    F.G = gridDim.x;
    const Args& A = args;
    { const int tid0 = F.wave * 64 + lane_now(); for (int u = tid0; u < (LDS_BYTES - LDSCTL_OFF) / 4; u += NWAVES * 64) ((LAS unsigned*)(F.lds + LDSCTL_OFF))[u] = 0u; }
    __syncthreads();
    gu32* ctl = (gu32*)(args.ws + WS_CTL);
    const int lo = args.ph_lo, hi = args.ph_hi;
    XcdBarrier bar; bar.bar = (unsigned*)(ctl + CW_BAR); bar.x = 0; bar.st = nullptr;
    if (hi - lo > 1) bar = xcd_barrier_post((unsigned*)(ctl + CW_BAR), (volatile LAS unsigned*)(F.lds + MISC_OFF) + 8, F.wave);
#define IN(k) (lo <= (k) && (k) < hi)
#define SEAM(k) do { if (IN(k) && IN((k) + 1)) xcd_barrier(bar, F.wave); } while (0)
    unsigned char* ws = args.ws;
    bf16* XB0 = (bf16*)(ws + WS_XB0); bf16* XB1 = (bf16*)(ws + WS_XB1);
    const int bid = (int)blockIdx.x;

    if (IN(0)) { p0_prologue(F, A); } SEAM(0);
    if (IN(1)) {
        pg8::Gemm g{XB0, (const bf16*)(ws + WS_WRIN), M, NREC, D}; pg8::StaticOrder S; S.init(M, NREC, F.G, bid);
        pg8::EpiBf16G E{(bf16*)(ws + WS_U), UW, 32, (float*)(ws + WS_G)};
        pg8::gemm_phase<pg8::EpiBf16G, pg8::StaticOrder, true, true>(F.lds + RING_OFF, g, S, E, F.wave);
    } SEAM(1);
    if (IN(2)) { for (int unit = bid; unit < 256; unit += F.G) { if (unit < 128) mlstm_unit(F, A, unit); else hgrn_unit(F, A, unit - 128); } } SEAM(2);
    if (IN(3)) { p3_finalize(F, A); } SEAM(3);
    if (IN(4)) {
        pg8::Gemm g{(const bf16*)(ws + WS_Y), (const bf16*)(ws + WS_WROUT), M, D, D}; pg8::StaticOrder S; S.init(M, D, F.G, bid);
        pg8::EpiResF32 E{A.in[I_X], A.out, D, ALPHA};
        pg8::gemm_phase<pg8::EpiResF32, pg8::StaticOrder, true, true>(F.lds + RING_OFF, g, S, E, F.wave);
    } SEAM(4);
    if (IN(5)) { ln_phase(F, A, A.in[I_LNW] + 0 * D, A.in[I_LNB] + 0 * D, XB1); } SEAM(5);
    if (IN(6)) {
        pg8::Gemm g{XB1, (const bf16*)(ws + WS_WFGU), M, 2 * FFN, D}; pg8::StaticOrder S; S.init(M, 2 * FFN, F.G, bid);
        pg8::EpiSwiglu E{(bf16*)(ws + WS_H), FFN, 2 * FFN / 256};
        pg8::gemm_phase<pg8::EpiSwiglu, pg8::StaticOrder, true, true>(F.lds + RING_OFF, g, S, E, F.wave);
    } SEAM(6);
    if (IN(7)) {
        pg8::Gemm g{(const bf16*)(ws + WS_H), (const bf16*)(ws + WS_WFDN), M, D, FFN}; pg8::StaticOrder S; S.init(M, D, F.G, bid);
        pg8::EpiResF32 E{A.out, A.out, D, ALPHA};
        pg8::gemm_phase<pg8::EpiResF32, pg8::StaticOrder, true, true>(F.lds + RING_OFF, g, S, E, F.wave);
    } SEAM(7);
    if (IN(8)) { ln_phase(F, A, A.in[I_LNW] + 1 * D, A.in[I_LNB] + 1 * D, XB0); } SEAM(8);
    if (IN(9)) {
        pg8::Gemm g{(const bf16*)(ws + WS_PB), (const bf16*)(ws + WS_WPP0), M, D, PLE_DIM}; pg8::StaticOrder S; S.init(M, D, F.G, bid);
        pg8::EpiStoreF32 E{(float*)(ws + WS_PP), D, D / 256};
        pg8::gemm_phase<pg8::EpiStoreF32, pg8::StaticOrder, true, true>(F.lds + RING_OFF, g, S, E, F.wave);
    } SEAM(9);
    if (IN(10)) {
        pg8::Gemm g{XB0, (const bf16*)(ws + WS_WPG0), M, D, D}; pg8::StaticOrder S; S.init(M, D, F.G, bid);
        pg8::EpiPle E{A.out, (const float*)(ws + WS_PP), XB1, D};
        pg8::gemm_phase<pg8::EpiPle, pg8::StaticOrder, true, true>(F.lds + RING_OFF, g, S, E, F.wave);
    } SEAM(10);
    if (IN(11)) {
        pg8::Gemm g{XB1, (const bf16*)(ws + WS_WQKV), M, NQKV, D}; pg8::StaticOrder S; S.init(M, NQKV, F.G, bid);
        pg8::EpiBf16G E{(bf16*)(ws + WS_QKV), NQKV, -1, nullptr};
        pg8::gemm_phase<pg8::EpiBf16G, pg8::StaticOrder, true, true>(F.lds + RING_OFF, g, S, E, F.wave);
    } SEAM(11);
    if (IN(12)) { na_phase_simple(F, A); } SEAM(12);
    if (IN(13)) {
        pg8::Gemm g{(const bf16*)(ws + WS_AO), (const bf16*)(ws + WS_WNAO), M, D, D}; pg8::StaticOrder S; S.init(M, D, F.G, bid);
        pg8::EpiResF32 E{A.out, A.out, D, ALPHA};
        pg8::gemm_phase<pg8::EpiResF32, pg8::StaticOrder, true, true>(F.lds + RING_OFF, g, S, E, F.wave);
    } SEAM(13);
    if (IN(14)) { ln_router_phase(F, A, A.in[I_LNW] + 2 * D, A.in[I_LNB] + 2 * D, XB0); } SEAM(14);
    if (IN(15)) { moe_scatter_phase(F, A, XB0); } SEAM(15);
    if (IN(16)) {
        const int* TILEE = (const int*)(ws + WS_TILEE); const int nrt = __builtin_amdgcn_readfirstlane(TILEE[0]);
        pg8::Gemm g{(const bf16*)(ws + WS_XS), (const bf16*)(ws + WS_WMGU), nrt * 256, 2 * MOE, D}; pg8::MoeOrder S; S.base.init(nrt * 256, 2 * MOE, F.G, bid); S.tile_e = TILEE + 1; S.nN = 2 * MOE / 256;
        pg8::EpiSwiglu E{(bf16*)(ws + WS_HM), MOE, 2 * MOE / 256};
        pg8::gemm_phase<pg8::EpiSwiglu, pg8::MoeOrder, true, true>(F.lds + RING_OFF, g, S, E, F.wave);
    } SEAM(16);
    if (IN(17)) {
        const int* TILEE = (const int*)(ws + WS_TILEE); const int nrt = __builtin_amdgcn_readfirstlane(TILEE[0]);
        pg8::Gemm g{(const bf16*)(ws + WS_HM), (const bf16*)(ws + WS_WMDN), nrt * 256, D, MOE}; pg8::MoeOrder S; S.base.init(nrt * 256, D, F.G, bid); S.tile_e = TILEE + 1; S.nN = D / 256;
        pg8::EpiStoreF32 E{(float*)(ws + WS_YS), D, D / 256};
        pg8::gemm_phase<pg8::EpiStoreF32, pg8::MoeOrder, true, true>(F.lds + RING_OFF, g, S, E, F.wave);
    } SEAM(17);
    if (IN(18)) { ln_moe_phase(F, A, A.in[I_LNW] + 3 * D, A.in[I_LNB] + 3 * D, XB1); } SEAM(18);
    if (IN(19)) {
        pg8::Gemm g{(const bf16*)(ws + WS_PB) + (size_t)M * PLE_DIM, (const bf16*)(ws + WS_WPP1), M, D, PLE_DIM}; pg8::StaticOrder S; S.init(M, D, F.G, bid);
        pg8::EpiStoreF32 E{(float*)(ws + WS_PP1), D, D / 256};
        pg8::gemm_phase<pg8::EpiStoreF32, pg8::StaticOrder, true, true>(F.lds + RING_OFF, g, S, E, F.wave);
    } SEAM(19);
    if (IN(20)) {
        pg8::Gemm g{XB1, (const bf16*)(ws + WS_WPG1), M, D, D}; pg8::StaticOrder S; S.init(M, D, F.G, bid);
        pg8::EpiPle E{A.out, (const float*)(ws + WS_PP1), nullptr, D};
        pg8::gemm_phase<pg8::EpiPle, pg8::StaticOrder, true, true>(F.lds + RING_OFF, g, S, E, F.wave);
    }
#undef IN
#undef SEAM
}

extern "C" void kernel_launch(void* const* d_in, const int* in_sizes, int n_in, void* d_out, int out_size, void* d_ws, size_t ws_size, hipStream_t stream) {
    static int grid = 0;
    if (grid == 0) {
        if (n_in != 23 || in_sizes[0] != M * D || out_size != M * D || ws_size < WS_END) { fprintf(stderr, "kernel_launch: unexpected shapes (n_in %d, in0 %d, out %d, ws %zu, need %zu)\n", n_in, n_in > 0 ? in_sizes[0] : -1, out_size, ws_size, (size_t)WS_END); grid = -1; return; }
        int dev = 0, cus = 0, per_cu = 0;
        if (hipGetDevice(&dev) != hipSuccess || hipDeviceGetAttribute(&cus, hipDeviceAttributeMultiprocessorCount, dev) != hipSuccess) { grid = -1; return; }
        if (hipFuncSetAttribute((const void*)trunk_fwd, hipFuncAttributeMaxDynamicSharedMemorySize, LDS_BYTES) != hipSuccess) { fprintf(stderr, "kernel_launch: hipFuncSetAttribute failed\n"); grid = -1; return; }
        if (hipOccupancyMaxActiveBlocksPerMultiprocessor(&per_cu, (const void*)trunk_fwd, NWAVES * 64, LDS_BYTES) != hipSuccess || per_cu < 1) { fprintf(stderr, "kernel_launch: occupancy query reports %d\n", per_cu); }
        (void)hipGetLastError();
        grid = cus;
    }
    if (grid < 0) return;
    (void)hipMemsetAsync((char*)d_ws + WS_CTL, 0, CTL_ZERO_BYTES, stream);
    Args a{};
    for (int i = 0; i < 23; ++i) a.in[i] = (const float*)d_in[i];
    a.out = (float*)d_out; a.ws = (unsigned char*)d_ws;
#if MK_ONE_LAUNCH
    a.ph_lo = 0; a.ph_hi = N_PHASES;
    hipLaunchKernelGGL(trunk_fwd, dim3(grid), dim3(NWAVES * 64), LDS_BYTES, stream, a);
#else
    for (int ph = 0; ph < N_PHASES; ++ph) { a.ph_lo = ph; a.ph_hi = ph + 1; hipLaunchKernelGGL(trunk_fwd, dim3(grid), dim3(NWAVES * 64), LDS_BYTES, stream, a); }
#endif
}
```

```cpp
#include <hip/hip_runtime.h>
#include <cstdio>
#include <cstdint>
__device__ __forceinline__ int lane_now() { int l; asm volatile("v_mbcnt_lo_u32_b32 %0, -1, 0\n\tv_mbcnt_hi_u32_b32 %0, -1, %0" : "=v"(l)); return l; }
namespace pg8 {
#define PG8_LAS __attribute__((address_space(3)))
typedef unsigned short bf16_t;
typedef short bf16x8 __attribute__((ext_vector_type(8)));
typedef float f32x4 __attribute__((ext_vector_type(4)));
typedef unsigned u32x4 __attribute__((ext_vector_type(4)));
constexpr int BM = 256, BK = 64, HALF = 128, HTB = HALF * BK * 2  , STAGE_BYTES = 8 * HTB, NXCD = 8, WGM = 8;

__host__ __device__ __forceinline__ int lds_byte(int r, int c) { const int st = (r >> 4) * 2 + (c >> 5), rr = r & 15, cc = c & 31, ob = rr * 64 + cc * 2; return st * 1024 + (ob ^ (((ob >> 9) & 1) << 5)); }
__host__ __device__ __forceinline__ void stage_rc(int b, int& R, int& C) { const int st = b / 1024, sb = b % 1024, swz = sb ^ (((sb >> 9) & 1) << 5); R = (st >> 1) * 16 + swz / 64; C = (st & 1) * 32 + (swz % 64) / 2; }
__host__ __device__ __forceinline__ int perm32(int rho) { const int n = rho >> 4, i = rho & 15; return 8 * (i >> 2) + 4 * n + (i & 3); }

struct Unit { int pm, pn; };
struct Gemm { const bf16_t* A; const bf16_t* Bt; int M, N, K; };

struct StaticOrder {
    int nM, nN, nwg, G, c;
    __host__ __device__ void init(int M, int N, int G_, int c_) { nM = M / BM; nN = N / BM; nwg = nM * nN; G = G_; c = c_; }
    __host__ __device__ bool next(int i, Unit& u) const {
        const long L = (long)i * G + c; if (L >= nwg) return false;
        int wgid = (int)L; { const int q = nwg / NXCD, r = nwg % NXCD, xcd = wgid % NXCD, off = wgid / NXCD; wgid = (xcd < r ? xcd * (q + 1) : r * (q + 1) + (xcd - r) * q) + off; }
        const int nig = WGM * nN, gid = wgid / nig, fm = gid * WGM, gsz = (nM - fm) < WGM ? (nM - fm) : WGM;
        u.pm = fm + ((wgid % nig) % gsz); u.pn = (wgid % nig) / gsz; return true;
    }
    __device__ __forceinline__ void a_ready(const Unit&) const {}
    __device__ __forceinline__ void done(const Unit&) const {}
};

__device__ __forceinline__ unsigned cvt_pk_bf16(float lo, float hi) { unsigned r; asm volatile("v_cvt_pk_bf16_f32 %0, %1, %2" : "=v"(r) : "v"(lo), "v"(hi)); return r; }
__device__ __forceinline__ float fsigmoid(float x) { return __builtin_amdgcn_rcpf(1.0f + __expf(-x)); }
__device__ __forceinline__ float fsilu(float x) { return x * fsigmoid(x); }


struct EpiBf16G {
    static constexpr bool PERM = true, AFTER_DRAIN = false;
    bf16_t* O; int ldc; int gate_pn; float* Gt;
    __device__ __forceinline__ void operator()(const f32x4 (&acc)[2][2][4][2], const Unit& u, int wr, int wc, int fr, int fq) const {
        const int row0 = u.pm * BM + wr * 64 + fr;
        if (u.pn == gate_pn) {
            if (wc == 0 && fq < 2) {
#pragma unroll
                for (int ai = 0; ai < 2; ++ai)
#pragma unroll
                    for (int m = 0; m < 4; ++m) { float* gp = Gt + (size_t)(row0 + ai * HALF + m * 16) * 16 + 8 * fq;
                        *(f32x4*)(gp) = acc[ai][0][m][0]; *(f32x4*)(gp + 4) = acc[ai][0][m][1]; }
            }
            return;
        }
        const int col0 = u.pn * BM + wc * 32 + 8 * fq;
#pragma unroll
        for (int ai = 0; ai < 2; ++ai)
#pragma unroll
            for (int m = 0; m < 4; ++m) { bf16_t* rowp = O + (size_t)(row0 + ai * HALF + m * 16) * ldc + col0;
#pragma unroll
                for (int bj = 0; bj < 2; ++bj) { const f32x4 v0 = acc[ai][bj][m][0], v1 = acc[ai][bj][m][1];
                    u32x4 w; w.x = cvt_pk_bf16(v0[0], v0[1]); w.y = cvt_pk_bf16(v0[2], v0[3]); w.z = cvt_pk_bf16(v1[0], v1[1]); w.w = cvt_pk_bf16(v1[2], v1[3]);
                    *(u32x4*)(rowp + bj * HALF) = w; } }
    }
};
struct EpiSwiglu {
    static constexpr bool PERM = true, AFTER_DRAIN = false;
    bf16_t* H; int ldh; int npn;
    __device__ __forceinline__ void operator()(const f32x4 (&acc)[2][2][4][2], const Unit& u, int wr, int wc, int fr, int fq) const {
        const int row0 = u.pm * BM + wr * 64 + fr; const int pl = u.pn % npn; const int col0 = pl * HALF + wc * 32 + 8 * fq;
#pragma unroll
        for (int ai = 0; ai < 2; ++ai)
#pragma unroll
            for (int m = 0; m < 4; ++m) { bf16_t* rowp = H + (size_t)(row0 + ai * HALF + m * 16) * ldh + col0;
                const f32x4 g0 = acc[ai][0][m][0], g1 = acc[ai][0][m][1], u0 = acc[ai][1][m][0], u1 = acc[ai][1][m][1];
                float o[8];
#pragma unroll
                for (int i = 0; i < 4; ++i) { o[i] = fsilu(g0[i]) * u0[i]; o[4 + i] = fsilu(g1[i]) * u1[i]; }
                u32x4 w; w.x = cvt_pk_bf16(o[0], o[1]); w.y = cvt_pk_bf16(o[2], o[3]); w.z = cvt_pk_bf16(o[4], o[5]); w.w = cvt_pk_bf16(o[6], o[7]);
                *(u32x4*)rowp = w; }
    }
};
struct EpiResF32 {
    static constexpr bool PERM = true, AFTER_DRAIN = false;
    const float* SRC; float* DST; int ldc; float alpha;
    __device__ __forceinline__ void operator()(const f32x4 (&acc)[2][2][4][2], const Unit& u, int wr, int wc, int fr, int fq) const {
        const int row0 = u.pm * BM + wr * 64 + fr; const int col0 = u.pn * BM + wc * 32 + 8 * fq;
#pragma unroll
        for (int ai = 0; ai < 2; ++ai)
#pragma unroll
            for (int m = 0; m < 4; ++m) { const size_t ro = (size_t)(row0 + ai * HALF + m * 16) * ldc + col0;
#pragma unroll
                for (int bj = 0; bj < 2; ++bj)
#pragma unroll
                    for (int n = 0; n < 2; ++n) { const size_t o = ro + bj * HALF + 4 * n; const f32x4 s = *(const f32x4*)(SRC + o); *(f32x4*)(DST + o) = s * alpha + acc[ai][bj][m][n]; } }
    }
};
struct EpiStoreF32 {
    static constexpr bool PERM = true, AFTER_DRAIN = false;
    float* O; int ldc; int npn;
    __device__ __forceinline__ void operator()(const f32x4 (&acc)[2][2][4][2], const Unit& u, int wr, int wc, int fr, int fq) const {
        const int row0 = u.pm * BM + wr * 64 + fr; const int col0 = (u.pn % npn) * BM + wc * 32 + 8 * fq;
#pragma unroll
        for (int ai = 0; ai < 2; ++ai)
#pragma unroll
            for (int m = 0; m < 4; ++m) { float* ro = O + (size_t)(row0 + ai * HALF + m * 16) * ldc + col0;
#pragma unroll
                for (int bj = 0; bj < 2; ++bj)
#pragma unroll
                    for (int n = 0; n < 2; ++n) *(f32x4*)(ro + bj * HALF + 4 * n) = acc[ai][bj][m][n]; }
    }
};
struct EpiPle {
    static constexpr bool PERM = true, AFTER_DRAIN = false;
    float* XF; const float* PP; bf16_t* XB; int ldc;
    __device__ __forceinline__ void operator()(const f32x4 (&acc)[2][2][4][2], const Unit& u, int wr, int wc, int fr, int fq) const {
        const int row0 = u.pm * BM + wr * 64 + fr; const int col0 = u.pn * BM + wc * 32 + 8 * fq;
#pragma unroll
        for (int ai = 0; ai < 2; ++ai)
#pragma unroll
            for (int m = 0; m < 4; ++m) { const size_t ro = (size_t)(row0 + ai * HALF + m * 16) * ldc + col0;
#pragma unroll
                for (int bj = 0; bj < 2; ++bj) { f32x4 o[2];
#pragma unroll
                    for (int n = 0; n < 2; ++n) { const size_t of = ro + bj * HALF + 4 * n; const f32x4 x = *(const f32x4*)(XF + of), pp = *(const f32x4*)(PP + of); const f32x4 a = acc[ai][bj][m][n];
                        f32x4 r; r[0] = x[0] + fsigmoid(a[0]) * pp[0]; r[1] = x[1] + fsigmoid(a[1]) * pp[1]; r[2] = x[2] + fsigmoid(a[2]) * pp[2]; r[3] = x[3] + fsigmoid(a[3]) * pp[3];
                        *(f32x4*)(XF + of) = r; o[n] = r; }
                    u32x4 w; w.x = cvt_pk_bf16(o[0][0], o[0][1]); w.y = cvt_pk_bf16(o[0][2], o[0][3]); w.z = cvt_pk_bf16(o[1][0], o[1][1]); w.w = cvt_pk_bf16(o[1][2], o[1][3]);
                    if (XB) *(u32x4*)(XB + ro + bj * HALF) = w; } }
    }
};
struct MoeOrder {
    StaticOrder base; const int* tile_e; int nN;
    __device__ __forceinline__ bool next(int i, Unit& u) const { if (!base.next(i, u)) return false; u.pn += tile_e[u.pm] * nN; return true; }
    __device__ __forceinline__ void a_ready(const Unit&) const {}
    __device__ __forceinline__ void done(const Unit&) const {}
};

template <class Epi, class Sched, bool ALIGN_EPI = false, bool SP2 = false>
__device__ __forceinline__ void gemm_phase(PG8_LAS unsigned char* lds, const Gemm g, const Sched& S, const Epi& E, int wave_s) {
    const int lane = lane_now(), wid = wave_s, tid = wave_s * 64 + lane, wr = wid >> 2, wc = wid & 3, fr = lane & 15, fq = lane >> 4;
    const int K = g.K, nt = K / BK;
    unsigned voffA[2], voffB[2];
#pragma unroll
    for (int i = 0; i < 2; ++i) { int R, C; stage_rc(tid * 16 + i * 8192, R, C); const int Rb = Epi::PERM ? ((R & ~31) + perm32(R & 31)) : R;
        voffA[i] = (unsigned)(R * K + C) * 2u; voffB[i] = (unsigned)(Rb * K + C) * 2u; }
    const size_t kstep = (size_t)(BK * 2);
    const size_t hstep = (size_t)HALF * K * 2;
    const size_t tstep = 2 * hstep;
    const unsigned ldsw = (unsigned)wid * 1024u;
    const int aoff = lds_byte(wr * 64 + fr, fq * 8), boff = lds_byte(wc * 32 + fr, fq * 8);
#define PG8_SA(b, h) (((b) * 2 + (h)) * HTB)
#define PG8_SB(b, h) ((4 + (b) * 2 + (h)) * HTB)
#define PG8_STAGE(bufoff, gbase, voff) do { _Pragma("unroll") for (int _i = 0; _i < 2; ++_i) \
        __builtin_amdgcn_global_load_lds((const unsigned*)((const char*)(gbase) + (voff)[_i]), (PG8_LAS unsigned*)(lds + (bufoff) + ldsw + _i * 8192), 16, 0, 0); } while (0)
#define PG8_LDA(dst, b, h) do { _Pragma("unroll") for (int m = 0; m < 4; ++m) _Pragma("unroll") for (int k = 0; k < 2; ++k) dst[m][k] = *(const PG8_LAS bf16x8*)(lds + PG8_SA(b, h) + aoff + m * 2048 + k * 1024); } while (0)
#define PG8_LDB(dst, b, h) do { _Pragma("unroll") for (int n = 0; n < 2; ++n) _Pragma("unroll") for (int k = 0; k < 2; ++k) dst[n][k] = *(const PG8_LAS bf16x8*)(lds + PG8_SB(b, h) + boff + n * 2048 + k * 1024); } while (0)
#define PG8_MMA(ai, bj, At, Bt) do { __builtin_amdgcn_s_setprio(1); _Pragma("unroll") for (int m = 0; m < 4; ++m) _Pragma("unroll") for (int n = 0; n < 2; ++n) _Pragma("unroll") for (int k = 0; k < 2; ++k) \
        acc[ai][bj][m][n] = __builtin_amdgcn_mfma_f32_16x16x32_bf16(Bt[n][k], At[m][k], acc[ai][bj][m][n], 0, 0, 0); __builtin_amdgcn_s_setprio(0); } while (0)
#define PG8_WAIT_V(n) asm volatile("s_waitcnt vmcnt(" #n ")" ::: "memory")
#define PG8_WAIT_L(n) asm volatile("s_waitcnt lgkmcnt(" #n ")" ::: "memory")
#define PG8_BAR __builtin_amdgcn_s_barrier()
#define PG8_SCHED __builtin_amdgcn_sched_barrier(0)
    Unit cur, nxt; int ui = 0;
    if (!S.next(0, cur)) return;
    f32x4 acc[2][2][4][2];
#pragma unroll
    for (int a = 0; a < 2; ++a)
#pragma unroll
        for (int b = 0; b < 2; ++b)
#pragma unroll
            for (int m = 0; m < 4; ++m)
#pragma unroll
                for (int n = 0; n < 2; ++n) acc[a][b][m][n] = (f32x4){0.f, 0.f, 0.f, 0.f};
    bf16x8 At[4][2], B0[2][2], B1[2][2];
    const char* cA = (const char*)g.A + (size_t)cur.pm * tstep; const char* cB = (const char*)g.Bt + (size_t)cur.pn * tstep;
    S.a_ready(cur);
    if constexpr (SP2) {
        PG8_STAGE(PG8_SB(0, 0), cB, voffB); PG8_STAGE(PG8_SB(0, 1), cB + hstep, voffB); PG8_STAGE(PG8_SA(0, 0), cA, voffA); PG8_STAGE(PG8_SA(0, 1), cA + hstep, voffA);
        if (wr == 1) PG8_BAR;
        PG8_WAIT_V(2); PG8_BAR;
        PG8_STAGE(PG8_SB(1, 0), cB + kstep, voffB); PG8_STAGE(PG8_SA(1, 0), cA + kstep, voffA); PG8_STAGE(PG8_SB(1, 1), cB + hstep + kstep, voffB);
        PG8_WAIT_V(6); PG8_BAR;
    } else {
        PG8_STAGE(PG8_SB(0, 0), cB, voffB); PG8_STAGE(PG8_SA(0, 0), cA, voffA); PG8_STAGE(PG8_SB(0, 1), cB + hstep, voffB); PG8_STAGE(PG8_SA(0, 1), cA + hstep, voffA);
        if (wr == 1) PG8_BAR;
        PG8_WAIT_V(4); PG8_BAR;
        PG8_STAGE(PG8_SB(1, 0), cB + kstep, voffB); PG8_STAGE(PG8_SA(1, 0), cA + kstep, voffA); PG8_STAGE(PG8_SB(1, 1), cB + hstep + kstep, voffB);
        PG8_WAIT_V(6); PG8_BAR;
    }
    for (;;) {
        const bool has_next = S.next(ui + 1, nxt);
        const char* nA = has_next ? (const char*)g.A + (size_t)nxt.pm * tstep : cA; const char* nB = has_next ? (const char*)g.Bt + (size_t)nxt.pn * tstep : cB;
        for (int t = 0; t < nt; t += 2) {
            const bool last = (t == nt - 2);
            const char* a1 = cA + (size_t)(t + 1) * kstep;
            const char* a2 = last ? nA : cA + (size_t)(t + 2) * kstep; const char* b2 = last ? nB : cB + (size_t)(t + 2) * kstep;
            const char* a3 = a2 + kstep; const char* b3 = b2 + kstep;
            if (last && has_next) S.a_ready(nxt);
            if constexpr (SP2) {
            PG8_LDB(B0, 0, 0); PG8_LDB(B1, 0, 1); PG8_SCHED; PG8_LDA(At, 0, 0); PG8_STAGE(PG8_SA(1, 1), a1 + hstep, voffA);
            PG8_WAIT_V(8); PG8_WAIT_L(0); PG8_BAR; PG8_MMA(0, 0, At, B0); PG8_MMA(0, 1, At, B1); PG8_BAR; PG8_SCHED;
            PG8_LDA(At, 0, 1); PG8_STAGE(PG8_SB(0, 0), b2, voffB); PG8_STAGE(PG8_SB(0, 1), b2 + hstep, voffB); PG8_STAGE(PG8_SA(0, 0), a2, voffA);
            PG8_WAIT_V(8); PG8_WAIT_L(0); PG8_BAR; PG8_MMA(1, 0, At, B0); PG8_MMA(1, 1, At, B1); PG8_BAR; PG8_SCHED;
            PG8_LDB(B0, 1, 0); PG8_LDB(B1, 1, 1); PG8_SCHED; PG8_LDA(At, 1, 0); PG8_STAGE(PG8_SA(0, 1), a2 + hstep, voffA);
            PG8_WAIT_V(8); PG8_WAIT_L(0); PG8_BAR; PG8_MMA(0, 0, At, B0); PG8_MMA(0, 1, At, B1); PG8_BAR; PG8_SCHED;
            PG8_LDA(At, 1, 1); PG8_STAGE(PG8_SB(1, 0), b3, voffB); PG8_STAGE(PG8_SB(1, 1), b3 + hstep, voffB); PG8_STAGE(PG8_SA(1, 0), a3, voffA);
            PG8_WAIT_V(8); PG8_WAIT_L(0); PG8_BAR; PG8_MMA(1, 0, At, B0); PG8_MMA(1, 1, At, B1); PG8_BAR; PG8_SCHED;
            } else {
            PG8_LDB(B0, 0, 0); PG8_SCHED; PG8_LDA(At, 0, 0); PG8_STAGE(PG8_SA(1, 1), a1 + hstep, voffA);
            PG8_WAIT_L(8); PG8_BAR; PG8_WAIT_L(0); PG8_MMA(0, 0, At, B0); PG8_BAR; PG8_SCHED;
            PG8_LDB(B1, 0, 1); PG8_STAGE(PG8_SB(0, 0), b2, voffB);
            PG8_BAR; PG8_WAIT_L(0); PG8_MMA(0, 1, At, B1); PG8_BAR;
            PG8_LDA(At, 0, 1); PG8_STAGE(PG8_SA(0, 0), a2, voffA);
            PG8_BAR; PG8_WAIT_L(0); PG8_MMA(1, 0, At, B0); PG8_BAR; PG8_SCHED;
            PG8_STAGE(PG8_SB(0, 1), b2 + hstep, voffB);
            PG8_WAIT_V(6); PG8_BAR; PG8_MMA(1, 1, At, B1); PG8_BAR;
            PG8_LDB(B0, 1, 0); PG8_SCHED; PG8_LDA(At, 1, 0); PG8_STAGE(PG8_SA(0, 1), a2 + hstep, voffA);
            PG8_WAIT_L(8); PG8_BAR; PG8_WAIT_L(0); PG8_MMA(0, 0, At, B0); PG8_BAR; PG8_SCHED;
            PG8_LDB(B1, 1, 1); PG8_STAGE(PG8_SB(1, 0), b3, voffB);
            PG8_BAR; PG8_WAIT_L(0); PG8_MMA(0, 1, At, B1); PG8_BAR;
            PG8_LDA(At, 1, 1); PG8_STAGE(PG8_SA(1, 0), a3, voffA);
            PG8_BAR; PG8_WAIT_L(0); PG8_MMA(1, 0, At, B0); PG8_BAR; PG8_SCHED;
            PG8_STAGE(PG8_SB(1, 1), b3 + hstep, voffB);
            PG8_WAIT_V(6); PG8_BAR; PG8_MMA(1, 1, At, B1); PG8_BAR;
            }
        }
        if constexpr (ALIGN_EPI) { if (wr == 0) PG8_BAR; }
        if constexpr (!Epi::AFTER_DRAIN) { E(acc, cur, wr, wc, fr, fq); S.done(cur); }
        if (!has_next) break;
#pragma unroll
        for (int a = 0; a < 2; ++a)
#pragma unroll
            for (int b = 0; b < 2; ++b)
#pragma unroll
                for (int m = 0; m < 4; ++m)
#pragma unroll
                    for (int n = 0; n < 2; ++n) acc[a][b][m][n] = (f32x4){0.f, 0.f, 0.f, 0.f};
        cur = nxt; cA = nA; cB = nB; ++ui;
        if constexpr (ALIGN_EPI) { if (wr == 1) PG8_BAR; }
    }
    PG8_WAIT_V(0);
    if constexpr (!ALIGN_EPI) { if (wr == 0) PG8_BAR; }
    PG8_BAR;
    if constexpr (Epi::AFTER_DRAIN) { E.fused(acc, cur, wr, wc, fr, fq, lds, wid, lane); S.done(cur); }
#undef PG8_SA
#undef PG8_SB
#undef PG8_STAGE
#undef PG8_LDA
#undef PG8_LDB
#undef PG8_MMA
#undef PG8_WAIT_V
#undef PG8_WAIT_L
#undef PG8_BAR
#undef PG8_SCHED
}
}
constexpr int NWAVES = 8;
constexpr int BATCH = 4, T = 4096, D = 2048, M = BATCH * T;
constexpr int PLE_DIM = 256, FFN = 5632, MOE = 7168, NE = 8;
constexpr int REC_IN = 8208, UW = 8192, NREC = 8448;
constexpr int U_QA = 0, U_KA = 512, U_VA = 1024, U_OA = 2048, U_QB = 3072, U_FF = 4096, U_FB = 5120, U_IB = 6144, U_GB = 7168;
constexpr int NQKV = 6144;
constexpr int XS_ROWS = 34816;
constexpr float LN_EPS = 1e-5f, RMS_EPS = 1e-6f, ALPHA = 1.41421356237f, GATE_CAP = 15.0f;

constexpr size_t MiB = 1u << 20;
constexpr size_t WS_CTL = 0, CTL_ZERO_BYTES = 1 * MiB;
constexpr size_t WS_TOKE = 1 * MiB, WS_TOKG = WS_TOKE + 256 * 1024, WS_DEST = WS_TOKG + 256 * 1024, WS_WGCNT = WS_DEST + 256 * 1024, WS_TILEE = WS_WGCNT + 64 * 1024;
constexpr size_t WS_WQKV = 4 * MiB, WS_WNAO = 28 * MiB, WS_WPG1 = 36 * MiB, WS_WPP1 = 44 * MiB, WS_WMGU = 48 * MiB, WS_WMDN = 496 * MiB;
constexpr size_t WS_XB0 = 720 * MiB, WS_XB1 = 784 * MiB, WS_PB = 848 * MiB, WS_G = 864 * MiB;
constexpr size_t WS_WRIN = 872 * MiB, WS_WROUT = 905 * MiB, WS_WFGU = 913 * MiB, WS_WFDN = 957 * MiB, WS_WPG0 = 979 * MiB, WS_WPP0 = 987 * MiB;
constexpr size_t WS_U = 992 * MiB, WS_HA = 1248 * MiB, WS_HB = 1376 * MiB, WS_Y = 1504 * MiB;
constexpr size_t WS_H = 992 * MiB;
constexpr size_t WS_PP = 1248 * MiB;
constexpr size_t WS_QKV = 992 * MiB;
constexpr size_t WS_AO = WS_Y;
constexpr size_t WS_HM = 872 * MiB;
constexpr size_t WS_YS = 1348 * MiB;
constexpr size_t WS_XS = 1348 * MiB;
constexpr size_t WS_PP1 = 872 * MiB;
constexpr size_t WS_END = 1620 * MiB;
static_assert(WS_WMGU + (size_t)NE * 2 * MOE * D * 2 <= WS_WMDN && WS_WMDN + (size_t)NE * D * MOE * 2 <= WS_XB0, "ws map 1");
static_assert(WS_WRIN + (size_t)NREC * D * 2 <= WS_WROUT && WS_WFGU + (size_t)2 * FFN * D * 2 <= WS_WFDN && WS_WFDN + (size_t)D * FFN * 2 <= WS_WPG0 && WS_WPP0 + (size_t)D * PLE_DIM * 2 <= WS_U, "ws map 2");
static_assert(WS_U + (size_t)M * UW * 2 <= WS_HA && WS_H + (size_t)M * FFN * 2 <= WS_HA && WS_QKV + (size_t)M * NQKV * 2 <= WS_HA, "ws map 3");
static_assert(WS_HM + (size_t)XS_ROWS * MOE * 2 <= WS_YS && WS_YS + (size_t)XS_ROWS * D * 4 <= WS_END && WS_XS + (size_t)XS_ROWS * D * 2 <= WS_Y, "ws map 4");
constexpr int CW_BAR = 4096;

constexpr int RING_OFF = 0, RING_BYTES = 131072;
constexpr int LDSCTL_OFF = RING_BYTES, MISC_OFF = LDSCTL_OFF + 320;
constexpr int LDS_BYTES = 147456;
static_assert(MISC_OFF + 128 <= LDS_BYTES, "LDS map");

#define GAS __attribute__((address_space(1)))
#define LAS __attribute__((address_space(3)))
typedef unsigned short bf16;
typedef unsigned v4u __attribute__((ext_vector_type(4)));
typedef unsigned v2u __attribute__((ext_vector_type(2)));
typedef float f32x4 __attribute__((ext_vector_type(4)));
typedef float f32x2 __attribute__((ext_vector_type(2)));
typedef GAS unsigned gu32;
#define RLX_AGENT __ATOMIC_RELAXED, __HIP_MEMORY_SCOPE_AGENT
#define LDS_WAIT() asm volatile("s_waitcnt lgkmcnt(0)" ::: "memory")
#define VM_WAIT() asm volatile("s_waitcnt vmcnt(0)" ::: "memory")
__device__ __forceinline__ unsigned f2bf(float f) { unsigned u = __builtin_bit_cast(unsigned, f); return (u + 0x7fffu + ((u >> 16) & 1u)) >> 16; }
__device__ __forceinline__ unsigned pk2(float lo, float hi) { return f2bf(lo) | (f2bf(hi) << 16); }
__device__ __forceinline__ float bflo(unsigned w) { return __builtin_bit_cast(float, w << 16); }
__device__ __forceinline__ float bfhi(unsigned w) { return __builtin_bit_cast(float, w & 0xffff0000u); }
__device__ __forceinline__ float bf1(bf16 h) { return __builtin_bit_cast(float, (unsigned)h << 16); }
__device__ __forceinline__ float sigm(float x) { return 1.0f / (1.0f + __expf(-x)); }
#define XB_TMO      128
#define XB_XCNT(j)  (256  + 64 * (j))
#define XB_XSUB(j)  (1280 + 64 * (j))
#define XB_XGEN(j)  (2304 + 64 * (j))
#define XB_TOP      3328
#define XB_TOPGEN   3392
#define XCD_BAR_WORDS 3456
#define XB_SPIN_CAP (1u << 18)

__device__ __forceinline__ unsigned xb_ld(unsigned* p)              { return __hip_atomic_load(p, __ATOMIC_RELAXED, __HIP_MEMORY_SCOPE_AGENT); }
__device__ __forceinline__ unsigned xb_add(unsigned* p, unsigned v) { return __hip_atomic_fetch_add(p, v, __ATOMIC_RELAXED, __HIP_MEMORY_SCOPE_AGENT); }
__device__ __forceinline__ unsigned xb_xcc_id() { return (unsigned)__builtin_amdgcn_s_getreg((3 << 11) | 20) & 0xFu; }
#define XB_SPIN(cond, bar) do { unsigned _sp = 0; while (cond) { __builtin_amdgcn_s_sleep(1); \
    if ((++_sp & 255u) == 0u) { if (xb_ld(&(bar)[XB_TMO])) break; if (_sp > XB_SPIN_CAP) { atomicAdd(&(bar)[XB_TMO], 1u); break; } } } } while (0)

struct XcdBarrier {
    unsigned* bar; unsigned x;
    volatile LAS unsigned* st;
};

__device__ __forceinline__ XcdBarrier xcd_barrier_post(unsigned* bar, volatile LAS unsigned* st, int wave_s) {
    XcdBarrier b; b.bar = bar; b.x = xb_xcc_id(); b.st = st;
    if (wave_s == 0 && lane_now() == 0) (void)xb_add(&bar[XB_XCNT(b.x)], 1u);
    return b;
}
__device__ __forceinline__ void xcd_barrier_complete(unsigned* bar, unsigned x, unsigned& nloc, unsigned& nx) {
    const unsigned G = gridDim.x * gridDim.y * gridDim.z;
    unsigned sum, cnt, mine, sp = 0u;
    for (;;) {
        sum = 0u; cnt = 0u; mine = 0u;
#pragma unroll
        for (unsigned j = 0; j < 16; ++j) { const unsigned c = xb_ld(&bar[XB_XCNT(j)]); sum += c; cnt += (c > 0u) ? 1u : 0u; mine = (j == x) ? c : mine; }
        if (sum == G) break;
        __builtin_amdgcn_s_sleep(1);
        if ((++sp & 255u) == 0u) { if (xb_ld(&bar[XB_TMO])) break; if (sp > XB_SPIN_CAP) { atomicAdd(&bar[XB_TMO], 1u); break; } }
    }
    nloc = mine > 0u ? mine : 1u; nx = cnt > 0u ? cnt : 1u;
}

__device__ __forceinline__ void xcd_barrier(const XcdBarrier& b, int wave_s) {
    asm volatile("s_waitcnt vmcnt(0)" ::: "memory");
    __syncthreads();
    if (wave_s == 0 && lane_now() == 0) {
        unsigned* bar = b.bar;
        __builtin_amdgcn_s_waitcnt(0);
        unsigned nloc = b.st[0], nx = b.st[1];
        if (nloc == 0u) { xcd_barrier_complete(bar, b.x, nloc, nx); b.st[0] = nloc; b.st[1] = nx; }
        const unsigned old = xb_add(&bar[XB_XSUB(b.x)], 1u);
        const unsigned gen = old / nloc;
        if (old + 1u == (gen + 1u) * nloc) {
            __builtin_amdgcn_fence(__ATOMIC_RELEASE, "agent");
            asm volatile("s_waitcnt vmcnt(0)" ::: "memory");
            const unsigned og = xb_add(&bar[XB_TOP], 1u);
            const unsigned tg = og / nx;
            if (og + 1u == (tg + 1u) * nx) xb_add(&bar[XB_TOPGEN], 1u);
            else XB_SPIN(xb_ld(&bar[XB_TOPGEN]) == tg, bar);
            __builtin_amdgcn_fence(__ATOMIC_ACQUIRE, "agent");
            xb_add(&bar[XB_XGEN(b.x)], 1u);
            asm volatile("s_waitcnt vmcnt(0)" ::: "memory");
        } else {
            XB_SPIN(xb_ld(&bar[XB_XGEN(b.x)]) == gen, bar);
            __builtin_amdgcn_fence(__ATOMIC_ACQUIRE, "agent");
            asm volatile("s_waitcnt vmcnt(0)" ::: "memory");
        }
    }
    __syncthreads();
}

struct Frame {
    LAS unsigned char* lds;
    int wave, G;
};
struct Args { const float* in[23]; float* out; unsigned char* ws; int ph_lo, ph_hi; };
enum { I_X = 0, I_P, I_LNW, I_LNB, I_RECWIN, I_GBIAS, I_MNORM, I_LBLOG, I_HNORM, I_RECWOUT, I_FWG, I_FWU, I_FWD, I_NAQKV, I_RPB, I_NAOUT, I_WR, I_BR, I_MWG, I_MWU, I_MWD, I_PLEG, I_PLEP };

__device__ __forceinline__ float wave_sum(float v) {
#pragma unroll
    for (int o = 1; o < 64; o <<= 1) v += __shfl_xor(v, o);
    return v;
}
__device__ __forceinline__ float wave_max(float v) {
#pragma unroll
    for (int o = 1; o < 64; o <<= 1) v = fmaxf(v, __shfl_xor(v, o));
    return v;
}

__device__ __forceinline__ void tr_item(const float* W, int ldn, int K, int srcc, int nvalid, bf16* WT, size_t drow, int k0, LAS float* scr, int lane) {
    const int c = lane & 31;
    {   float tmp[32]; const float* wp = W + (size_t)(k0 + (lane >> 5)) * ldn + srcc + c; const bool ok = c < nvalid;
#pragma unroll
        for (int i = 0; i < 32; ++i) tmp[i] = ok ? __builtin_nontemporal_load(wp + (size_t)(2 * i) * ldn) : 0.f;
#pragma unroll
        for (int i = 0; i < 32; ++i) scr[(2 * i + (lane >> 5)) * 33 + c] = tmp[i]; }
    LDS_WAIT(); asm volatile("" ::: "memory");
    const int c8 = lane & 7;
#pragma unroll
    for (int j = 0; j < 4; ++j) { const int n = (lane >> 3) + 8 * j; const LAS float* s = scr + (8 * c8) * 33 + n;
        v4u o; o.x = pk2(s[0 * 33], s[1 * 33]); o.y = pk2(s[2 * 33], s[3 * 33]); o.z = pk2(s[4 * 33], s[5 * 33]); o.w = pk2(s[6 * 33], s[7 * 33]);
        *(GAS v4u*)(WT + (drow + n) * (size_t)K + k0 + 8 * c8) = o; }
    LDS_WAIT(); asm volatile("" ::: "memory");
}
__device__ __forceinline__ void p0_prologue(const Frame& F, const Args& A) {
    const int lane = lane_now(), tid = F.wave * 64 + lane; (void)tid;
    LAS float* scr = (LAS float*)(F.lds + RING_OFF + F.wave * 16384);
    const int gw = blockIdx.x * NWAVES + F.wave, NGW = F.G * NWAVES;
    unsigned char* ws = A.ws;
    constexpr int N_RIN = 32 * (NREC / 32), N_ROUT = 32 * 64, N_FGU = 32 * (2 * FFN / 32), N_FDN = (FFN / 64) * 64, N_PG = 32 * 64, N_PP = 4 * 64, N_QKV = 32 * (NQKV / 32), N_NAO = 32 * 64;
    constexpr int N_MGU = 32 * (NE * 2 * MOE / 32), N_MDN = (MOE / 64) * (NE * D / 32);
    constexpr int NITEMS = N_RIN + N_ROUT + N_FGU + N_FDN + 2 * N_PG + 2 * N_PP + N_QKV + N_NAO + N_MGU + N_MDN;
    for (int it = gw; it < NITEMS; it += NGW) {
        int r = it; const float* W; bf16* WT; int ldn, K, nblk;
        int srcc, nvalid = 32; size_t drow; int kb, nb;
        if (r < N_RIN) { W = A.in[I_RECWIN]; WT = (bf16*)(ws + WS_WRIN); ldn = REC_IN; K = D; nblk = NREC / 32; kb = r / nblk; nb = r % nblk; drow = (size_t)nb * 32;
            if (nb < 96) srcc = nb * 32; else if (nb < 256) srcc = nb * 32 + 16; else { srcc = 3072; nvalid = (nb == 256) ? 16 : 0; } }
        else if ((r -= N_RIN) < N_ROUT) { W = A.in[I_RECWOUT]; WT = (bf16*)(ws + WS_WROUT); ldn = D; K = D; nblk = 64; kb = r / nblk; nb = r % nblk; drow = (size_t)nb * 32; srcc = nb * 32; }
        else if ((r -= N_ROUT) < N_FGU) { WT = (bf16*)(ws + WS_WFGU); ldn = FFN; K = D; nblk = 2 * FFN / 32; kb = r / nblk; nb = r % nblk; drow = (size_t)nb * 32;
            const int tile = nb >> 3, w = nb & 7; W = (w < 4) ? A.in[I_FWG] : A.in[I_FWU]; srcc = tile * 128 + (w & 3) * 32; }
        else if ((r -= N_FGU) < N_FDN) { W = A.in[I_FWD]; WT = (bf16*)(ws + WS_WFDN); ldn = D; K = FFN; nblk = 64; kb = r / nblk; nb = r % nblk; drow = (size_t)nb * 32; srcc = nb * 32; }
        else if ((r -= N_FDN) < 2 * N_PG) { const int l = r / N_PG; r -= l * N_PG; W = A.in[I_PLEG] + (size_t)l * D * D; WT = (bf16*)(ws + (l ? WS_WPG1 : WS_WPG0)); ldn = D; K = D; nblk = 64; kb = r / nblk; nb = r % nblk; drow = (size_t)nb * 32; srcc = nb * 32; }
        else if ((r -= 2 * N_PG) < 2 * N_PP) { const int l = r / N_PP; r -= l * N_PP; W = A.in[I_PLEP] + (size_t)l * PLE_DIM * D; WT = (bf16*)(ws + (l ? WS_WPP1 : WS_WPP0)); ldn = D; K = PLE_DIM; nblk = 64; kb = r / nblk; nb = r % nblk; drow = (size_t)nb * 32; srcc = nb * 32; }
        else if ((r -= 2 * N_PP) < N_QKV) { W = A.in[I_NAQKV]; WT = (bf16*)(ws + WS_WQKV); ldn = NQKV; K = D; nblk = NQKV / 32; kb = r / nblk; nb = r % nblk; drow = (size_t)nb * 32; srcc = nb * 32; }
        else if ((r -= N_QKV) < N_NAO) { W = A.in[I_NAOUT]; WT = (bf16*)(ws + WS_WNAO); ldn = D; K = D; nblk = 64; kb = r / nblk; nb = r % nblk; drow = (size_t)nb * 32; srcc = nb * 32; }
        else if ((r -= N_NAO) < N_MGU) { WT = (bf16*)(ws + WS_WMGU); ldn = MOE; K = D; nblk = NE * 2 * MOE / 32; kb = r / nblk; nb = r % nblk; drow = (size_t)nb * 32;
            const int e = nb / (2 * MOE / 32), nl = nb % (2 * MOE / 32), tile = nl >> 3, w = nl & 7; W = ((w < 4) ? A.in[I_MWG] : A.in[I_MWU]) + (size_t)e * D * MOE; srcc = tile * 128 + (w & 3) * 32; }
        else { r -= N_MGU; WT = (bf16*)(ws + WS_WMDN); ldn = D; K = MOE; nblk = NE * D / 32; kb = r / nblk; nb = r % nblk; drow = (size_t)nb * 32;
            const int e = nb / (D / 32), nl = nb % (D / 32); W = A.in[I_MWD] + (size_t)e * MOE * D; srcc = nl * 32; }
        tr_item(W, ldn, K, srcc, nvalid, WT, drow, kb * 64, scr, lane);
    }
    const size_t gt = (size_t)blockIdx.x * (NWAVES * 64) + tid, NGT = (size_t)F.G * NWAVES * 64;
    { const GAS f32x4* src = (const GAS f32x4*)A.in[I_X]; GAS v4u* dst = (GAS v4u*)(ws + WS_XB0);
      for (size_t i = gt; i < (size_t)M * D / 8; i += NGT) { const f32x4 a = src[2 * i], b = src[2 * i + 1]; v4u o; o.x = pk2(a[0], a[1]); o.y = pk2(a[2], a[3]); o.z = pk2(b[0], b[1]); o.w = pk2(b[2], b[3]); dst[i] = o; } }
    { const GAS f32x4* src = (const GAS f32x4*)A.in[I_P]; GAS v4u* dst = (GAS v4u*)(ws + WS_PB);
      for (size_t i = gt; i < (size_t)2 * M * PLE_DIM / 8; i += NGT) { const f32x4 a = src[2 * i], b = src[2 * i + 1]; v4u o; o.x = pk2(a[0], a[1]); o.y = pk2(a[2], a[3]); o.z = pk2(b[0], b[1]); o.w = pk2(b[2], b[3]); dst[i] = o; } }
}

constexpr int RB = 32;
#define T0_OF(blk) (dir ? (T - RB - (blk) * RB) : (blk) * RB)
__device__ __forceinline__ void mlstm_unit(const Frame& F, const Args& A, int unit) {
    const int lane = lane_now(), tid = F.wave * 64 + lane; (void)tid;
    const int cg = unit & 3, dir = (unit >> 2) & 1, h = (unit >> 3) & 3, b = unit >> 5;
    LAS float* qs = (LAS float*)(F.lds + RING_OFF);
    LAS float* ks = qs + RB * 128;
    LAS float* vs = ks + RB * 128;
    LAS float* fi = vs + RB * 64;
    LAS float* ob = fi + RB * 2;
    const bf16* U = (const bf16*)(A.ws + WS_U); const float* Gt = (const float*)(A.ws + WS_G);
    float* HA = (float*)(A.ws + WS_HA) + (size_t)dir * M * 1024;
    const int e = lane & 7, dg = lane >> 3, colw = F.wave * 8 + e;
    const int srow = tid >> 4, sc = tid & 15;
    const float bias_i = A.in[I_GBIAS][(dir ? 2 : 0) * 4 + h], bias_f = A.in[I_GBIAS][(dir ? 3 : 1) * 4 + h];
    float C[16], n[16];
#pragma unroll
    for (int j = 0; j < 16; ++j) { C[j] = 0.f; n[j] = 0.f; }
    v4u rq, rk; v2u rv; float rgi = 0.f, rgf = 0.f;
    {   const size_t row = (size_t)b * T + T0_OF(0) + srow; const bf16* ur = U + row * UW;
        rq = *(const GAS v4u*)(ur + U_QA + h * 128 + sc * 8); rk = *(const GAS v4u*)(ur + U_KA + h * 128 + sc * 8); rv = *(const GAS v2u*)(ur + U_VA + h * 256 + cg * 64 + sc * 4);
        if (tid < RB) { const size_t r2 = (size_t)b * T + T0_OF(0) + tid; rgi = Gt[r2 * 16 + (dir ? 2 : 0) * 4 + h]; rgf = Gt[r2 * 16 + (dir ? 3 : 1) * 4 + h]; } }
    for (int blk = 0; blk < T / RB; ++blk) {
        const int t0 = T0_OF(blk);
        {   const float qsc = 0.08838834764831845f;
            LAS float* qd = qs + srow * 128 + sc * 8; LAS float* kd = ks + srow * 128 + sc * 8;
            *(LAS f32x4*)qd = (f32x4){bflo(rq.x) * qsc, bfhi(rq.x) * qsc, bflo(rq.y) * qsc, bfhi(rq.y) * qsc}; *(LAS f32x4*)(qd + 4) = (f32x4){bflo(rq.z) * qsc, bfhi(rq.z) * qsc, bflo(rq.w) * qsc, bfhi(rq.w) * qsc};
            *(LAS f32x4*)kd = (f32x4){bflo(rk.x), bfhi(rk.x), bflo(rk.y), bfhi(rk.y)}; *(LAS f32x4*)(kd + 4) = (f32x4){bflo(rk.z), bfhi(rk.z), bflo(rk.w), bfhi(rk.w)};
            *(LAS f32x4*)(vs + srow * 64 + sc * 4) = (f32x4){bflo(rv.x), bfhi(rv.x), bflo(rv.y), bfhi(rv.y)};
            if (tid < RB) { const float gi = GATE_CAP * tanhf((rgi + bias_i) * (1.0f / GATE_CAP)), gf = GATE_CAP * tanhf((rgf + bias_f) * (1.0f / GATE_CAP));
                fi[tid * 2] = sigm(gf); fi[tid * 2 + 1] = __expf(gi); } }
        __syncthreads();
        if (blk + 1 < T / RB) { const size_t row = (size_t)b * T + T0_OF(blk + 1) + srow; const bf16* ur = U + row * UW;
            rq = *(const GAS v4u*)(ur + U_QA + h * 128 + sc * 8); rk = *(const GAS v4u*)(ur + U_KA + h * 128 + sc * 8); rv = *(const GAS v2u*)(ur + U_VA + h * 256 + cg * 64 + sc * 4);
            if (tid < RB) { const size_t r2 = (size_t)b * T + T0_OF(blk + 1) + tid; rgi = Gt[r2 * 16 + (dir ? 2 : 0) * 4 + h]; rgf = Gt[r2 * 16 + (dir ? 3 : 1) * 4 + h]; } }
        for (int s = 0; s < RB; ++s) {
            const int tl = dir ? (RB - 1 - s) : s;
            const float f = fi[tl * 2], ii = fi[tl * 2 + 1], v = vs[tl * 64 + colw];
            const LAS f32x4* qp = (const LAS f32x4*)(qs + tl * 128 + dg * 16); const LAS f32x4* kp = (const LAS f32x4*)(ks + tl * 128 + dg * 16);
            float num = 0.f, den = 0.f;
#pragma unroll
            for (int j4 = 0; j4 < 4; ++j4) { const f32x4 q4 = qp[j4], k4 = kp[j4];
#pragma unroll
                for (int i = 0; i < 4; ++i) { const int j = j4 * 4 + i; const float kk = ii * k4[i]; C[j] = f * C[j] + kk * v; n[j] = f * n[j] + kk; num += C[j] * q4[i]; den += n[j] * q4[i]; } }
            num += __shfl_xor(num, 8); den += __shfl_xor(den, 8); num += __shfl_xor(num, 16); den += __shfl_xor(den, 16); num += __shfl_xor(num, 32); den += __shfl_xor(den, 32);
            if (dg == 0) ob[tl * 64 + colw] = num / fmaxf(fabsf(den), 1.0f);
        }
        __syncthreads();
        *(GAS f32x4*)(HA + ((size_t)b * T + t0 + srow) * 1024 + h * 256 + cg * 64 + sc * 4) = *(const LAS f32x4*)(ob + srow * 64 + sc * 4);
    }
    __syncthreads();
}
__device__ __forceinline__ void hgrn_unit(const Frame& F, const Args& A, int unit) {
    const int lane = lane_now(), tid = F.wave * 64 + lane; (void)tid;
    const int cg = unit & 1, dir = (unit >> 1) & 1, h = (unit >> 2) & 7, b = unit >> 5;
    LAS float* qs = (LAS float*)(F.lds + RING_OFF);
    LAS float* fs = qs + RB * 128;
    LAS float* vs = fs + RB * 128;
    LAS float* ob = vs + RB * 64;
    const bf16* U = (const bf16*)(A.ws + WS_U);
    float* HB = (float*)(A.ws + WS_HB) + (size_t)dir * M * 1024;
    const int e = lane & 7, dg = lane >> 3, colw = F.wave * 8 + e;
    const int srow = tid >> 4, sc = tid & 15;
    float lb[8];
#pragma unroll
    for (int i = 0; i < 8; ++i) { const float l0 = A.in[I_LBLOG][(dir * 2 + 0) * 1024 + h * 128 + sc * 8 + i], l1 = A.in[I_LBLOG][(dir * 2 + 1) * 1024 + h * 128 + sc * 8 + i]; lb[i] = 1.0f / (1.0f + __expf(l1 - l0)); }
    float S[16];
#pragma unroll
    for (int j = 0; j < 16; ++j) S[j] = 0.f;
    v4u rq, rf; v2u rv;
    {   const size_t row = (size_t)b * T + T0_OF(0) + srow; const bf16* ur = U + row * UW;
        rq = *(const GAS v4u*)(ur + U_QB + h * 128 + sc * 8); rf = *(const GAS v4u*)(ur + (dir ? U_FB : U_FF) + h * 128 + sc * 8); rv = *(const GAS v2u*)(ur + U_IB + h * 128 + cg * 64 + sc * 4); }
    for (int blk = 0; blk < T / RB; ++blk) {
        const int t0 = T0_OF(blk);
        {   LAS float* qd = qs + srow * 128 + sc * 8; LAS float* fd = fs + srow * 128 + sc * 8;
            float qv[8] = {bflo(rq.x), bfhi(rq.x), bflo(rq.y), bfhi(rq.y), bflo(rq.z), bfhi(rq.z), bflo(rq.w), bfhi(rq.w)};
            float fv[8] = {bflo(rf.x), bfhi(rf.x), bflo(rf.y), bfhi(rf.y), bflo(rf.z), bfhi(rf.z), bflo(rf.w), bfhi(rf.w)};
#pragma unroll
            for (int i = 0; i < 8; ++i) { qv[i] = qv[i] * sigm(qv[i]); fv[i] = lb[i] + (1.0f - lb[i]) * sigm(fv[i]); }
            *(LAS f32x4*)qd = (f32x4){qv[0], qv[1], qv[2], qv[3]}; *(LAS f32x4*)(qd + 4) = (f32x4){qv[4], qv[5], qv[6], qv[7]};
            *(LAS f32x4*)fd = (f32x4){fv[0], fv[1], fv[2], fv[3]}; *(LAS f32x4*)(fd + 4) = (f32x4){fv[4], fv[5], fv[6], fv[7]};
            *(LAS f32x4*)(vs + srow * 64 + sc * 4) = (f32x4){bflo(rv.x), bfhi(rv.x), bflo(rv.y), bfhi(rv.y)}; }
        __syncthreads();
        if (blk + 1 < T / RB) { const size_t row = (size_t)b * T + T0_OF(blk + 1) + srow; const bf16* ur = U + row * UW;
            rq = *(const GAS v4u*)(ur + U_QB + h * 128 + sc * 8); rf = *(const GAS v4u*)(ur + (dir ? U_FB : U_FF) + h * 128 + sc * 8); rv = *(const GAS v2u*)(ur + U_IB + h * 128 + cg * 64 + sc * 4); }
        for (int s = 0; s < RB; ++s) {
            const int tl = dir ? (RB - 1 - s) : s;
            const float v = vs[tl * 64 + colw];
            const LAS f32x4* qp = (const LAS f32x4*)(qs + tl * 128 + dg * 16); const LAS f32x4* fp = (const LAS f32x4*)(fs + tl * 128 + dg * 16);
            float o = 0.f;
#pragma unroll
            for (int j4 = 0; j4 < 4; ++j4) { const f32x4 q4 = qp[j4], f4 = fp[j4];
#pragma unroll
                for (int i = 0; i < 4; ++i) { const int j = j4 * 4 + i; S[j] = f4[i] * S[j] + (1.0f - f4[i]) * v; o += S[j] * q4[i]; } }
            o += __shfl_xor(o, 8); o += __shfl_xor(o, 16); o += __shfl_xor(o, 32);
            if (dg == 0) ob[tl * 64 + colw] = o;
        }
        __syncthreads();
        *(GAS f32x4*)(HB + ((size_t)b * T + t0 + srow) * 1024 + h * 128 + cg * 64 + sc * 4) = *(const LAS f32x4*)(ob + srow * 64 + sc * 4);
    }
    __syncthreads();
}
__device__ __forceinline__ void p3_finalize(const Frame& F, const Args& A) {
    const int lane = lane_now(), tid = F.wave * 64 + lane; (void)tid;
    const int gw = blockIdx.x * NWAVES + F.wave, NGW = F.G * NWAVES;
    const bf16* U = (const bf16*)(A.ws + WS_U); bf16* Y = (bf16*)(A.ws + WS_Y);
    const float* HA = (const float*)(A.ws + WS_HA); const float* HB = (const float*)(A.ws + WS_HB);
    for (int row = gw; row < M; row += NGW) {
        const bf16* ur = U + (size_t)row * UW; bf16* yr = Y + (size_t)row * D;
#pragma unroll
        for (int h = 0; h < 4; ++h) { const int c = h * 256 + lane * 4;
            const f32x4 a = *(const GAS f32x4*)(HA + (size_t)row * 1024 + c), bq = *(const GAS f32x4*)(HA + (size_t)M * 1024 + (size_t)row * 1024 + c);
            const f32x4 s = a + bq; float ss = (s[0] * s[0] + s[1] * s[1]) + (s[2] * s[2] + s[3] * s[3]); ss = wave_sum(ss);
            const float r = 1.0f / sqrtf(ss * (1.0f / 256.0f) + RMS_EPS);
            const f32x4 w = *(const GAS f32x4*)(A.in[I_MNORM] + c); const v2u og = *(const GAS v2u*)(ur + U_OA + c);
            const float o0 = s[0] * r * w[0] * sigm(bflo(og.x)), o1 = s[1] * r * w[1] * sigm(bfhi(og.x)), o2 = s[2] * r * w[2] * sigm(bflo(og.y)), o3 = s[3] * r * w[3] * sigm(bfhi(og.y));
            v2u o; o.x = pk2(o0, o1); o.y = pk2(o2, o3); *(GAS v2u*)(yr + c) = o; }
#pragma unroll
        for (int hp = 0; hp < 4; ++hp) { const int c = hp * 256 + lane * 4;
            const f32x4 a = *(const GAS f32x4*)(HB + (size_t)row * 1024 + c), bq = *(const GAS f32x4*)(HB + (size_t)M * 1024 + (size_t)row * 1024 + c);
            const f32x4 s = a + bq; float ss = (s[0] * s[0] + s[1] * s[1]) + (s[2] * s[2] + s[3] * s[3]);
#pragma unroll
            for (int o = 1; o < 32; o <<= 1) ss += __shfl_xor(ss, o);
            const float r = 1.0f / sqrtf(ss * (1.0f / 128.0f) + RMS_EPS);
            const f32x4 w = *(const GAS f32x4*)(A.in[I_HNORM] + c); const v2u gg = *(const GAS v2u*)(ur + U_GB + c);
            const float g0 = bflo(gg.x), g1 = bfhi(gg.x), g2 = bflo(gg.y), g3 = bfhi(gg.y);
            const float o0 = s[0] * r * w[0] * g0 * sigm(g0), o1 = s[1] * r * w[1] * g1 * sigm(g1), o2 = s[2] * r * w[2] * g2 * sigm(g2), o3 = s[3] * r * w[3] * g3 * sigm(g3);
            v2u o; o.x = pk2(o0, o1); o.y = pk2(o2, o3); *(GAS v2u*)(yr + 1024 + c) = o; }
    }
}

__device__ __forceinline__ void ln_row_regs(f32x4 (&v)[8], const float* w, const float* bvec, int lane) {
    float s = 0.f;
#pragma unroll
    for (int j = 0; j < 8; ++j) s += (v[j][0] + v[j][1]) + (v[j][2] + v[j][3]);
    const float mean = wave_sum(s) * (1.0f / D); float s2 = 0.f;
#pragma unroll
    for (int j = 0; j < 8; ++j) { v[j] = v[j] - mean; s2 += (v[j][0] * v[j][0] + v[j][1] * v[j][1]) + (v[j][2] * v[j][2] + v[j][3] * v[j][3]); }
    const float rstd = 1.0f / sqrtf(wave_sum(s2) * (1.0f / D) + LN_EPS);
#pragma unroll
    for (int j = 0; j < 8; ++j) { const f32x4 ww = *(const GAS f32x4*)(w + 256 * j + 4 * lane), bb = *(const GAS f32x4*)(bvec + 256 * j + 4 * lane); v[j] = v[j] * rstd * ww + bb; }
}
__device__ __forceinline__ void store_row(const f32x4 (&v)[8], float* xf, bf16* xb, int lane) {
#pragma unroll
    for (int j = 0; j < 8; ++j) { *(GAS f32x4*)(xf + 256 * j + 4 * lane) = v[j]; v2u o; o.x = pk2(v[j][0], v[j][1]); o.y = pk2(v[j][2], v[j][3]); *(GAS v2u*)(xb + 256 * j + 4 * lane) = o; }
}
__device__ __forceinline__ void ln_phase(const Frame& F, const Args& A, const float* w, const float* bvec, bf16* XB) {
    const int lane = lane_now(), tid = F.wave * 64 + lane; (void)tid;
    const int gw = blockIdx.x * NWAVES + F.wave, NGW = F.G * NWAVES;
    for (int row = gw; row < M; row += NGW) { float* xr = A.out + (size_t)row * D; f32x4 v[8];
#pragma unroll
        for (int j = 0; j < 8; ++j) v[j] = *(const GAS f32x4*)(xr + 256 * j + 4 * lane);
        ln_row_regs(v, w, bvec, lane); store_row(v, xr, XB + (size_t)row * D, lane); }
}
__device__ __forceinline__ void ln_router_phase(const Frame& F, const Args& A, const float* w, const float* bvec, bf16* XB) {
    const int lane = lane_now(), tid = F.wave * 64 + lane; (void)tid;
    LAS int* cnt = (LAS int*)(F.lds + RING_OFF);
    int* TOKE = (int*)(A.ws + WS_TOKE); float* TOKG = (float*)(A.ws + WS_TOKG); int* WGCNT = (int*)(A.ws + WS_WGCNT);
    const float* wr = A.in[I_WR]; const float* br = A.in[I_BR];
    for (int vb = blockIdx.x; vb < M / 64; vb += F.G) {
        if (tid < 8) cnt[tid] = 0;
        __syncthreads();
        for (int k = 0; k < 8; ++k) { const int row = vb * 64 + F.wave * 8 + k; float* xr = A.out + (size_t)row * D; f32x4 v[8];
#pragma unroll
            for (int j = 0; j < 8; ++j) v[j] = *(const GAS f32x4*)(xr + 256 * j + 4 * lane);
            ln_row_regs(v, w, bvec, lane); store_row(v, xr, XB + (size_t)row * D, lane);
            float lg[8];
#pragma unroll
            for (int e = 0; e < 8; ++e) lg[e] = 0.f;
#pragma unroll
            for (int j = 0; j < 8; ++j)
#pragma unroll
                for (int i = 0; i < 4; ++i) { const float* wp = wr + (size_t)(256 * j + 4 * lane + i) * NE; const f32x4 w0 = *(const GAS f32x4*)wp, w1 = *(const GAS f32x4*)(wp + 4); const float xv = v[j][i];
                    lg[0] += xv * w0[0]; lg[1] += xv * w0[1]; lg[2] += xv * w0[2]; lg[3] += xv * w0[3]; lg[4] += xv * w1[0]; lg[5] += xv * w1[1]; lg[6] += xv * w1[2]; lg[7] += xv * w1[3]; }
#pragma unroll
            for (int e = 0; e < 8; ++e) lg[e] = wave_sum(lg[e]) + br[e];
            int e1 = 0; float l1 = lg[0];
#pragma unroll
            for (int e = 1; e < 8; ++e) if (lg[e] > l1) { l1 = lg[e]; e1 = e; }
            int e2 = -1; float l2 = -3.0e38f;
#pragma unroll
            for (int e = 0; e < 8; ++e) if (e != e1 && lg[e] > l2) { l2 = lg[e]; e2 = e; }
            const float g2 = 1.0f / (1.0f + __expf(l1 - l2)), g1 = 1.0f - g2;
            if (lane == 0) { TOKE[2 * row] = e1; TOKE[2 * row + 1] = e2; TOKG[2 * row] = g1; TOKG[2 * row + 1] = g2; __hip_atomic_fetch_add(&cnt[e1], 1, __ATOMIC_RELAXED, __HIP_MEMORY_SCOPE_WORKGROUP); __hip_atomic_fetch_add(&cnt[e2], 1, __ATOMIC_RELAXED, __HIP_MEMORY_SCOPE_WORKGROUP); }
        }
        __syncthreads();
        if (tid < 8) WGCNT[vb * 8 + tid] = cnt[tid];
        __syncthreads();
    }
}
__device__ __forceinline__ void moe_scatter_phase(const Frame& F, const Args& A, const bf16* XB) {
    const int lane = lane_now(), tid = F.wave * 64 + lane; (void)tid;
    LAS int* sm = (LAS int*)(F.lds + RING_OFF);
    const int* TOKE = (const int*)(A.ws + WS_TOKE); int* DEST = (int*)(A.ws + WS_DEST); const int* WGCNT = (const int*)(A.ws + WS_WGCNT); int* TILEE = (int*)(A.ws + WS_TILEE);
    bf16* XS = (bf16*)(A.ws + WS_XS);
    for (int vb = blockIdx.x; vb < M / 64; vb += F.G) {
        if (tid < 16) sm[tid] = 0;
        if (tid >= 64 && tid < 192) sm[32 + tid - 64] = TOKE[vb * 128 + tid - 64];
        __syncthreads();
        {   const int e = tid & 7, wq = tid >> 3; int tot = 0, pre = 0;
#pragma unroll
            for (int i = 0; i < 4; ++i) { const int w = wq * 4 + i; const int c = WGCNT[w * 8 + e]; tot += c; pre += (w < vb) ? c : 0; }
            __hip_atomic_fetch_add(&sm[e], tot, __ATOMIC_RELAXED, __HIP_MEMORY_SCOPE_WORKGROUP); __hip_atomic_fetch_add(&sm[8 + e], pre, __ATOMIC_RELAXED, __HIP_MEMORY_SCOPE_WORKGROUP); }
        __syncthreads();
        if (tid == 0) { int base = 0; for (int e = 0; e < 8; ++e) { sm[16 + e] = base; base += ((sm[e] + 255) >> 8) << 8; }
            if (vb == 0) { int rt = 0; for (int e = 0; e < 8; ++e) { const int nt = (sm[e] + 255) >> 8; for (int i = 0; i < nt; ++i) TILEE[1 + rt++] = e; } TILEE[0] = rt; } }
        __syncthreads();
        if (tid < 128) { const int e = sm[32 + tid]; int rank = 0; for (int s = 0; s < tid; ++s) rank += (sm[32 + s] == e) ? 1 : 0; const int d = sm[16 + e] + sm[8 + e] + rank; sm[160 + tid] = d; DEST[vb * 128 + tid] = d; }
        __syncthreads();
        for (int s = F.wave; s < 128; s += NWAVES) { const int tok = vb * 64 + (s >> 1); const int d = sm[160 + s];
            const GAS v4u* src = (const GAS v4u*)(XB + (size_t)tok * D); GAS v4u* dst = (GAS v4u*)(XS + (size_t)d * D);
#pragma unroll
            for (int j = 0; j < 4; ++j) dst[64 * j + lane] = src[64 * j + lane]; }
        __syncthreads();
    }
}
__device__ __forceinline__ void ln_moe_phase(const Frame& F, const Args& A, const float* w, const float* bvec, bf16* XB) {
    const int lane = lane_now(), tid = F.wave * 64 + lane; (void)tid;
    const int gw = blockIdx.x * NWAVES + F.wave, NGW = F.G * NWAVES;
    const float* TOKG = (const float*)(A.ws + WS_TOKG); const int* DEST = (const int*)(A.ws + WS_DEST); const float* YS = (const float*)(A.ws + WS_YS);
    for (int row = gw; row < M; row += NGW) { float* xr = A.out + (size_t)row * D; f32x4 v[8];
        const int d1 = DEST[2 * row], d2 = DEST[2 * row + 1]; const float g1 = TOKG[2 * row], g2 = TOKG[2 * row + 1];
        const float* y1 = YS + (size_t)d1 * D; const float* y2 = YS + (size_t)d2 * D;
#pragma unroll
        for (int j = 0; j < 8; ++j) { const int c = 256 * j + 4 * lane; v[j] = *(const GAS f32x4*)(xr + c) * ALPHA + *(const GAS f32x4*)(y1 + c) * g1 + *(const GAS f32x4*)(y2 + c) * g2; }
        ln_row_regs(v, w, bvec, lane); store_row(v, xr, XB + (size_t)row * D, lane); }
}

__device__ __forceinline__ void na_phase_simple(const Frame& F, const Args& A) {
    const int lane = lane_now(), tid = F.wave * 64 + lane; (void)tid;
    const int gw = blockIdx.x * NWAVES + F.wave, NGW = F.G * NWAVES;
    const bf16* QKV = (const bf16*)(A.ws + WS_QKV); bf16* AO = (bf16*)(A.ws + WS_AO); const float* rpb = A.in[I_RPB];
    const float scale = 0.08838834764831845f;
    for (int task = gw; task < M * 16; task += NGW) {
        const int tok = task >> 4, h = task & 15, b = tok >> 12, r = (tok >> 6) & 63, c = tok & 63;
        const int rs = min(max(r - 4, 0), 56), cs = min(max(c - 8, 0), 48);
        const GAS v4u* qp = (const GAS v4u*)(QKV + (size_t)tok * NQKV + h * 128);
        float sc[2];
#pragma unroll
        for (int i = 0; i < 2; ++i) { const int kk = lane + 64 * i, jr = kk >> 4, jc = kk & 15; const int ktok = b * T + (rs + jr) * 64 + cs + jc;
            const GAS v4u* kp = (const GAS v4u*)(QKV + (size_t)ktok * NQKV + D + h * 128); float acc = 0.f;
#pragma unroll 4
            for (int j = 0; j < 16; ++j) { const v4u q = qp[j], k = kp[j];
                acc += bflo(q.x) * bflo(k.x) + bfhi(q.x) * bfhi(k.x) + bflo(q.y) * bflo(k.y) + bfhi(q.y) * bfhi(k.y) + bflo(q.z) * bflo(k.z) + bfhi(q.z) * bfhi(k.z) + bflo(q.w) * bflo(k.w) + bfhi(q.w) * bfhi(k.w); }
            sc[i] = acc * scale + rpb[(h * 15 + (rs + jr - r + 7)) * 31 + (cs + jc - c + 15)]; }
        const float mx = wave_max(fmaxf(sc[0], sc[1]));
        const float p0 = __expf(sc[0] - mx), p1 = __expf(sc[1] - mx);
        const float inv = 1.0f / wave_sum(p0 + p1);
        float a0 = 0.f, a1 = 0.f;
        const bf16* vbase = QKV + 2 * D + h * 128 + 2 * lane;
#pragma unroll
        for (int i = 0; i < 2; ++i) { const float pi = i ? p1 : p0;
#pragma unroll 8
            for (int l = 0; l < 64; ++l) { const int kk = l + 64 * i, jr = kk >> 4, jc = kk & 15; const int ktok = b * T + (rs + jr) * 64 + cs + jc;
                const float pk = __builtin_bit_cast(float, __builtin_amdgcn_readlane(__builtin_bit_cast(int, pi), l));
                const unsigned vv = *(const GAS unsigned*)(vbase + (size_t)ktok * NQKV); a0 += pk * bflo(vv); a1 += pk * bfhi(vv); } }
        *(GAS unsigned*)(AO + (size_t)tok * D + h * 128 + 2 * lane) = pk2(a0 * inv, a1 * inv);
    }
}
typedef short bf16x8 __attribute__((ext_vector_type(8)));
typedef short s16x4 __attribute__((ext_vector_type(4)));
__device__ __forceinline__ s16x4 lds_tr(LAS unsigned char* p) { return __builtin_bit_cast(s16x4, __builtin_amdgcn_ds_read_tr16_b64_v4i16((LAS s16x4*)p)); }
__device__ __forceinline__ unsigned cvtpk(float lo, float hi) { unsigned r; asm volatile("v_cvt_pk_bf16_f32 %0, %1, %2" : "=v"(r) : "v"(lo), "v"(hi)); return r; }
constexpr int NA_VP = 288;
__device__ __forceinline__ void na_phase_mfma(const Frame& F, const Args& A) {
    const int lane = lane_now(), tid = F.wave * 64 + lane, i = lane & 15, fq = lane >> 4;
    const bf16* QKV = (const bf16*)(A.ws + WS_QKV); bf16* AO = (bf16*)(A.ws + WS_AO); const float* rpb = A.in[I_RPB];
    LAS unsigned char* vl = F.lds + RING_OFF;
    LAS float* rp = (LAS float*)(F.lds + RING_OFF + 5 * 64 * NA_VP);
    const int qsel = F.wave >> 2, qi = F.wave & 3, wc = min(max(16 * qi - 8, 0), 32);
    const int qc = 16 * qi + i, cs = min(max(qc - 8, 0), 48);
    const float scale = 0.08838834764831845f;
    for (int unit = blockIdx.x; unit < 64 * 32; unit += F.G) {
        const int rpi = unit & 31, bh = unit >> 5, h = bh & 15, b = bh >> 4;
        const int r0 = 2 * rpi, qrow = r0 + qsel, R0 = min(max(r0 - 4, 0), 56), rsw = min(max(qrow - 4, 0), 56);
        const size_t tokb = (size_t)b * T;
        if (tid < 465) rp[tid] = rpb[h * 465 + tid];
        v4u vreg[10];
#pragma unroll
        for (int k = 0; k < 10; ++k) { const int ch = tid + 512 * k, row = ch >> 10, key = (ch >> 4) & 63, c16 = ch & 15; const int vr = min(R0 + row, 63);
            vreg[k] = *(const GAS v4u*)(QKV + (tokb + vr * 64 + key) * NQKV + 2 * D + h * 128 + c16 * 8); }
        bf16x8 bq[4];
        { const bf16* qp = QKV + (tokb + qrow * 64 + qc) * NQKV + h * 128 + 8 * fq;
#pragma unroll
          for (int kk = 0; kk < 4; ++kk) bq[kk] = *(const GAS bf16x8*)(qp + 32 * kk); }
        f32x4 acc[16];
#pragma unroll
        for (int kt = 0; kt < 16; ++kt) acc[kt] = (f32x4){0.f, 0.f, 0.f, 0.f};
#pragma unroll
        for (int jr = 0; jr < 8; ++jr) {
            bf16x8 ka[2][4];
#pragma unroll
            for (int kb2 = 0; kb2 < 2; ++kb2) { const bf16* kp = QKV + (tokb + (rsw + jr) * 64 + wc + 16 * kb2 + i) * NQKV + D + h * 128 + 8 * fq;
#pragma unroll
                for (int kk = 0; kk < 4; ++kk) ka[kb2][kk] = *(const GAS bf16x8*)(kp + 32 * kk); }
#pragma unroll
            for (int kb2 = 0; kb2 < 2; ++kb2)
#pragma unroll
                for (int kk = 0; kk < 4; ++kk) acc[2 * jr + kb2] = __builtin_amdgcn_mfma_f32_16x16x32_bf16(ka[kb2][kk], bq[kk], acc[2 * jr + kb2], 0, 0, 0);
        }
        __syncthreads();
#pragma unroll
        for (int k = 0; k < 10; ++k) { const int ch = tid + 512 * k, row = ch >> 10, key = (ch >> 4) & 63, c16 = ch & 15; *(LAS v4u*)(vl + (row * 64 + key) * NA_VP + c16 * 16) = vreg[k]; }
#pragma unroll
        for (int k = 0; k < 8; ++k) { const int ch = tid + 512 * k, row = ch >> 10, key = (ch >> 4) & 63, c16 = ch & 15; const int vr = min(R0 + 5 + row, 63);
            vreg[k] = *(const GAS v4u*)(QKV + (tokb + vr * 64 + key) * NQKV + 2 * D + h * 128 + c16 * 8); }
        float mx = -3.0e38f;
#pragma unroll
        for (int kt = 0; kt < 16; ++kt) { const int jr = kt >> 1, kb2 = kt & 1; const int dr = rsw + jr - qrow + 7;
#pragma unroll
            for (int r = 0; r < 4; ++r) { const int kc = wc + 16 * kb2 + 4 * fq + r; const int dc = min(max(kc - qc + 15, 0), 30); const bool ok = (kc >= cs) && (kc < cs + 16);
                const float s = ok ? acc[kt][r] * scale + rp[dr * 31 + dc] : -3.0e38f; acc[kt][r] = s; mx = fmaxf(mx, s); } }
        mx = fmaxf(mx, __shfl_xor(mx, 16)); mx = fmaxf(mx, __shfl_xor(mx, 32));
        float sum = 0.f;
#pragma unroll
        for (int kt = 0; kt < 16; ++kt)
#pragma unroll
            for (int r = 0; r < 4; ++r) { const float p = __expf(acc[kt][r] - mx); acc[kt][r] = p; sum += p; }
        sum += __shfl_xor(sum, 16); sum += __shfl_xor(sum, 32);
        const float inv = 1.0f / sum;
        bf16x8 pb[8];
#pragma unroll
        for (int ks = 0; ks < 8; ++ks) { v4u w; w.x = cvtpk(acc[2 * ks][0], acc[2 * ks][1]); w.y = cvtpk(acc[2 * ks][2], acc[2 * ks][3]); w.z = cvtpk(acc[2 * ks + 1][0], acc[2 * ks + 1][1]); w.w = cvtpk(acc[2 * ks + 1][2], acc[2 * ks + 1][3]);
            pb[ks] = __builtin_bit_cast(bf16x8, w); }
        __syncthreads();
        f32x4 o[8];
#pragma unroll
        for (int db = 0; db < 8; ++db) o[db] = (f32x4){0.f, 0.f, 0.f, 0.f};
        const int q4 = (lane & 15) >> 2, p4 = lane & 3;
        LAS unsigned char* vb0 = vl + (wc + 4 * fq + q4) * NA_VP + 8 * p4;
#pragma unroll
        for (int jr = 0; jr < 8; ++jr) { const int la = rsw + jr - R0;
            if (la <= 4) { LAS unsigned char* vp = vb0 + la * 64 * NA_VP;
#pragma unroll
                for (int db = 0; db < 8; ++db) { const s16x4 x0 = lds_tr(vp + 32 * db), x1 = lds_tr(vp + 16 * NA_VP + 32 * db);
                    const bf16x8 a = (bf16x8){x0[0], x0[1], x0[2], x0[3], x1[0], x1[1], x1[2], x1[3]};
                    o[db] = __builtin_amdgcn_mfma_f32_16x16x32_bf16(a, pb[jr], o[db], 0, 0, 0); } } }
        __syncthreads();
#pragma unroll
        for (int k = 0; k < 8; ++k) { const int ch = tid + 512 * k, row = ch >> 10, key = (ch >> 4) & 63, c16 = ch & 15; *(LAS v4u*)(vl + (row * 64 + key) * NA_VP + c16 * 16) = vreg[k]; }
        __syncthreads();
#pragma unroll
        for (int jr = 0; jr < 8; ++jr) { const int la = rsw + jr - R0 - 5;
            if (la >= 0) { LAS unsigned char* vp = vb0 + la * 64 * NA_VP;
#pragma unroll
                for (int db = 0; db < 8; ++db) { const s16x4 x0 = lds_tr(vp + 32 * db), x1 = lds_tr(vp + 16 * NA_VP + 32 * db);
                    const bf16x8 a = (bf16x8){x0[0], x0[1], x0[2], x0[3], x1[0], x1[1], x1[2], x1[3]};
                    o[db] = __builtin_amdgcn_mfma_f32_16x16x32_bf16(a, pb[jr], o[db], 0, 0, 0); } } }
        bf16* op = AO + (tokb + qrow * 64 + qc) * D + h * 128 + 4 * fq;
#pragma unroll
        for (int db = 0; db < 8; ++db) { v2u w; w.x = cvtpk(o[db][0] * inv, o[db][1] * inv); w.y = cvtpk(o[db][2] * inv, o[db][3] * inv); *(GAS v2u*)(op + 16 * db) = w; }
    }
    __syncthreads();
}
#ifndef MK_ONE_LAUNCH
#define MK_ONE_LAUNCH 1
#endif
constexpr int N_PHASES = 21;
__global__ void __launch_bounds__(NWAVES * 64, 2) trunk_fwd(Args args) {
    extern __shared__ __attribute__((aligned(16))) unsigned char lds[];
    Frame F;
    F.lds = (LAS unsigned char*)lds;
    F.wave = __builtin_amdgcn_readfirstlane(threadIdx.x >> 6);
    F.G = gridDim.x;
    const Args& A = args;
    { const int tid0 = F.wave * 64 + lane_now(); for (int u = tid0; u < (LDS_BYTES - LDSCTL_OFF) / 4; u += NWAVES * 64) ((LAS unsigned*)(F.lds + LDSCTL_OFF))[u] = 0u; }
    __syncthreads();
    gu32* ctl = (gu32*)(args.ws + WS_CTL);
    const int lo = args.ph_lo, hi = args.ph_hi;
    XcdBarrier bar; bar.bar = (unsigned*)(ctl + CW_BAR); bar.x = 0; bar.st = nullptr;
    if (hi - lo > 1) bar = xcd_barrier_post((unsigned*)(ctl + CW_BAR), (volatile LAS unsigned*)(F.lds + MISC_OFF) + 8, F.wave);
#ifndef PROBE_MASK
#define PROBE_MASK 0u
#endif
#define IN(k) (lo <= (k) && (k) < hi)
#define REP(k) _Pragma("unroll") for (int rep_ = 0; rep_ < (((PROBE_MASK >> (k)) & 1u) ? 2 : 1); ++rep_)
#define RSEAM(k) do { if (((PROBE_MASK >> (k)) & 1u) && rep_ == 0) xcd_barrier(bar, F.wave); } while (0)
#define SEAM(k) do { if (IN(k) && IN((k) + 1)) xcd_barrier(bar, F.wave); } while (0)
    unsigned char* ws = args.ws;
    bf16* XB0 = (bf16*)(ws + WS_XB0); bf16* XB1 = (bf16*)(ws + WS_XB1);
    const int bid = (int)blockIdx.x;

    REP(0) if (IN(0)) { p0_prologue(F, A); RSEAM(0); } SEAM(0);
    REP(1) if (IN(1)) {
        pg8::Gemm g{XB0, (const bf16*)(ws + WS_WRIN), M, NREC, D}; pg8::StaticOrder S; S.init(M, NREC, F.G, bid);
        pg8::EpiBf16G E{(bf16*)(ws + WS_U), UW, 32, (float*)(ws + WS_G)};
        pg8::gemm_phase<pg8::EpiBf16G, pg8::StaticOrder, true, true>(F.lds + RING_OFF, g, S, E, F.wave);
    RSEAM(1); } SEAM(1);
    REP(2) if (IN(2)) { for (int unit = bid; unit < 256; unit += F.G) { if (unit < 128) mlstm_unit(F, A, unit); else hgrn_unit(F, A, unit - 128); } RSEAM(2); } SEAM(2);
    REP(3) if (IN(3)) { p3_finalize(F, A); RSEAM(3); } SEAM(3);
    REP(4) if (IN(4)) {
        pg8::Gemm g{(const bf16*)(ws + WS_Y), (const bf16*)(ws + WS_WROUT), M, D, D}; pg8::StaticOrder S; S.init(M, D, F.G, bid);
        pg8::EpiResF32 E{A.in[I_X], A.out, D, ALPHA};
        pg8::gemm_phase<pg8::EpiResF32, pg8::StaticOrder, true, true>(F.lds + RING_OFF, g, S, E, F.wave);
    RSEAM(4); } SEAM(4);
    REP(5) if (IN(5)) { ln_phase(F, A, A.in[I_LNW] + 0 * D, A.in[I_LNB] + 0 * D, XB1); RSEAM(5); } SEAM(5);
    REP(6) if (IN(6)) {
        pg8::Gemm g{XB1, (const bf16*)(ws + WS_WFGU), M, 2 * FFN, D}; pg8::StaticOrder S; S.init(M, 2 * FFN, F.G, bid);
        pg8::EpiSwiglu E{(bf16*)(ws + WS_H), FFN, 2 * FFN / 256};
        pg8::gemm_phase<pg8::EpiSwiglu, pg8::StaticOrder, true, true>(F.lds + RING_OFF, g, S, E, F.wave);
    RSEAM(6); } SEAM(6);
    REP(7) if (IN(7)) {
        pg8::Gemm g{(const bf16*)(ws + WS_H), (const bf16*)(ws + WS_WFDN), M, D, FFN}; pg8::StaticOrder S; S.init(M, D, F.G, bid);
        pg8::EpiResF32 E{A.out, A.out, D, ALPHA};
        pg8::gemm_phase<pg8::EpiResF32, pg8::StaticOrder, true, true>(F.lds + RING_OFF, g, S, E, F.wave);
    RSEAM(7); } SEAM(7);
    REP(8) if (IN(8)) { ln_phase(F, A, A.in[I_LNW] + 1 * D, A.in[I_LNB] + 1 * D, XB0); RSEAM(8); } SEAM(8);
    REP(9) if (IN(9)) {
        pg8::Gemm g{(const bf16*)(ws + WS_PB), (const bf16*)(ws + WS_WPP0), M, D, PLE_DIM}; pg8::StaticOrder S; S.init(M, D, F.G, bid);
        pg8::EpiStoreF32 E{(float*)(ws + WS_PP), D, D / 256};
        pg8::gemm_phase<pg8::EpiStoreF32, pg8::StaticOrder, true, true>(F.lds + RING_OFF, g, S, E, F.wave);
    RSEAM(9); } SEAM(9);
    REP(10) if (IN(10)) {
        pg8::Gemm g{XB0, (const bf16*)(ws + WS_WPG0), M, D, D}; pg8::StaticOrder S; S.init(M, D, F.G, bid);
        pg8::EpiPle E{A.out, (const float*)(ws + WS_PP), XB1, D};
        pg8::gemm_phase<pg8::EpiPle, pg8::StaticOrder, true, true>(F.lds + RING_OFF, g, S, E, F.wave);
    RSEAM(10); } SEAM(10);
    REP(11) if (IN(11)) {
        pg8::Gemm g{XB1, (const bf16*)(ws + WS_WQKV), M, NQKV, D}; pg8::StaticOrder S; S.init(M, NQKV, F.G, bid);
        pg8::EpiBf16G E{(bf16*)(ws + WS_QKV), NQKV, -1, nullptr};
        pg8::gemm_phase<pg8::EpiBf16G, pg8::StaticOrder, true, true>(F.lds + RING_OFF, g, S, E, F.wave);
    RSEAM(11); } SEAM(11);
    REP(12) if (IN(12)) { na_phase_mfma(F, A); RSEAM(12); } SEAM(12);
    REP(13) if (IN(13)) {
        pg8::Gemm g{(const bf16*)(ws + WS_AO), (const bf16*)(ws + WS_WNAO), M, D, D}; pg8::StaticOrder S; S.init(M, D, F.G, bid);
        pg8::EpiResF32 E{A.out, A.out, D, ALPHA};
        pg8::gemm_phase<pg8::EpiResF32, pg8::StaticOrder, true, true>(F.lds + RING_OFF, g, S, E, F.wave);
    RSEAM(13); } SEAM(13);
    REP(14) if (IN(14)) { ln_router_phase(F, A, A.in[I_LNW] + 2 * D, A.in[I_LNB] + 2 * D, XB0); RSEAM(14); } SEAM(14);
    REP(15) if (IN(15)) { moe_scatter_phase(F, A, XB0); RSEAM(15); } SEAM(15);
    REP(16) if (IN(16)) {
        const int* TILEE = (const int*)(ws + WS_TILEE); const int nrt = __builtin_amdgcn_readfirstlane(TILEE[0]);
        pg8::Gemm g{(const bf16*)(ws + WS_XS), (const bf16*)(ws + WS_WMGU), nrt * 256, 2 * MOE, D}; pg8::MoeOrder S; S.base.init(nrt * 256, 2 * MOE, F.G, bid); S.tile_e = TILEE + 1; S.nN = 2 * MOE / 256;
        pg8::EpiSwiglu E{(bf16*)(ws + WS_HM), MOE, 2 * MOE / 256};
        pg8::gemm_phase<pg8::EpiSwiglu, pg8::MoeOrder, true, true>(F.lds + RING_OFF, g, S, E, F.wave);
    RSEAM(16); } SEAM(16);
    REP(17) if (IN(17)) {
        const int* TILEE = (const int*)(ws + WS_TILEE); const int nrt = __builtin_amdgcn_readfirstlane(TILEE[0]);
        pg8::Gemm g{(const bf16*)(ws + WS_HM), (const bf16*)(ws + WS_WMDN), nrt * 256, D, MOE}; pg8::MoeOrder S; S.base.init(nrt * 256, D, F.G, bid); S.tile_e = TILEE + 1; S.nN = D / 256;
        pg8::EpiStoreF32 E{(float*)(ws + WS_YS), D, D / 256};
        pg8::gemm_phase<pg8::EpiStoreF32, pg8::MoeOrder, true, true>(F.lds + RING_OFF, g, S, E, F.wave);
    RSEAM(17); } SEAM(17);
    REP(18) if (IN(18)) { ln_moe_phase(F, A, A.in[I_LNW] + 3 * D, A.in[I_LNB] + 3 * D, XB1); RSEAM(18); } SEAM(18);
    REP(19) if (IN(19)) {
        pg8::Gemm g{(const bf16*)(ws + WS_PB) + (size_t)M * PLE_DIM, (const bf16*)(ws + WS_WPP1), M, D, PLE_DIM}; pg8::StaticOrder S; S.init(M, D, F.G, bid);
        pg8::EpiStoreF32 E{(float*)(ws + WS_PP1), D, D / 256};
        pg8::gemm_phase<pg8::EpiStoreF32, pg8::StaticOrder, true, true>(F.lds + RING_OFF, g, S, E, F.wave);
    RSEAM(19); } SEAM(19);
    REP(20) if (IN(20)) {
        pg8::Gemm g{XB1, (const bf16*)(ws + WS_WPG1), M, D, D}; pg8::StaticOrder S; S.init(M, D, F.G, bid);
        pg8::EpiPle E{A.out, (const float*)(ws + WS_PP1), nullptr, D};
        pg8::gemm_phase<pg8::EpiPle, pg8::StaticOrder, true, true>(F.lds + RING_OFF, g, S, E, F.wave);
    }
#undef IN
#undef SEAM
}

extern "C" void kernel_launch(void* const* d_in, const int* in_sizes, int n_in, void* d_out, int out_size, void* d_ws, size_t ws_size, hipStream_t stream) {
    static int grid = 0;
    if (grid == 0) {
        if (n_in != 23 || in_sizes[0] != M * D || out_size != M * D || ws_size < WS_END) { fprintf(stderr, "kernel_launch: unexpected shapes (n_in %d, in0 %d, out %d, ws %zu, need %zu)\n", n_in, n_in > 0 ? in_sizes[0] : -1, out_size, ws_size, (size_t)WS_END); grid = -1; return; }
        int dev = 0, cus = 0, per_cu = 0;
        if (hipGetDevice(&dev) != hipSuccess || hipDeviceGetAttribute(&cus, hipDeviceAttributeMultiprocessorCount, dev) != hipSuccess) { grid = -1; return; }
        if (hipFuncSetAttribute((const void*)trunk_fwd, hipFuncAttributeMaxDynamicSharedMemorySize, LDS_BYTES) != hipSuccess) { fprintf(stderr, "kernel_launch: hipFuncSetAttribute failed\n"); grid = -1; return; }
        if (hipOccupancyMaxActiveBlocksPerMultiprocessor(&per_cu, (const void*)trunk_fwd, NWAVES * 64, LDS_BYTES) != hipSuccess || per_cu < 1) { fprintf(stderr, "kernel_launch: occupancy query reports %d\n", per_cu); }
        (void)hipGetLastError();
        grid = cus;
    }
    if (grid < 0) return;
    (void)hipMemsetAsync((char*)d_ws + WS_CTL, 0, CTL_ZERO_BYTES, stream);
    Args a{};
    for (int i = 0; i < 23; ++i) a.in[i] = (const float*)d_in[i];
    a.out = (float*)d_out; a.ws = (unsigned char*)d_ws;
#if MK_ONE_LAUNCH
    a.ph_lo = 0; a.ph_hi = N_PHASES;
    hipLaunchKernelGGL(trunk_fwd, dim3(grid), dim3(NWAVES * 64), LDS_BYTES, stream, a);
#else
    for (int ph = 0; ph < N_PHASES; ++ph) { a.ph_lo = ph; a.ph_hi = ph + 1; hipLaunchKernelGGL(trunk_fwd, dim3(grid), dim3(NWAVES * 64), LDS_BYTES, stream, a); }
#endif
}
```

```cpp
#include <hip/hip_runtime.h>
#include <cstdio>
#include <cstdint>
__device__ __forceinline__ int lane_now() { int l; asm volatile("v_mbcnt_lo_u32_b32 %0, -1, 0\n\tv_mbcnt_hi_u32_b32 %0, -1, %0" : "=v"(l)); return l; }
namespace pg8 {
#define PG8_LAS __attribute__((address_space(3)))
typedef unsigned short bf16_t;
typedef short bf16x8 __attribute__((ext_vector_type(8)));
typedef float f32x4 __attribute__((ext_vector_type(4)));
typedef unsigned u32x4 __attribute__((ext_vector_type(4)));
constexpr int BM = 256, BK = 64, HALF = 128, HTB = HALF * BK * 2  , STAGE_BYTES = 8 * HTB, NXCD = 8, WGM = 8;

__host__ __device__ __forceinline__ int lds_byte(int r, int c) { const int st = (r >> 4) * 2 + (c >> 5), rr = r & 15, cc = c & 31, ob = rr * 64 + cc * 2; return st * 1024 + (ob ^ (((ob >> 9) & 1) << 5)); }
__host__ __device__ __forceinline__ void stage_rc(int b, int& R, int& C) { const int st = b / 1024, sb = b % 1024, swz = sb ^ (((sb >> 9) & 1) << 5); R = (st >> 1) * 16 + swz / 64; C = (st & 1) * 32 + (swz % 64) / 2; }
__host__ __device__ __forceinline__ int perm32(int rho) { const int n = rho >> 4, i = rho & 15; return 8 * (i >> 2) + 4 * n + (i & 3); }

struct Unit { int pm, pn; };
struct Gemm { const bf16_t* A; const bf16_t* Bt; int M, N, K; };

struct StaticOrder {
    int nM, nN, nwg, G, c;
    __host__ __device__ void init(int M, int N, int G_, int c_) { nM = M / BM; nN = N / BM; nwg = nM * nN; G = G_; c = c_; }
    __host__ __device__ bool next(int i, Unit& u) const {
        const long L = (long)i * G + c; if (L >= nwg) return false;
        int wgid = (int)L; { const int q = nwg / NXCD, r = nwg % NXCD, xcd = wgid % NXCD, off = wgid / NXCD; wgid = (xcd < r ? xcd * (q + 1) : r * (q + 1) + (xcd - r) * q) + off; }
        const int nig = WGM * nN, gid = wgid / nig, fm = gid * WGM, gsz = (nM - fm) < WGM ? (nM - fm) : WGM;
        u.pm = fm + ((wgid % nig) % gsz); u.pn = (wgid % nig) / gsz; return true;
    }
    __device__ __forceinline__ void a_ready(const Unit&) const {}
    __device__ __forceinline__ void done(const Unit&) const {}
};

typedef float f32x2c_t __attribute__((ext_vector_type(2))); typedef __bf16 bf16x2c_t __attribute__((ext_vector_type(2)));
__device__ __forceinline__ unsigned cvt_pk_bf16(float lo, float hi) { f32x2c_t v = {lo, hi}; bf16x2c_t b = __builtin_convertvector(v, bf16x2c_t); return __builtin_bit_cast(unsigned, b); }
__device__ __forceinline__ float fsigmoid(float x) { return __builtin_amdgcn_rcpf(1.0f + __expf(-x)); }
__device__ __forceinline__ float fsilu(float x) { return x * fsigmoid(x); }


struct EpiBf16G {
    static constexpr bool PERM = true, AFTER_DRAIN = false;
    bf16_t* O; int ldc; int gate_pn; float* Gt;
    __device__ __forceinline__ void operator()(const f32x4 (&acc)[2][2][4][2], const Unit& u, int wr, int wc, int fr, int fq) const {
        const int row0 = u.pm * BM + wr * 64 + fr;
        if (u.pn == gate_pn) {
            if (wc == 0 && fq < 2) {
#pragma unroll
                for (int ai = 0; ai < 2; ++ai)
#pragma unroll
                    for (int m = 0; m < 4; ++m) { float* gp = Gt + (size_t)(row0 + ai * HALF + m * 16) * 16 + 8 * fq;
                        *(f32x4*)(gp) = acc[ai][0][m][0]; *(f32x4*)(gp + 4) = acc[ai][0][m][1]; }
            }
            return;
        }
        const int col0 = u.pn * BM + wc * 32 + 8 * fq;
#pragma unroll
        for (int ai = 0; ai < 2; ++ai)
#pragma unroll
            for (int m = 0; m < 4; ++m) { bf16_t* rowp = O + (size_t)(row0 + ai * HALF + m * 16) * ldc + col0;
#pragma unroll
                for (int bj = 0; bj < 2; ++bj) { const f32x4 v0 = acc[ai][bj][m][0], v1 = acc[ai][bj][m][1];
                    u32x4 w; w.x = cvt_pk_bf16(v0[0], v0[1]); w.y = cvt_pk_bf16(v0[2], v0[3]); w.z = cvt_pk_bf16(v1[0], v1[1]); w.w = cvt_pk_bf16(v1[2], v1[3]);
                    *(u32x4*)(rowp + bj * HALF) = w; } }
    }
};
struct EpiSwiglu {
    static constexpr bool PERM = true, AFTER_DRAIN = false;
    bf16_t* H; int ldh; int npn;
    __device__ __forceinline__ void operator()(const f32x4 (&acc)[2][2][4][2], const Unit& u, int wr, int wc, int fr, int fq) const {
        const int row0 = u.pm * BM + wr * 64 + fr; const int pl = u.pn % npn; const int col0 = pl * HALF + wc * 32 + 8 * fq;
#pragma unroll
        for (int ai = 0; ai < 2; ++ai)
#pragma unroll
            for (int m = 0; m < 4; ++m) { bf16_t* rowp = H + (size_t)(row0 + ai * HALF + m * 16) * ldh + col0;
                const f32x4 g0 = acc[ai][0][m][0], g1 = acc[ai][0][m][1], u0 = acc[ai][1][m][0], u1 = acc[ai][1][m][1];
                float o[8];
#pragma unroll
                for (int i = 0; i < 4; ++i) { o[i] = fsilu(g0[i]) * u0[i]; o[4 + i] = fsilu(g1[i]) * u1[i]; }
                u32x4 w; w.x = cvt_pk_bf16(o[0], o[1]); w.y = cvt_pk_bf16(o[2], o[3]); w.z = cvt_pk_bf16(o[4], o[5]); w.w = cvt_pk_bf16(o[6], o[7]);
                *(u32x4*)rowp = w; }
    }
};
struct EpiResF32 {
    static constexpr bool PERM = true, AFTER_DRAIN = false;
    const float* SRC; float* DST; int ldc; float alpha;
    __device__ __forceinline__ void operator()(const f32x4 (&acc)[2][2][4][2], const Unit& u, int wr, int wc, int fr, int fq) const {
        const int row0 = u.pm * BM + wr * 64 + fr; const int col0 = u.pn * BM + wc * 32 + 8 * fq;
#pragma unroll
        for (int ai = 0; ai < 2; ++ai)
#pragma unroll
            for (int m = 0; m < 4; ++m) { const size_t ro = (size_t)(row0 + ai * HALF + m * 16) * ldc + col0;
#pragma unroll
                for (int bj = 0; bj < 2; ++bj)
#pragma unroll
                    for (int n = 0; n < 2; ++n) { const size_t o = ro + bj * HALF + 4 * n; const f32x4 s = *(const f32x4*)(SRC + o); *(f32x4*)(DST + o) = s * alpha + acc[ai][bj][m][n]; } }
    }
};
struct EpiStoreF32 {
    static constexpr bool PERM = true, AFTER_DRAIN = false;
    float* O; int ldc; int npn;
    __device__ __forceinline__ void operator()(const f32x4 (&acc)[2][2][4][2], const Unit& u, int wr, int wc, int fr, int fq) const {
        const int row0 = u.pm * BM + wr * 64 + fr; const int col0 = (u.pn % npn) * BM + wc * 32 + 8 * fq;
#pragma unroll
        for (int ai = 0; ai < 2; ++ai)
#pragma unroll
            for (int m = 0; m < 4; ++m) { float* ro = O + (size_t)(row0 + ai * HALF + m * 16) * ldc + col0;
#pragma unroll
                for (int bj = 0; bj < 2; ++bj)
#pragma unroll
                    for (int n = 0; n < 2; ++n) *(f32x4*)(ro + bj * HALF + 4 * n) = acc[ai][bj][m][n]; }
    }
};
struct EpiPle {
    static constexpr bool PERM = true, AFTER_DRAIN = false;
    float* XF; const float* PP; bf16_t* XB; int ldc;
    __device__ __forceinline__ void operator()(const f32x4 (&acc)[2][2][4][2], const Unit& u, int wr, int wc, int fr, int fq) const {
        const int row0 = u.pm * BM + wr * 64 + fr; const int col0 = u.pn * BM + wc * 32 + 8 * fq;
#pragma unroll
        for (int ai = 0; ai < 2; ++ai)
#pragma unroll
            for (int m = 0; m < 4; ++m) { const size_t ro = (size_t)(row0 + ai * HALF + m * 16) * ldc + col0;
#pragma unroll
                for (int bj = 0; bj < 2; ++bj) { f32x4 o[2];
#pragma unroll
                    for (int n = 0; n < 2; ++n) { const size_t of = ro + bj * HALF + 4 * n; const f32x4 x = *(const f32x4*)(XF + of), pp = *(const f32x4*)(PP + of); const f32x4 a = acc[ai][bj][m][n];
                        f32x4 r; r[0] = x[0] + fsigmoid(a[0]) * pp[0]; r[1] = x[1] + fsigmoid(a[1]) * pp[1]; r[2] = x[2] + fsigmoid(a[2]) * pp[2]; r[3] = x[3] + fsigmoid(a[3]) * pp[3];
                        *(f32x4*)(XF + of) = r; o[n] = r; }
                    u32x4 w; w.x = cvt_pk_bf16(o[0][0], o[0][1]); w.y = cvt_pk_bf16(o[0][2], o[0][3]); w.z = cvt_pk_bf16(o[1][0], o[1][1]); w.w = cvt_pk_bf16(o[1][2], o[1][3]);
                    if (XB) *(u32x4*)(XB + ro + bj * HALF) = w; } }
    }
};
struct MoeOrder {
    StaticOrder base; const int* tile_e; int nN;
    __device__ __forceinline__ bool next(int i, Unit& u) const { if (!base.next(i, u)) return false; u.pn += tile_e[u.pm] * nN; return true; }
    __device__ __forceinline__ void a_ready(const Unit&) const {}
    __device__ __forceinline__ void done(const Unit&) const {}
};

template <class Epi, class Sched, bool ALIGN_EPI = false, bool SP2 = false>
__device__ __forceinline__ void gemm_phase(PG8_LAS unsigned char* lds, const Gemm g, const Sched& S, const Epi& E, int wave_s) {
    const int lane = lane_now(), wid = wave_s, tid = wave_s * 64 + lane, wr = wid >> 2, wc = wid & 3, fr = lane & 15, fq = lane >> 4;
    const int K = g.K, nt = K / BK;
    unsigned voffA[2], voffB[2];
#pragma unroll
    for (int i = 0; i < 2; ++i) { int R, C; stage_rc(tid * 16 + i * 8192, R, C); const int Rb = Epi::PERM ? ((R & ~31) + perm32(R & 31)) : R;
        voffA[i] = (unsigned)(R * K + C) * 2u; voffB[i] = (unsigned)(Rb * K + C) * 2u; }
    const size_t kstep = (size_t)(BK * 2);
    const size_t hstep = (size_t)HALF * K * 2;
    const size_t tstep = 2 * hstep;
    const unsigned ldsw = (unsigned)wid * 1024u;
    const int aoff = lds_byte(wr * 64 + fr, fq * 8), boff = lds_byte(wc * 32 + fr, fq * 8);
#define PG8_SA(b, h) (((b) * 2 + (h)) * HTB)
#define PG8_SB(b, h) ((4 + (b) * 2 + (h)) * HTB)
#define PG8_STAGE(bufoff, gbase, voff) do { _Pragma("unroll") for (int _i = 0; _i < 2; ++_i) \
        __builtin_amdgcn_global_load_lds((const unsigned*)((const char*)(gbase) + (voff)[_i]), (PG8_LAS unsigned*)(lds + (bufoff) + ldsw + _i * 8192), 16, 0, 0); } while (0)
#define PG8_LDA(dst, b, h) do { _Pragma("unroll") for (int m = 0; m < 4; ++m) _Pragma("unroll") for (int k = 0; k < 2; ++k) dst[m][k] = *(const PG8_LAS bf16x8*)(lds + PG8_SA(b, h) + aoff + m * 2048 + k * 1024); } while (0)
#define PG8_LDB(dst, b, h) do { _Pragma("unroll") for (int n = 0; n < 2; ++n) _Pragma("unroll") for (int k = 0; k < 2; ++k) dst[n][k] = *(const PG8_LAS bf16x8*)(lds + PG8_SB(b, h) + boff + n * 2048 + k * 1024); } while (0)
#define PG8_MMA(ai, bj, At, Bt) do { __builtin_amdgcn_s_setprio(1); _Pragma("unroll") for (int m = 0; m < 4; ++m) _Pragma("unroll") for (int n = 0; n < 2; ++n) _Pragma("unroll") for (int k = 0; k < 2; ++k) \
        acc[ai][bj][m][n] = __builtin_amdgcn_mfma_f32_16x16x32_bf16(Bt[n][k], At[m][k], acc[ai][bj][m][n], 0, 0, 0); __builtin_amdgcn_s_setprio(0); } while (0)
#define PG8_WAIT_V(n) asm volatile("s_waitcnt vmcnt(" #n ")" ::: "memory")
#define PG8_WAIT_L(n) asm volatile("s_waitcnt lgkmcnt(" #n ")" ::: "memory")
#define PG8_BAR __builtin_amdgcn_s_barrier()
#define PG8_SCHED __builtin_amdgcn_sched_barrier(0)
    Unit cur, nxt; int ui = 0;
    if (!S.next(0, cur)) return;
    f32x4 acc[2][2][4][2];
#pragma unroll
    for (int a = 0; a < 2; ++a)
#pragma unroll
        for (int b = 0; b < 2; ++b)
#pragma unroll
            for (int m = 0; m < 4; ++m)
#pragma unroll
                for (int n = 0; n < 2; ++n) acc[a][b][m][n] = (f32x4){0.f, 0.f, 0.f, 0.f};
    bf16x8 At[4][2], B0[2][2], B1[2][2];
    const char* cA = (const char*)g.A + (size_t)cur.pm * tstep; const char* cB = (const char*)g.Bt + (size_t)cur.pn * tstep;
    S.a_ready(cur);
    if constexpr (SP2) {
        PG8_STAGE(PG8_SB(0, 0), cB, voffB); PG8_STAGE(PG8_SB(0, 1), cB + hstep, voffB); PG8_STAGE(PG8_SA(0, 0), cA, voffA); PG8_STAGE(PG8_SA(0, 1), cA + hstep, voffA);
        if (wr == 1) PG8_BAR;
        PG8_WAIT_V(2); PG8_BAR;
        PG8_STAGE(PG8_SB(1, 0), cB + kstep, voffB); PG8_STAGE(PG8_SA(1, 0), cA + kstep, voffA); PG8_STAGE(PG8_SB(1, 1), cB + hstep + kstep, voffB);
        PG8_WAIT_V(6); PG8_BAR;
    } else {
        PG8_STAGE(PG8_SB(0, 0), cB, voffB); PG8_STAGE(PG8_SA(0, 0), cA, voffA); PG8_STAGE(PG8_SB(0, 1), cB + hstep, voffB); PG8_STAGE(PG8_SA(0, 1), cA + hstep, voffA);
        if (wr == 1) PG8_BAR;
        PG8_WAIT_V(4); PG8_BAR;
        PG8_STAGE(PG8_SB(1, 0), cB + kstep, voffB); PG8_STAGE(PG8_SA(1, 0), cA + kstep, voffA); PG8_STAGE(PG8_SB(1, 1), cB + hstep + kstep, voffB);
        PG8_WAIT_V(6); PG8_BAR;
    }
    for (;;) {
        const bool has_next = S.next(ui + 1, nxt);
        const char* nA = has_next ? (const char*)g.A + (size_t)nxt.pm * tstep : cA; const char* nB = has_next ? (const char*)g.Bt + (size_t)nxt.pn * tstep : cB;
        for (int t = 0; t < nt; t += 2) {
            const bool last = (t == nt - 2);
            const char* a1 = cA + (size_t)(t + 1) * kstep;
            const char* a2 = last ? nA : cA + (size_t)(t + 2) * kstep; const char* b2 = last ? nB : cB + (size_t)(t + 2) * kstep;
            const char* a3 = a2 + kstep; const char* b3 = b2 + kstep;
            if (last && has_next) S.a_ready(nxt);
            if constexpr (SP2) {
            PG8_LDB(B0, 0, 0); PG8_LDB(B1, 0, 1); PG8_SCHED; PG8_LDA(At, 0, 0); PG8_STAGE(PG8_SA(1, 1), a1 + hstep, voffA);
            PG8_WAIT_V(8); PG8_WAIT_L(0); PG8_BAR; PG8_MMA(0, 0, At, B0); PG8_MMA(0, 1, At, B1); PG8_BAR; PG8_SCHED;
            PG8_LDA(At, 0, 1); PG8_STAGE(PG8_SB(0, 0), b2, voffB); PG8_STAGE(PG8_SB(0, 1), b2 + hstep, voffB); PG8_STAGE(PG8_SA(0, 0), a2, voffA);
            PG8_WAIT_V(8); PG8_WAIT_L(0); PG8_BAR; PG8_MMA(1, 0, At, B0); PG8_MMA(1, 1, At, B1); PG8_BAR; PG8_SCHED;
            PG8_LDB(B0, 1, 0); PG8_LDB(B1, 1, 1); PG8_SCHED; PG8_LDA(At, 1, 0); PG8_STAGE(PG8_SA(0, 1), a2 + hstep, voffA);
            PG8_WAIT_V(8); PG8_WAIT_L(0); PG8_BAR; PG8_MMA(0, 0, At, B0); PG8_MMA(0, 1, At, B1); PG8_BAR; PG8_SCHED;
            PG8_LDA(At, 1, 1); PG8_STAGE(PG8_SB(1, 0), b3, voffB); PG8_STAGE(PG8_SB(1, 1), b3 + hstep, voffB); PG8_STAGE(PG8_SA(1, 0), a3, voffA);
            PG8_WAIT_V(8); PG8_WAIT_L(0); PG8_BAR; PG8_MMA(1, 0, At, B0); PG8_MMA(1, 1, At, B1); PG8_BAR; PG8_SCHED;
            } else {
            PG8_LDB(B0, 0, 0); PG8_SCHED; PG8_LDA(At, 0, 0); PG8_STAGE(PG8_SA(1, 1), a1 + hstep, voffA);
            PG8_WAIT_L(8); PG8_BAR; PG8_WAIT_L(0); PG8_MMA(0, 0, At, B0); PG8_BAR; PG8_SCHED;
            PG8_LDB(B1, 0, 1); PG8_STAGE(PG8_SB(0, 0), b2, voffB);
            PG8_BAR; PG8_WAIT_L(0); PG8_MMA(0, 1, At, B1); PG8_BAR;
            PG8_LDA(At, 0, 1); PG8_STAGE(PG8_SA(0, 0), a2, voffA);
            PG8_BAR; PG8_WAIT_L(0); PG8_MMA(1, 0, At, B0); PG8_BAR; PG8_SCHED;
            PG8_STAGE(PG8_SB(0, 1), b2 + hstep, voffB);
            PG8_WAIT_V(6); PG8_BAR; PG8_MMA(1, 1, At, B1); PG8_BAR;
            PG8_LDB(B0, 1, 0); PG8_SCHED; PG8_LDA(At, 1, 0); PG8_STAGE(PG8_SA(0, 1), a2 + hstep, voffA);
            PG8_WAIT_L(8); PG8_BAR; PG8_WAIT_L(0); PG8_MMA(0, 0, At, B0); PG8_BAR; PG8_SCHED;
            PG8_LDB(B1, 1, 1); PG8_STAGE(PG8_SB(1, 0), b3, voffB);
            PG8_BAR; PG8_WAIT_L(0); PG8_MMA(0, 1, At, B1); PG8_BAR;
            PG8_LDA(At, 1, 1); PG8_STAGE(PG8_SA(1, 0), a3, voffA);
            PG8_BAR; PG8_WAIT_L(0); PG8_MMA(1, 0, At, B0); PG8_BAR; PG8_SCHED;
            PG8_STAGE(PG8_SB(1, 1), b3 + hstep, voffB);
            PG8_WAIT_V(6); PG8_BAR; PG8_MMA(1, 1, At, B1); PG8_BAR;
            }
        }
        if constexpr (ALIGN_EPI) { if (wr == 0) PG8_BAR; }
        if constexpr (!Epi::AFTER_DRAIN) { E(acc, cur, wr, wc, fr, fq); S.done(cur); }
        if (!has_next) break;
#pragma unroll
        for (int a = 0; a < 2; ++a)
#pragma unroll
            for (int b = 0; b < 2; ++b)
#pragma unroll
                for (int m = 0; m < 4; ++m)
#pragma unroll
                    for (int n = 0; n < 2; ++n) acc[a][b][m][n] = (f32x4){0.f, 0.f, 0.f, 0.f};
        cur = nxt; cA = nA; cB = nB; ++ui;
        if constexpr (ALIGN_EPI) { if (wr == 1) PG8_BAR; }
    }
    PG8_WAIT_V(0);
    if constexpr (!ALIGN_EPI) { if (wr == 0) PG8_BAR; }
    PG8_BAR;
    if constexpr (Epi::AFTER_DRAIN) { E.fused(acc, cur, wr, wc, fr, fq, lds, wid, lane); S.done(cur); }
#undef PG8_SA
#undef PG8_SB
#undef PG8_STAGE
#undef PG8_LDA
#undef PG8_LDB
#undef PG8_MMA
#undef PG8_WAIT_V
#undef PG8_WAIT_L
#undef PG8_BAR
#undef PG8_SCHED
}
}
constexpr int NWAVES = 8;
constexpr int BATCH = 4, T = 4096, D = 2048, M = BATCH * T;
constexpr int PLE_DIM = 256, FFN = 5632, MOE = 7168, NE = 8;
constexpr int REC_IN = 8208, UW = 8192, NREC = 8448;
constexpr int U_QA = 0, U_KA = 512, U_VA = 1024, U_OA = 2048, U_QB = 3072, U_FF = 4096, U_FB = 5120, U_IB = 6144, U_GB = 7168;
constexpr int NQKV = 6144;
constexpr int XS_ROWS = 34816;
constexpr float LN_EPS = 1e-5f, RMS_EPS = 1e-6f, ALPHA = 1.41421356237f, GATE_CAP = 15.0f;

constexpr size_t MiB = 1u << 20;
constexpr size_t WS_CTL = 0, CTL_ZERO_BYTES = 1 * MiB;
constexpr size_t WS_TOKE = 1 * MiB, WS_TOKG = WS_TOKE + 256 * 1024, WS_DEST = WS_TOKG + 256 * 1024, WS_WGCNT = WS_DEST + 256 * 1024, WS_TILEE = WS_WGCNT + 64 * 1024;
constexpr size_t WS_WQKV = 4 * MiB, WS_WNAO = 28 * MiB, WS_WPG1 = 36 * MiB, WS_WPP1 = 44 * MiB, WS_WMGU = 48 * MiB, WS_WMDN = 496 * MiB;
constexpr size_t WS_XB0 = 720 * MiB, WS_XB1 = 784 * MiB, WS_PB = 848 * MiB, WS_G = 864 * MiB;
constexpr size_t WS_WRIN = 872 * MiB, WS_WROUT = 905 * MiB, WS_WFGU = 913 * MiB, WS_WFDN = 957 * MiB, WS_WPG0 = 979 * MiB, WS_WPP0 = 987 * MiB;
constexpr size_t WS_U = 992 * MiB, WS_HA = 1248 * MiB, WS_HB = 1376 * MiB, WS_Y = 1504 * MiB;
constexpr size_t WS_H = 992 * MiB;
constexpr size_t WS_PP = 1248 * MiB;
constexpr size_t WS_QKV = 992 * MiB;
constexpr size_t WS_AO = WS_Y;
constexpr size_t WS_HM = 872 * MiB;
constexpr size_t WS_YS = 1348 * MiB;
constexpr size_t WS_XS = 1348 * MiB;
constexpr size_t WS_PP1 = 872 * MiB;
constexpr size_t WS_END = 1620 * MiB;
static_assert(WS_WMGU + (size_t)NE * 2 * MOE * D * 2 <= WS_WMDN && WS_WMDN + (size_t)NE * D * MOE * 2 <= WS_XB0, "ws map 1");
static_assert(WS_WRIN + (size_t)NREC * D * 2 <= WS_WROUT && WS_WFGU + (size_t)2 * FFN * D * 2 <= WS_WFDN && WS_WFDN + (size_t)D * FFN * 2 <= WS_WPG0 && WS_WPP0 + (size_t)D * PLE_DIM * 2 <= WS_U, "ws map 2");
static_assert(WS_U + (size_t)M * UW * 2 <= WS_HA && WS_H + (size_t)M * FFN * 2 <= WS_HA && WS_QKV + (size_t)M * NQKV * 2 <= WS_HA, "ws map 3");
static_assert(WS_HM + (size_t)XS_ROWS * MOE * 2 <= WS_YS && WS_YS + (size_t)XS_ROWS * D * 4 <= WS_END && WS_XS + (size_t)XS_ROWS * D * 2 <= WS_Y, "ws map 4");
constexpr int CW_BAR = 4096;

constexpr int RING_OFF = 0, RING_BYTES = 131072;
constexpr int LDSCTL_OFF = RING_BYTES, MISC_OFF = LDSCTL_OFF + 320;
constexpr int LDS_BYTES = 147456;
static_assert(MISC_OFF + 128 <= LDS_BYTES, "LDS map");

#define GAS __attribute__((address_space(1)))
#define LAS __attribute__((address_space(3)))
typedef unsigned short bf16;
typedef unsigned v4u __attribute__((ext_vector_type(4)));
typedef unsigned v2u __attribute__((ext_vector_type(2)));
typedef float f32x4 __attribute__((ext_vector_type(4)));
typedef float f32x2 __attribute__((ext_vector_type(2)));
typedef GAS unsigned gu32;
#define RLX_AGENT __ATOMIC_RELAXED, __HIP_MEMORY_SCOPE_AGENT
#define LDS_WAIT() asm volatile("s_waitcnt lgkmcnt(0)" ::: "memory")
#define VM_WAIT() asm volatile("s_waitcnt vmcnt(0)" ::: "memory")
__device__ __forceinline__ unsigned f2bf(float f) { unsigned u = __builtin_bit_cast(unsigned, f); return (u + 0x7fffu + ((u >> 16) & 1u)) >> 16; }
__device__ __forceinline__ unsigned pk2(float lo, float hi) { return f2bf(lo) | (f2bf(hi) << 16); }
__device__ __forceinline__ float bflo(unsigned w) { return __builtin_bit_cast(float, w << 16); }
__device__ __forceinline__ float bfhi(unsigned w) { return __builtin_bit_cast(float, w & 0xffff0000u); }
__device__ __forceinline__ float bf1(bf16 h) { return __builtin_bit_cast(float, (unsigned)h << 16); }
__device__ __forceinline__ float sigm(float x) { return 1.0f / (1.0f + __expf(-x)); }
#define XB_TMO      128
#define XB_XCNT(j)  (256  + 64 * (j))
#define XB_XSUB(j)  (1280 + 64 * (j))
#define XB_XGEN(j)  (2304 + 64 * (j))
#define XB_TOP      3328
#define XB_TOPGEN   3392
#define XCD_BAR_WORDS 3456
#define XB_SPIN_CAP (1u << 18)

__device__ __forceinline__ unsigned xb_ld(unsigned* p)              { return __hip_atomic_load(p, __ATOMIC_RELAXED, __HIP_MEMORY_SCOPE_AGENT); }
__device__ __forceinline__ unsigned xb_add(unsigned* p, unsigned v) { return __hip_atomic_fetch_add(p, v, __ATOMIC_RELAXED, __HIP_MEMORY_SCOPE_AGENT); }
__device__ __forceinline__ unsigned xb_xcc_id() { return (unsigned)__builtin_amdgcn_s_getreg((3 << 11) | 20) & 0xFu; }
#define XB_SPIN(cond, bar) do { unsigned _sp = 0; while (cond) { __builtin_amdgcn_s_sleep(1); \
    if ((++_sp & 255u) == 0u) { if (xb_ld(&(bar)[XB_TMO])) break; if (_sp > XB_SPIN_CAP) { atomicAdd(&(bar)[XB_TMO], 1u); break; } } } } while (0)

struct XcdBarrier {
    unsigned* bar; unsigned x;
    volatile LAS unsigned* st;
};

__device__ __forceinline__ XcdBarrier xcd_barrier_post(unsigned* bar, volatile LAS unsigned* st, int wave_s) {
    XcdBarrier b; b.bar = bar; b.x = xb_xcc_id(); b.st = st;
    if (wave_s == 0 && lane_now() == 0) (void)xb_add(&bar[XB_XCNT(b.x)], 1u);
    return b;
}
__device__ __forceinline__ void xcd_barrier_complete(unsigned* bar, unsigned x, unsigned& nloc, unsigned& nx) {
    const unsigned G = gridDim.x * gridDim.y * gridDim.z;
    unsigned sum, cnt, mine, sp = 0u;
    for (;;) {
        sum = 0u; cnt = 0u; mine = 0u;
#pragma unroll
        for (unsigned j = 0; j < 16; ++j) { const unsigned c = xb_ld(&bar[XB_XCNT(j)]); sum += c; cnt += (c > 0u) ? 1u : 0u; mine = (j == x) ? c : mine; }
        if (sum == G) break;
        __builtin_amdgcn_s_sleep(1);
        if ((++sp & 255u) == 0u) { if (xb_ld(&bar[XB_TMO])) break; if (sp > XB_SPIN_CAP) { atomicAdd(&bar[XB_TMO], 1u); break; } }
    }
    nloc = mine > 0u ? mine : 1u; nx = cnt > 0u ? cnt : 1u;
}

__device__ __forceinline__ void xcd_barrier(const XcdBarrier& b, int wave_s) {
    asm volatile("s_waitcnt vmcnt(0)" ::: "memory");
    __syncthreads();
    if (wave_s == 0 && lane_now() == 0) {
        unsigned* bar = b.bar;
        __builtin_amdgcn_s_waitcnt(0);
        unsigned nloc = b.st[0], nx = b.st[1];
        if (nloc == 0u) { xcd_barrier_complete(bar, b.x, nloc, nx); b.st[0] = nloc; b.st[1] = nx; }
        const unsigned old = xb_add(&bar[XB_XSUB(b.x)], 1u);
        const unsigned gen = old / nloc;
        if (old + 1u == (gen + 1u) * nloc) {
            __builtin_amdgcn_fence(__ATOMIC_RELEASE, "agent");
            asm volatile("s_waitcnt vmcnt(0)" ::: "memory");
            const unsigned og = xb_add(&bar[XB_TOP], 1u);
            const unsigned tg = og / nx;
            if (og + 1u == (tg + 1u) * nx) xb_add(&bar[XB_TOPGEN], 1u);
            else XB_SPIN(xb_ld(&bar[XB_TOPGEN]) == tg, bar);
            __builtin_amdgcn_fence(__ATOMIC_ACQUIRE, "agent");
            xb_add(&bar[XB_XGEN(b.x)], 1u);
            asm volatile("s_waitcnt vmcnt(0)" ::: "memory");
        } else {
            XB_SPIN(xb_ld(&bar[XB_XGEN(b.x)]) == gen, bar);
            __builtin_amdgcn_fence(__ATOMIC_ACQUIRE, "agent");
            asm volatile("s_waitcnt vmcnt(0)" ::: "memory");
        }
    }
    __syncthreads();
}

struct Frame {
    LAS unsigned char* lds;
    int wave, G;
};
struct Args { const float* in[23]; float* out; unsigned char* ws; int ph_lo, ph_hi; };
enum { I_X = 0, I_P, I_LNW, I_LNB, I_RECWIN, I_GBIAS, I_MNORM, I_LBLOG, I_HNORM, I_RECWOUT, I_FWG, I_FWU, I_FWD, I_NAQKV, I_RPB, I_NAOUT, I_WR, I_BR, I_MWG, I_MWU, I_MWD, I_PLEG, I_PLEP };

__device__ __forceinline__ float wave_sum(float v) {
#pragma unroll
    for (int o = 1; o < 64; o <<= 1) v += __shfl_xor(v, o);
    return v;
}
__device__ __forceinline__ float wave_max(float v) {
#pragma unroll
    for (int o = 1; o < 64; o <<= 1) v = fmaxf(v, __shfl_xor(v, o));
    return v;
}

__device__ __forceinline__ void tr_item(const float* W, int ldn, int K, int srcc, int nvalid, bf16* WT, size_t drow, int k0, LAS float* scr, int lane) {
    const int c = lane & 31;
    {   float tmp[32]; const float* wp = W + (size_t)(k0 + (lane >> 5)) * ldn + srcc + c; const bool ok = c < nvalid;
#pragma unroll
        for (int i = 0; i < 32; ++i) tmp[i] = ok ? __builtin_nontemporal_load(wp + (size_t)(2 * i) * ldn) : 0.f;
#pragma unroll
        for (int i = 0; i < 32; ++i) scr[(2 * i + (lane >> 5)) * 33 + c] = tmp[i]; }
    LDS_WAIT(); asm volatile("" ::: "memory");
    const int c8 = lane & 7;
#pragma unroll
    for (int j = 0; j < 4; ++j) { const int n = (lane >> 3) + 8 * j; const LAS float* s = scr + (8 * c8) * 33 + n;
        v4u o; o.x = pk2(s[0 * 33], s[1 * 33]); o.y = pk2(s[2 * 33], s[3 * 33]); o.z = pk2(s[4 * 33], s[5 * 33]); o.w = pk2(s[6 * 33], s[7 * 33]);
        *(GAS v4u*)(WT + (drow + n) * (size_t)K + k0 + 8 * c8) = o; }
    LDS_WAIT(); asm volatile("" ::: "memory");
}
__device__ __forceinline__ void p0_prologue(const Frame& F, const Args& A) {
    const int lane = lane_now(), tid = F.wave * 64 + lane; (void)tid;
    LAS float* scr = (LAS float*)(F.lds + RING_OFF + F.wave * 16384);
    const int gw = blockIdx.x * NWAVES + F.wave, NGW = F.G * NWAVES;
    unsigned char* ws = A.ws;
    constexpr int N_RIN = 32 * (NREC / 32), N_ROUT = 32 * 64, N_FGU = 32 * (2 * FFN / 32), N_FDN = (FFN / 64) * 64, N_PG = 32 * 64, N_PP = 4 * 64, N_QKV = 32 * (NQKV / 32), N_NAO = 32 * 64;
    constexpr int N_MGU = 32 * (NE * 2 * MOE / 32), N_MDN = (MOE / 64) * (NE * D / 32);
    constexpr int NITEMS = N_RIN + N_ROUT + N_FGU + N_FDN + 2 * N_PG + 2 * N_PP + N_QKV + N_NAO + N_MGU + N_MDN;
    for (int it = gw; it < NITEMS; it += NGW) {
        int r = it; const float* W; bf16* WT; int ldn, K, nblk;
        int srcc, nvalid = 32; size_t drow; int kb, nb;
        if (r < N_RIN) { W = A.in[I_RECWIN]; WT = (bf16*)(ws + WS_WRIN); ldn = REC_IN; K = D; nblk = NREC / 32; kb = r / nblk; nb = r % nblk; drow = (size_t)nb * 32;
            if (nb < 96) srcc = nb * 32; else if (nb < 256) srcc = nb * 32 + 16; else { srcc = 3072; nvalid = (nb == 256) ? 16 : 0; } }
        else if ((r -= N_RIN) < N_ROUT) { W = A.in[I_RECWOUT]; WT = (bf16*)(ws + WS_WROUT); ldn = D; K = D; nblk = 64; kb = r / nblk; nb = r % nblk; drow = (size_t)nb * 32; srcc = nb * 32; }
        else if ((r -= N_ROUT) < N_FGU) { WT = (bf16*)(ws + WS_WFGU); ldn = FFN; K = D; nblk = 2 * FFN / 32; kb = r / nblk; nb = r % nblk; drow = (size_t)nb * 32;
            const int tile = nb >> 3, w = nb & 7; W = (w < 4) ? A.in[I_FWG] : A.in[I_FWU]; srcc = tile * 128 + (w & 3) * 32; }
        else if ((r -= N_FGU) < N_FDN) { W = A.in[I_FWD]; WT = (bf16*)(ws + WS_WFDN); ldn = D; K = FFN; nblk = 64; kb = r / nblk; nb = r % nblk; drow = (size_t)nb * 32; srcc = nb * 32; }
        else if ((r -= N_FDN) < 2 * N_PG) { const int l = r / N_PG; r -= l * N_PG; W = A.in[I_PLEG] + (size_t)l * D * D; WT = (bf16*)(ws + (l ? WS_WPG1 : WS_WPG0)); ldn = D; K = D; nblk = 64; kb = r / nblk; nb = r % nblk; drow = (size_t)nb * 32; srcc = nb * 32; }
        else if ((r -= 2 * N_PG) < 2 * N_PP) { const int l = r / N_PP; r -= l * N_PP; W = A.in[I_PLEP] + (size_t)l * PLE_DIM * D; WT = (bf16*)(ws + (l ? WS_WPP1 : WS_WPP0)); ldn = D; K = PLE_DIM; nblk = 64; kb = r / nblk; nb = r % nblk; drow = (size_t)nb * 32; srcc = nb * 32; }
        else if ((r -= 2 * N_PP) < N_QKV) { W = A.in[I_NAQKV]; WT = (bf16*)(ws + WS_WQKV); ldn = NQKV; K = D; nblk = NQKV / 32; kb = r / nblk; nb = r % nblk; drow = (size_t)nb * 32; srcc = nb * 32; }
        else if ((r -= N_QKV) < N_NAO) { W = A.in[I_NAOUT]; WT = (bf16*)(ws + WS_WNAO); ldn = D; K = D; nblk = 64; kb = r / nblk; nb = r % nblk; drow = (size_t)nb * 32; srcc = nb * 32; }
        else if ((r -= N_NAO) < N_MGU) { WT = (bf16*)(ws + WS_WMGU); ldn = MOE; K = D; nblk = NE * 2 * MOE / 32; kb = r / nblk; nb = r % nblk; drow = (size_t)nb * 32;
            const int e = nb / (2 * MOE / 32), nl = nb % (2 * MOE / 32), tile = nl >> 3, w = nl & 7; W = ((w < 4) ? A.in[I_MWG] : A.in[I_MWU]) + (size_t)e * D * MOE; srcc = tile * 128 + (w & 3) * 32; }
        else { r -= N_MGU; WT = (bf16*)(ws + WS_WMDN); ldn = D; K = MOE; nblk = NE * D / 32; kb = r / nblk; nb = r % nblk; drow = (size_t)nb * 32;
            const int e = nb / (D / 32), nl = nb % (D / 32); W = A.in[I_MWD] + (size_t)e * MOE * D; srcc = nl * 32; }
        tr_item(W, ldn, K, srcc, nvalid, WT, drow, kb * 64, scr, lane);
    }
    const size_t gt = (size_t)blockIdx.x * (NWAVES * 64) + tid, NGT = (size_t)F.G * NWAVES * 64;
    { const GAS f32x4* src = (const GAS f32x4*)A.in[I_X]; GAS v4u* dst = (GAS v4u*)(ws + WS_XB0);
      for (size_t i = gt; i < (size_t)M * D / 8; i += NGT) { const f32x4 a = src[2 * i], b = src[2 * i + 1]; v4u o; o.x = pk2(a[0], a[1]); o.y = pk2(a[2], a[3]); o.z = pk2(b[0], b[1]); o.w = pk2(b[2], b[3]); dst[i] = o; } }
    { const GAS f32x4* src = (const GAS f32x4*)A.in[I_P]; GAS v4u* dst = (GAS v4u*)(ws + WS_PB);
      for (size_t i = gt; i < (size_t)2 * M * PLE_DIM / 8; i += NGT) { const f32x4 a = src[2 * i], b = src[2 * i + 1]; v4u o; o.x = pk2(a[0], a[1]); o.y = pk2(a[2], a[3]); o.z = pk2(b[0], b[1]); o.w = pk2(b[2], b[3]); dst[i] = o; } }
}

constexpr int RB = 32;
#define T0_OF(blk) (dir ? (T - RB - (blk) * RB) : (blk) * RB)
__device__ __forceinline__ void mlstm_unit(const Frame& F, const Args& A, int unit) {
    const int lane = lane_now(), tid = F.wave * 64 + lane; (void)tid;
    const int cg = unit & 3, dir = (unit >> 2) & 1, h = (unit >> 3) & 3, b = unit >> 5;
    LAS float* qs = (LAS float*)(F.lds + RING_OFF);
    LAS float* ks = qs + RB * 128;
    LAS float* vs = ks + RB * 128;
    LAS float* fi = vs + RB * 64;
    LAS float* ob = fi + RB * 2;
    const bf16* U = (const bf16*)(A.ws + WS_U); const float* Gt = (const float*)(A.ws + WS_G);
    float* HA = (float*)(A.ws + WS_HA) + (size_t)dir * M * 1024;
    const int e = lane & 7, dg = lane >> 3, colw = F.wave * 8 + e;
    const int srow = tid >> 4, sc = tid & 15;
    const float bias_i = A.in[I_GBIAS][(dir ? 2 : 0) * 4 + h], bias_f = A.in[I_GBIAS][(dir ? 3 : 1) * 4 + h];
    float C[16], n[16];
#pragma unroll
    for (int j = 0; j < 16; ++j) { C[j] = 0.f; n[j] = 0.f; }
    v4u rq, rk; v2u rv; float rgi = 0.f, rgf = 0.f;
    {   const size_t row = (size_t)b * T + T0_OF(0) + srow; const bf16* ur = U + row * UW;
        rq = *(const GAS v4u*)(ur + U_QA + h * 128 + sc * 8); rk = *(const GAS v4u*)(ur + U_KA + h * 128 + sc * 8); rv = *(const GAS v2u*)(ur + U_VA + h * 256 + cg * 64 + sc * 4);
        if (tid < RB) { const size_t r2 = (size_t)b * T + T0_OF(0) + tid; rgi = Gt[r2 * 16 + (dir ? 2 : 0) * 4 + h]; rgf = Gt[r2 * 16 + (dir ? 3 : 1) * 4 + h]; } }
    for (int blk = 0; blk < T / RB; ++blk) {
        const int t0 = T0_OF(blk);
        {   const float qsc = 0.08838834764831845f;
            LAS float* qd = qs + srow * 128 + sc * 8; LAS float* kd = ks + srow * 128 + sc * 8;
            *(LAS f32x4*)qd = (f32x4){bflo(rq.x) * qsc, bfhi(rq.x) * qsc, bflo(rq.y) * qsc, bfhi(rq.y) * qsc}; *(LAS f32x4*)(qd + 4) = (f32x4){bflo(rq.z) * qsc, bfhi(rq.z) * qsc, bflo(rq.w) * qsc, bfhi(rq.w) * qsc};
            *(LAS f32x4*)kd = (f32x4){bflo(rk.x), bfhi(rk.x), bflo(rk.y), bfhi(rk.y)}; *(LAS f32x4*)(kd + 4) = (f32x4){bflo(rk.z), bfhi(rk.z), bflo(rk.w), bfhi(rk.w)};
            *(LAS f32x4*)(vs + srow * 64 + sc * 4) = (f32x4){bflo(rv.x), bfhi(rv.x), bflo(rv.y), bfhi(rv.y)};
            if (tid < RB) { const float gi = GATE_CAP * tanhf((rgi + bias_i) * (1.0f / GATE_CAP)), gf = GATE_CAP * tanhf((rgf + bias_f) * (1.0f / GATE_CAP));
                fi[tid * 2] = sigm(gf); fi[tid * 2 + 1] = __expf(gi); } }
        __syncthreads();
        if (blk + 1 < T / RB) { const size_t row = (size_t)b * T + T0_OF(blk + 1) + srow; const bf16* ur = U + row * UW;
            rq = *(const GAS v4u*)(ur + U_QA + h * 128 + sc * 8); rk = *(const GAS v4u*)(ur + U_KA + h * 128 + sc * 8); rv = *(const GAS v2u*)(ur + U_VA + h * 256 + cg * 64 + sc * 4);
            if (tid < RB) { const size_t r2 = (size_t)b * T + T0_OF(blk + 1) + tid; rgi = Gt[r2 * 16 + (dir ? 2 : 0) * 4 + h]; rgf = Gt[r2 * 16 + (dir ? 3 : 1) * 4 + h]; } }
        for (int s = 0; s < RB; ++s) {
            const int tl = dir ? (RB - 1 - s) : s;
            const float f = fi[tl * 2], ii = fi[tl * 2 + 1], v = vs[tl * 64 + colw];
            const LAS f32x4* qp = (const LAS f32x4*)(qs + tl * 128 + dg * 16); const LAS f32x4* kp = (const LAS f32x4*)(ks + tl * 128 + dg * 16);
            float num = 0.f, den = 0.f;
#pragma unroll
            for (int j4 = 0; j4 < 4; ++j4) { const f32x4 q4 = qp[j4], k4 = kp[j4];
#pragma unroll
                for (int i = 0; i < 4; ++i) { const int j = j4 * 4 + i; const float kk = ii * k4[i]; C[j] = f * C[j] + kk * v; n[j] = f * n[j] + kk; num += C[j] * q4[i]; den += n[j] * q4[i]; } }
            num += __shfl_xor(num, 8); den += __shfl_xor(den, 8); num += __shfl_xor(num, 16); den += __shfl_xor(den, 16); num += __shfl_xor(num, 32); den += __shfl_xor(den, 32);
            if (dg == 0) ob[tl * 64 + colw] = num / fmaxf(fabsf(den), 1.0f);
        }
        __syncthreads();
        *(GAS f32x4*)(HA + ((size_t)b * T + t0 + srow) * 1024 + h * 256 + cg * 64 + sc * 4) = *(const LAS f32x4*)(ob + srow * 64 + sc * 4);
    }
    __syncthreads();
}
__device__ __forceinline__ void hgrn_unit(const Frame& F, const Args& A, int unit) {
    const int lane = lane_now(), tid = F.wave * 64 + lane; (void)tid;
    const int cg = unit & 1, dir = (unit >> 1) & 1, h = (unit >> 2) & 7, b = unit >> 5;
    LAS float* qs = (LAS float*)(F.lds + RING_OFF);
    LAS float* fs = qs + RB * 128;
    LAS float* vs = fs + RB * 128;
    LAS float* ob = vs + RB * 64;
    const bf16* U = (const bf16*)(A.ws + WS_U);
    float* HB = (float*)(A.ws + WS_HB) + (size_t)dir * M * 1024;
    const int e = lane & 7, dg = lane >> 3, colw = F.wave * 8 + e;
    const int srow = tid >> 4, sc = tid & 15;
    float lb[8];
#pragma unroll
    for (int i = 0; i < 8; ++i) { const float l0 = A.in[I_LBLOG][(dir * 2 + 0) * 1024 + h * 128 + sc * 8 + i], l1 = A.in[I_LBLOG][(dir * 2 + 1) * 1024 + h * 128 + sc * 8 + i]; lb[i] = 1.0f / (1.0f + __expf(l1 - l0)); }
    float S[16];
#pragma unroll
    for (int j = 0; j < 16; ++j) S[j] = 0.f;
    v4u rq, rf; v2u rv;
    {   const size_t row = (size_t)b * T + T0_OF(0) + srow; const bf16* ur = U + row * UW;
        rq = *(const GAS v4u*)(ur + U_QB + h * 128 + sc * 8); rf = *(const GAS v4u*)(ur + (dir ? U_FB : U_FF) + h * 128 + sc * 8); rv = *(const GAS v2u*)(ur + U_IB + h * 128 + cg * 64 + sc * 4); }
    for (int blk = 0; blk < T / RB; ++blk) {
        const int t0 = T0_OF(blk);
        {   LAS float* qd = qs + srow * 128 + sc * 8; LAS float* fd = fs + srow * 128 + sc * 8;
            float qv[8] = {bflo(rq.x), bfhi(rq.x), bflo(rq.y), bfhi(rq.y), bflo(rq.z), bfhi(rq.z), bflo(rq.w), bfhi(rq.w)};
            float fv[8] = {bflo(rf.x), bfhi(rf.x), bflo(rf.y), bfhi(rf.y), bflo(rf.z), bfhi(rf.z), bflo(rf.w), bfhi(rf.w)};
#pragma unroll
            for (int i = 0; i < 8; ++i) { qv[i] = qv[i] * sigm(qv[i]); fv[i] = lb[i] + (1.0f - lb[i]) * sigm(fv[i]); }
            *(LAS f32x4*)qd = (f32x4){qv[0], qv[1], qv[2], qv[3]}; *(LAS f32x4*)(qd + 4) = (f32x4){qv[4], qv[5], qv[6], qv[7]};
            *(LAS f32x4*)fd = (f32x4){fv[0], fv[1], fv[2], fv[3]}; *(LAS f32x4*)(fd + 4) = (f32x4){fv[4], fv[5], fv[6], fv[7]};
            *(LAS f32x4*)(vs + srow * 64 + sc * 4) = (f32x4){bflo(rv.x), bfhi(rv.x), bflo(rv.y), bfhi(rv.y)}; }
        __syncthreads();
        if (blk + 1 < T / RB) { const size_t row = (size_t)b * T + T0_OF(blk + 1) + srow; const bf16* ur = U + row * UW;
            rq = *(const GAS v4u*)(ur + U_QB + h * 128 + sc * 8); rf = *(const GAS v4u*)(ur + (dir ? U_FB : U_FF) + h * 128 + sc * 8); rv = *(const GAS v2u*)(ur + U_IB + h * 128 + cg * 64 + sc * 4); }
        for (int s = 0; s < RB; ++s) {
            const int tl = dir ? (RB - 1 - s) : s;
            const float v = vs[tl * 64 + colw];
            const LAS f32x4* qp = (const LAS f32x4*)(qs + tl * 128 + dg * 16); const LAS f32x4* fp = (const LAS f32x4*)(fs + tl * 128 + dg * 16);
            float o = 0.f;
#pragma unroll
            for (int j4 = 0; j4 < 4; ++j4) { const f32x4 q4 = qp[j4], f4 = fp[j4];
#pragma unroll
                for (int i = 0; i < 4; ++i) { const int j = j4 * 4 + i; S[j] = f4[i] * S[j] + (1.0f - f4[i]) * v; o += S[j] * q4[i]; } }
            o += __shfl_xor(o, 8); o += __shfl_xor(o, 16); o += __shfl_xor(o, 32);
            if (dg == 0) ob[tl * 64 + colw] = o;
        }
        __syncthreads();
        *(GAS f32x4*)(HB + ((size_t)b * T + t0 + srow) * 1024 + h * 128 + cg * 64 + sc * 4) = *(const LAS f32x4*)(ob + srow * 64 + sc * 4);
    }
    __syncthreads();
}
__device__ __forceinline__ void p3_finalize(const Frame& F, const Args& A) {
    const int lane = lane_now(), tid = F.wave * 64 + lane; (void)tid;
    const int gw = blockIdx.x * NWAVES + F.wave, NGW = F.G * NWAVES;
    const bf16* U = (const bf16*)(A.ws + WS_U); bf16* Y = (bf16*)(A.ws + WS_Y);
    const float* HA = (const float*)(A.ws + WS_HA); const float* HB = (const float*)(A.ws + WS_HB);
    for (int row = gw; row < M; row += NGW) {
        const bf16* ur = U + (size_t)row * UW; bf16* yr = Y + (size_t)row * D;
#pragma unroll
        for (int h = 0; h < 4; ++h) { const int c = h * 256 + lane * 4;
            const f32x4 a = *(const GAS f32x4*)(HA + (size_t)row * 1024 + c), bq = *(const GAS f32x4*)(HA + (size_t)M * 1024 + (size_t)row * 1024 + c);
            const f32x4 s = a + bq; float ss = (s[0] * s[0] + s[1] * s[1]) + (s[2] * s[2] + s[3] * s[3]); ss = wave_sum(ss);
            const float r = 1.0f / sqrtf(ss * (1.0f / 256.0f) + RMS_EPS);
            const f32x4 w = *(const GAS f32x4*)(A.in[I_MNORM] + c); const v2u og = *(const GAS v2u*)(ur + U_OA + c);
            const float o0 = s[0] * r * w[0] * sigm(bflo(og.x)), o1 = s[1] * r * w[1] * sigm(bfhi(og.x)), o2 = s[2] * r * w[2] * sigm(bflo(og.y)), o3 = s[3] * r * w[3] * sigm(bfhi(og.y));
            v2u o; o.x = pk2(o0, o1); o.y = pk2(o2, o3); *(GAS v2u*)(yr + c) = o; }
#pragma unroll
        for (int hp = 0; hp < 4; ++hp) { const int c = hp * 256 + lane * 4;
            const f32x4 a = *(const GAS f32x4*)(HB + (size_t)row * 1024 + c), bq = *(const GAS f32x4*)(HB + (size_t)M * 1024 + (size_t)row * 1024 + c);
            const f32x4 s = a + bq; float ss = (s[0] * s[0] + s[1] * s[1]) + (s[2] * s[2] + s[3] * s[3]);
#pragma unroll
            for (int o = 1; o < 32; o <<= 1) ss += __shfl_xor(ss, o);
            const float r = 1.0f / sqrtf(ss * (1.0f / 128.0f) + RMS_EPS);
            const f32x4 w = *(const GAS f32x4*)(A.in[I_HNORM] + c); const v2u gg = *(const GAS v2u*)(ur + U_GB + c);
            const float g0 = bflo(gg.x), g1 = bfhi(gg.x), g2 = bflo(gg.y), g3 = bfhi(gg.y);
            const float o0 = s[0] * r * w[0] * g0 * sigm(g0), o1 = s[1] * r * w[1] * g1 * sigm(g1), o2 = s[2] * r * w[2] * g2 * sigm(g2), o3 = s[3] * r * w[3] * g3 * sigm(g3);
            v2u o; o.x = pk2(o0, o1); o.y = pk2(o2, o3); *(GAS v2u*)(yr + 1024 + c) = o; }
    }
}

__device__ __forceinline__ void ln_row_regs(f32x4 (&v)[8], const float* w, const float* bvec, int lane) {
    float s = 0.f;
#pragma unroll
    for (int j = 0; j < 8; ++j) s += (v[j][0] + v[j][1]) + (v[j][2] + v[j][3]);
    const float mean = wave_sum(s) * (1.0f / D); float s2 = 0.f;
#pragma unroll
    for (int j = 0; j < 8; ++j) { v[j] = v[j] - mean; s2 += (v[j][0] * v[j][0] + v[j][1] * v[j][1]) + (v[j][2] * v[j][2] + v[j][3] * v[j][3]); }
    const float rstd = 1.0f / sqrtf(wave_sum(s2) * (1.0f / D) + LN_EPS);
#pragma unroll
    for (int j = 0; j < 8; ++j) { const f32x4 ww = *(const GAS f32x4*)(w + 256 * j + 4 * lane), bb = *(const GAS f32x4*)(bvec + 256 * j + 4 * lane); v[j] = v[j] * rstd * ww + bb; }
}
__device__ __forceinline__ void store_row(const f32x4 (&v)[8], float* xf, bf16* xb, int lane) {
#pragma unroll
    for (int j = 0; j < 8; ++j) { *(GAS f32x4*)(xf + 256 * j + 4 * lane) = v[j]; v2u o; o.x = pk2(v[j][0], v[j][1]); o.y = pk2(v[j][2], v[j][3]); *(GAS v2u*)(xb + 256 * j + 4 * lane) = o; }
}
__device__ __forceinline__ void ln_phase(const Frame& F, const Args& A, const float* w, const float* bvec, bf16* XB) {
    const int lane = lane_now(), tid = F.wave * 64 + lane; (void)tid;
    const int gw = blockIdx.x * NWAVES + F.wave, NGW = F.G * NWAVES;
    for (int row = gw; row < M; row += NGW) { float* xr = A.out + (size_t)row * D; f32x4 v[8];
#pragma unroll
        for (int j = 0; j < 8; ++j) v[j] = *(const GAS f32x4*)(xr + 256 * j + 4 * lane);
        ln_row_regs(v, w, bvec, lane); store_row(v, xr, XB + (size_t)row * D, lane); }
}
__device__ __forceinline__ void ln_router_phase(const Frame& F, const Args& A, const float* w, const float* bvec, bf16* XB) {
    const int lane = lane_now(), tid = F.wave * 64 + lane; (void)tid;
    LAS int* cnt = (LAS int*)(F.lds + RING_OFF);
    int* TOKE = (int*)(A.ws + WS_TOKE); float* TOKG = (float*)(A.ws + WS_TOKG); int* WGCNT = (int*)(A.ws + WS_WGCNT);
    const float* wr = A.in[I_WR]; const float* br = A.in[I_BR];
    for (int vb = blockIdx.x; vb < M / 64; vb += F.G) {
        if (tid < 8) cnt[tid] = 0;
        __syncthreads();
        for (int k = 0; k < 8; ++k) { const int row = vb * 64 + F.wave * 8 + k; float* xr = A.out + (size_t)row * D; f32x4 v[8];
#pragma unroll
            for (int j = 0; j < 8; ++j) v[j] = *(const GAS f32x4*)(xr + 256 * j + 4 * lane);
            ln_row_regs(v, w, bvec, lane); store_row(v, xr, XB + (size_t)row * D, lane);
            float lg[8];
#pragma unroll
            for (int e = 0; e < 8; ++e) lg[e] = 0.f;
#pragma unroll
            for (int j = 0; j < 8; ++j)
#pragma unroll
                for (int i = 0; i < 4; ++i) { const float* wp = wr + (size_t)(256 * j + 4 * lane + i) * NE; const f32x4 w0 = *(const GAS f32x4*)wp, w1 = *(const GAS f32x4*)(wp + 4); const float xv = v[j][i];
                    lg[0] += xv * w0[0]; lg[1] += xv * w0[1]; lg[2] += xv * w0[2]; lg[3] += xv * w0[3]; lg[4] += xv * w1[0]; lg[5] += xv * w1[1]; lg[6] += xv * w1[2]; lg[7] += xv * w1[3]; }
#pragma unroll
            for (int e = 0; e < 8; ++e) lg[e] = wave_sum(lg[e]) + br[e];
            int e1 = 0; float l1 = lg[0];
#pragma unroll
            for (int e = 1; e < 8; ++e) if (lg[e] > l1) { l1 = lg[e]; e1 = e; }
            int e2 = -1; float l2 = -3.0e38f;
#pragma unroll
            for (int e = 0; e < 8; ++e) if (e != e1 && lg[e] > l2) { l2 = lg[e]; e2 = e; }
            const float g2 = 1.0f / (1.0f + __expf(l1 - l2)), g1 = 1.0f - g2;
            if (lane == 0) { TOKE[2 * row] = e1; TOKE[2 * row + 1] = e2; TOKG[2 * row] = g1; TOKG[2 * row + 1] = g2; __hip_atomic_fetch_add(&cnt[e1], 1, __ATOMIC_RELAXED, __HIP_MEMORY_SCOPE_WORKGROUP); __hip_atomic_fetch_add(&cnt[e2], 1, __ATOMIC_RELAXED, __HIP_MEMORY_SCOPE_WORKGROUP); }
        }
        __syncthreads();
        if (tid < 8) WGCNT[vb * 8 + tid] = cnt[tid];
        __syncthreads();
    }
}
__device__ __forceinline__ void moe_scatter_phase(const Frame& F, const Args& A, const bf16* XB) {
    const int lane = lane_now(), tid = F.wave * 64 + lane; (void)tid;
    LAS int* sm = (LAS int*)(F.lds + RING_OFF);
    const int* TOKE = (const int*)(A.ws + WS_TOKE); int* DEST = (int*)(A.ws + WS_DEST); const int* WGCNT = (const int*)(A.ws + WS_WGCNT); int* TILEE = (int*)(A.ws + WS_TILEE);
    bf16* XS = (bf16*)(A.ws + WS_XS);
    for (int vb = blockIdx.x; vb < M / 64; vb += F.G) {
        if (tid < 16) sm[tid] = 0;
        if (tid >= 64 && tid < 192) sm[32 + tid - 64] = TOKE[vb * 128 + tid - 64];
        __syncthreads();
        {   const int e = tid & 7, wq = tid >> 3; int tot = 0, pre = 0;
#pragma unroll
            for (int i = 0; i < 4; ++i) { const int w = wq * 4 + i; const int c = WGCNT[w * 8 + e]; tot += c; pre += (w < vb) ? c : 0; }
            __hip_atomic_fetch_add(&sm[e], tot, __ATOMIC_RELAXED, __HIP_MEMORY_SCOPE_WORKGROUP); __hip_atomic_fetch_add(&sm[8 + e], pre, __ATOMIC_RELAXED, __HIP_MEMORY_SCOPE_WORKGROUP); }
        __syncthreads();
        if (tid == 0) { int base = 0; for (int e = 0; e < 8; ++e) { sm[16 + e] = base; base += ((sm[e] + 255) >> 8) << 8; }
            if (vb == 0) { int rt = 0; for (int e = 0; e < 8; ++e) { const int nt = (sm[e] + 255) >> 8; for (int i = 0; i < nt; ++i) TILEE[1 + rt++] = e; } TILEE[0] = rt; } }
        __syncthreads();
        if (tid < 128) { const int e = sm[32 + tid]; int rank = 0; for (int s = 0; s < tid; ++s) rank += (sm[32 + s] == e) ? 1 : 0; const int d = sm[16 + e] + sm[8 + e] + rank; sm[160 + tid] = d; DEST[vb * 128 + tid] = d; }
        __syncthreads();
        for (int s = F.wave; s < 128; s += NWAVES) { const int tok = vb * 64 + (s >> 1); const int d = sm[160 + s];
            const GAS v4u* src = (const GAS v4u*)(XB + (size_t)tok * D); GAS v4u* dst = (GAS v4u*)(XS + (size_t)d * D);
#pragma unroll
            for (int j = 0; j < 4; ++j) dst[64 * j + lane] = src[64 * j + lane]; }
        __syncthreads();
    }
}
__device__ __forceinline__ void ln_moe_phase(const Frame& F, const Args& A, const float* w, const float* bvec, bf16* XB) {
    const int lane = lane_now(), tid = F.wave * 64 + lane; (void)tid;
    const int gw = blockIdx.x * NWAVES + F.wave, NGW = F.G * NWAVES;
    const float* TOKG = (const float*)(A.ws + WS_TOKG); const int* DEST = (const int*)(A.ws + WS_DEST); const float* YS = (const float*)(A.ws + WS_YS);
    for (int row = gw; row < M; row += NGW) { float* xr = A.out + (size_t)row * D; f32x4 v[8];
        const int d1 = DEST[2 * row], d2 = DEST[2 * row + 1]; const float g1 = TOKG[2 * row], g2 = TOKG[2 * row + 1];
        const float* y1 = YS + (size_t)d1 * D; const float* y2 = YS + (size_t)d2 * D;
#pragma unroll
        for (int j = 0; j < 8; ++j) { const int c = 256 * j + 4 * lane; v[j] = *(const GAS f32x4*)(xr + c) * ALPHA + *(const GAS f32x4*)(y1 + c) * g1 + *(const GAS f32x4*)(y2 + c) * g2; }
        ln_row_regs(v, w, bvec, lane); store_row(v, xr, XB + (size_t)row * D, lane); }
}

__device__ __forceinline__ void na_phase_simple(const Frame& F, const Args& A) {
    const int lane = lane_now(), tid = F.wave * 64 + lane; (void)tid;
    const int gw = blockIdx.x * NWAVES + F.wave, NGW = F.G * NWAVES;
    const bf16* QKV = (const bf16*)(A.ws + WS_QKV); bf16* AO = (bf16*)(A.ws + WS_AO); const float* rpb = A.in[I_RPB];
    const float scale = 0.08838834764831845f;
    for (int task = gw; task < M * 16; task += NGW) {
        const int tok = task >> 4, h = task & 15, b = tok >> 12, r = (tok >> 6) & 63, c = tok & 63;
        const int rs = min(max(r - 4, 0), 56), cs = min(max(c - 8, 0), 48);
        const GAS v4u* qp = (const GAS v4u*)(QKV + (size_t)tok * NQKV + h * 128);
        float sc[2];
#pragma unroll
        for (int i = 0; i < 2; ++i) { const int kk = lane + 64 * i, jr = kk >> 4, jc = kk & 15; const int ktok = b * T + (rs + jr) * 64 + cs + jc;
            const GAS v4u* kp = (const GAS v4u*)(QKV + (size_t)ktok * NQKV + D + h * 128); float acc = 0.f;
#pragma unroll 4
            for (int j = 0; j < 16; ++j) { const v4u q = qp[j], k = kp[j];
                acc += bflo(q.x) * bflo(k.x) + bfhi(q.x) * bfhi(k.x) + bflo(q.y) * bflo(k.y) + bfhi(q.y) * bfhi(k.y) + bflo(q.z) * bflo(k.z) + bfhi(q.z) * bfhi(k.z) + bflo(q.w) * bflo(k.w) + bfhi(q.w) * bfhi(k.w); }
            sc[i] = acc * scale + rpb[(h * 15 + (rs + jr - r + 7)) * 31 + (cs + jc - c + 15)]; }
        const float mx = wave_max(fmaxf(sc[0], sc[1]));
        const float p0 = __expf(sc[0] - mx), p1 = __expf(sc[1] - mx);
        const float inv = 1.0f / wave_sum(p0 + p1);
        float a0 = 0.f, a1 = 0.f;
        const bf16* vbase = QKV + 2 * D + h * 128 + 2 * lane;
#pragma unroll
        for (int i = 0; i < 2; ++i) { const float pi = i ? p1 : p0;
#pragma unroll 8
            for (int l = 0; l < 64; ++l) { const int kk = l + 64 * i, jr = kk >> 4, jc = kk & 15; const int ktok = b * T + (rs + jr) * 64 + cs + jc;
                const float pk = __builtin_bit_cast(float, __builtin_amdgcn_readlane(__builtin_bit_cast(int, pi), l));
                const unsigned vv = *(const GAS unsigned*)(vbase + (size_t)ktok * NQKV); a0 += pk * bflo(vv); a1 += pk * bfhi(vv); } }
        *(GAS unsigned*)(AO + (size_t)tok * D + h * 128 + 2 * lane) = pk2(a0 * inv, a1 * inv);
    }
}
typedef short bf16x8 __attribute__((ext_vector_type(8)));
typedef short s16x4 __attribute__((ext_vector_type(4)));
__device__ __forceinline__ s16x4 lds_tr(LAS unsigned char* p) { return __builtin_bit_cast(s16x4, __builtin_amdgcn_ds_read_tr16_b64_v4i16((LAS s16x4*)p)); }
typedef float f32x2_t __attribute__((ext_vector_type(2))); typedef __bf16 bf16x2_t __attribute__((ext_vector_type(2)));
__device__ __forceinline__ unsigned cvtpk(float lo, float hi) { f32x2_t v = {lo, hi}; bf16x2_t b = __builtin_convertvector(v, bf16x2_t); return __builtin_bit_cast(unsigned, b); }
constexpr int NA_VP = 288;
__device__ __forceinline__ void na_phase_mfma(const Frame& F, const Args& A) {
    const int lane = lane_now(), tid = F.wave * 64 + lane, i = lane & 15, fq = lane >> 4;
    const bf16* QKV = (const bf16*)(A.ws + WS_QKV); bf16* AO = (bf16*)(A.ws + WS_AO); const float* rpb = A.in[I_RPB];
    LAS unsigned char* vl = F.lds + RING_OFF;
    LAS float* rp = (LAS float*)(F.lds + RING_OFF + 5 * 64 * NA_VP);
    const int qsel = F.wave >> 2, qi = F.wave & 3, wc = min(max(16 * qi - 8, 0), 32);
    const int qc = 16 * qi + i, cs = min(max(qc - 8, 0), 48);
    const float scale = 0.08838834764831845f;
    for (int unit = blockIdx.x; unit < 64 * 32; unit += F.G) {
        const int rpi = unit & 31, bh = unit >> 5, h = bh & 15, b = bh >> 4;
        const int r0 = 2 * rpi, qrow = r0 + qsel, R0 = min(max(r0 - 4, 0), 56), rsw = min(max(qrow - 4, 0), 56);
        const size_t tokb = (size_t)b * T;
        if (tid < 465) rp[tid] = rpb[h * 465 + tid];
        v4u vreg[10];
#pragma unroll
        for (int k = 0; k < 10; ++k) { const int ch = tid + 512 * k, row = ch >> 10, key = (ch >> 4) & 63, c16 = ch & 15; const int vr = min(R0 + row, 63);
            vreg[k] = *(const GAS v4u*)(QKV + (tokb + vr * 64 + key) * NQKV + 2 * D + h * 128 + c16 * 8); }
        bf16x8 bq[4];
        { const bf16* qp = QKV + (tokb + qrow * 64 + qc) * NQKV + h * 128 + 8 * fq;
#pragma unroll
          for (int kk = 0; kk < 4; ++kk) bq[kk] = *(const GAS bf16x8*)(qp + 32 * kk); }
        f32x4 acc[16];
#pragma unroll
        for (int kt = 0; kt < 16; ++kt) acc[kt] = (f32x4){0.f, 0.f, 0.f, 0.f};
#pragma unroll
        for (int jr = 0; jr < 8; ++jr) {
            bf16x8 ka[2][4];
#pragma unroll
            for (int kb2 = 0; kb2 < 2; ++kb2) { const bf16* kp = QKV + (tokb + (rsw + jr) * 64 + wc + 16 * kb2 + i) * NQKV + D + h * 128 + 8 * fq;
#pragma unroll
                for (int kk = 0; kk < 4; ++kk) ka[kb2][kk] = *(const GAS bf16x8*)(kp + 32 * kk); }
#pragma unroll
            for (int kb2 = 0; kb2 < 2; ++kb2)
#pragma unroll
                for (int kk = 0; kk < 4; ++kk) acc[2 * jr + kb2] = __builtin_amdgcn_mfma_f32_16x16x32_bf16(ka[kb2][kk], bq[kk], acc[2 * jr + kb2], 0, 0, 0);
        }
        __syncthreads();
#pragma unroll
        for (int k = 0; k < 10; ++k) { const int ch = tid + 512 * k, row = ch >> 10, key = (ch >> 4) & 63, c16 = ch & 15; *(LAS v4u*)(vl + (row * 64 + key) * NA_VP + c16 * 16) = vreg[k]; }
#pragma unroll
        for (int k = 0; k < 8; ++k) { const int ch = tid + 512 * k, row = ch >> 10, key = (ch >> 4) & 63, c16 = ch & 15; const int vr = min(R0 + 5 + row, 63);
            vreg[k] = *(const GAS v4u*)(QKV + (tokb + vr * 64 + key) * NQKV + 2 * D + h * 128 + c16 * 8); }
        float mx = -3.0e38f;
#pragma unroll
        for (int kt = 0; kt < 16; ++kt) { const int jr = kt >> 1, kb2 = kt & 1; const int dr = rsw + jr - qrow + 7;
#pragma unroll
            for (int r = 0; r < 4; ++r) { const int kc = wc + 16 * kb2 + 4 * fq + r; const int dc = min(max(kc - qc + 15, 0), 30); const bool ok = (kc >= cs) && (kc < cs + 16);
                const float s = ok ? acc[kt][r] * scale + rp[dr * 31 + dc] : -3.0e38f; acc[kt][r] = s; mx = fmaxf(mx, s); } }
        mx = fmaxf(mx, __shfl_xor(mx, 16)); mx = fmaxf(mx, __shfl_xor(mx, 32));
        float sum = 0.f;
#pragma unroll
        for (int kt = 0; kt < 16; ++kt)
#pragma unroll
            for (int r = 0; r < 4; ++r) { const float p = __expf(acc[kt][r] - mx); acc[kt][r] = p; sum += p; }
        sum += __shfl_xor(sum, 16); sum += __shfl_xor(sum, 32);
        const float inv = 1.0f / sum;
        bf16x8 pb[8];
#pragma unroll
        for (int ks = 0; ks < 8; ++ks) { v4u w; w.x = cvtpk(acc[2 * ks][0], acc[2 * ks][1]); w.y = cvtpk(acc[2 * ks][2], acc[2 * ks][3]); w.z = cvtpk(acc[2 * ks + 1][0], acc[2 * ks + 1][1]); w.w = cvtpk(acc[2 * ks + 1][2], acc[2 * ks + 1][3]);
            pb[ks] = __builtin_bit_cast(bf16x8, w); }
        __syncthreads();
        f32x4 o[8];
#pragma unroll
        for (int db = 0; db < 8; ++db) o[db] = (f32x4){0.f, 0.f, 0.f, 0.f};
        const int q4 = (lane & 15) >> 2, p4 = lane & 3;
        LAS unsigned char* vb0 = vl + (wc + 4 * fq + q4) * NA_VP + 8 * p4;
#pragma unroll
        for (int jr = 0; jr < 8; ++jr) { const int la = rsw + jr - R0;
            if (la <= 4) { LAS unsigned char* vp = vb0 + la * 64 * NA_VP;
#pragma unroll
                for (int db = 0; db < 8; ++db) { const s16x4 x0 = lds_tr(vp + 32 * db), x1 = lds_tr(vp + 16 * NA_VP + 32 * db);
                    const bf16x8 a = (bf16x8){x0[0], x0[1], x0[2], x0[3], x1[0], x1[1], x1[2], x1[3]};
                    o[db] = __builtin_amdgcn_mfma_f32_16x16x32_bf16(a, pb[jr], o[db], 0, 0, 0); } } }
        __syncthreads();
#pragma unroll
        for (int k = 0; k < 8; ++k) { const int ch = tid + 512 * k, row = ch >> 10, key = (ch >> 4) & 63, c16 = ch & 15; *(LAS v4u*)(vl + (row * 64 + key) * NA_VP + c16 * 16) = vreg[k]; }
        __syncthreads();
#pragma unroll
        for (int jr = 0; jr < 8; ++jr) { const int la = rsw + jr - R0 - 5;
            if (la >= 0) { LAS unsigned char* vp = vb0 + la * 64 * NA_VP;
#pragma unroll
                for (int db = 0; db < 8; ++db) { const s16x4 x0 = lds_tr(vp + 32 * db), x1 = lds_tr(vp + 16 * NA_VP + 32 * db);
                    const bf16x8 a = (bf16x8){x0[0], x0[1], x0[2], x0[3], x1[0], x1[1], x1[2], x1[3]};
                    o[db] = __builtin_amdgcn_mfma_f32_16x16x32_bf16(a, pb[jr], o[db], 0, 0, 0); } } }
        bf16* op = AO + (tokb + qrow * 64 + qc) * D + h * 128 + 4 * fq;
#pragma unroll
        for (int db = 0; db < 8; ++db) { v2u w; w.x = cvtpk(o[db][0] * inv, o[db][1] * inv); w.y = cvtpk(o[db][2] * inv, o[db][3] * inv); *(GAS v2u*)(op + 16 * db) = w; }
    }
    __syncthreads();
}
__device__ __forceinline__ float wave_scan_incl(float v, int lane) {
#pragma unroll
    for (int off = 1; off < 64; off <<= 1) { const float t = __shfl_up(v, off); if (lane >= off) v += t; }
    return v;
}
constexpr int RQ_P = 272, RV_P = 104;
constexpr int ML_Q = 0, ML_K = 17408, ML_V = 34816, ML_VW = 41472, ML_TB = 48128, ML_PAR = 49152, ML_CB = 98304, ML_CBSZ = 128 * RV_P;
static_assert(ML_CB + 2 * ML_CBSZ <= RING_BYTES, "mLSTM LDS map");
__device__ __forceinline__ void mlstm_chunk_unit(const Frame& F, const Args& A, int unit) {
    const int lane = lane_now(), tid = F.wave * 64 + lane, i = lane & 15, fq = lane >> 4, q4 = i >> 2, p4 = lane & 3;
    const int es = unit & 7, dir = (unit >> 3) & 1, h = (unit >> 4) & 3, b = unit >> 6;
    LAS unsigned char* L = F.lds + RING_OFF;
    const bf16* U = (const bf16*)(A.ws + WS_U); const float* Gt = (const float*)(A.ws + WS_G);
    float* HA = (float*)(A.ws + WS_HA) + (size_t)dir * M * 1024;
    const float bias_i = A.in[I_GBIAS][(dir ? 2 : 0) * 4 + h], bias_f = A.in[I_GBIAS][(dir ? 3 : 1) * 4 + h];
    const float qscale = 0.08838834764831845f;
#define ML_TOK(c, tau) ((size_t)b * T + (dir ? (T - 1 - (64 * (c) + (tau))) : (64 * (c) + (tau))))
    for (int x = tid; x < ML_CBSZ / 4; x += NWAVES * 64) ((LAS unsigned*)(L + ML_CB))[x] = 0u;
    v4u rq[2], rk[2], rv[4]; float rgi = 0.f, rgf = 0.f;
#define ML_LOAD(c) do { \
        _Pragma("unroll") for (int k = 0; k < 2; ++k) { const int ch = tid + 512 * k, row = ch >> 4, c16 = ch & 15; const bf16* ur = U + ML_TOK(c, row) * UW + h * 128 + c16 * 8; \
            rq[k] = *(const GAS v4u*)(ur + U_QA); rk[k] = *(const GAS v4u*)(ur + U_KA); } \
        if (F.wave == 4) { const size_t tk = ML_TOK(c, lane); const bf16* vr = U + tk * UW + U_VA + h * 256 + es * 32; \
            _Pragma("unroll") for (int k = 0; k < 4; ++k) rv[k] = *(const GAS v4u*)(vr + 8 * k); \
            rgi = Gt[tk * 16 + (dir ? 2 : 0) * 4 + h]; rgf = Gt[tk * 16 + (dir ? 3 : 1) * 4 + h]; } } while (0)
#define ML_STAGE(par) do { LAS unsigned char* P = L + (par) * ML_PAR; \
        _Pragma("unroll") for (int k = 0; k < 2; ++k) { const int ch = tid + 512 * k, row = ch >> 4, c16 = ch & 15; \
            *(LAS v4u*)(P + ML_Q + row * RQ_P + c16 * 16) = rq[k]; *(LAS v4u*)(P + ML_K + row * RQ_P + c16 * 16) = rk[k]; } \
        if (F.wave == 4) { \
            const float gi = GATE_CAP * tanhf((rgi + bias_i) * (1.0f / GATE_CAP)), gf = GATE_CAP * tanhf((rgf + bias_f) * (1.0f / GATE_CAP)); \
            const float lf = -log1pf(__expf(-gf)); const float bb = wave_scan_incl(lf, lane); \
            const float gg = __builtin_bit_cast(float, __builtin_amdgcn_readlane(__builtin_bit_cast(int, bb), 63)); \
            const float wgt = __expf(gg - bb + gi); \
            LAS float* tb = (LAS float*)(P + ML_TB); tb[lane] = bb; tb[64 + lane] = gi - bb; if (lane == 0) tb[128] = gg; \
            LAS unsigned char* vrow = P + ML_V + lane * RV_P; LAS unsigned char* wrow = P + ML_VW + lane * RV_P; \
            _Pragma("unroll") for (int k = 0; k < 4; ++k) { const unsigned xs[4] = {rv[k].x, rv[k].y, rv[k].z, rv[k].w}; \
                _Pragma("unroll") for (int m2 = 0; m2 < 2; ++m2) { v2u o; o.x = xs[2 * m2]; o.y = xs[2 * m2 + 1]; *(LAS v2u*)(vrow + 16 * k + 8 * m2) = o; \
                    v2u ow; ow.x = cvtpk(bflo(xs[2 * m2]) * wgt, bfhi(xs[2 * m2]) * wgt); ow.y = cvtpk(bflo(xs[2 * m2 + 1]) * wgt, bfhi(xs[2 * m2 + 1]) * wgt); *(LAS v2u*)(wrow + 16 * k + 8 * m2) = ow; } } \
            { v2u o; o.x = 0x3f80u; o.y = 0u; *(LAS v2u*)(vrow + 64) = o; v2u ow; ow.x = cvtpk(wgt, 0.f); ow.y = 0u; *(LAS v2u*)(wrow + 64) = ow; \
              v2u z; z.x = 0u; z.y = 0u; _Pragma("unroll") for (int k = 1; k < 4; ++k) { *(LAS v2u*)(vrow + 64 + 8 * k) = z; *(LAS v2u*)(wrow + 64 + 8 * k) = z; } } \
        } } while (0)
    ML_LOAD(0);
    ML_STAGE(0);
    ML_LOAD(1);
    f32x4 Cst[3][2];
#pragma unroll
    for (int eb = 0; eb < 3; ++eb)
#pragma unroll
        for (int dbi = 0; dbi < 2; ++dbi) Cst[eb][dbi] = (f32x4){0.f, 0.f, 0.f, 0.f};
    __syncthreads();
    for (int c = 0; c < T / 64; ++c) {
        const int par = c & 1;
        if (c + 1 < T / 64) { ML_STAGE(par ^ 1); if (c + 2 < T / 64) ML_LOAD(c + 2); }
        LAS unsigned char* P = L + par * ML_PAR; LAS unsigned char* CBc = L + ML_CB + par * ML_CBSZ; LAS unsigned char* CBn = L + ML_CB + (par ^ 1) * ML_CBSZ;
        const LAS float* tb = (const LAS float*)(P + ML_TB);
        if (F.wave < 4) {
            const int tbk = F.wave;
            bf16x8 qf[4];
#pragma unroll
            for (int kk = 0; kk < 4; ++kk) qf[kk] = *(const LAS bf16x8*)(P + ML_Q + (16 * tbk + i) * RQ_P + (32 * kk + 8 * fq) * 2);
            const float btt = tb[16 * tbk + i];
            f32x4 pt[4];
#pragma unroll
            for (int sb = 0; sb < 4; ++sb) { pt[sb] = (f32x4){0.f, 0.f, 0.f, 0.f};
                if (sb <= tbk) { f32x4 acc = (f32x4){0.f, 0.f, 0.f, 0.f};
#pragma unroll
                    for (int kk = 0; kk < 4; ++kk) { const bf16x8 kf = *(const LAS bf16x8*)(P + ML_K + (16 * sb + i) * RQ_P + (32 * kk + 8 * fq) * 2); acc = __builtin_amdgcn_mfma_f32_16x16x32_bf16(kf, qf[kk], acc, 0, 0, 0); }
                    const f32x4 at4 = *(const LAS f32x4*)(tb + 64 + 16 * sb + 4 * fq);
#pragma unroll
                    for (int r = 0; r < 4; ++r) { const bool ok = (sb < tbk) || (4 * fq + r <= i); const float wg = qscale * __expf(btt + at4[r]); pt[sb][r] = ok ? acc[r] * wg : 0.f; } } }
            f32x4 num[3], itr[3];
#pragma unroll
            for (int eb = 0; eb < 3; ++eb) { num[eb] = (f32x4){0.f, 0.f, 0.f, 0.f}; itr[eb] = (f32x4){0.f, 0.f, 0.f, 0.f}; }
#pragma unroll
            for (int ks = 0; ks < 2; ++ks) if (2 * ks <= tbk) {
                v4u w; w.x = cvtpk(pt[2 * ks][0], pt[2 * ks][1]); w.y = cvtpk(pt[2 * ks][2], pt[2 * ks][3]); w.z = cvtpk(pt[2 * ks + 1][0], pt[2 * ks + 1][1]); w.w = cvtpk(pt[2 * ks + 1][2], pt[2 * ks + 1][3]);
                const bf16x8 pf = __builtin_bit_cast(bf16x8, w);
#pragma unroll
                for (int eb = 0; eb < 3; ++eb) { LAS unsigned char* vp = P + ML_V + (32 * ks + 4 * fq + q4) * RV_P + (16 * eb + 4 * p4) * 2;
                    const s16x4 x0 = lds_tr(vp), x1 = lds_tr(vp + 16 * RV_P);
                    const bf16x8 a = (bf16x8){x0[0], x0[1], x0[2], x0[3], x1[0], x1[1], x1[2], x1[3]};
                    num[eb] = __builtin_amdgcn_mfma_f32_16x16x32_bf16(a, pf, num[eb], 0, 0, 0); } }
#pragma unroll
            for (int kk = 0; kk < 4; ++kk)
#pragma unroll
                for (int eb = 0; eb < 3; ++eb) { LAS unsigned char* cp = CBc + (32 * kk + 8 * fq + q4) * RV_P + (16 * eb + 4 * p4) * 2;
                    const s16x4 x0 = lds_tr(cp), x1 = lds_tr(cp + 4 * RV_P);
                    const bf16x8 a = (bf16x8){x0[0], x0[1], x0[2], x0[3], x1[0], x1[1], x1[2], x1[3]};
                    itr[eb] = __builtin_amdgcn_mfma_f32_16x16x32_bf16(a, qf[kk], itr[eb], 0, 0, 0); }
            const float iw = qscale * __expf(btt);
#pragma unroll
            for (int eb = 0; eb < 3; ++eb) num[eb] = num[eb] + itr[eb] * iw;
            const float den = __shfl(num[2][0], i);
            const float rden = 1.0f / fmaxf(fabsf(den), 1.0f);
            float* hp = HA + ML_TOK(c, 16 * tbk + i) * 1024 + h * 256 + es * 32 + 4 * fq;
            *(GAS f32x4*)(hp) = num[0] * rden; *(GAS f32x4*)(hp + 16) = num[1] * rden;
        } else {
            const int wq = F.wave - 4;
            const float eg = __expf(tb[128]);
#pragma unroll
            for (int eb = 0; eb < 3; ++eb)
#pragma unroll
                for (int dbi = 0; dbi < 2; ++dbi) Cst[eb][dbi] = Cst[eb][dbi] * eg;
#pragma unroll
            for (int ks = 0; ks < 2; ++ks) {
                bf16x8 af[3], bfr[2];
#pragma unroll
                for (int eb = 0; eb < 3; ++eb) { LAS unsigned char* vp = P + ML_VW + (32 * ks + 8 * fq + q4) * RV_P + (16 * eb + 4 * p4) * 2; const s16x4 x0 = lds_tr(vp), x1 = lds_tr(vp + 4 * RV_P);
                    af[eb] = (bf16x8){x0[0], x0[1], x0[2], x0[3], x1[0], x1[1], x1[2], x1[3]}; }
#pragma unroll
                for (int dbi = 0; dbi < 2; ++dbi) { LAS unsigned char* kp = P + ML_K + (32 * ks + 8 * fq + q4) * RQ_P + (16 * (2 * wq + dbi) + 4 * p4) * 2; const s16x4 x0 = lds_tr(kp), x1 = lds_tr(kp + 4 * RQ_P);
                    bfr[dbi] = (bf16x8){x0[0], x0[1], x0[2], x0[3], x1[0], x1[1], x1[2], x1[3]}; }
#pragma unroll
                for (int eb = 0; eb < 3; ++eb)
#pragma unroll
                    for (int dbi = 0; dbi < 2; ++dbi) Cst[eb][dbi] = __builtin_amdgcn_mfma_f32_16x16x32_bf16(af[eb], bfr[dbi], Cst[eb][dbi], 0, 0, 0);
            }
#pragma unroll
            for (int eb = 0; eb < 3; ++eb)
#pragma unroll
                for (int dbi = 0; dbi < 2; ++dbi) { v2u o; o.x = cvtpk(Cst[eb][dbi][0], Cst[eb][dbi][1]); o.y = cvtpk(Cst[eb][dbi][2], Cst[eb][dbi][3]);
                    *(LAS v2u*)(CBn + (16 * (2 * wq + dbi) + i) * RV_P + (16 * eb + 4 * fq) * 2) = o; }
        }
        __syncthreads();
    }
#undef ML_LOAD
#undef ML_STAGE
#undef ML_TOK
}
constexpr int HG_Q = 0, HG_K = 17408, HG_V = 34816, HG_VP = 72, HG_TB = 34816 + 64 * 72, HG_PAR = HG_TB + 1024, HG_SB = 2 * HG_PAR, HG_SBSZ = 128 * HG_VP;
static_assert(HG_SB + 2 * HG_SBSZ <= RING_BYTES && (HG_PAR % 16) == 0, "HGRN LDS map");
__device__ __forceinline__ void hgrn_chunk_unit(const Frame& F, const Args& A, int unit) {
    const int lane = lane_now(), tid = F.wave * 64 + lane, i = lane & 15, fq = lane >> 4, q4 = i >> 2, p4 = lane & 3;
    const int es = unit & 3, dir = (unit >> 2) & 1, h = (unit >> 3) & 7, b = unit >> 6;
    LAS unsigned char* L = F.lds + RING_OFF;
    const bf16* U = (const bf16*)(A.ws + WS_U);
    float* HB = (float*)(A.ws + WS_HB) + (size_t)dir * M * 1024;
    const int ch0 = h * 128 + 16 * F.wave;
#define HG_TOK(c, tau) ((size_t)b * T + (dir ? (T - 1 - (64 * (c) + (tau))) : (64 * (c) + (tau))))
    for (int x = tid; x < HG_SBSZ / 4; x += NWAVES * 64) ((LAS unsigned*)(L + HG_SB))[x] = 0u;
    float lb[16];
#pragma unroll
    for (int k = 0; k < 16; ++k) { const float l0 = A.in[I_LBLOG][(dir * 2 + 0) * 1024 + ch0 + k], l1 = A.in[I_LBLOG][(dir * 2 + 1) * 1024 + ch0 + k]; lb[k] = 1.0f / (1.0f + __expf(l1 - l0)); }
    v4u rq[2], rf[2], rv;
#define HG_LOAD(c) do { const bf16* ur = U + HG_TOK(c, lane) * UW + ch0; \
        rq[0] = *(const GAS v4u*)(ur + U_QB); rq[1] = *(const GAS v4u*)(ur + U_QB + 8); rf[0] = *(const GAS v4u*)(ur + (dir ? U_FB : U_FF)); rf[1] = *(const GAS v4u*)(ur + (dir ? U_FB : U_FF) + 8); \
        if (tid < 256) rv = *(const GAS v4u*)(U + HG_TOK(c, tid >> 2) * UW + U_IB + h * 128 + es * 32 + (tid & 3) * 8); } while (0)
#define HG_STAGE(par) do { LAS unsigned char* P = L + (par) * HG_PAR; \
        const unsigned qw[8] = {rq[0].x, rq[0].y, rq[0].z, rq[0].w, rq[1].x, rq[1].y, rq[1].z, rq[1].w}; const unsigned fw[8] = {rf[0].x, rf[0].y, rf[0].z, rf[0].w, rf[1].x, rf[1].y, rf[1].z, rf[1].w}; \
        unsigned qo[8], ko[8]; \
        _Pragma("unroll") for (int k2 = 0; k2 < 8; ++k2) { float qi_[2], ki_[2]; \
            _Pragma("unroll") for (int hh = 0; hh < 2; ++hh) { const int k = 2 * k2 + hh; const float qr = hh ? bfhi(qw[k2]) : bflo(qw[k2]), fr = hh ? bfhi(fw[k2]) : bflo(fw[k2]); \
                const float qv = qr * sigm(qr); const float f = lb[k] + (1.0f - lb[k]) * sigm(fr); const float bb = wave_scan_incl(__logf(f), lane); \
                if (lane == 63) ((LAS float*)(P + HG_TB))[16 * F.wave + k] = bb; \
                qi_[hh] = qv * __expf(bb); ki_[hh] = (1.0f - f) * __expf(-bb); } \
            qo[k2] = cvtpk(qi_[0], qi_[1]); ko[k2] = cvtpk(ki_[0], ki_[1]); } \
        { v4u o; o.x = qo[0]; o.y = qo[1]; o.z = qo[2]; o.w = qo[3]; *(LAS v4u*)(P + HG_Q + lane * RQ_P + 32 * F.wave) = o; o.x = qo[4]; o.y = qo[5]; o.z = qo[6]; o.w = qo[7]; *(LAS v4u*)(P + HG_Q + lane * RQ_P + 32 * F.wave + 16) = o; \
          o.x = ko[0]; o.y = ko[1]; o.z = ko[2]; o.w = ko[3]; *(LAS v4u*)(P + HG_K + lane * RQ_P + 32 * F.wave) = o; o.x = ko[4]; o.y = ko[5]; o.z = ko[6]; o.w = ko[7]; *(LAS v4u*)(P + HG_K + lane * RQ_P + 32 * F.wave + 16) = o; } \
        if (tid < 256) { v2u o; o.x = rv.x; o.y = rv.y; *(LAS v2u*)(P + HG_V + (tid >> 2) * HG_VP + (tid & 3) * 16) = o; o.x = rv.z; o.y = rv.w; *(LAS v2u*)(P + HG_V + (tid >> 2) * HG_VP + (tid & 3) * 16 + 8) = o; } } while (0)
    HG_LOAD(0);
    HG_STAGE(0);
    HG_LOAD(1);
    f32x4 Sst[2][2];
#pragma unroll
    for (int eb = 0; eb < 2; ++eb)
#pragma unroll
        for (int dbi = 0; dbi < 2; ++dbi) Sst[eb][dbi] = (f32x4){0.f, 0.f, 0.f, 0.f};
    __syncthreads();
    for (int c = 0; c < T / 64; ++c) {
        const int par = c & 1;
        if (c + 1 < T / 64) { HG_STAGE(par ^ 1); if (c + 2 < T / 64) HG_LOAD(c + 2); }
        LAS unsigned char* P = L + par * HG_PAR; LAS unsigned char* SBc = L + HG_SB + par * HG_SBSZ; LAS unsigned char* SBn = L + HG_SB + (par ^ 1) * HG_SBSZ;
        if (F.wave < 4) {
            const int tbk = F.wave;
            bf16x8 qf[4];
#pragma unroll
            for (int kk = 0; kk < 4; ++kk) qf[kk] = *(const LAS bf16x8*)(P + HG_Q + (16 * tbk + i) * RQ_P + (32 * kk + 8 * fq) * 2);
            f32x4 pt[4];
#pragma unroll
            for (int sb = 0; sb < 4; ++sb) { pt[sb] = (f32x4){0.f, 0.f, 0.f, 0.f};
                if (sb <= tbk) { f32x4 acc = (f32x4){0.f, 0.f, 0.f, 0.f};
#pragma unroll
                    for (int kk = 0; kk < 4; ++kk) { const bf16x8 kf = *(const LAS bf16x8*)(P + HG_K + (16 * sb + i) * RQ_P + (32 * kk + 8 * fq) * 2); acc = __builtin_amdgcn_mfma_f32_16x16x32_bf16(kf, qf[kk], acc, 0, 0, 0); }
#pragma unroll
                    for (int r = 0; r < 4; ++r) { const bool ok = (sb < tbk) || (4 * fq + r <= i); pt[sb][r] = ok ? acc[r] : 0.f; } } }
            f32x4 o[2];
#pragma unroll
            for (int eb = 0; eb < 2; ++eb) o[eb] = (f32x4){0.f, 0.f, 0.f, 0.f};
#pragma unroll
            for (int ks = 0; ks < 2; ++ks) if (2 * ks <= tbk) {
                v4u w; w.x = cvtpk(pt[2 * ks][0], pt[2 * ks][1]); w.y = cvtpk(pt[2 * ks][2], pt[2 * ks][3]); w.z = cvtpk(pt[2 * ks + 1][0], pt[2 * ks + 1][1]); w.w = cvtpk(pt[2 * ks + 1][2], pt[2 * ks + 1][3]);
                const bf16x8 pf = __builtin_bit_cast(bf16x8, w);
#pragma unroll
                for (int eb = 0; eb < 2; ++eb) { LAS unsigned char* vp = P + HG_V + (32 * ks + 4 * fq + q4) * HG_VP + (16 * eb + 4 * p4) * 2;
                    const s16x4 x0 = lds_tr(vp), x1 = lds_tr(vp + 16 * HG_VP);
                    const bf16x8 a = (bf16x8){x0[0], x0[1], x0[2], x0[3], x1[0], x1[1], x1[2], x1[3]};
                    o[eb] = __builtin_amdgcn_mfma_f32_16x16x32_bf16(a, pf, o[eb], 0, 0, 0); } }
#pragma unroll
            for (int kk = 0; kk < 4; ++kk)
#pragma unroll
                for (int eb = 0; eb < 2; ++eb) { LAS unsigned char* cp = SBc + (32 * kk + 8 * fq + q4) * HG_VP + (16 * eb + 4 * p4) * 2;
                    const s16x4 x0 = lds_tr(cp), x1 = lds_tr(cp + 4 * HG_VP);
                    const bf16x8 a = (bf16x8){x0[0], x0[1], x0[2], x0[3], x1[0], x1[1], x1[2], x1[3]};
                    o[eb] = __builtin_amdgcn_mfma_f32_16x16x32_bf16(a, qf[kk], o[eb], 0, 0, 0); }
            float* hp = HB + HG_TOK(c, 16 * tbk + i) * 1024 + h * 128 + es * 32 + 4 * fq;
            *(GAS f32x4*)(hp) = o[0]; *(GAS f32x4*)(hp + 16) = o[1];
        } else {
            const int wq = F.wave - 4;
#pragma unroll
            for (int ks = 0; ks < 2; ++ks) {
                bf16x8 af[2], bfr[2];
#pragma unroll
                for (int eb = 0; eb < 2; ++eb) { LAS unsigned char* vp = P + HG_V + (32 * ks + 8 * fq + q4) * HG_VP + (16 * eb + 4 * p4) * 2; const s16x4 x0 = lds_tr(vp), x1 = lds_tr(vp + 4 * HG_VP);
                    af[eb] = (bf16x8){x0[0], x0[1], x0[2], x0[3], x1[0], x1[1], x1[2], x1[3]}; }
#pragma unroll
                for (int dbi = 0; dbi < 2; ++dbi) { LAS unsigned char* kp = P + HG_K + (32 * ks + 8 * fq + q4) * RQ_P + (16 * (2 * wq + dbi) + 4 * p4) * 2; const s16x4 x0 = lds_tr(kp), x1 = lds_tr(kp + 4 * RQ_P);
                    bfr[dbi] = (bf16x8){x0[0], x0[1], x0[2], x0[3], x1[0], x1[1], x1[2], x1[3]}; }
#pragma unroll
                for (int eb = 0; eb < 2; ++eb)
#pragma unroll
                    for (int dbi = 0; dbi < 2; ++dbi) Sst[eb][dbi] = __builtin_amdgcn_mfma_f32_16x16x32_bf16(af[eb], bfr[dbi], Sst[eb][dbi], 0, 0, 0);
            }
#pragma unroll
            for (int dbi = 0; dbi < 2; ++dbi) { const float eg = __expf(((const LAS float*)(P + HG_TB))[16 * (2 * wq + dbi) + i]);
#pragma unroll
                for (int eb = 0; eb < 2; ++eb) { Sst[eb][dbi] = Sst[eb][dbi] * eg; v2u o; o.x = cvtpk(Sst[eb][dbi][0], Sst[eb][dbi][1]); o.y = cvtpk(Sst[eb][dbi][2], Sst[eb][dbi][3]);
                    *(LAS v2u*)(SBn + (16 * (2 * wq + dbi) + i) * HG_VP + (16 * eb + 4 * fq) * 2) = o; } }
        }
        __syncthreads();
    }
#undef HG_LOAD
#undef HG_STAGE
#undef HG_TOK
}
#ifndef MK_ONE_LAUNCH
#define MK_ONE_LAUNCH 1
#endif
constexpr int N_PHASES = 21;
__global__ void __launch_bounds__(NWAVES * 64, 2) trunk_fwd(Args args) {
    extern __shared__ __attribute__((aligned(16))) unsigned char lds[];
    Frame F;
    F.lds = (LAS unsigned char*)lds;
    F.wave = __builtin_amdgcn_readfirstlane(threadIdx.x >> 6);
    F.G = gridDim.x;
    const Args& A = args;
    { const int tid0 = F.wave * 64 + lane_now(); for (int u = tid0; u < (LDS_BYTES - LDSCTL_OFF) / 4; u += NWAVES * 64) ((LAS unsigned*)(F.lds + LDSCTL_OFF))[u] = 0u; }
    __syncthreads();
    gu32* ctl = (gu32*)(args.ws + WS_CTL);
    const int lo = args.ph_lo, hi = args.ph_hi;
    XcdBarrier bar; bar.bar = (unsigned*)(ctl + CW_BAR); bar.x = 0; bar.st = nullptr;
    if (hi - lo > 1) bar = xcd_barrier_post((unsigned*)(ctl + CW_BAR), (volatile LAS unsigned*)(F.lds + MISC_OFF) + 8, F.wave);
#ifndef PROBE_MASK
#define PROBE_MASK 0u
#endif
#define IN(k) (lo <= (k) && (k) < hi)
#define REP(k) _Pragma("unroll") for (int rep_ = 0; rep_ < (((PROBE_MASK >> (k)) & 1u) ? 2 : 1); ++rep_)
#define RSEAM(k) do { if (((PROBE_MASK >> (k)) & 1u) && rep_ == 0) xcd_barrier(bar, F.wave); } while (0)
#define SEAM(k) do { if (IN(k) && IN((k) + 1)) xcd_barrier(bar, F.wave); } while (0)
    unsigned char* ws = args.ws;
    bf16* XB0 = (bf16*)(ws + WS_XB0); bf16* XB1 = (bf16*)(ws + WS_XB1);
    const int bid = (int)blockIdx.x;

    REP(0) if (IN(0)) { p0_prologue(F, A); RSEAM(0); } SEAM(0);
    REP(1) if (IN(1)) {
        pg8::Gemm g{XB0, (const bf16*)(ws + WS_WRIN), M, NREC, D}; pg8::StaticOrder S; S.init(M, NREC, F.G, bid);
        pg8::EpiBf16G E{(bf16*)(ws + WS_U), UW, 32, (float*)(ws + WS_G)};
        pg8::gemm_phase<pg8::EpiBf16G, pg8::StaticOrder, true, true>(F.lds + RING_OFF, g, S, E, F.wave);
    RSEAM(1); } SEAM(1);
    REP(2) if (IN(2)) { for (int unit = bid; unit < 256; unit += F.G) mlstm_chunk_unit(F, A, unit); for (int unit = bid; unit < 256; unit += F.G) hgrn_chunk_unit(F, A, unit); RSEAM(2); } SEAM(2);
    REP(3) if (IN(3)) { p3_finalize(F, A); RSEAM(3); } SEAM(3);
    REP(4) if (IN(4)) {
        pg8::Gemm g{(const bf16*)(ws + WS_Y), (const bf16*)(ws + WS_WROUT), M, D, D}; pg8::StaticOrder S; S.init(M, D, F.G, bid);
        pg8::EpiResF32 E{A.in[I_X], A.out, D, ALPHA};
        pg8::gemm_phase<pg8::EpiResF32, pg8::StaticOrder, true, true>(F.lds + RING_OFF, g, S, E, F.wave);
    RSEAM(4); } SEAM(4);
    REP(5) if (IN(5)) { ln_phase(F, A, A.in[I_LNW] + 0 * D, A.in[I_LNB] + 0 * D, XB1); RSEAM(5); } SEAM(5);
    REP(6) if (IN(6)) {
        pg8::Gemm g{XB1, (const bf16*)(ws + WS_WFGU), M, 2 * FFN, D}; pg8::StaticOrder S; S.init(M, 2 * FFN, F.G, bid);
        pg8::EpiSwiglu E{(bf16*)(ws + WS_H), FFN, 2 * FFN / 256};
        pg8::gemm_phase<pg8::EpiSwiglu, pg8::StaticOrder, true, true>(F.lds + RING_OFF, g, S, E, F.wave);
    RSEAM(6); } SEAM(6);
    REP(7) if (IN(7)) {
        pg8::Gemm g{(const bf16*)(ws + WS_H), (const bf16*)(ws + WS_WFDN), M, D, FFN}; pg8::StaticOrder S; S.init(M, D, F.G, bid);
        pg8::EpiResF32 E{A.out, A.out, D, ALPHA};
        pg8::gemm_phase<pg8::EpiResF32, pg8::StaticOrder, true, true>(F.lds + RING_OFF, g, S, E, F.wave);
    RSEAM(7); } SEAM(7);
    REP(8) if (IN(8)) { ln_phase(F, A, A.in[I_LNW] + 1 * D, A.in[I_LNB] + 1 * D, XB0); RSEAM(8); } SEAM(8);
    REP(9) if (IN(9)) {
        pg8::Gemm g{(const bf16*)(ws + WS_PB), (const bf16*)(ws + WS_WPP0), M, D, PLE_DIM}; pg8::StaticOrder S; S.init(M, D, F.G, bid);
        pg8::EpiStoreF32 E{(float*)(ws + WS_PP), D, D / 256};
        pg8::gemm_phase<pg8::EpiStoreF32, pg8::StaticOrder, true, true>(F.lds + RING_OFF, g, S, E, F.wave);
    RSEAM(9); } SEAM(9);
    REP(10) if (IN(10)) {
        pg8::Gemm g{XB0, (const bf16*)(ws + WS_WPG0), M, D, D}; pg8::StaticOrder S; S.init(M, D, F.G, bid);
        pg8::EpiPle E{A.out, (const float*)(ws + WS_PP), XB1, D};
        pg8::gemm_phase<pg8::EpiPle, pg8::StaticOrder, true, true>(F.lds + RING_OFF, g, S, E, F.wave);
    RSEAM(10); } SEAM(10);
    REP(11) if (IN(11)) {
        pg8::Gemm g{XB1, (const bf16*)(ws + WS_WQKV), M, NQKV, D}; pg8::StaticOrder S; S.init(M, NQKV, F.G, bid);
        pg8::EpiBf16G E{(bf16*)(ws + WS_QKV), NQKV, -1, nullptr};
        pg8::gemm_phase<pg8::EpiBf16G, pg8::StaticOrder, true, true>(F.lds + RING_OFF, g, S, E, F.wave);
    RSEAM(11); } SEAM(11);
    REP(12) if (IN(12)) { na_phase_mfma(F, A); RSEAM(12); } SEAM(12);
    REP(13) if (IN(13)) {
        pg8::Gemm g{(const bf16*)(ws + WS_AO), (const bf16*)(ws + WS_WNAO), M, D, D}; pg8::StaticOrder S; S.init(M, D, F.G, bid);
        pg8::EpiResF32 E{A.out, A.out, D, ALPHA};
        pg8::gemm_phase<pg8::EpiResF32, pg8::StaticOrder, true, true>(F.lds + RING_OFF, g, S, E, F.wave);
    RSEAM(13); } SEAM(13);
    REP(14) if (IN(14)) { ln_router_phase(F, A, A.in[I_LNW] + 2 * D, A.in[I_LNB] + 2 * D, XB0); RSEAM(14); } SEAM(14);
    REP(15) if (IN(15)) { moe_scatter_phase(F, A, XB0); RSEAM(15); } SEAM(15);
    REP(16) if (IN(16)) {
        const int* TILEE = (const int*)(ws + WS_TILEE); const int nrt = __builtin_amdgcn_readfirstlane(TILEE[0]);
        pg8::Gemm g{(const bf16*)(ws + WS_XS), (const bf16*)(ws + WS_WMGU), nrt * 256, 2 * MOE, D}; pg8::MoeOrder S; S.base.init(nrt * 256, 2 * MOE, F.G, bid); S.tile_e = TILEE + 1; S.nN = 2 * MOE / 256;
        pg8::EpiSwiglu E{(bf16*)(ws + WS_HM), MOE, 2 * MOE / 256};
        pg8::gemm_phase<pg8::EpiSwiglu, pg8::MoeOrder, true, true>(F.lds + RING_OFF, g, S, E, F.wave);
    RSEAM(16); } SEAM(16);
    REP(17) if (IN(17)) {
        const int* TILEE = (const int*)(ws + WS_TILEE); const int nrt = __builtin_amdgcn_readfirstlane(TILEE[0]);
        pg8::Gemm g{(const bf16*)(ws + WS_HM), (const bf16*)(ws + WS_WMDN), nrt * 256, D, MOE}; pg8::MoeOrder S; S.base.init(nrt * 256, D, F.G, bid); S.tile_e = TILEE + 1; S.nN = D / 256;
        pg8::EpiStoreF32 E{(float*)(ws + WS_YS), D, D / 256};
        pg8::gemm_phase<pg8::EpiStoreF32, pg8::MoeOrder, true, true>(F.lds + RING_OFF, g, S, E, F.wave);
    RSEAM(17); } SEAM(17);
    REP(18) if (IN(18)) { ln_moe_phase(F, A, A.in[I_LNW] + 3 * D, A.in[I_LNB] + 3 * D, XB1); RSEAM(18); } SEAM(18);
    REP(19) if (IN(19)) {
        pg8::Gemm g{(const bf16*)(ws + WS_PB) + (size_t)M * PLE_DIM, (const bf16*)(ws + WS_WPP1), M, D, PLE_DIM}; pg8::StaticOrder S; S.init(M, D, F.G, bid);
        pg8::EpiStoreF32 E{(float*)(ws + WS_PP1), D, D / 256};
        pg8::gemm_phase<pg8::EpiStoreF32, pg8::StaticOrder, true, true>(F.lds + RING_OFF, g, S, E, F.wave);
    RSEAM(19); } SEAM(19);
    REP(20) if (IN(20)) {
        pg8::Gemm g{XB1, (const bf16*)(ws + WS_WPG1), M, D, D}; pg8::StaticOrder S; S.init(M, D, F.G, bid);
        pg8::EpiPle E{A.out, (const float*)(ws + WS_PP1), nullptr, D};
        pg8::gemm_phase<pg8::EpiPle, pg8::StaticOrder, true, true>(F.lds + RING_OFF, g, S, E, F.wave);
    }
#undef IN
#undef SEAM
}

extern "C" void kernel_launch(void* const* d_in, const int* in_sizes, int n_in, void* d_out, int out_size, void* d_ws, size_t ws_size, hipStream_t stream) {
    static int grid = 0;
    if (grid == 0) {
        if (n_in != 23 || in_sizes[0] != M * D || out_size != M * D || ws_size < WS_END) { fprintf(stderr, "kernel_launch: unexpected shapes (n_in %d, in0 %d, out %d, ws %zu, need %zu)\n", n_in, n_in > 0 ? in_sizes[0] : -1, out_size, ws_size, (size_t)WS_END); grid = -1; return; }
        int dev = 0, cus = 0, per_cu = 0;
        if (hipGetDevice(&dev) != hipSuccess || hipDeviceGetAttribute(&cus, hipDeviceAttributeMultiprocessorCount, dev) != hipSuccess) { grid = -1; return; }
        if (hipFuncSetAttribute((const void*)trunk_fwd, hipFuncAttributeMaxDynamicSharedMemorySize, LDS_BYTES) != hipSuccess) { fprintf(stderr, "kernel_launch: hipFuncSetAttribute failed\n"); grid = -1; return; }
        if (hipOccupancyMaxActiveBlocksPerMultiprocessor(&per_cu, (const void*)trunk_fwd, NWAVES * 64, LDS_BYTES) != hipSuccess || per_cu < 1) { fprintf(stderr, "kernel_launch: occupancy query reports %d\n", per_cu); }
        (void)hipGetLastError();
        grid = cus;
    }
    if (grid < 0) return;
    (void)hipMemsetAsync((char*)d_ws + WS_CTL, 0, CTL_ZERO_BYTES, stream);
    Args a{};
    for (int i = 0; i < 23; ++i) a.in[i] = (const float*)d_in[i];
    a.out = (float*)d_out; a.ws = (unsigned char*)d_ws;
#if MK_ONE_LAUNCH
    a.ph_lo = 0; a.ph_hi = N_PHASES;
    hipLaunchKernelGGL(trunk_fwd, dim3(grid), dim3(NWAVES * 64), LDS_BYTES, stream, a);
#else
    for (int ph = 0; ph < N_PHASES; ++ph) { a.ph_lo = ph; a.ph_hi = ph + 1; hipLaunchKernelGGL(trunk_fwd, dim3(grid), dim3(NWAVES * 64), LDS_BYTES, stream, a); }
#endif
}
```

```cpp
#include <hip/hip_runtime.h>
#include <cstdio>
#include <cstdint>
__device__ __forceinline__ int lane_now() { int l; asm volatile("v_mbcnt_lo_u32_b32 %0, -1, 0\n\tv_mbcnt_hi_u32_b32 %0, -1, %0" : "=v"(l)); return l; }
namespace pg8 {
#define PG8_LAS __attribute__((address_space(3)))
typedef unsigned short bf16_t;
typedef short bf16x8 __attribute__((ext_vector_type(8)));
typedef float f32x4 __attribute__((ext_vector_type(4)));
typedef unsigned u32x4 __attribute__((ext_vector_type(4)));
constexpr int BM = 256, BK = 64, HALF = 128, HTB = HALF * BK * 2  , STAGE_BYTES = 8 * HTB, NXCD = 8, WGM = 8;

__host__ __device__ __forceinline__ int lds_byte(int r, int c) { const int st = (r >> 4) * 2 + (c >> 5), rr = r & 15, cc = c & 31, ob = rr * 64 + cc * 2; return st * 1024 + (ob ^ (((ob >> 9) & 1) << 5)); }
__host__ __device__ __forceinline__ void stage_rc(int b, int& R, int& C) { const int st = b / 1024, sb = b % 1024, swz = sb ^ (((sb >> 9) & 1) << 5); R = (st >> 1) * 16 + swz / 64; C = (st & 1) * 32 + (swz % 64) / 2; }
__host__ __device__ __forceinline__ int perm32(int rho) { const int n = rho >> 4, i = rho & 15; return 8 * (i >> 2) + 4 * n + (i & 3); }

__host__ __device__ __forceinline__ size_t bt_tiled_off(int n, int k, int K) {
    const int pn = n >> 8, hf = (n >> 7) & 1, nr = n & 127, v = nr & 31;
    const int R = (nr & ~31) + 16 * ((v >> 2) & 1) + 4 * (v >> 3) + (v & 3);
    return ((size_t)((pn * 2 + hf) * (K / 64) + (k >> 6))) * 16384 + (size_t)lds_byte(R, k & 63);
}
__host__ __device__ __forceinline__ size_t at_tiled_off(int m, int k, int K) {
    return ((size_t)(((m >> 8) * 2 + ((m >> 7) & 1)) * (K >> 6) + (k >> 6))) * 16384 + (size_t)lds_byte(m & 127, k & 63);
}
struct Unit { int pm, pn, koff; };
struct Gemm { const bf16_t* A; const bf16_t* Bt; int M, N, K; int Kloop = 0; const int* Ainv = nullptr; };

struct StaticOrder {
    int nM, nN, nwg, G, c;
    __host__ __device__ void init(int M, int N, int G_, int c_) { nM = M / BM; nN = N / BM; nwg = nM * nN; G = G_; c = c_; }
    __host__ __device__ bool next(int i, Unit& u) const {
        const long L = (long)i * G + c; if (L >= nwg) return false;
        int wgid = (int)L; { const int q = nwg / NXCD, r = nwg % NXCD, xcd = wgid % NXCD, off = wgid / NXCD; wgid = (xcd < r ? xcd * (q + 1) : r * (q + 1) + (xcd - r) * q) + off; }
        const int nig = WGM * nN, gid = wgid / nig, fm = gid * WGM, gsz = (nM - fm) < WGM ? (nM - fm) : WGM;
        const int w = wgid % nig;
        if (gsz == WGM) { u.pm = fm + (w & (WGM - 1)); u.pn = w / WGM; } else { u.pm = fm + (w % gsz); u.pn = w / gsz; }
        u.koff = 0; return true;
    }
    __device__ __forceinline__ void a_ready(const Unit&) const {}
    __device__ __forceinline__ void done(const Unit&) const {}
};

typedef float f32x2c_t __attribute__((ext_vector_type(2))); typedef __bf16 bf16x2c_t __attribute__((ext_vector_type(2)));
__device__ __forceinline__ unsigned cvt_pk_bf16(float lo, float hi) { f32x2c_t v = {lo, hi}; bf16x2c_t b = __builtin_convertvector(v, bf16x2c_t); return __builtin_bit_cast(unsigned, b); }
__device__ __forceinline__ float fsigmoid(float x) { return __builtin_amdgcn_rcpf(1.0f + __expf(-x)); }
__device__ __forceinline__ float fsilu(float x) { return x * fsigmoid(x); }


struct EpiBf16G {
    static constexpr bool PERM = true, AFTER_DRAIN = false;
    bf16_t* O; int ldc; int gate_pn; float* Gt;
    __device__ __forceinline__ void operator()(const f32x4 (&acc)[2][2][4][2], const Unit& u, int wr, int wc, int fr, int fq) const {
        const int row0 = u.pm * BM + wr * 64 + fr;
        if (u.pn == gate_pn) {
            if (wc == 0 && fq < 2) {
#pragma unroll
                for (int ai = 0; ai < 2; ++ai)
#pragma unroll
                    for (int m = 0; m < 4; ++m) { float* gp = Gt + (size_t)(row0 + ai * HALF + m * 16) * 16 + 8 * fq;
                        *(f32x4*)(gp) = acc[ai][0][m][0]; *(f32x4*)(gp + 4) = acc[ai][0][m][1]; }
            }
            return;
        }
        const int col0 = u.pn * BM + wc * 32 + 8 * fq;
#pragma unroll
        for (int ai = 0; ai < 2; ++ai)
#pragma unroll
            for (int m = 0; m < 4; ++m) { bf16_t* rowp = O + (size_t)(row0 + ai * HALF + m * 16) * ldc + col0;
#pragma unroll
                for (int bj = 0; bj < 2; ++bj) { const f32x4 v0 = acc[ai][bj][m][0], v1 = acc[ai][bj][m][1];
                    u32x4 w; w.x = cvt_pk_bf16(v0[0], v0[1]); w.y = cvt_pk_bf16(v0[2], v0[3]); w.z = cvt_pk_bf16(v1[0], v1[1]); w.w = cvt_pk_bf16(v1[2], v1[3]);
                    *(u32x4*)(rowp + bj * HALF) = w; } }
    }
};

struct EpiQKVHeads {
    static constexpr bool PERM = true, AFTER_DRAIN = false;
    bf16_t* O; int Tlen, nheads;
    __device__ __forceinline__ void operator()(const f32x4 (&acc)[2][2][4][2], const Unit& u, int wr, int wc, int fr, int fq) const {
        const int which = u.pn >> 3, hp = u.pn & 7;
        const int row0 = u.pm * BM + wr * 64 + fr; const int b = (u.pm * BM) / Tlen; const int t0 = row0 - b * Tlen;
#pragma unroll
        for (int bj = 0; bj < 2; ++bj) { bf16_t* hb = O + ((size_t)which * 4 * nheads + (size_t)b * nheads + (2 * hp + bj)) * (size_t)Tlen * 128 + wc * 32 + 8 * fq;
#pragma unroll
            for (int ai = 0; ai < 2; ++ai)
#pragma unroll
                for (int m = 0; m < 4; ++m) { const f32x4 v0 = acc[ai][bj][m][0], v1 = acc[ai][bj][m][1];
                    u32x4 w; w.x = cvt_pk_bf16(v0[0], v0[1]); w.y = cvt_pk_bf16(v0[2], v0[3]); w.z = cvt_pk_bf16(v1[0], v1[1]); w.w = cvt_pk_bf16(v1[2], v1[3]);
                    *(u32x4*)(hb + (size_t)(t0 + ai * HALF + m * 16) * 128) = w; } }
    }
};

struct EpiRecIn {
    static constexpr bool PERM = true, AFTER_DRAIN = false;
    bf16_t* O; int ldc; bf16_t* VM; bf16_t* VH; int Tlen;
    __device__ __forceinline__ void operator()(const f32x4 (&acc)[2][2][4][2], const Unit& u, int wr, int wc, int fr, int fq) const {
        const int row0 = u.pm * BM + wr * 64 + fr;
        const bool isvm = (u.pn >= 4 && u.pn < 8), isvh = (u.pn >= 24 && u.pn < 28);
        if (isvm || isvh) {
            const int b = (u.pm * BM) / Tlen; const int t0 = row0 - b * Tlen;
#pragma unroll
            for (int bj = 0; bj < 2; ++bj) {
                bf16_t* base = isvm ? VM + ((size_t)((b * 4 + (u.pn - 4)) * 8 + 4 * bj + wc)) * (size_t)Tlen * 32 + 8 * fq
                                    : VH + ((size_t)((b * 8 + 2 * (u.pn - 24) + bj) * 4 + wc)) * (size_t)Tlen * 32 + 8 * fq;
#pragma unroll
                for (int ai = 0; ai < 2; ++ai)
#pragma unroll
                    for (int m = 0; m < 4; ++m) { const f32x4 v0 = acc[ai][bj][m][0], v1 = acc[ai][bj][m][1];
                        u32x4 w; w.x = cvt_pk_bf16(v0[0], v0[1]); w.y = cvt_pk_bf16(v0[2], v0[3]); w.z = cvt_pk_bf16(v1[0], v1[1]); w.w = cvt_pk_bf16(v1[2], v1[3]);
                        *(u32x4*)(base + (size_t)(t0 + ai * HALF + m * 16) * 32) = w; } }
            return;
        }
        const int col0 = u.pn * BM + wc * 32 + 8 * fq;
#pragma unroll
        for (int ai = 0; ai < 2; ++ai)
#pragma unroll
            for (int m = 0; m < 4; ++m) { bf16_t* rowp = O + (size_t)(row0 + ai * HALF + m * 16) * ldc + col0;
#pragma unroll
                for (int bj = 0; bj < 2; ++bj) { const f32x4 v0 = acc[ai][bj][m][0], v1 = acc[ai][bj][m][1];
                    u32x4 w; w.x = cvt_pk_bf16(v0[0], v0[1]); w.y = cvt_pk_bf16(v0[2], v0[3]); w.z = cvt_pk_bf16(v1[0], v1[1]); w.w = cvt_pk_bf16(v1[2], v1[3]);
                    *(u32x4*)(rowp + bj * HALF) = w; } }
    }
};
struct EpiSwiglu {
    static constexpr bool PERM = true, AFTER_DRAIN = false;
    bf16_t* H; int ldh; int npn;
    __device__ __forceinline__ void operator()(const f32x4 (&acc)[2][2][4][2], const Unit& u, int wr, int wc, int fr, int fq) const {
        const int row0 = u.pm * BM + wr * 64 + fr; const int pl = u.pn % npn; const int col0 = pl * HALF + wc * 32 + 8 * fq;
#pragma unroll
        for (int ai = 0; ai < 2; ++ai)
#pragma unroll
            for (int m = 0; m < 4; ++m) { bf16_t* rowp = (bf16_t*)((unsigned char*)H + at_tiled_off(row0 + ai * HALF + m * 16, col0, ldh));
                const f32x4 g0 = acc[ai][0][m][0], g1 = acc[ai][0][m][1], u0 = acc[ai][1][m][0], u1 = acc[ai][1][m][1];
                float o[8];
#pragma unroll
                for (int i = 0; i < 4; ++i) { o[i] = fsilu(g0[i]) * u0[i]; o[4 + i] = fsilu(g1[i]) * u1[i]; }
                u32x4 w; w.x = cvt_pk_bf16(o[0], o[1]); w.y = cvt_pk_bf16(o[2], o[3]); w.z = cvt_pk_bf16(o[4], o[5]); w.w = cvt_pk_bf16(o[6], o[7]);
                *(u32x4*)rowp = w; }
    }
};
struct EpiResF32 {
    static constexpr bool PERM = true, AFTER_DRAIN = false;
    const float* SRC; float* DST; int ldc; float alpha;
    __device__ __forceinline__ void operator()(const f32x4 (&acc)[2][2][4][2], const Unit& u, int wr, int wc, int fr, int fq) const {
        const int row0 = u.pm * BM + wr * 64 + fr; const int col0 = u.pn * BM + wc * 32 + 8 * fq;
#pragma unroll
        for (int ai = 0; ai < 2; ++ai)
#pragma unroll
            for (int m = 0; m < 4; ++m) { const size_t ro = (size_t)(row0 + ai * HALF + m * 16) * ldc + col0;
#pragma unroll
                for (int bj = 0; bj < 2; ++bj)
#pragma unroll
                    for (int n = 0; n < 2; ++n) { const size_t o = ro + bj * HALF + 4 * n; const f32x4 s = *(const f32x4*)(SRC + o); *(f32x4*)(DST + o) = s * alpha + acc[ai][bj][m][n]; } }
    }
};
struct EpiStoreF32 {
    static constexpr bool PERM = true, AFTER_DRAIN = false;
    float* O; int ldc; int npn;
    __device__ __forceinline__ void operator()(const f32x4 (&acc)[2][2][4][2], const Unit& u, int wr, int wc, int fr, int fq) const {
        const int row0 = u.pm * BM + wr * 64 + fr; const int col0 = (u.pn % npn) * BM + wc * 32 + 8 * fq;
#pragma unroll
        for (int ai = 0; ai < 2; ++ai)
#pragma unroll
            for (int m = 0; m < 4; ++m) { float* ro = O + (size_t)(row0 + ai * HALF + m * 16) * ldc + col0;
#pragma unroll
                for (int bj = 0; bj < 2; ++bj)
#pragma unroll
                    for (int n = 0; n < 2; ++n) *(f32x4*)(ro + bj * HALF + 4 * n) = acc[ai][bj][m][n]; }
    }
};
struct EpiPle {
    static constexpr bool PERM = true, AFTER_DRAIN = false;
    float* XF; const float* PP; bf16_t* XB; int ldc;
    __device__ __forceinline__ void operator()(const f32x4 (&acc)[2][2][4][2], const Unit& u, int wr, int wc, int fr, int fq) const {
        const int row0 = u.pm * BM + wr * 64 + fr; const int col0 = u.pn * BM + wc * 32 + 8 * fq;
#pragma unroll
        for (int ai = 0; ai < 2; ++ai)
#pragma unroll
            for (int m = 0; m < 4; ++m) { const size_t ro = (size_t)(row0 + ai * HALF + m * 16) * ldc + col0;
#pragma unroll
                for (int bj = 0; bj < 2; ++bj) { f32x4 o[2];
#pragma unroll
                    for (int n = 0; n < 2; ++n) { const size_t of = ro + bj * HALF + 4 * n; const f32x4 x = *(const f32x4*)(XF + of), pp = *(const f32x4*)(PP + of); const f32x4 a = acc[ai][bj][m][n];
                        f32x4 r; r[0] = x[0] + fsigmoid(a[0]) * pp[0]; r[1] = x[1] + fsigmoid(a[1]) * pp[1]; r[2] = x[2] + fsigmoid(a[2]) * pp[2]; r[3] = x[3] + fsigmoid(a[3]) * pp[3];
                        *(f32x4*)(XF + of) = r; o[n] = r; }
                    u32x4 w; w.x = cvt_pk_bf16(o[0][0], o[0][1]); w.y = cvt_pk_bf16(o[0][2], o[0][3]); w.z = cvt_pk_bf16(o[1][0], o[1][1]); w.w = cvt_pk_bf16(o[1][2], o[1][3]);
                    if (XB) *(u32x4*)(XB + ro + bj * HALF) = w; } }
    }
};

__device__ __forceinline__ float bf_lo(unsigned w) { return __builtin_bit_cast(float, w << 16); }
__device__ __forceinline__ float bf_hi(unsigned w) { return __builtin_bit_cast(float, w & 0xffff0000u); }
typedef unsigned u32x2 __attribute__((ext_vector_type(2)));
struct EpiResB {
    static constexpr bool PERM = true, AFTER_DRAIN = false;
    const float* SRCF_unused; const bf16_t* SRCB; bf16_t* DSTB; int ldc; float alpha;
    __device__ __forceinline__ void operator()(const f32x4 (&acc)[2][2][4][2], const Unit& u, int wr, int wc, int fr, int fq) const {
        const int row0 = u.pm * BM + wr * 64 + fr; const int col0 = u.pn * BM + wc * 32 + 8 * fq;
        u32x4 sv[2][4][2];
#pragma unroll
        for (int ai = 0; ai < 2; ++ai)
#pragma unroll
            for (int m = 0; m < 4; ++m)
#pragma unroll
                for (int bj = 0; bj < 2; ++bj) sv[ai][m][bj] = *(const u32x4*)(SRCB + (size_t)(row0 + ai * HALF + m * 16) * ldc + col0 + bj * HALF);
#pragma unroll
        for (int ai = 0; ai < 2; ++ai)
#pragma unroll
            for (int m = 0; m < 4; ++m)
#pragma unroll
                for (int bj = 0; bj < 2; ++bj) { const size_t o = (size_t)(row0 + ai * HALF + m * 16) * ldc + col0 + bj * HALF; const u32x4 w0 = sv[ai][m][bj];
                    const f32x4 s0 = (f32x4){bf_lo(w0.x), bf_hi(w0.x), bf_lo(w0.y), bf_hi(w0.y)}, s1 = (f32x4){bf_lo(w0.z), bf_hi(w0.z), bf_lo(w0.w), bf_hi(w0.w)};
                    const f32x4 v0 = s0 * alpha + acc[ai][bj][m][0], v1 = s1 * alpha + acc[ai][bj][m][1];
                    u32x4 w; w.x = cvt_pk_bf16(v0[0], v0[1]); w.y = cvt_pk_bf16(v0[2], v0[3]); w.z = cvt_pk_bf16(v1[0], v1[1]); w.w = cvt_pk_bf16(v1[2], v1[3]);
                    *(u32x4*)(DSTB + o) = w; }
    }
};
struct EpiResBF {
    static constexpr bool PERM = true, AFTER_DRAIN = false;
    const bf16_t* SRCB; float* DSTF; int ldc; float alpha;
    __device__ __forceinline__ void operator()(const f32x4 (&acc)[2][2][4][2], const Unit& u, int wr, int wc, int fr, int fq) const {
        const int row0 = u.pm * BM + wr * 64 + fr; const int col0 = u.pn * BM + wc * 32 + 8 * fq;
        u32x4 sv[2][4][2];
#pragma unroll
        for (int ai = 0; ai < 2; ++ai)
#pragma unroll
            for (int m = 0; m < 4; ++m)
#pragma unroll
                for (int bj = 0; bj < 2; ++bj) sv[ai][m][bj] = *(const u32x4*)(SRCB + (size_t)(row0 + ai * HALF + m * 16) * ldc + col0 + bj * HALF);
#pragma unroll
        for (int ai = 0; ai < 2; ++ai)
#pragma unroll
            for (int m = 0; m < 4; ++m)
#pragma unroll
                for (int bj = 0; bj < 2; ++bj) { const size_t o = (size_t)(row0 + ai * HALF + m * 16) * ldc + col0 + bj * HALF; const u32x4 w = sv[ai][m][bj];
                    const f32x4 s0 = (f32x4){bf_lo(w.x), bf_hi(w.x), bf_lo(w.y), bf_hi(w.y)}, s1 = (f32x4){bf_lo(w.z), bf_hi(w.z), bf_lo(w.w), bf_hi(w.w)};
                    *(f32x4*)(DSTF + o) = s0 * alpha + acc[ai][bj][m][0]; *(f32x4*)(DSTF + o + 4) = s1 * alpha + acc[ai][bj][m][1]; }
    }
};
struct EpiStoreB {
    static constexpr bool PERM = true, AFTER_DRAIN = false;
    bf16_t* O; int ldc; int npn;
    __device__ __forceinline__ void operator()(const f32x4 (&acc)[2][2][4][2], const Unit& u, int wr, int wc, int fr, int fq) const {
        const int row0 = u.pm * BM + wr * 64 + fr; const int col0 = (u.pn % npn) * BM + wc * 32 + 8 * fq;
#pragma unroll
        for (int ai = 0; ai < 2; ++ai)
#pragma unroll
            for (int m = 0; m < 4; ++m) { bf16_t* rowp = O + (size_t)(row0 + ai * HALF + m * 16) * ldc + col0;
#pragma unroll
                for (int bj = 0; bj < 2; ++bj) { const f32x4 v0 = acc[ai][bj][m][0], v1 = acc[ai][bj][m][1];
                    u32x4 w; w.x = cvt_pk_bf16(v0[0], v0[1]); w.y = cvt_pk_bf16(v0[2], v0[3]); w.z = cvt_pk_bf16(v1[0], v1[1]); w.w = cvt_pk_bf16(v1[2], v1[3]);
                    *(u32x4*)(rowp + bj * HALF) = w; } }
    }
};
struct EpiPleB {
    static constexpr bool PERM = true, AFTER_DRAIN = false;
    const bf16_t* XIN; const bf16_t* PP; bf16_t* XOUT; float* OUTF; int ldc;
    __device__ __forceinline__ void operator()(const f32x4 (&acc)[2][2][4][2], const Unit& u, int wr, int wc, int fr, int fq) const {
        const int row0 = u.pm * BM + wr * 64 + fr; const int col0 = u.pn * BM + wc * 32 + 8 * fq;
#pragma unroll
        for (int ai = 0; ai < 2; ++ai) {
            u32x4 xv[4][2], pv[4][2];
#pragma unroll
            for (int m = 0; m < 4; ++m)
#pragma unroll
                for (int bj = 0; bj < 2; ++bj) { const size_t o = (size_t)(row0 + ai * HALF + m * 16) * ldc + col0 + bj * HALF; xv[m][bj] = *(const u32x4*)(XIN + o); pv[m][bj] = *(const u32x4*)(PP + o); }
#pragma unroll
            for (int m = 0; m < 4; ++m)
#pragma unroll
                for (int bj = 0; bj < 2; ++bj) { const size_t o = (size_t)(row0 + ai * HALF + m * 16) * ldc + col0 + bj * HALF; const u32x4 xw = xv[m][bj], pw = pv[m][bj];
                    const float xs[8] = {bf_lo(xw.x), bf_hi(xw.x), bf_lo(xw.y), bf_hi(xw.y), bf_lo(xw.z), bf_hi(xw.z), bf_lo(xw.w), bf_hi(xw.w)};
                    const float ps[8] = {bf_lo(pw.x), bf_hi(pw.x), bf_lo(pw.y), bf_hi(pw.y), bf_lo(pw.z), bf_hi(pw.z), bf_lo(pw.w), bf_hi(pw.w)};
                    float r[8];
#pragma unroll
                    for (int i = 0; i < 4; ++i) { r[i] = xs[i] + fsigmoid(acc[ai][bj][m][0][i]) * ps[i]; r[4 + i] = xs[4 + i] + fsigmoid(acc[ai][bj][m][1][i]) * ps[4 + i]; }
                    if (XOUT) { u32x4 w; w.x = cvt_pk_bf16(r[0], r[1]); w.y = cvt_pk_bf16(r[2], r[3]); w.z = cvt_pk_bf16(r[4], r[5]); w.w = cvt_pk_bf16(r[6], r[7]); *(u32x4*)(XOUT + o) = w; }
                    if (OUTF) { *(f32x4*)(OUTF + o) = (f32x4){r[0], r[1], r[2], r[3]}; *(f32x4*)(OUTF + o + 4) = (f32x4){r[4], r[5], r[6], r[7]}; } }
        }
    }
};

constexpr int TAIL_PM0 = 128, TAIL_KS = 8, TAIL_ROWS = 8 * 256;
struct MoeTailOrder {
    const int* tile_e; int ntail, G, c, nN, ktiles;
    __device__ __forceinline__ bool next(int i, Unit& u) const {
        const int L = i * G + c; if (L >= ntail * nN * TAIL_KS) return false;
        const int ks = L & (TAIL_KS - 1), pn = (L >> 3) % nN, pm = TAIL_PM0 + (L >> 3) / nN;
        u.pm = pm; u.pn = tile_e[pm] * nN + pn; u.koff = ks * ktiles * 16384; return true; }
    __device__ __forceinline__ void a_ready(const Unit&) const {}
    __device__ __forceinline__ void done(const Unit&) const {}
};
struct EpiStorePart {
    static constexpr bool PERM = true, AFTER_DRAIN = false;
    bf16_t* O; int ldc; int npn; int ktiles;
    __device__ __forceinline__ void operator()(const f32x4 (&acc)[2][2][4][2], const Unit& u, int wr, int wc, int fr, int fq) const {
        const int ks = u.koff / (ktiles * 16384);
        const int row0 = (u.pm - TAIL_PM0) * BM + wr * 64 + fr; const int col0 = (u.pn % npn) * BM + wc * 32 + 8 * fq;
        bf16_t* base = O + (size_t)ks * TAIL_ROWS * ldc;
#pragma unroll
        for (int ai = 0; ai < 2; ++ai)
#pragma unroll
            for (int m = 0; m < 4; ++m) { bf16_t* ro = base + (size_t)(row0 + ai * HALF + m * 16) * ldc + col0;
#pragma unroll
                for (int bj = 0; bj < 2; ++bj) { const f32x4 v0 = acc[ai][bj][m][0], v1 = acc[ai][bj][m][1];
                    u32x4 w; w.x = cvt_pk_bf16(v0[0], v0[1]); w.y = cvt_pk_bf16(v0[2], v0[3]); w.z = cvt_pk_bf16(v1[0], v1[1]); w.w = cvt_pk_bf16(v1[2], v1[3]);
                    *(u32x4*)(ro + bj * HALF) = w; } }
    }
};
struct MoeOrder {
    StaticOrder base; const int* tile_e; int nN;
    __device__ __forceinline__ bool next(int i, Unit& u) const { if (!base.next(i, u)) return false; u.pn += tile_e[u.pm] * nN; return true; }
    __device__ __forceinline__ void a_ready(const Unit&) const {}
    __device__ __forceinline__ void done(const Unit&) const {}
};

template <class Epi, class Sched, bool ALIGN_EPI = false, bool SP2 = false, bool ATILED = false, bool AGATHER = false>
__device__ __forceinline__ void gemm_phase(PG8_LAS unsigned char* lds, const Gemm g, const Sched& S, const Epi& E, int wave_s) {
    const int lane = lane_now(), wid = wave_s, tid = wave_s * 64 + lane, wr = wid >> 2, wc = wid & 3, fr = lane & 15, fq = lane >> 4;
    const int K = g.K, nt = (g.Kloop ? g.Kloop : K) / BK;
    unsigned voffA[2], voffB[2];
    unsigned gP[2] = {0u, 0u}, gN[2] = {0u, 0u}, ridx2 = 0u, cC2 = 0u;
#pragma unroll
    for (int i = 0; i < 2; ++i) { int R, C; stage_rc(tid * 16 + i * 8192, R, C); const int Rb = Epi::PERM ? ((R & ~31) + perm32(R & 31)) : R;
        voffA[i] = ATILED ? (unsigned)(tid * 16 + i * 8192) : (unsigned)(R * K + C) * 2u;     voffB[i] = (unsigned)(tid * 16 + i * 8192); (void)Rb; if (i == 0) { ridx2 = (unsigned)R * 4u; cC2 = (unsigned)C * 2u; } }
    const size_t kstep = (size_t)(BK * 2);
    const size_t kstepB = (size_t)(HALF * BK * 2);
    const size_t kstepA = ATILED ? kstepB : kstep;
    const size_t hstep = (size_t)HALF * K * 2;
    const size_t tstep = 2 * hstep;
    const unsigned ldsw = (unsigned)wid * 1024u;
    const int aoff = lds_byte(wr * 64 + fr, fq * 8), boff = lds_byte(wc * 32 + fr, fq * 8);
#define PG8_SA(b, h) (((b) * 2 + (h)) * HTB)
#define PG8_SB(b, h) ((4 + (b) * 2 + (h)) * HTB)
#define PG8_STAGE(bufoff, gbase, voff) do { _Pragma("unroll") for (int _i = 0; _i < 2; ++_i) \
        __builtin_amdgcn_global_load_lds((const unsigned*)((const char*)(gbase) + (voff)[_i]), (PG8_LAS unsigned*)(lds + (bufoff) + ldsw + _i * 8192), 16, 0, 0); } while (0)
#define PG8_LDA(dst, b, h) do { _Pragma("unroll") for (int m = 0; m < 4; ++m) _Pragma("unroll") for (int k = 0; k < 2; ++k) dst[m][k] = *(const PG8_LAS bf16x8*)(lds + PG8_SA(b, h) + aoff + m * 2048 + k * 1024); } while (0)
#define PG8_LDB(dst, b, h) do { _Pragma("unroll") for (int n = 0; n < 2; ++n) _Pragma("unroll") for (int k = 0; k < 2; ++k) dst[n][k] = *(const PG8_LAS bf16x8*)(lds + PG8_SB(b, h) + boff + n * 2048 + k * 1024); } while (0)
#define PG8_GIDX(dst, pm_) do { const int* _ip = g.Ainv + (size_t)(pm_) * 128;        \
        asm volatile("global_load_dword %0, %1, %2" : "+v"(dst[0]) : "v"(ridx2), "s"(_ip) : "memory"); asm volatile("global_load_dword %0, %1, %2 offset:256" : "+v"(dst[1]) : "v"(ridx2), "s"(_ip) : "memory"); } while (0)
#define PG8_STA(bufoff, kptr, h_, nx_) do { if constexpr (AGATHER) { const unsigned _s = ((nx_) && last) ? gN[h_] : gP[h_]; unsigned _g[2] = { (_s & 0xffffu) * (unsigned)(K * 2) + cC2, (_s >> 16) * (unsigned)(K * 2) + cC2 }; PG8_STAGE(bufoff, kptr, _g); } \
        else PG8_STAGE(bufoff, (kptr) + (h_) * hstep, voffA); } while (0)
#define PG8_MMA(ai, bj, At, Bt) do { __builtin_amdgcn_s_setprio(1); _Pragma("unroll") for (int m = 0; m < 4; ++m) _Pragma("unroll") for (int n = 0; n < 2; ++n) _Pragma("unroll") for (int k = 0; k < 2; ++k) \
        acc[ai][bj][m][n] = __builtin_amdgcn_mfma_f32_16x16x32_bf16(Bt[n][k], At[m][k], acc[ai][bj][m][n], 0, 0, 0); __builtin_amdgcn_s_setprio(0); } while (0)
#define PG8_WAIT_V(n) asm volatile("s_waitcnt vmcnt(" #n ")" ::: "memory")
#define PG8_WAIT_L(n) asm volatile("s_waitcnt lgkmcnt(" #n ")" ::: "memory")
#define PG8_BAR __builtin_amdgcn_s_barrier()
#define PG8_SCHED __builtin_amdgcn_sched_barrier(0)
    Unit cur, nxt; int ui = 0;
    if (!S.next(0, cur)) return;
    f32x4 acc[2][2][4][2];
#pragma unroll
    for (int a = 0; a < 2; ++a)
#pragma unroll
        for (int b = 0; b < 2; ++b)
#pragma unroll
            for (int m = 0; m < 4; ++m)
#pragma unroll
                for (int n = 0; n < 2; ++n) acc[a][b][m][n] = (f32x4){0.f, 0.f, 0.f, 0.f};
    bf16x8 At[4][2], B0[2][2], B1[2][2];
    const char* cA = AGATHER ? (const char*)g.A : (const char*)g.A + (size_t)cur.pm * tstep + cur.koff; const char* cB = (const char*)g.Bt + (size_t)cur.pn * tstep + cur.koff;
    if constexpr (AGATHER) { static_assert(!AGATHER || (SP2 && !ATILED), "AGATHER: SP2, row-major A"); PG8_GIDX(gP, cur.pm); asm volatile("s_waitcnt vmcnt(0)" ::: "memory"); asm volatile("" : "+v"(gP[0]), "+v"(gP[1])); }
    S.a_ready(cur);
    if constexpr (SP2) {
        const bool last = false; (void)last;
        PG8_STAGE(PG8_SB(0, 0), cB, voffB); PG8_STAGE(PG8_SB(0, 1), cB + hstep, voffB); PG8_STA(PG8_SA(0, 0), cA, 0, false); PG8_STA(PG8_SA(0, 1), cA, 1, false);
        if (wr == 1) PG8_BAR;
        PG8_WAIT_V(2); PG8_BAR;
        PG8_STAGE(PG8_SB(1, 0), cB + kstepB, voffB); PG8_STA(PG8_SA(1, 0), cA + kstepA, 0, false); PG8_STAGE(PG8_SB(1, 1), cB + hstep + kstepB, voffB);
        PG8_WAIT_V(6); PG8_BAR;
    } else {
        PG8_STAGE(PG8_SB(0, 0), cB, voffB); PG8_STAGE(PG8_SA(0, 0), cA, voffA); PG8_STAGE(PG8_SB(0, 1), cB + hstep, voffB); PG8_STAGE(PG8_SA(0, 1), cA + hstep, voffA);
        if (wr == 1) PG8_BAR;
        PG8_WAIT_V(4); PG8_BAR;
        PG8_STAGE(PG8_SB(1, 0), cB + kstepB, voffB); PG8_STAGE(PG8_SA(1, 0), cA + kstepA, voffA); PG8_STAGE(PG8_SB(1, 1), cB + hstep + kstepB, voffB);
        PG8_WAIT_V(6); PG8_BAR;
    }
    for (;;) {
        const bool has_next = S.next(ui + 1, nxt);
        const char* nA = AGATHER ? cA : has_next ? (const char*)g.A + (size_t)nxt.pm * tstep + nxt.koff : cA; const char* nB = has_next ? (const char*)g.Bt + (size_t)nxt.pn * tstep + nxt.koff : cB;
        if constexpr (AGATHER) { if (!has_next) { gN[0] = gP[0]; gN[1] = gP[1]; } }
        for (int t = 0; t < nt; t += 2) {
            const bool last = (t == nt - 2);
            const bool gfetch = AGATHER && has_next && t == 2;
            if constexpr (AGATHER) { if (gfetch) PG8_GIDX(gN, nxt.pm); }
            const char* a1 = cA + (size_t)(t + 1) * kstepA;
            const char* a2 = last ? nA : cA + (size_t)(t + 2) * kstepA; const char* b2 = last ? nB : cB + (size_t)(t + 2) * kstepB;
            const char* a3 = a2 + kstepA; const char* b3 = b2 + kstepB;
            if (last && has_next) S.a_ready(nxt);
            if constexpr (SP2) {
            PG8_LDB(B0, 0, 0); PG8_LDB(B1, 0, 1); PG8_SCHED; PG8_LDA(At, 0, 0); PG8_STA(PG8_SA(1, 1), a1, 1, false);
            if (gfetch) PG8_WAIT_V(10); else PG8_WAIT_V(8);
            PG8_WAIT_L(0); PG8_BAR; PG8_MMA(0, 0, At, B0); PG8_MMA(0, 1, At, B1); PG8_BAR; PG8_SCHED;
            PG8_LDA(At, 0, 1); PG8_STAGE(PG8_SB(0, 0), b2, voffB); PG8_STAGE(PG8_SB(0, 1), b2 + hstep, voffB); PG8_STA(PG8_SA(0, 0), a2, 0, true);
            PG8_WAIT_V(8); PG8_WAIT_L(0); PG8_BAR; PG8_MMA(1, 0, At, B0); PG8_MMA(1, 1, At, B1); PG8_BAR; PG8_SCHED;
            PG8_LDB(B0, 1, 0); PG8_LDB(B1, 1, 1); PG8_SCHED; PG8_LDA(At, 1, 0); PG8_STA(PG8_SA(0, 1), a2, 1, true);
            PG8_WAIT_V(8); PG8_WAIT_L(0); PG8_BAR; PG8_MMA(0, 0, At, B0); PG8_MMA(0, 1, At, B1); PG8_BAR; PG8_SCHED;
            PG8_LDA(At, 1, 1); PG8_STAGE(PG8_SB(1, 0), b3, voffB); PG8_STAGE(PG8_SB(1, 1), b3 + hstep, voffB); PG8_STA(PG8_SA(1, 0), a3, 0, true);
            PG8_WAIT_V(8); PG8_WAIT_L(0); PG8_BAR; PG8_MMA(1, 0, At, B0); PG8_MMA(1, 1, At, B1); PG8_BAR; PG8_SCHED;
            } else {
            PG8_LDB(B0, 0, 0); PG8_SCHED; PG8_LDA(At, 0, 0); PG8_STAGE(PG8_SA(1, 1), a1 + hstep, voffA);
            PG8_WAIT_L(8); PG8_BAR; PG8_WAIT_L(0); PG8_MMA(0, 0, At, B0); PG8_BAR; PG8_SCHED;
            PG8_LDB(B1, 0, 1); PG8_STAGE(PG8_SB(0, 0), b2, voffB);
            PG8_BAR; PG8_WAIT_L(0); PG8_MMA(0, 1, At, B1); PG8_BAR;
            PG8_LDA(At, 0, 1); PG8_STAGE(PG8_SA(0, 0), a2, voffA);
            PG8_BAR; PG8_WAIT_L(0); PG8_MMA(1, 0, At, B0); PG8_BAR; PG8_SCHED;
            PG8_STAGE(PG8_SB(0, 1), b2 + hstep, voffB);
            PG8_WAIT_V(6); PG8_BAR; PG8_MMA(1, 1, At, B1); PG8_BAR;
            PG8_LDB(B0, 1, 0); PG8_SCHED; PG8_LDA(At, 1, 0); PG8_STAGE(PG8_SA(0, 1), a2 + hstep, voffA);
            PG8_WAIT_L(8); PG8_BAR; PG8_WAIT_L(0); PG8_MMA(0, 0, At, B0); PG8_BAR; PG8_SCHED;
            PG8_LDB(B1, 1, 1); PG8_STAGE(PG8_SB(1, 0), b3, voffB);
            PG8_BAR; PG8_WAIT_L(0); PG8_MMA(0, 1, At, B1); PG8_BAR;
            PG8_LDA(At, 1, 1); PG8_STAGE(PG8_SA(1, 0), a3, voffA);
            PG8_BAR; PG8_WAIT_L(0); PG8_MMA(1, 0, At, B0); PG8_BAR; PG8_SCHED;
            PG8_STAGE(PG8_SB(1, 1), b3 + hstep, voffB);
            PG8_WAIT_V(6); PG8_BAR; PG8_MMA(1, 1, At, B1); PG8_BAR;
            }
        }
        if constexpr (ALIGN_EPI) { if (wr == 0) PG8_BAR; }
        if constexpr (!Epi::AFTER_DRAIN) { E(acc, cur, wr, wc, fr, fq); S.done(cur); }
        if (!has_next) break;
#pragma unroll
        for (int a = 0; a < 2; ++a)
#pragma unroll
            for (int b = 0; b < 2; ++b)
#pragma unroll
                for (int m = 0; m < 4; ++m)
#pragma unroll
                    for (int n = 0; n < 2; ++n) acc[a][b][m][n] = (f32x4){0.f, 0.f, 0.f, 0.f};
        cur = nxt; cA = nA; cB = nB; ++ui;
        if constexpr (AGATHER) { gP[0] = gN[0]; gP[1] = gN[1]; }
        if constexpr (ALIGN_EPI) { if (wr == 1) PG8_BAR; }
    }
    PG8_WAIT_V(0);
    if constexpr (!ALIGN_EPI) { if (wr == 0) PG8_BAR; }
    PG8_BAR;
    if constexpr (Epi::AFTER_DRAIN) { E.fused(acc, cur, wr, wc, fr, fq, lds, wid, lane); S.done(cur); }
#undef PG8_SA
#undef PG8_SB
#undef PG8_STAGE
#undef PG8_LDA
#undef PG8_LDB
#undef PG8_GIDX
#undef PG8_STA
#undef PG8_MMA
#undef PG8_WAIT_V
#undef PG8_WAIT_L
#undef PG8_BAR
#undef PG8_SCHED
}
}
constexpr int NWAVES = 8;
constexpr int BATCH = 4, T = 4096, D = 2048, M = BATCH * T;
constexpr int PLE_DIM = 256, FFN = 5632, MOE = 7168, NE = 8;
constexpr int REC_IN = 8208, UW = 8192, NREC = 8448;
constexpr int U_QA = 0, U_KA = 512, U_VA = 1024, U_OA = 2048, U_QB = 3072, U_FF = 4096, U_FB = 5120, U_IB = 6144, U_GB = 7168;
constexpr int NQKV = 6144;
constexpr int XS_ROWS = 34816;
constexpr float LN_EPS = 1e-5f, RMS_EPS = 1e-6f, ALPHA = 1.41421356237f, GATE_CAP = 15.0f;

constexpr size_t MiB = 1u << 20;
constexpr size_t WS_CTL = 0, CTL_ZERO_BYTES = 1 * MiB;
constexpr size_t WS_INV = 2 * MiB;
constexpr size_t WS_TOKE = 1 * MiB, WS_TOKG = WS_TOKE + 256 * 1024, WS_DEST = WS_TOKG + 256 * 1024, WS_WGCNT = WS_DEST + 256 * 1024, WS_TILEE = WS_WGCNT + 64 * 1024;
constexpr size_t WS_WQKV = 4 * MiB, WS_WNAO = 28 * MiB, WS_WPG1 = 36 * MiB, WS_WPP1 = 44 * MiB, WS_WMGU = 48 * MiB, WS_WMDN = 496 * MiB;
constexpr size_t WS_XB0 = 720 * MiB, WS_XB1 = 784 * MiB, WS_PB = 848 * MiB, WS_G = 864 * MiB, WS_WGATE = 866 * MiB;
constexpr size_t WS_WRIN = 872 * MiB, WS_WROUT = 905 * MiB, WS_WFGU = 913 * MiB, WS_WFDN = 957 * MiB, WS_WPG0 = 979 * MiB, WS_WPP0 = 987 * MiB;
constexpr size_t WS_U = 992 * MiB, WS_HA = 1248 * MiB, WS_HB = 1376 * MiB, WS_Y = 1504 * MiB;
constexpr size_t WS_H = 992 * MiB;
constexpr size_t WS_PP = 1248 * MiB;
constexpr size_t WS_QKV = 992 * MiB;
constexpr size_t WS_AO = WS_Y;
constexpr size_t WS_HM = 872 * MiB;
constexpr size_t WS_YS = 1348 * MiB;
constexpr size_t WS_XS = 1348 * MiB;
constexpr size_t WS_PP1 = 1620 * MiB;
constexpr size_t WS_QIN = 1568 * MiB, WS_KIN = 1632 * MiB, WS_GTAB = 1696 * MiB, WS_GTABM = 1698 * MiB, WS_QINM = 1700 * MiB, WS_KINM = 1732 * MiB, WS_EQM = 1700 * MiB, WS_EKM = 1701 * MiB;
constexpr size_t WS_VINM = 1504 * MiB, WS_VINH = 1536 * MiB;
constexpr size_t WS_PART = 1484 * MiB;
constexpr size_t WS_END = 1764 * MiB;
static_assert(WS_WMGU + (size_t)NE * 2 * MOE * D * 2 <= WS_WMDN && WS_WMDN + (size_t)NE * D * MOE * 2 <= WS_XB0, "ws map 1");
static_assert(WS_WRIN + (size_t)NREC * D * 2 <= WS_WROUT && WS_WFGU + (size_t)2 * FFN * D * 2 <= WS_WFDN && WS_WFDN + (size_t)D * FFN * 2 <= WS_WPG0 && WS_WPP0 + (size_t)D * PLE_DIM * 2 <= WS_U, "ws map 2");
static_assert(WS_U + (size_t)M * UW * 2 <= WS_HA && WS_H + (size_t)M * FFN * 2 <= WS_HA && WS_QKV + (size_t)M * NQKV * 2 <= WS_HA, "ws map 3");
static_assert(WS_HM + (size_t)XS_ROWS * MOE * 2 <= WS_YS && WS_YS + (size_t)XS_ROWS * D * 4 <= WS_END && WS_XS + (size_t)XS_ROWS * D * 2 <= WS_Y, "ws map 4");
constexpr int CW_BAR = 4096;

constexpr int RING_OFF = 0, RING_BYTES = 131072;
constexpr int LDSCTL_OFF = RING_BYTES, MISC_OFF = LDSCTL_OFF + 320;
constexpr int LDS_BYTES = 147456;
static_assert(MISC_OFF + 128 <= LDS_BYTES, "LDS map");

#define GAS __attribute__((address_space(1)))
#define LAS __attribute__((address_space(3)))
typedef unsigned short bf16;
typedef unsigned v4u __attribute__((ext_vector_type(4)));
typedef unsigned v2u __attribute__((ext_vector_type(2)));
typedef float f32x4 __attribute__((ext_vector_type(4)));
typedef float f32x2 __attribute__((ext_vector_type(2)));
typedef GAS unsigned gu32;
#define RLX_AGENT __ATOMIC_RELAXED, __HIP_MEMORY_SCOPE_AGENT
#define LDS_WAIT() asm volatile("s_waitcnt lgkmcnt(0)" ::: "memory")
#define VM_WAIT() asm volatile("s_waitcnt vmcnt(0)" ::: "memory")
__device__ __forceinline__ unsigned f2bf(float f) { unsigned u = __builtin_bit_cast(unsigned, f); return (u + 0x7fffu + ((u >> 16) & 1u)) >> 16; }
typedef float f32x2_t __attribute__((ext_vector_type(2))); typedef __bf16 bf16x2_t __attribute__((ext_vector_type(2)));
__device__ __forceinline__ unsigned cvtpk(float lo, float hi) { f32x2_t v = {lo, hi}; bf16x2_t b = __builtin_convertvector(v, bf16x2_t); return __builtin_bit_cast(unsigned, b); }
__device__ __forceinline__ unsigned pk2(float lo, float hi) { return cvtpk(lo, hi); }
__device__ __forceinline__ float bflo(unsigned w) { return __builtin_bit_cast(float, w << 16); }
__device__ __forceinline__ float bfhi(unsigned w) { return __builtin_bit_cast(float, w & 0xffff0000u); }
__device__ __forceinline__ float bf1(bf16 h) { return __builtin_bit_cast(float, (unsigned)h << 16); }
typedef short bf16x8 __attribute__((ext_vector_type(8)));
typedef short s16x4 __attribute__((ext_vector_type(4)));
__device__ __forceinline__ s16x4 lds_tr(LAS unsigned char* p) { return __builtin_bit_cast(s16x4, __builtin_amdgcn_ds_read_tr16_b64_v4i16((LAS s16x4*)p)); }
__device__ __forceinline__ float sigm(float x) { return __builtin_amdgcn_rcpf(1.0f + __expf(-x)); }
#define AT(base, m, k, K) ((bf16*)((unsigned char*)(base) + pg8::at_tiled_off((int)(m), (int)(k), (K))))
#define XB_TMO      128
#define XB_XCNT(j)  (256  + 64 * (j))
#define XB_XSUB(j)  (1280 + 64 * (j))
#define XB_XGEN(j)  (2304 + 64 * (j))
#define XB_TOP      3328
#define XB_TOPGEN   3392
#define XCD_BAR_WORDS 3456
#define XB_SPIN_CAP (1u << 18)

__device__ __forceinline__ unsigned xb_ld(unsigned* p)              { return __hip_atomic_load(p, __ATOMIC_RELAXED, __HIP_MEMORY_SCOPE_AGENT); }
__device__ __forceinline__ unsigned xb_add(unsigned* p, unsigned v) { return __hip_atomic_fetch_add(p, v, __ATOMIC_RELAXED, __HIP_MEMORY_SCOPE_AGENT); }
__device__ __forceinline__ unsigned xb_xcc_id() { return (unsigned)__builtin_amdgcn_s_getreg((3 << 11) | 20) & 0xFu; }
#define XB_SPIN(cond, bar) do { unsigned _sp = 0; while (cond) { __builtin_amdgcn_s_sleep(1); \
    if ((++_sp & 255u) == 0u) { if (xb_ld(&(bar)[XB_TMO])) break; if (_sp > XB_SPIN_CAP) { atomicAdd(&(bar)[XB_TMO], 1u); break; } } } } while (0)

struct XcdBarrier {
    unsigned* bar; unsigned x;
    volatile LAS unsigned* st;
};

__device__ __forceinline__ XcdBarrier xcd_barrier_post(unsigned* bar, volatile LAS unsigned* st, int wave_s) {
    XcdBarrier b; b.bar = bar; b.x = xb_xcc_id(); b.st = st;
    if (wave_s == 0 && lane_now() == 0) (void)xb_add(&bar[XB_XCNT(b.x)], 1u);
    return b;
}
__device__ __forceinline__ void xcd_barrier_complete(unsigned* bar, unsigned x, unsigned& nloc, unsigned& nx) {
    const unsigned G = gridDim.x * gridDim.y * gridDim.z;
    unsigned sum, cnt, mine, sp = 0u;
    for (;;) {
        sum = 0u; cnt = 0u; mine = 0u;
#pragma unroll
        for (unsigned j = 0; j < 16; ++j) { const unsigned c = xb_ld(&bar[XB_XCNT(j)]); sum += c; cnt += (c > 0u) ? 1u : 0u; mine = (j == x) ? c : mine; }
        if (sum == G) break;
        __builtin_amdgcn_s_sleep(1);
        if ((++sp & 255u) == 0u) { if (xb_ld(&bar[XB_TMO])) break; if (sp > XB_SPIN_CAP) { atomicAdd(&bar[XB_TMO], 1u); break; } }
    }
    nloc = mine > 0u ? mine : 1u; nx = cnt > 0u ? cnt : 1u;
}

__device__ __forceinline__ void xcd_barrier(const XcdBarrier& b, int wave_s) {
    asm volatile("s_waitcnt vmcnt(0)" ::: "memory");
    __syncthreads();
    if (wave_s == 0 && lane_now() == 0) {
        unsigned* bar = b.bar;
        __builtin_amdgcn_s_waitcnt(0);
        unsigned nloc = b.st[0], nx = b.st[1];
        if (nloc == 0u) { xcd_barrier_complete(bar, b.x, nloc, nx); b.st[0] = nloc; b.st[1] = nx; }
        const unsigned old = xb_add(&bar[XB_XSUB(b.x)], 1u);
        const unsigned gen = old / nloc;
        if (old + 1u == (gen + 1u) * nloc) {
            __builtin_amdgcn_fence(__ATOMIC_RELEASE, "agent");
            asm volatile("s_waitcnt vmcnt(0)" ::: "memory");
            const unsigned og = xb_add(&bar[XB_TOP], 1u);
            const unsigned tg = og / nx;
            if (og + 1u == (tg + 1u) * nx) xb_add(&bar[XB_TOPGEN], 1u);
            else XB_SPIN(xb_ld(&bar[XB_TOPGEN]) == tg, bar);
            __builtin_amdgcn_fence(__ATOMIC_ACQUIRE, "agent");
            xb_add(&bar[XB_XGEN(b.x)], 1u);
            asm volatile("s_waitcnt vmcnt(0)" ::: "memory");
        } else {
            XB_SPIN(xb_ld(&bar[XB_XGEN(b.x)]) == gen, bar);
            __builtin_amdgcn_fence(__ATOMIC_ACQUIRE, "agent");
            asm volatile("s_waitcnt vmcnt(0)" ::: "memory");
        }
    }
    __syncthreads();
}

struct Frame {
    LAS unsigned char* lds;
    int wave, G;
};
struct Args { const float* in[23]; float* out; unsigned char* ws; int ph_lo, ph_hi; };
enum { I_X = 0, I_P, I_LNW, I_LNB, I_RECWIN, I_GBIAS, I_MNORM, I_LBLOG, I_HNORM, I_RECWOUT, I_FWG, I_FWU, I_FWD, I_NAQKV, I_RPB, I_NAOUT, I_WR, I_BR, I_MWG, I_MWU, I_MWD, I_PLEG, I_PLEP };

#define DPP_ADD(v, ctrl) ((v) + __builtin_bit_cast(float, __builtin_amdgcn_update_dpp(0, __builtin_bit_cast(int, (v)), (ctrl), 0xF, 0xF, true)))
__device__ __forceinline__ float row_sum16(float v) {
    v = DPP_ADD(v, 0xB1);
    v = DPP_ADD(v, 0x4E);
    v = DPP_ADD(v, 0x141);
    v = DPP_ADD(v, 0x140);
    return v;
}
__device__ __forceinline__ float wave_sum(float v) {
    v = row_sum16(v);
    const float r0 = __builtin_bit_cast(float, __builtin_amdgcn_readlane(__builtin_bit_cast(int, v), 0)), r1 = __builtin_bit_cast(float, __builtin_amdgcn_readlane(__builtin_bit_cast(int, v), 16));
    const float r2 = __builtin_bit_cast(float, __builtin_amdgcn_readlane(__builtin_bit_cast(int, v), 32)), r3 = __builtin_bit_cast(float, __builtin_amdgcn_readlane(__builtin_bit_cast(int, v), 48));
    return (r0 + r1) + (r2 + r3);
}
__device__ __forceinline__ float half_sum32(float v, int lane) {
    v = row_sum16(v);
    const float r0 = __builtin_bit_cast(float, __builtin_amdgcn_readlane(__builtin_bit_cast(int, v), 0)), r1 = __builtin_bit_cast(float, __builtin_amdgcn_readlane(__builtin_bit_cast(int, v), 16));
    const float r2 = __builtin_bit_cast(float, __builtin_amdgcn_readlane(__builtin_bit_cast(int, v), 32)), r3 = __builtin_bit_cast(float, __builtin_amdgcn_readlane(__builtin_bit_cast(int, v), 48));
    return (lane < 32) ? (r0 + r1) : (r2 + r3);
}
__device__ __forceinline__ float wave_max(float v) {
#pragma unroll
    for (int o = 1; o < 64; o <<= 1) v = fmaxf(v, __shfl_xor(v, o));
    return v;
}

__device__ __forceinline__ void tr_item(const float* W, int ldn, int K, int srcc, int nvalid, bf16* WT, size_t drow, int k0, LAS float* scr, int lane, bool tiled) {
    const int c = lane & 31;
    {   float tmp[32]; const float* wp = W + (size_t)(k0 + (lane >> 5)) * ldn + srcc + c; const bool ok = c < nvalid;
#pragma unroll
        for (int i = 0; i < 32; ++i) tmp[i] = ok ? __builtin_nontemporal_load(wp + (size_t)(2 * i) * ldn) : 0.f;
#pragma unroll
        for (int i = 0; i < 32; ++i) scr[(2 * i + (lane >> 5)) * 33 + c] = tmp[i]; }
    LDS_WAIT(); asm volatile("" ::: "memory");
    const int c8 = lane & 7;
#pragma unroll
    for (int j = 0; j < 4; ++j) { const int n = (lane >> 3) + 8 * j; const LAS float* s = scr + (8 * c8) * 33 + n;
        v4u o; o.x = pk2(s[0 * 33], s[1 * 33]); o.y = pk2(s[2 * 33], s[3 * 33]); o.z = pk2(s[4 * 33], s[5 * 33]); o.w = pk2(s[6 * 33], s[7 * 33]);
        if (tiled) *(GAS v4u*)((GAS unsigned char*)WT + pg8::bt_tiled_off((int)drow + n, k0 + 8 * c8, K)) = o; else *(GAS v4u*)(WT + (drow + n) * (size_t)K + k0 + 8 * c8) = o; }
    LDS_WAIT(); asm volatile("" ::: "memory");
}
constexpr int TR2_P = 288;
struct Tr2D { const float* W; unsigned char* WT; int ldn, K, srcc, drow, k0; };
__device__ __forceinline__ void tr2_load(f32x2 (&tmp)[32], const Tr2D& t, int lane) {
    const float* wp = t.W + (size_t)t.k0 * t.ldn + t.srcc + 2 * lane;
#pragma unroll
    for (int i = 0; i < 32; ++i) tmp[i] = __builtin_nontemporal_load((const GAS f32x2*)(wp + (size_t)i * t.ldn));
}
__device__ __forceinline__ void tr2_store(const f32x2 (&tmp)[32], const Tr2D& t, LAS unsigned char* scr, int lane) {
    {   const int n = 2 * lane, v = n & 31, slot = (n & ~31) + 16 * ((v >> 2) & 1) + 4 * (v >> 3) + (v & 3);
#pragma unroll
        for (int i = 0; i < 32; ++i) *(LAS unsigned*)(scr + i * TR2_P + slot * 2) = cvtpk(tmp[i][0], tmp[i][1]); }
    LDS_WAIT(); asm volatile("" ::: "memory");
    const int g = lane >> 4, i16 = lane & 15, q = i16 >> 2, p4 = lane & 3;
    unsigned char* blk = t.WT + ((size_t)(((t.drow >> 8) * 2 + ((t.drow >> 7) & 1)) * (t.K >> 6) + (t.k0 >> 6))) * 16384;
    const int C = (t.k0 & 63) + 8 * g;
#pragma unroll
    for (int s = 0; s < 8; ++s) { LAS unsigned char* tp = scr + (8 * g + q) * TR2_P + (16 * s + 4 * p4) * 2;
        const s16x4 x0 = lds_tr(tp), x1 = lds_tr(tp + 4 * TR2_P);
        v4u o = __builtin_bit_cast(v4u, (bf16x8){x0[0], x0[1], x0[2], x0[3], x1[0], x1[1], x1[2], x1[3]});
        *(GAS v4u*)(blk + pg8::lds_byte(16 * s + i16, C)) = o; }
    LDS_WAIT(); asm volatile("" ::: "memory");
}
constexpr int N2_RIN = 64 * (UW / 128), N2_ROUT = 64 * 16, N2_FGU = 64 * (2 * FFN / 128), N2_FDN = (FFN / 32) * 16, N2_PG = 64 * 16, N2_PP = 8 * 16, N2_QKV = 64 * (NQKV / 128), N2_NAO = 64 * 16;
constexpr int N2_MGU = 64 * (NE * 2 * MOE / 128), N2_MDN = (MOE / 32) * (NE * D / 128);
constexpr int N2_ITEMS = N2_RIN + N2_ROUT + N2_FGU + N2_FDN + 2 * N2_PG + 2 * N2_PP + N2_QKV + N2_NAO + N2_MGU + N2_MDN;
__device__ __forceinline__ Tr2D tr2_decode(const Args& A, int r) {
    unsigned char* ws = A.ws; const float* W; unsigned char* WT; int ldn, K; int srcc, kb, nb;
#define TR_KN() { const int nk2_ = K / 64, g8_ = r >> 3, w8_ = r & 7; kb = (g8_ % nk2_) * 2 + (w8_ & 1); nb = (g8_ / nk2_) * 4 + (w8_ >> 1); }
    if (r < N2_RIN) { W = A.in[I_RECWIN]; WT = ws + WS_WRIN; ldn = REC_IN; K = D; TR_KN(); srcc = (nb < 24) ? nb * 128 : nb * 128 + 16; }
    else if ((r -= N2_RIN) < N2_ROUT) { W = A.in[I_RECWOUT]; WT = ws + WS_WROUT; ldn = D; K = D; TR_KN(); srcc = nb * 128; }
    else if ((r -= N2_ROUT) < N2_FGU) { WT = ws + WS_WFGU; ldn = FFN; K = D; TR_KN(); W = (nb & 1) ? A.in[I_FWU] : A.in[I_FWG]; srcc = (nb >> 1) * 128; }
    else if ((r -= N2_FGU) < N2_FDN) { W = A.in[I_FWD]; WT = ws + WS_WFDN; ldn = D; K = FFN; TR_KN(); srcc = nb * 128; }
    else if ((r -= N2_FDN) < 2 * N2_PG) { const int l = r / N2_PG; r -= l * N2_PG; W = A.in[I_PLEG] + (size_t)l * D * D; WT = ws + (l ? WS_WPG1 : WS_WPG0); ldn = D; K = D; TR_KN(); srcc = nb * 128; }
    else if ((r -= 2 * N2_PG) < 2 * N2_PP) { const int l = r / N2_PP; r -= l * N2_PP; W = A.in[I_PLEP] + (size_t)l * PLE_DIM * D; WT = ws + (l ? WS_WPP1 : WS_WPP0); ldn = D; K = PLE_DIM; TR_KN(); srcc = nb * 128; }
    else if ((r -= 2 * N2_PP) < N2_QKV) { W = A.in[I_NAQKV]; WT = ws + WS_WQKV; ldn = NQKV; K = D; TR_KN(); srcc = nb * 128; }
    else if ((r -= N2_QKV) < N2_NAO) { W = A.in[I_NAOUT]; WT = ws + WS_WNAO; ldn = D; K = D; TR_KN(); srcc = nb * 128; }
    else if ((r -= N2_NAO) < N2_MGU) { WT = ws + WS_WMGU; ldn = MOE; K = D; TR_KN(); const int e = nb / (2 * MOE / 128), nl = nb % (2 * MOE / 128); W = ((nl & 1) ? A.in[I_MWU] : A.in[I_MWG]) + (size_t)e * D * MOE; srcc = (nl >> 1) * 128; }
    else { r -= N2_MGU; WT = ws + WS_WMDN; ldn = D; K = MOE; TR_KN(); const int e = nb / (D / 128), nl = nb % (D / 128); W = A.in[I_MWD] + (size_t)e * MOE * D; srcc = nl * 128; }
#undef TR_KN
    Tr2D t; t.W = W; t.WT = WT; t.ldn = ldn; t.K = K; t.srcc = srcc; t.drow = nb * 128; t.k0 = kb * 32; return t;
}
__device__ __forceinline__ void p0_prologue(const Frame& F, const Args& A) {
    const int lane = lane_now(), tid = F.wave * 64 + lane; (void)tid;
    LAS float* scr = (LAS float*)(F.lds + RING_OFF + F.wave * 16384);
    const int gw = blockIdx.x * NWAVES + F.wave, NGW = F.G * NWAVES;
    unsigned char* ws = A.ws;
    {
        f32x2 ra[32], rb[32]; Tr2D da, db; int it = gw;
        if (it < N2_ITEMS) { da = tr2_decode(A, it); tr2_load(ra, da, lane); }
        while (it < N2_ITEMS) {
            int nx = it + NGW; if (nx < N2_ITEMS) { db = tr2_decode(A, nx); tr2_load(rb, db, lane); }
            tr2_store(ra, da, (LAS unsigned char*)scr, lane);
            it = nx; if (it >= N2_ITEMS) break;
            nx = it + NGW; if (nx < N2_ITEMS) { da = tr2_decode(A, nx); tr2_load(ra, da, lane); }
            tr2_store(rb, db, (LAS unsigned char*)scr, lane);
            it = nx;
        }
    }
    for (int it = gw; it < 32 * 8; it += NGW) { const int kb = it >> 3, nb = it & 7; tr_item(A.in[I_RECWIN], REC_IN, D, 3072, (nb == 0) ? 16 : 0, (bf16*)(ws + WS_WGATE), (size_t)nb * 32, kb * 64, scr, lane, false); }
    const size_t gt = (size_t)blockIdx.x * (NWAVES * 64) + tid, NGT = (size_t)F.G * NWAVES * 64;
    { const GAS f32x4* src = (const GAS f32x4*)A.in[I_X]; GAS v4u* dst = (GAS v4u*)(ws + WS_XB0); const size_t NCH = (size_t)M * D / 8;
      for (size_t i = gt; i < NCH; i += 4 * NGT) { f32x4 a[4], b[4];
#pragma unroll
          for (int u = 0; u < 4; ++u) { const size_t iu = i + u * NGT; if (iu < NCH) { a[u] = __builtin_nontemporal_load(src + 2 * iu); b[u] = __builtin_nontemporal_load(src + 2 * iu + 1); } }
#pragma unroll
          for (int u = 0; u < 4; ++u) { const size_t iu = i + u * NGT; if (iu < NCH) { v4u o; o.x = pk2(a[u][0], a[u][1]); o.y = pk2(a[u][2], a[u][3]); o.z = pk2(b[u][0], b[u][1]); o.w = pk2(b[u][2], b[u][3]); dst[iu] = o; } } } }
    { const GAS f32x4* src = (const GAS f32x4*)A.in[I_P]; GAS v4u* dst = (GAS v4u*)(ws + WS_PB); const size_t NCH = (size_t)2 * M * PLE_DIM / 8;
      for (size_t i = gt; i < NCH; i += 4 * NGT) { f32x4 a[4], b[4];
#pragma unroll
          for (int u = 0; u < 4; ++u) { const size_t iu = i + u * NGT; if (iu < NCH) { a[u] = __builtin_nontemporal_load(src + 2 * iu); b[u] = __builtin_nontemporal_load(src + 2 * iu + 1); } }
#pragma unroll
          for (int u = 0; u < 4; ++u) { const size_t iu = i + u * NGT; if (iu < NCH) { v4u o; o.x = pk2(a[u][0], a[u][1]); o.y = pk2(a[u][2], a[u][3]); o.z = pk2(b[u][0], b[u][1]); o.w = pk2(b[u][2], b[u][3]);
              *(GAS v4u*)AT(dst, (iu * 8) / PLE_DIM, (iu * 8) % PLE_DIM, PLE_DIM) = o; } } } }
}

constexpr int RB = 32;
#define T0_OF(blk) (dir ? (T - RB - (blk) * RB) : (blk) * RB)
__device__ __forceinline__ void mlstm_unit(const Frame& F, const Args& A, int unit) {
    const int lane = lane_now(), tid = F.wave * 64 + lane; (void)tid;
    const int cg = unit & 3, dir = (unit >> 2) & 1, h = (unit >> 3) & 3, b = unit >> 5;
    LAS float* qs = (LAS float*)(F.lds + RING_OFF);
    LAS float* ks = qs + RB * 128;
    LAS float* vs = ks + RB * 128;
    LAS float* fi = vs + RB * 64;
    LAS float* ob = fi + RB * 2;
    const bf16* U = (const bf16*)(A.ws + WS_U); const float* Gt = (const float*)(A.ws + WS_G);
    float* HA = (float*)(A.ws + WS_HA) + (size_t)dir * M * 1024;
    const int e = lane & 7, dg = lane >> 3, colw = F.wave * 8 + e;
    const int srow = tid >> 4, sc = tid & 15;
    const float bias_i = A.in[I_GBIAS][(dir ? 2 : 0) * 4 + h], bias_f = A.in[I_GBIAS][(dir ? 3 : 1) * 4 + h];
    float C[16], n[16];
#pragma unroll
    for (int j = 0; j < 16; ++j) { C[j] = 0.f; n[j] = 0.f; }
    v4u rq, rk; v2u rv; float rgi = 0.f, rgf = 0.f;
    {   const size_t row = (size_t)b * T + T0_OF(0) + srow; const bf16* ur = U + row * UW;
        rq = *(const GAS v4u*)(ur + U_QA + h * 128 + sc * 8); rk = *(const GAS v4u*)(ur + U_KA + h * 128 + sc * 8); rv = *(const GAS v2u*)(ur + U_VA + h * 256 + cg * 64 + sc * 4);
        if (tid < RB) { const size_t r2 = (size_t)b * T + T0_OF(0) + tid; rgi = Gt[r2 * 16 + (dir ? 2 : 0) * 4 + h]; rgf = Gt[r2 * 16 + (dir ? 3 : 1) * 4 + h]; } }
    for (int blk = 0; blk < T / RB; ++blk) {
        const int t0 = T0_OF(blk);
        {   const float qsc = 0.08838834764831845f;
            LAS float* qd = qs + srow * 128 + sc * 8; LAS float* kd = ks + srow * 128 + sc * 8;
            *(LAS f32x4*)qd = (f32x4){bflo(rq.x) * qsc, bfhi(rq.x) * qsc, bflo(rq.y) * qsc, bfhi(rq.y) * qsc}; *(LAS f32x4*)(qd + 4) = (f32x4){bflo(rq.z) * qsc, bfhi(rq.z) * qsc, bflo(rq.w) * qsc, bfhi(rq.w) * qsc};
            *(LAS f32x4*)kd = (f32x4){bflo(rk.x), bfhi(rk.x), bflo(rk.y), bfhi(rk.y)}; *(LAS f32x4*)(kd + 4) = (f32x4){bflo(rk.z), bfhi(rk.z), bflo(rk.w), bfhi(rk.w)};
            *(LAS f32x4*)(vs + srow * 64 + sc * 4) = (f32x4){bflo(rv.x), bfhi(rv.x), bflo(rv.y), bfhi(rv.y)};
            if (tid < RB) { const float gi = GATE_CAP * tanhf((rgi + bias_i) * (1.0f / GATE_CAP)), gf = GATE_CAP * tanhf((rgf + bias_f) * (1.0f / GATE_CAP));
                fi[tid * 2] = sigm(gf); fi[tid * 2 + 1] = __expf(gi); } }
        __syncthreads();
        if (blk + 1 < T / RB) { const size_t row = (size_t)b * T + T0_OF(blk + 1) + srow; const bf16* ur = U + row * UW;
            rq = *(const GAS v4u*)(ur + U_QA + h * 128 + sc * 8); rk = *(const GAS v4u*)(ur + U_KA + h * 128 + sc * 8); rv = *(const GAS v2u*)(ur + U_VA + h * 256 + cg * 64 + sc * 4);
            if (tid < RB) { const size_t r2 = (size_t)b * T + T0_OF(blk + 1) + tid; rgi = Gt[r2 * 16 + (dir ? 2 : 0) * 4 + h]; rgf = Gt[r2 * 16 + (dir ? 3 : 1) * 4 + h]; } }
        for (int s = 0; s < RB; ++s) {
            const int tl = dir ? (RB - 1 - s) : s;
            const float f = fi[tl * 2], ii = fi[tl * 2 + 1], v = vs[tl * 64 + colw];
            const LAS f32x4* qp = (const LAS f32x4*)(qs + tl * 128 + dg * 16); const LAS f32x4* kp = (const LAS f32x4*)(ks + tl * 128 + dg * 16);
            float num = 0.f, den = 0.f;
#pragma unroll
            for (int j4 = 0; j4 < 4; ++j4) { const f32x4 q4 = qp[j4], k4 = kp[j4];
#pragma unroll
                for (int i = 0; i < 4; ++i) { const int j = j4 * 4 + i; const float kk = ii * k4[i]; C[j] = f * C[j] + kk * v; n[j] = f * n[j] + kk; num += C[j] * q4[i]; den += n[j] * q4[i]; } }
            num += __shfl_xor(num, 8); den += __shfl_xor(den, 8); num += __shfl_xor(num, 16); den += __shfl_xor(den, 16); num += __shfl_xor(num, 32); den += __shfl_xor(den, 32);
            if (dg == 0) ob[tl * 64 + colw] = num / fmaxf(fabsf(den), 1.0f);
        }
        __syncthreads();
        *(GAS f32x4*)(HA + ((size_t)b * T + t0 + srow) * 1024 + h * 256 + cg * 64 + sc * 4) = *(const LAS f32x4*)(ob + srow * 64 + sc * 4);
    }
    __syncthreads();
}
__device__ __forceinline__ void hgrn_unit(const Frame& F, const Args& A, int unit) {
    const int lane = lane_now(), tid = F.wave * 64 + lane; (void)tid;
    const int cg = unit & 1, dir = (unit >> 1) & 1, h = (unit >> 2) & 7, b = unit >> 5;
    LAS float* qs = (LAS float*)(F.lds + RING_OFF);
    LAS float* fs = qs + RB * 128;
    LAS float* vs = fs + RB * 128;
    LAS float* ob = vs + RB * 64;
    const bf16* U = (const bf16*)(A.ws + WS_U);
    float* HB = (float*)(A.ws + WS_HB) + (size_t)dir * M * 1024;
    const int e = lane & 7, dg = lane >> 3, colw = F.wave * 8 + e;
    const int srow = tid >> 4, sc = tid & 15;
    float lb[8];
#pragma unroll
    for (int i = 0; i < 8; ++i) { const float l0 = A.in[I_LBLOG][(dir * 2 + 0) * 1024 + h * 128 + sc * 8 + i], l1 = A.in[I_LBLOG][(dir * 2 + 1) * 1024 + h * 128 + sc * 8 + i]; lb[i] = 1.0f / (1.0f + __expf(l1 - l0)); }
    float S[16];
#pragma unroll
    for (int j = 0; j < 16; ++j) S[j] = 0.f;
    v4u rq, rf; v2u rv;
    {   const size_t row = (size_t)b * T + T0_OF(0) + srow; const bf16* ur = U + row * UW;
        rq = *(const GAS v4u*)(ur + U_QB + h * 128 + sc * 8); rf = *(const GAS v4u*)(ur + (dir ? U_FB : U_FF) + h * 128 + sc * 8); rv = *(const GAS v2u*)(ur + U_IB + h * 128 + cg * 64 + sc * 4); }
    for (int blk = 0; blk < T / RB; ++blk) {
        const int t0 = T0_OF(blk);
        {   LAS float* qd = qs + srow * 128 + sc * 8; LAS float* fd = fs + srow * 128 + sc * 8;
            float qv[8] = {bflo(rq.x), bfhi(rq.x), bflo(rq.y), bfhi(rq.y), bflo(rq.z), bfhi(rq.z), bflo(rq.w), bfhi(rq.w)};
            float fv[8] = {bflo(rf.x), bfhi(rf.x), bflo(rf.y), bfhi(rf.y), bflo(rf.z), bfhi(rf.z), bflo(rf.w), bfhi(rf.w)};
#pragma unroll
            for (int i = 0; i < 8; ++i) { qv[i] = qv[i] * sigm(qv[i]); fv[i] = lb[i] + (1.0f - lb[i]) * sigm(fv[i]); }
            *(LAS f32x4*)qd = (f32x4){qv[0], qv[1], qv[2], qv[3]}; *(LAS f32x4*)(qd + 4) = (f32x4){qv[4], qv[5], qv[6], qv[7]};
            *(LAS f32x4*)fd = (f32x4){fv[0], fv[1], fv[2], fv[3]}; *(LAS f32x4*)(fd + 4) = (f32x4){fv[4], fv[5], fv[6], fv[7]};
            *(LAS f32x4*)(vs + srow * 64 + sc * 4) = (f32x4){bflo(rv.x), bfhi(rv.x), bflo(rv.y), bfhi(rv.y)}; }
        __syncthreads();
        if (blk + 1 < T / RB) { const size_t row = (size_t)b * T + T0_OF(blk + 1) + srow; const bf16* ur = U + row * UW;
            rq = *(const GAS v4u*)(ur + U_QB + h * 128 + sc * 8); rf = *(const GAS v4u*)(ur + (dir ? U_FB : U_FF) + h * 128 + sc * 8); rv = *(const GAS v2u*)(ur + U_IB + h * 128 + cg * 64 + sc * 4); }
        for (int s = 0; s < RB; ++s) {
            const int tl = dir ? (RB - 1 - s) : s;
            const float v = vs[tl * 64 + colw];
            const LAS f32x4* qp = (const LAS f32x4*)(qs + tl * 128 + dg * 16); const LAS f32x4* fp = (const LAS f32x4*)(fs + tl * 128 + dg * 16);
            float o = 0.f;
#pragma unroll
            for (int j4 = 0; j4 < 4; ++j4) { const f32x4 q4 = qp[j4], f4 = fp[j4];
#pragma unroll
                for (int i = 0; i < 4; ++i) { const int j = j4 * 4 + i; S[j] = f4[i] * S[j] + (1.0f - f4[i]) * v; o += S[j] * q4[i]; } }
            o += __shfl_xor(o, 8); o += __shfl_xor(o, 16); o += __shfl_xor(o, 32);
            if (dg == 0) ob[tl * 64 + colw] = o;
        }
        __syncthreads();
        *(GAS f32x4*)(HB + ((size_t)b * T + t0 + srow) * 1024 + h * 128 + cg * 64 + sc * 4) = *(const LAS f32x4*)(ob + srow * 64 + sc * 4);
    }
    __syncthreads();
}
__device__ __forceinline__ void p3_finalize(const Frame& F, const Args& A) {
    const int lane = lane_now(), tid = F.wave * 64 + lane; (void)tid;
    const int gw = blockIdx.x * NWAVES + F.wave, NGW = F.G * NWAVES;
    const bf16* U = (const bf16*)(A.ws + WS_U); bf16* Y = (bf16*)(A.ws + WS_Y);
    const bf16* HA = (const bf16*)(A.ws + WS_HA); const bf16* HB = (const bf16*)(A.ws + WS_HB);
    f32x4 nw[8];
#pragma unroll
    for (int ps = 0; ps < 8; ++ps) nw[ps] = *(const GAS f32x4*)((ps < 4 ? A.in[I_MNORM] : A.in[I_HNORM]) + (ps & 3) * 256 + lane * 4);
    v2u ra[8], rb[8], rg[8];
#define P3_LOAD(row_) do { const size_t ro_ = (size_t)(row_) * 1024; const bf16* ur_ = U + (size_t)(row_) * UW; \
        _Pragma("unroll") for (int ps = 0; ps < 8; ++ps) { const int c = (ps & 3) * 256 + lane * 4; const bf16* hb_ = (ps < 4) ? HA : HB; \
            ra[ps] = *(const GAS v2u*)(hb_ + ro_ + c); rb[ps] = *(const GAS v2u*)(hb_ + (size_t)M * 1024 + ro_ + c); rg[ps] = *(const GAS v2u*)(ur_ + (ps < 4 ? U_OA : U_GB) + c); } } while (0)
    int row = gw; if (row < M) P3_LOAD(row);
    for (; row < M; row += NGW) {
        v2u out[8];
#pragma unroll
        for (int ps = 0; ps < 8; ++ps) { const v2u a2 = ra[ps], b2 = rb[ps], gg = rg[ps];
            const f32x4 s = (f32x4){bflo(a2.x) + bflo(b2.x), bfhi(a2.x) + bfhi(b2.x), bflo(a2.y) + bflo(b2.y), bfhi(a2.y) + bfhi(b2.y)}; float ss = (s[0] * s[0] + s[1] * s[1]) + (s[2] * s[2] + s[3] * s[3]);
            ss = (ps < 4) ? wave_sum(ss) : half_sum32(ss, lane);
            const float r = __builtin_amdgcn_rsqf(ss * (ps < 4 ? (1.0f / 256.0f) : (1.0f / 128.0f)) + RMS_EPS);
            const float g0 = bflo(gg.x), g1 = bfhi(gg.x), g2 = bflo(gg.y), g3 = bfhi(gg.y);
            float m0, m1, m2, m3;
            if (ps < 4) { m0 = sigm(g0); m1 = sigm(g1); m2 = sigm(g2); m3 = sigm(g3); } else { m0 = g0 * sigm(g0); m1 = g1 * sigm(g1); m2 = g2 * sigm(g2); m3 = g3 * sigm(g3); }
            out[ps].x = pk2(s[0] * r * nw[ps][0] * m0, s[1] * r * nw[ps][1] * m1); out[ps].y = pk2(s[2] * r * nw[ps][2] * m2, s[3] * r * nw[ps][3] * m3); }
        const int rown = row + NGW; if (rown < M) P3_LOAD(rown);
#pragma unroll
        for (int ps = 0; ps < 8; ++ps) *(GAS v2u*)AT(Y, row, ps * 256 + lane * 4, D) = out[ps];
    }
#undef P3_LOAD
}

struct LnAff { f32x4 w[8], b[8]; };
__device__ __forceinline__ LnAff ln_aff_load(const float* w, const float* bvec, int lane) { LnAff a;
#pragma unroll
    for (int j = 0; j < 8; ++j) { a.w[j] = *(const GAS f32x4*)(w + 256 * j + 4 * lane); a.b[j] = *(const GAS f32x4*)(bvec + 256 * j + 4 * lane); }
    return a; }
__device__ __forceinline__ void ln_row_regs(f32x4 (&v)[8], const LnAff& af, int lane) {
    float s = 0.f;
#pragma unroll
    for (int j = 0; j < 8; ++j) s += (v[j][0] + v[j][1]) + (v[j][2] + v[j][3]);
    const float mean = wave_sum(s) * (1.0f / D); float s2 = 0.f;
#pragma unroll
    for (int j = 0; j < 8; ++j) { v[j] = v[j] - mean; s2 += (v[j][0] * v[j][0] + v[j][1] * v[j][1]) + (v[j][2] * v[j][2] + v[j][3] * v[j][3]); }
    const float rstd = 1.0f / sqrtf(wave_sum(s2) * (1.0f / D) + LN_EPS);
#pragma unroll
    for (int j = 0; j < 8; ++j) v[j] = v[j] * rstd * af.w[j] + af.b[j];
}
__device__ __forceinline__ void store_row(const f32x4 (&v)[8], float* xf, bf16* xb, int lane) {
#pragma unroll
    for (int j = 0; j < 8; ++j) { *(GAS f32x4*)(xf + 256 * j + 4 * lane) = v[j]; v2u o; o.x = pk2(v[j][0], v[j][1]); o.y = pk2(v[j][2], v[j][3]); *(GAS v2u*)(xb + 256 * j + 4 * lane) = o; }
}

__device__ __forceinline__ void load_row_b(f32x4 (&v)[8], const bf16* xb, int lane) {
#pragma unroll
    for (int j = 0; j < 8; ++j) { const v2u w = *(const GAS v2u*)(xb + 256 * j + 4 * lane); v[j] = (f32x4){bflo(w.x), bfhi(w.x), bflo(w.y), bfhi(w.y)}; }
}
__device__ __forceinline__ void store_row_b(const f32x4 (&v)[8], bf16* xb, int lane) {
#pragma unroll
    for (int j = 0; j < 8; ++j) { v2u o; o.x = pk2(v[j][0], v[j][1]); o.y = pk2(v[j][2], v[j][3]); *(GAS v2u*)(xb + 256 * j + 4 * lane) = o; }
}
__device__ __forceinline__ void load_row_bt(f32x4 (&v)[8], const bf16* base, int row, int lane) {
#pragma unroll
    for (int j = 0; j < 8; ++j) { const v2u w = *(const GAS v2u*)AT(base, row, 256 * j + 4 * lane, D); v[j] = (f32x4){bflo(w.x), bfhi(w.x), bflo(w.y), bfhi(w.y)}; }
}
__device__ __forceinline__ void store_row_bt(const f32x4 (&v)[8], bf16* base, int row, int lane) {
#pragma unroll
    for (int j = 0; j < 8; ++j) { v2u o; o.x = pk2(v[j][0], v[j][1]); o.y = pk2(v[j][2], v[j][3]); *(GAS v2u*)AT(base, row, 256 * j + 4 * lane, D) = o; }
}
__device__ __forceinline__ void ln_phase_b(const Frame& F, const Args& A, const float* w, const float* bvec, const bf16* TB, bf16* XB) {
    const int lane = lane_now(); const int gw = blockIdx.x * NWAVES + F.wave, NGW = F.G * NWAVES;
    const LnAff af = ln_aff_load(w, bvec, lane);
    f32x4 v[8], vn[8]; int row = gw; if (row < M) load_row_b(v, TB + (size_t)row * D, lane);
    for (; row < M; row += NGW) {
        const int rn = row + NGW; if (rn < M) load_row_b(vn, TB + (size_t)rn * D, lane);
        ln_row_regs(v, af, lane); store_row_b(v, XB + (size_t)row * D, lane);
#pragma unroll
        for (int j = 0; j < 8; ++j) v[j] = vn[j]; }
}
__device__ __forceinline__ void ln_phase(const Frame& F, const Args& A, const float* w, const float* bvec, bf16* XB) {
    const int lane = lane_now(), tid = F.wave * 64 + lane; (void)tid;
    const LnAff af = ln_aff_load(w, bvec, lane);
    const int gw = blockIdx.x * NWAVES + F.wave, NGW = F.G * NWAVES;
    for (int row = gw; row < M; row += NGW) { float* xr = A.out + (size_t)row * D; f32x4 v[8];
#pragma unroll
        for (int j = 0; j < 8; ++j) v[j] = *(const GAS f32x4*)(xr + 256 * j + 4 * lane);
        ln_row_regs(v, af, lane); store_row(v, xr, XB + (size_t)row * D, lane); }
}
__device__ __forceinline__ void ln_router_phase(const Frame& F, const Args& A, const float* w, const float* bvec, bf16* XB) {
    const int lane = lane_now(), tid = F.wave * 64 + lane; (void)tid;
    const LnAff af = ln_aff_load(w, bvec, lane);
    LAS int* cnt = (LAS int*)(F.lds + RING_OFF);
    int* TOKE = (int*)(A.ws + WS_TOKE); float* TOKG = (float*)(A.ws + WS_TOKG); int* WGCNT = (int*)(A.ws + WS_WGCNT);
    const float* wr = A.in[I_WR]; const float* br = A.in[I_BR];
    LAS f32x4* wt = (LAS f32x4*)(F.lds + RING_OFF + 1024);
    for (int x = tid; x < 2048 * 2; x += NWAVES * 64) { const int col = x >> 1, half = x & 1; const int j = col >> 8, ln = (col & 255) >> 2, i = col & 3;
        wt[((j * 4 + i) * 2 + half) * 64 + ln] = *(const GAS f32x4*)(wr + (size_t)col * NE + 4 * half); }
    for (int vb = blockIdx.x; vb < M / 64; vb += F.G) {
        if (tid < 8) cnt[tid] = 0;
        __syncthreads();
        f32x4 v[8], vn[8];
        { const float* xr0 = A.out + (size_t)(vb * 64 + F.wave * 8) * D;
#pragma unroll
          for (int j = 0; j < 8; ++j) v[j] = *(const GAS f32x4*)(xr0 + 256 * j + 4 * lane); }
        for (int k = 0; k < 8; ++k) { const int row = vb * 64 + F.wave * 8 + k;
            if (k + 1 < 8) { const float* xn = A.out + (size_t)(row + 1) * D;
#pragma unroll
                for (int j = 0; j < 8; ++j) vn[j] = *(const GAS f32x4*)(xn + 256 * j + 4 * lane); }
            ln_row_regs(v, af, lane); store_row_b(v, XB + (size_t)row * D, lane);
            float lg[8];
#pragma unroll
            for (int e = 0; e < 8; ++e) lg[e] = 0.f;
#pragma unroll
            for (int j = 0; j < 8; ++j)
#pragma unroll
                for (int i = 0; i < 4; ++i) { const f32x4 w0 = wt[((j * 4 + i) * 2 + 0) * 64 + lane], w1 = wt[((j * 4 + i) * 2 + 1) * 64 + lane]; const float xv = v[j][i];
                    lg[0] += xv * w0[0]; lg[1] += xv * w0[1]; lg[2] += xv * w0[2]; lg[3] += xv * w0[3]; lg[4] += xv * w1[0]; lg[5] += xv * w1[1]; lg[6] += xv * w1[2]; lg[7] += xv * w1[3]; }
#pragma unroll
            for (int e = 0; e < 8; ++e) lg[e] = wave_sum(lg[e]) + br[e];
            int e1 = 0; float l1 = lg[0];
#pragma unroll
            for (int e = 1; e < 8; ++e) if (lg[e] > l1) { l1 = lg[e]; e1 = e; }
            int e2 = -1; float l2 = -3.0e38f;
#pragma unroll
            for (int e = 0; e < 8; ++e) if (e != e1 && lg[e] > l2) { l2 = lg[e]; e2 = e; }
            const float g2 = 1.0f / (1.0f + __expf(l1 - l2)), g1 = 1.0f - g2;
            if (lane == 0) { TOKE[2 * row] = e1; TOKE[2 * row + 1] = e2; TOKG[2 * row] = g1; TOKG[2 * row + 1] = g2; __hip_atomic_fetch_add(&cnt[e1], 1, __ATOMIC_RELAXED, __HIP_MEMORY_SCOPE_WORKGROUP); __hip_atomic_fetch_add(&cnt[e2], 1, __ATOMIC_RELAXED, __HIP_MEMORY_SCOPE_WORKGROUP); }
#pragma unroll
            for (int j = 0; j < 8; ++j) v[j] = vn[j];
        }
        __syncthreads();
        if (tid < 8) WGCNT[vb * 8 + tid] = cnt[tid];
        __syncthreads();
    }
}
__device__ __forceinline__ int inv_slot(int d) { const int rr = d & 127; return (((d >> 7) * 64 + (rr & 63)) << 1) + (rr >> 6); }
__device__ __forceinline__ void moe_route_phase(const Frame& F, const Args& A) {
    const int lane = lane_now(), tid = F.wave * 64 + lane; (void)lane;
    LAS int* sm = (LAS int*)(F.lds + RING_OFF);
    const int* TOKE = (const int*)(A.ws + WS_TOKE); int* DEST = (int*)(A.ws + WS_DEST); const int* WGCNT = (const int*)(A.ws + WS_WGCNT); int* TILEE = (int*)(A.ws + WS_TILEE); unsigned short* INV = (unsigned short*)(A.ws + WS_INV);
    for (int vb = blockIdx.x; vb < M / 64; vb += F.G) {
        if (tid < 16) sm[tid] = 0;
        if (tid >= 64 && tid < 192) sm[32 + tid - 64] = TOKE[vb * 128 + tid - 64];
        __syncthreads();
        {   const int e = tid & 7, wq = tid >> 3; int tot = 0, pre = 0;
#pragma unroll
            for (int i = 0; i < 4; ++i) { const int w = wq * 4 + i; const int c = WGCNT[w * 8 + e]; tot += c; pre += (w < vb) ? c : 0; }
            __hip_atomic_fetch_add(&sm[e], tot, __ATOMIC_RELAXED, __HIP_MEMORY_SCOPE_WORKGROUP); __hip_atomic_fetch_add(&sm[8 + e], pre, __ATOMIC_RELAXED, __HIP_MEMORY_SCOPE_WORKGROUP); }
        __syncthreads();
        if (tid == 0) { int base = 0; for (int e = 0; e < 8; ++e) { sm[16 + e] = base; base += ((sm[e] + 255) >> 8) << 8; }
            if (vb == 0) { int rt = 0; for (int e = 0; e < 8; ++e) { const int nt = (sm[e] + 255) >> 8; for (int i = 0; i < nt; ++i) TILEE[1 + rt++] = e; } TILEE[0] = rt; } }
        __syncthreads();
        if (tid < 128) { const int e = sm[32 + tid]; int rank = 0; for (int s = 0; s < tid; ++s) rank += (sm[32 + s] == e) ? 1 : 0; const int d = sm[16 + e] + sm[8 + e] + rank; DEST[vb * 128 + tid] = d; INV[inv_slot(d)] = (unsigned short)(vb * 64 + (tid >> 1)); }
        if (vb == 0) { for (int e = 0; e < 8; ++e) { const int tot = sm[e], pad = ((tot + 255) >> 8) << 8, base = sm[16 + e]; for (int i = tot + tid; i < pad; i += NWAVES * 64) INV[inv_slot(base + i)] = 0; } }
        __syncthreads();
    }
}
__device__ __forceinline__ void ln_moe_phase(const Frame& F, const Args& A, const float* w, const float* bvec, const bf16* XBin, bf16* XBout) {
    const int lane = lane_now(); const int gw = blockIdx.x * NWAVES + F.wave, NGW = F.G * NWAVES;
    const LnAff af = ln_aff_load(w, bvec, lane);
    const float* TOKG = (const float*)(A.ws + WS_TOKG); const int* DEST = (const int*)(A.ws + WS_DEST); const bf16* YS = (const bf16*)(A.ws + WS_YS);
    const bf16* PARTB = (const bf16*)(A.ws + WS_PART);
    f32x4 v[8], y1[8], y2[8]; int row = gw; int d1 = 0, d2 = 0; float g1 = 0.f, g2 = 0.f;
    if (row < M) { d1 = DEST[2 * row]; d2 = DEST[2 * row + 1]; g1 = TOKG[2 * row]; g2 = TOKG[2 * row + 1]; }
#define LD_YROW(dst, d_) do { if ((d_) < pg8::TAIL_PM0 * 256) load_row_b(dst, YS + (size_t)(d_) * D, lane); else { const bf16* pb_ = PARTB + (size_t)((d_) - pg8::TAIL_PM0 * 256) * D; \
        load_row_b(dst, pb_, lane); \
        for (int ks_ = 1; ks_ < pg8::TAIL_KS; ++ks_) { f32x4 t_[8]; load_row_b(t_, pb_ + (size_t)ks_ * pg8::TAIL_ROWS * D, lane); _Pragma("unroll") for (int j = 0; j < 8; ++j) dst[j] = dst[j] + t_[j]; } } } while (0)
    for (; row < M; row += NGW) {
        load_row_b(v, XBin + (size_t)row * D, lane); LD_YROW(y1, d1); LD_YROW(y2, d2);
        const float cg1 = g1, cg2 = g2; const int rn = row + NGW;
        if (rn < M) { d1 = DEST[2 * rn]; d2 = DEST[2 * rn + 1]; g1 = TOKG[2 * rn]; g2 = TOKG[2 * rn + 1]; }
#pragma unroll
        for (int j = 0; j < 8; ++j) v[j] = v[j] * ALPHA + y1[j] * cg1 + y2[j] * cg2;
        ln_row_regs(v, af, lane); store_row_b(v, XBout + (size_t)row * D, lane); }
#undef LD_YROW
}

__device__ __forceinline__ void na_phase_simple(const Frame& F, const Args& A) {
    const int lane = lane_now(), tid = F.wave * 64 + lane; (void)tid;
    const int gw = blockIdx.x * NWAVES + F.wave, NGW = F.G * NWAVES;
    const bf16* QKV = (const bf16*)(A.ws + WS_QKV); bf16* AO = (bf16*)(A.ws + WS_AO); const float* rpb = A.in[I_RPB];
    const float scale = 0.08838834764831845f;
    for (int task = gw; task < M * 16; task += NGW) {
        const int tok = task >> 4, h = task & 15, b = tok >> 12, r = (tok >> 6) & 63, c = tok & 63;
        const int rs = min(max(r - 4, 0), 56), cs = min(max(c - 8, 0), 48);
        const GAS v4u* qp = (const GAS v4u*)(QKV + (size_t)tok * NQKV + h * 128);
        float sc[2];
#pragma unroll
        for (int i = 0; i < 2; ++i) { const int kk = lane + 64 * i, jr = kk >> 4, jc = kk & 15; const int ktok = b * T + (rs + jr) * 64 + cs + jc;
            const GAS v4u* kp = (const GAS v4u*)(QKV + (size_t)ktok * NQKV + D + h * 128); float acc = 0.f;
#pragma unroll 4
            for (int j = 0; j < 16; ++j) { const v4u q = qp[j], k = kp[j];
                acc += bflo(q.x) * bflo(k.x) + bfhi(q.x) * bfhi(k.x) + bflo(q.y) * bflo(k.y) + bfhi(q.y) * bfhi(k.y) + bflo(q.z) * bflo(k.z) + bfhi(q.z) * bfhi(k.z) + bflo(q.w) * bflo(k.w) + bfhi(q.w) * bfhi(k.w); }
            sc[i] = acc * scale + rpb[(h * 15 + (rs + jr - r + 7)) * 31 + (cs + jc - c + 15)]; }
        const float mx = wave_max(fmaxf(sc[0], sc[1]));
        const float p0 = __expf(sc[0] - mx), p1 = __expf(sc[1] - mx);
        const float inv = 1.0f / wave_sum(p0 + p1);
        float a0 = 0.f, a1 = 0.f;
        const bf16* vbase = QKV + 2 * D + h * 128 + 2 * lane;
#pragma unroll
        for (int i = 0; i < 2; ++i) { const float pi = i ? p1 : p0;
#pragma unroll 8
            for (int l = 0; l < 64; ++l) { const int kk = l + 64 * i, jr = kk >> 4, jc = kk & 15; const int ktok = b * T + (rs + jr) * 64 + cs + jc;
                const float pk = __builtin_bit_cast(float, __builtin_amdgcn_readlane(__builtin_bit_cast(int, pi), l));
                const unsigned vv = *(const GAS unsigned*)(vbase + (size_t)ktok * NQKV); a0 += pk * bflo(vv); a1 += pk * bfhi(vv); } }
        *(GAS unsigned*)(AO + (size_t)tok * D + h * 128 + 2 * lane) = pk2(a0 * inv, a1 * inv);
    }
}
constexpr int NA_VP = 288, NA_KP = 272;
__device__ __forceinline__ void na_phase_mfma(const Frame& F, const Args& A) {
    const int lane = lane_now(), tid = F.wave * 64 + lane, i = lane & 15, fq = lane >> 4;
    const bf16* QKV = (const bf16*)(A.ws + WS_QKV); bf16* AO = (bf16*)(A.ws + WS_AO); const float* rpb = A.in[I_RPB];
    LAS unsigned char* vl = F.lds + RING_OFF;
    LAS float* rp = (LAS float*)(F.lds + RING_OFF + 5 * 64 * NA_VP);
    const int qsel = F.wave >> 2, qi = F.wave & 3, wc = min(max(16 * qi - 8, 0), 32);
    const int qc = 16 * qi + i, cs = min(max(qc - 8, 0), 48);
    const float scale = 0.08838834764831845f;
    const int q4 = (lane & 15) >> 2, p4 = lane & 3;
    v4u vreg[10];
#define NA_LOAD(NR, row0, moff, tokb_, h_) do { _Pragma("unroll") for (int k = 0; k < 2 * (NR); ++k) { const int ch = tid + 512 * k, row = ch >> 10, key = (ch >> 4) & 63, c16 = ch & 15; const int vr = min((row0) + row, 63); \
        vreg[k] = *(const GAS v4u*)(QKV + (size_t)(moff) * ((size_t)M * D) + ((tokb_) + vr * 64 + key) * 128 + c16 * 8); } } while (0)
#define NA_STORE(NR, pitch) do { _Pragma("unroll") for (int k = 0; k < 2 * (NR); ++k) { const int ch = tid + 512 * k, row = ch >> 10, key = (ch >> 4) & 63, c16 = ch & 15; *(LAS v4u*)(vl + (row * 64 + key) * (pitch) + c16 * 16) = vreg[k]; } } while (0)
    const int upw = (64 * 32 + F.G - 1) / F.G; int unit = blockIdx.x * upw; const int unit_end = min(unit + upw, 64 * 32);
    if (unit < 64 * 32) { const int rpi = unit & 31, bh = unit >> 5, h = bh & 15, b = bh >> 4; const int R0 = min(max(2 * rpi - 4, 0), 56); NA_LOAD(5, R0, 1, (size_t)(b * 16 + h) * T, h); }
    for (; unit < unit_end; unit += 1) {
        const int rpi = unit & 31, bh = unit >> 5, h = bh & 15, b = bh >> 4;
        const int r0 = 2 * rpi, qrow = r0 + qsel, R0 = min(max(r0 - 4, 0), 56), rsw = min(max(qrow - 4, 0), 56);
        const size_t tokb = (size_t)b * T, hrow = (size_t)(b * 16 + h) * T;
        bf16x8 bq[4];
        { const bf16* qp = QKV + (hrow + qrow * 64 + qc) * 128 + 8 * fq;
#pragma unroll
          for (int kk = 0; kk < 4; ++kk) bq[kk] = *(const GAS bf16x8*)(qp + 32 * kk); }
        __syncthreads();
        if (tid < 465) rp[tid] = rpb[h * 465 + tid];
        NA_STORE(5, NA_KP); NA_LOAD(4, R0 + 5, 1, hrow, h);
        __syncthreads();
        f32x4 acc[16];
#pragma unroll
        for (int kt = 0; kt < 16; ++kt) acc[kt] = (f32x4){0.f, 0.f, 0.f, 0.f};
        LAS unsigned char* kb0 = vl + (wc + i) * NA_KP + 16 * fq;
#pragma unroll
        for (int jr = 0; jr < 8; ++jr) { const int la = rsw + jr - R0;
            if (la <= 4) { LAS unsigned char* kp = kb0 + la * 64 * NA_KP;
                bf16x8 ka[2][4];
#pragma unroll
                for (int kb2 = 0; kb2 < 2; ++kb2)
#pragma unroll
                    for (int kk = 0; kk < 4; ++kk) ka[kb2][kk] = *(const LAS bf16x8*)(kp + 16 * kb2 * NA_KP + 64 * kk);
#pragma unroll
                for (int kb2 = 0; kb2 < 2; ++kb2)
#pragma unroll
                    for (int kk = 0; kk < 4; ++kk) acc[2 * jr + kb2] = __builtin_amdgcn_mfma_f32_16x16x32_bf16(ka[kb2][kk], bq[kk], acc[2 * jr + kb2], 0, 0, 0); } }
        __syncthreads();
        NA_STORE(4, NA_KP); NA_LOAD(5, R0, 2, hrow, h);
        __syncthreads();
#pragma unroll
        for (int jr = 0; jr < 8; ++jr) { const int la = rsw + jr - R0 - 5;
            if (la >= 0) { LAS unsigned char* kp = kb0 + la * 64 * NA_KP;
                bf16x8 ka[2][4];
#pragma unroll
                for (int kb2 = 0; kb2 < 2; ++kb2)
#pragma unroll
                    for (int kk = 0; kk < 4; ++kk) ka[kb2][kk] = *(const LAS bf16x8*)(kp + 16 * kb2 * NA_KP + 64 * kk);
#pragma unroll
                for (int kb2 = 0; kb2 < 2; ++kb2)
#pragma unroll
                    for (int kk = 0; kk < 4; ++kk) acc[2 * jr + kb2] = __builtin_amdgcn_mfma_f32_16x16x32_bf16(ka[kb2][kk], bq[kk], acc[2 * jr + kb2], 0, 0, 0); } }
        float mx = -3.0e38f;
#pragma unroll
        for (int kt = 0; kt < 16; ++kt) { const int jr = kt >> 1, kb2 = kt & 1; const int dr = rsw + jr - qrow + 7;
#pragma unroll
            for (int r = 0; r < 4; ++r) { const int kc = wc + 16 * kb2 + 4 * fq + r; const int dc = min(max(kc - qc + 15, 0), 30); const bool ok = (kc >= cs) && (kc < cs + 16);
                const float s = ok ? acc[kt][r] * scale + rp[dr * 31 + dc] : -3.0e38f; acc[kt][r] = s; mx = fmaxf(mx, s); } }
        mx = fmaxf(mx, __shfl_xor(mx, 16)); mx = fmaxf(mx, __shfl_xor(mx, 32));
        float sum = 0.f;
#pragma unroll
        for (int kt = 0; kt < 16; ++kt)
#pragma unroll
            for (int r = 0; r < 4; ++r) { const float p = __expf(acc[kt][r] - mx); acc[kt][r] = p; sum += p; }
        sum += __shfl_xor(sum, 16); sum += __shfl_xor(sum, 32);
        const float inv = 1.0f / sum;
        bf16x8 pb[8];
#pragma unroll
        for (int ks = 0; ks < 8; ++ks) { v4u w; w.x = cvtpk(acc[2 * ks][0], acc[2 * ks][1]); w.y = cvtpk(acc[2 * ks][2], acc[2 * ks][3]); w.z = cvtpk(acc[2 * ks + 1][0], acc[2 * ks + 1][1]); w.w = cvtpk(acc[2 * ks + 1][2], acc[2 * ks + 1][3]);
            pb[ks] = __builtin_bit_cast(bf16x8, w); }
        __syncthreads();
        NA_STORE(5, NA_VP); NA_LOAD(4, R0 + 5, 2, hrow, h);
        __syncthreads();
        f32x4 o[8];
#pragma unroll
        for (int db = 0; db < 8; ++db) o[db] = (f32x4){0.f, 0.f, 0.f, 0.f};
        LAS unsigned char* vb0 = vl + (wc + 4 * fq + q4) * NA_VP + 8 * p4;
#pragma unroll
        for (int jr = 0; jr < 8; ++jr) { const int la = rsw + jr - R0;
            if (la <= 4) { LAS unsigned char* vp = vb0 + la * 64 * NA_VP;
                s16x4 x0[8], x1[8];
#pragma unroll
                for (int db = 0; db < 8; ++db) { x0[db] = lds_tr(vp + 32 * db); x1[db] = lds_tr(vp + 16 * NA_VP + 32 * db); }
#pragma unroll
                for (int db = 0; db < 8; ++db) { const bf16x8 a = (bf16x8){x0[db][0], x0[db][1], x0[db][2], x0[db][3], x1[db][0], x1[db][1], x1[db][2], x1[db][3]};
                    o[db] = __builtin_amdgcn_mfma_f32_16x16x32_bf16(a, pb[jr], o[db], 0, 0, 0); } } }
        __syncthreads();
        NA_STORE(4, NA_VP);
        { const int un = unit + 1; if (un < unit_end) { const int rpn = un & 31, bhn = un >> 5, hn = bhn & 15, bn = bhn >> 4; const int R0n = min(max(2 * rpn - 4, 0), 56); NA_LOAD(5, R0n, 1, (size_t)(bn * 16 + hn) * T, hn); } }
        __syncthreads();
#pragma unroll
        for (int jr = 0; jr < 8; ++jr) { const int la = rsw + jr - R0 - 5;
            if (la >= 0) { LAS unsigned char* vp = vb0 + la * 64 * NA_VP;
                s16x4 x0[8], x1[8];
#pragma unroll
                for (int db = 0; db < 8; ++db) { x0[db] = lds_tr(vp + 32 * db); x1[db] = lds_tr(vp + 16 * NA_VP + 32 * db); }
#pragma unroll
                for (int db = 0; db < 8; ++db) { const bf16x8 a = (bf16x8){x0[db][0], x0[db][1], x0[db][2], x0[db][3], x1[db][0], x1[db][1], x1[db][2], x1[db][3]};
                    o[db] = __builtin_amdgcn_mfma_f32_16x16x32_bf16(a, pb[jr], o[db], 0, 0, 0); } } }
        const int orow = (int)(tokb + qrow * 64 + qc);
#pragma unroll
        for (int db = 0; db < 8; ++db) { v2u w; w.x = cvtpk(o[db][0] * inv, o[db][1] * inv); w.y = cvtpk(o[db][2] * inv, o[db][3] * inv); *(GAS v2u*)AT(AO, orow, h * 128 + 16 * db + 4 * fq, D) = w; }
    }
#undef NA_LOAD
#undef NA_STORE
    __syncthreads();
}
__device__ __forceinline__ float wave_scan_incl(float v, int lane) {
#pragma unroll
    for (int off = 1; off < 64; off <<= 1) { const float t = __shfl_up(v, off); if (lane >= off) v += t; }
    return v;
}
__device__ __forceinline__ void rec_prep(const Frame& F, const Args& A) {
    const int lane = lane_now(); const int gw = blockIdx.x * NWAVES + F.wave, NGW = F.G * NWAVES;
    const bf16* U = (const bf16*)(A.ws + WS_U); const float* Gt = (const float*)(A.ws + WS_G);
    bf16* QIN = (bf16*)(A.ws + WS_QIN); bf16* KIN = (bf16*)(A.ws + WS_KIN); float* GTAB = (float*)(A.ws + WS_GTAB);
    float* EQM = (float*)(A.ws + WS_EQM); float* EKM = (float*)(A.ws + WS_EKM); float* GTABM = (float*)(A.ws + WS_GTABM);
    for (int item = gw; item < 2048; item += NGW) {
        const int c = item & 63, dir = (item >> 6) & 1, h = (item >> 7) & 3, b = item >> 9;
        const size_t tk = (size_t)b * T + (dir ? (T - 1 - (64 * c + lane)) : (64 * c + lane));
        const float bias_i = A.in[I_GBIAS][(dir ? 2 : 0) * 4 + h], bias_f = A.in[I_GBIAS][(dir ? 3 : 1) * 4 + h];
        const float gi = GATE_CAP * tanhf((Gt[tk * 16 + (dir ? 2 : 0) * 4 + h] + bias_i) * (1.0f / GATE_CAP)), gf = GATE_CAP * tanhf((Gt[tk * 16 + (dir ? 3 : 1) * 4 + h] + bias_f) * (1.0f / GATE_CAP));
        const float lf = -log1pf(__expf(-gf)); const float bb = wave_scan_incl(lf, lane);
        const float gg = __builtin_bit_cast(float, __builtin_amdgcn_readlane(__builtin_bit_cast(int, bb), 63));
        const float eq = 0.08838834764831845f * __expf(bb), ek = __expf(gi - bb);
        GTABM[(size_t)item * 128 + lane] = gg; GTABM[(size_t)item * 128 + 64 + lane] = gg;
        EQM[(size_t)item * 64 + lane] = eq; EKM[(size_t)item * 64 + lane] = ek;
    }
    for (int item = gw; item < 4096; item += NGW) {
        const int c = item & 63, dir = (item >> 6) & 1, h = (item >> 7) & 7, b = item >> 10;
        const int ch = h * 128 + 2 * lane;
        const float l00 = A.in[I_LBLOG][(dir * 2 + 0) * 1024 + ch], l01 = A.in[I_LBLOG][(dir * 2 + 1) * 1024 + ch], l10 = A.in[I_LBLOG][(dir * 2 + 0) * 1024 + ch + 1], l11 = A.in[I_LBLOG][(dir * 2 + 1) * 1024 + ch + 1];
        const float lb0 = 1.0f / (1.0f + __expf(l01 - l00)), lb1 = 1.0f / (1.0f + __expf(l11 - l10));
        float pr0 = 1.f, pr1 = 1.f;
        for (int tb = 0; tb < 64; tb += 16) {
            unsigned qw[16], fw[16];
#pragma unroll
            for (int u = 0; u < 16; ++u) { const int tau = tb + u; const size_t tk = (size_t)b * T + (dir ? (T - 1 - (64 * c + tau)) : (64 * c + tau));
                qw[u] = *(const GAS unsigned*)(U + tk * UW + U_QB + ch); fw[u] = *(const GAS unsigned*)(U + tk * UW + (dir ? U_FB : U_FF) + ch); }
#pragma unroll
            for (int u = 0; u < 16; ++u) { const int tau = tb + u; const int tl = dir ? (T - 1 - (64 * c + tau)) : (64 * c + tau);
                const float q0 = bflo(qw[u]), q1 = bfhi(qw[u]);
                const float f0 = lb0 + (1.0f - lb0) * sigm(bflo(fw[u])), f1 = lb1 + (1.0f - lb1) * sigm(bfhi(fw[u]));
                pr0 *= f0; pr1 *= f1;
                const size_t o = ((size_t)(((dir * 4 + b) * 8 + h)) * T + tl) * 128 + 2 * lane;
                *(GAS unsigned*)(QIN + o) = cvtpk(q0 * sigm(q0) * pr0, q1 * sigm(q1) * pr1);
                *(GAS unsigned*)(KIN + o) = cvtpk((1.0f - f0) * __builtin_amdgcn_rcpf(pr0), (1.0f - f1) * __builtin_amdgcn_rcpf(pr1)); }
        }
        *(GAS f32x2*)(GTAB + (size_t)item * 128 + 2 * lane) = (f32x2){__logf(pr0), __logf(pr1)};
    }
}

__device__ __forceinline__ void gates_mfma(const Frame& F, const Args& A) {
    const int lane = lane_now(), i = lane & 15, fq = lane >> 4; const int gw = blockIdx.x * NWAVES + F.wave, NGW = F.G * NWAVES;
    const bf16* X = (const bf16*)(A.ws + WS_XB0); const bf16* Wg = (const bf16*)(A.ws + WS_WGATE);
    float* Gt = (float*)(A.ws + WS_G);
    for (int blk = gw; blk < M / 16; blk += NGW) {
        const bf16* wp = Wg + (size_t)i * D + 8 * fq; const int xrow = 16 * blk + i;
        f32x4 acc0 = (f32x4){0.f, 0.f, 0.f, 0.f}, acc1 = (f32x4){0.f, 0.f, 0.f, 0.f};
#pragma unroll 4
        for (int kk = 0; kk < D / 32; kk += 2) {
            const bf16x8 a0 = *(const GAS bf16x8*)(wp + 32 * kk), b0 = *(const GAS bf16x8*)(X + (size_t)xrow * D + 32 * kk + 8 * fq), a1 = *(const GAS bf16x8*)(wp + 32 * kk + 32), b1 = *(const GAS bf16x8*)(X + (size_t)xrow * D + 32 * kk + 32 + 8 * fq);
            acc0 = __builtin_amdgcn_mfma_f32_16x16x32_bf16(a0, b0, acc0, 0, 0, 0); acc1 = __builtin_amdgcn_mfma_f32_16x16x32_bf16(a1, b1, acc1, 0, 0, 0);
        }
        *(GAS f32x4*)(Gt + (size_t)(16 * blk + i) * 16 + 4 * fq) = acc0 + acc1;
    }
}
constexpr int RQ_P = 272;
template <int NEB> struct RecMap {
    static constexpr int VP = NEB * 32 + 8, Q = 0, K = 17408, V = 34816, TB = V + 64 * VP, EQ = TB + 512, PAR = EQ + 256, SB = 2 * PAR, SBSZ = 128 * VP;
    static_assert(TB % 16 == 0 && PAR % 16 == 0 && SB + 2 * SBSZ <= RING_BYTES, "recurrence LDS map");
};
struct RecP { const bf16* qin; const bf16* kin;
              const bf16* vsrc;
              const float* gtab;
              bf16* out;
              int b, dir;
              int qs;
              const float* eq; const float* ek; };

template <int NEB>
__device__ __forceinline__ void rec_compute(int wave, int lane, LAS unsigned char* P, LAS unsigned char* SBc, LAS unsigned char* SBn, f32x4 (&Sst)[NEB][2], bf16* outrow  ) {
    typedef RecMap<NEB> Mp;
    const int i = lane & 15, fq = lane >> 4, q4 = i >> 2, p4 = lane & 3;
#define RC_TR2(dst, ptr, step) do { const s16x4 x0_ = lds_tr(ptr), x1_ = lds_tr((ptr) + (step)); dst = (bf16x8){x0_[0], x0_[1], x0_[2], x0_[3], x1_[0], x1_[1], x1_[2], x1_[3]}; } while (0)
    if (wave < 4) {
        __builtin_amdgcn_s_setprio(2);
        const int tbk = wave;
        bf16x8 qf[4], sf[4][NEB], kf[4][4], vf[2][NEB];
#pragma unroll
        for (int kk = 0; kk < 4; ++kk) qf[kk] = *(const LAS bf16x8*)(P + Mp::Q + (16 * tbk + i) * RQ_P + (32 * kk + 8 * fq) * 2);
#pragma unroll
        for (int kk = 0; kk < 4; ++kk)
#pragma unroll
            for (int eb = 0; eb < NEB; ++eb) RC_TR2(sf[kk][eb], SBc + (32 * kk + 8 * fq + q4) * Mp::VP + (16 * eb + 4 * p4) * 2, 4 * Mp::VP);
#pragma unroll
        for (int sb = 0; sb < 2; ++sb) if (sb <= tbk) {
#pragma unroll
            for (int kk = 0; kk < 4; ++kk) kf[sb][kk] = *(const LAS bf16x8*)(P + Mp::K + (16 * sb + i) * RQ_P + (32 * kk + 8 * fq) * 2); }
        f32x4 o[NEB];
#pragma unroll
        for (int eb = 0; eb < NEB; ++eb) o[eb] = (f32x4){0.f, 0.f, 0.f, 0.f};
#pragma unroll
        for (int kk = 0; kk < 4; ++kk)
#pragma unroll
            for (int eb = 0; eb < NEB; ++eb) o[eb] = __builtin_amdgcn_mfma_f32_16x16x32_bf16(sf[kk][eb], qf[kk], o[eb], 0, 0, 0);
        asm volatile("" ::: "memory");
#pragma unroll
        for (int sb = 2; sb < 4; ++sb) if (sb <= tbk) {
#pragma unroll
            for (int kk = 0; kk < 4; ++kk) kf[sb][kk] = *(const LAS bf16x8*)(P + Mp::K + (16 * sb + i) * RQ_P + (32 * kk + 8 * fq) * 2); }
#pragma unroll
        for (int ks = 0; ks < 2; ++ks) if (2 * ks <= tbk) {
#pragma unroll
            for (int eb = 0; eb < NEB; ++eb) RC_TR2(vf[ks][eb], P + Mp::V + (32 * ks + 4 * fq + q4) * Mp::VP + (16 * eb + 4 * p4) * 2, 16 * Mp::VP); }
        f32x4 pt[4];
#pragma unroll
        for (int sb = 0; sb < 4; ++sb) { pt[sb] = (f32x4){0.f, 0.f, 0.f, 0.f};
            if (sb <= tbk) { f32x4 acc = (f32x4){0.f, 0.f, 0.f, 0.f};
#pragma unroll
                for (int kk = 0; kk < 4; ++kk) acc = __builtin_amdgcn_mfma_f32_16x16x32_bf16(kf[sb][kk], qf[kk], acc, 0, 0, 0);
#pragma unroll
                for (int r = 0; r < 4; ++r) { const bool ok = (sb < tbk) || (4 * fq + r <= i); pt[sb][r] = ok ? acc[r] : 0.f; } } }
#pragma unroll
        for (int ks = 0; ks < 2; ++ks) if (2 * ks <= tbk) {
            v4u w; w.x = cvtpk(pt[2 * ks][0], pt[2 * ks][1]); w.y = cvtpk(pt[2 * ks][2], pt[2 * ks][3]); w.z = cvtpk(pt[2 * ks + 1][0], pt[2 * ks + 1][1]); w.w = cvtpk(pt[2 * ks + 1][2], pt[2 * ks + 1][3]);
            const bf16x8 pf = __builtin_bit_cast(bf16x8, w);
#pragma unroll
            for (int eb = 0; eb < NEB; ++eb) o[eb] = __builtin_amdgcn_mfma_f32_16x16x32_bf16(vf[ks][eb], pf, o[eb], 0, 0, 0); }
        bf16* hp = outrow + 4 * fq; float rden = 1.0f;
        if (NEB == 3) { const float eqt = ((const LAS float*)(P + Mp::EQ))[16 * tbk + i]; const float den = __shfl(o[NEB - 1][0], i) * eqt; rden = __builtin_amdgcn_rcpf(fmaxf(fabsf(den), 1.0f)) * eqt; }
        { v2u w; w.x = cvtpk(o[0][0] * rden, o[0][1] * rden); w.y = cvtpk(o[0][2] * rden, o[0][3] * rden); *(GAS v2u*)(hp) = w; w.x = cvtpk(o[1][0] * rden, o[1][1] * rden); w.y = cvtpk(o[1][2] * rden, o[1][3] * rden); *(GAS v2u*)(hp + 16) = w; }
        __builtin_amdgcn_s_setprio(0);
    } else {
        const int wq = wave - 4;
        bf16x8 af[2][NEB], bfr[2][2];
#pragma unroll
        for (int ks = 0; ks < 2; ++ks) {
#pragma unroll
            for (int eb = 0; eb < NEB; ++eb) RC_TR2(af[ks][eb], P + Mp::V + (32 * ks + 8 * fq + q4) * Mp::VP + (16 * eb + 4 * p4) * 2, 4 * Mp::VP);
#pragma unroll
            for (int dbi = 0; dbi < 2; ++dbi) RC_TR2(bfr[ks][dbi], P + Mp::K + (32 * ks + 8 * fq + q4) * RQ_P + (16 * (2 * wq + dbi) + 4 * p4) * 2, 4 * RQ_P); }
        float eg[2];
#pragma unroll
        for (int dbi = 0; dbi < 2; ++dbi) eg[dbi] = __expf(((const LAS float*)(P + Mp::TB))[16 * (2 * wq + dbi) + i]);
#pragma unroll
        for (int ks = 0; ks < 2; ++ks)
#pragma unroll
            for (int eb = 0; eb < NEB; ++eb)
#pragma unroll
                for (int dbi = 0; dbi < 2; ++dbi) Sst[eb][dbi] = __builtin_amdgcn_mfma_f32_16x16x32_bf16(af[ks][eb], bfr[ks][dbi], Sst[eb][dbi], 0, 0, 0);
#pragma unroll
        for (int dbi = 0; dbi < 2; ++dbi)
#pragma unroll
            for (int eb = 0; eb < NEB; ++eb) { Sst[eb][dbi] = Sst[eb][dbi] * eg[dbi]; v2u o; o.x = cvtpk(Sst[eb][dbi][0], Sst[eb][dbi][1]); o.y = cvtpk(Sst[eb][dbi][2], Sst[eb][dbi][3]);
                *(LAS v2u*)(SBn + (16 * (2 * wq + dbi) + i) * Mp::VP + (16 * eb + 4 * fq) * 2) = o; }
    }
#undef RC_TR2
}
template <int NEB>
__device__ __forceinline__ void rec_unit(const Frame& F, const RecP R) {
    typedef RecMap<NEB> Mp;
    const int lane = lane_now(), tid = F.wave * 64 + lane;
    LAS unsigned char* L = F.lds + RING_OFF;
    const int b = R.b, dir = R.dir;
#define RC_T(c, tau) (dir ? (T - 1 - (64 * (c) + (tau))) : (64 * (c) + (tau)))
#define RC_TOK(c, tau) ((size_t)b * T + RC_T(c, tau))
    for (int x = tid; x < Mp::SBSZ / 4; x += NWAVES * 64) ((LAS unsigned*)(L + Mp::SB))[x] = 0u;
    if (NEB == 3 && tid < 128) { LAS unsigned char* vr = L + (tid >> 6) * Mp::PAR + Mp::V + (tid & 63) * Mp::VP + 64;
        *(LAS unsigned short*)(vr + 2) = (unsigned short)0; *(LAS unsigned*)(vr + 4) = 0u; v2u o; o.x = 0u; o.y = 0u; *(LAS v2u*)(vr + 8) = o; *(LAS v2u*)(vr + 16) = o; *(LAS v2u*)(vr + 24) = o; }
    v4u rqA[2], rkA[2], rvA, rqB[2], rkB[2], rvB; float rgA, rgB, reA = 0.f, rsA = 0.f, reB = 0.f, rsB = 0.f;
#define RC_LOAD(cc, S) do { const int c_ = (cc) < T / 64 ? (cc) : T / 64 - 1; \
        _Pragma("unroll") for (int k = 0; k < 2; ++k) { const int ch = tid + 512 * k, row = ch >> 4, c16 = ch & 15; const size_t o = (size_t)RC_T(c_, row) * R.qs + c16 * 8; \
            rq##S[k] = *(const GAS v4u*)(R.qin + o); rk##S[k] = *(const GAS v4u*)(R.kin + o); } \
        rv##S = *(const GAS v4u*)(R.vsrc + (size_t)RC_T(c_, (tid & 255) >> 2) * 32 + (tid & 3) * 8); \
        rg##S = R.gtab[(size_t)c_ * 128 + (tid & 127)]; \
        if (NEB == 3) { re##S = R.eq[(size_t)c_ * 64 + (tid & 63)]; rs##S = R.ek[(size_t)c_ * 64 + ((tid & 255) >> 2)]; } } while (0)
#define RC_STAGE(par, S) do { LAS unsigned char* P = L + (par) * Mp::PAR; \
        _Pragma("unroll") for (int k = 0; k < 2; ++k) { const int ch = tid + 512 * k, row = ch >> 4, c16 = ch & 15; \
            *(LAS v4u*)(P + Mp::Q + row * RQ_P + c16 * 16) = rq##S[k]; *(LAS v4u*)(P + Mp::K + row * RQ_P + c16 * 16) = rk##S[k]; } \
        ((LAS float*)(P + Mp::TB))[tid & 127] = rg##S;     \
        if (NEB == 3) { const float sc_ = rs##S;       \
            rv##S.x = cvtpk(bflo(rv##S.x) * sc_, bfhi(rv##S.x) * sc_); rv##S.y = cvtpk(bflo(rv##S.y) * sc_, bfhi(rv##S.y) * sc_); rv##S.z = cvtpk(bflo(rv##S.z) * sc_, bfhi(rv##S.z) * sc_); rv##S.w = cvtpk(bflo(rv##S.w) * sc_, bfhi(rv##S.w) * sc_); \
            *(LAS unsigned short*)(P + Mp::V + ((tid & 255) >> 2) * Mp::VP + 64) = (unsigned short)(cvtpk(sc_, sc_) & 0xffffu); \
            ((LAS float*)(P + Mp::EQ))[tid & 63] = re##S; } \
        { v2u o; o.x = rv##S.x; o.y = rv##S.y; *(LAS v2u*)(P + Mp::V + ((tid & 255) >> 2) * Mp::VP + (tid & 3) * 16) = o; o.x = rv##S.z; o.y = rv##S.w; *(LAS v2u*)(P + Mp::V + ((tid & 255) >> 2) * Mp::VP + (tid & 3) * 16 + 8) = o; } } while (0)
    RC_LOAD(0, A);
    RC_STAGE(0, A);
    RC_LOAD(1, B);
    RC_LOAD(2, A);
    f32x4 Sst[NEB][2];
#pragma unroll
    for (int eb = 0; eb < NEB; ++eb)
#pragma unroll
        for (int dbi = 0; dbi < 2; ++dbi) Sst[eb][dbi] = (f32x4){0.f, 0.f, 0.f, 0.f};
    __syncthreads();
    LAS unsigned char* P0 = L; LAS unsigned char* P1 = L + Mp::PAR; LAS unsigned char* S0 = L + Mp::SB; LAS unsigned char* S1 = L + Mp::SB + Mp::SBSZ;
    const int orow = 16 * (F.wave & 3) + (lane & 15);
    for (int c = 0; c < T / 64; c += 2) {
        RC_STAGE(1, B); RC_LOAD(c + 3, B);
        rec_compute<NEB>(F.wave, lane, P0, S0, S1, Sst, R.out + RC_TOK(c, orow) * 1024);
        __syncthreads();
        RC_STAGE(0, A); RC_LOAD(c + 4, A);
        rec_compute<NEB>(F.wave, lane, P1, S1, S0, Sst, R.out + RC_TOK(c + 1, orow) * 1024);
        __syncthreads();
    }
#undef RC_LOAD
#undef RC_STAGE
#undef RC_TOK
#undef RC_T
}
__device__ __forceinline__ void mlstm_chunk_unit(const Frame& F, const Args& A, int unit) {
    const int es = unit & 7, dir = (unit >> 3) & 1, h = (unit >> 4) & 3, b = unit >> 6;
    RecP R; const size_t chain = (size_t)((dir * 4 + b) * 4 + h) * T * 128;
    (void)chain; const bf16* Ub = (const bf16*)(A.ws + WS_U) + (size_t)b * T * UW + h * 128;
    R.qin = Ub + U_QA; R.kin = Ub + U_KA; R.qs = UW;
    R.eq = (const float*)(A.ws + WS_EQM) + (size_t)(((b * 4 + h) * 2 + dir) * 64) * 64; R.ek = (const float*)(A.ws + WS_EKM) + (size_t)(((b * 4 + h) * 2 + dir) * 64) * 64;
    R.vsrc = (const bf16*)(A.ws + WS_VINM) + (size_t)(((b * 4 + h) * 8 + es)) * T * 32; R.gtab = (const float*)(A.ws + WS_GTABM) + (size_t)((((b * 4 + h) * 2 + dir) * 64)) * 128;
    R.out = (bf16*)(A.ws + WS_HA) + (size_t)dir * M * 1024 + h * 256 + es * 32; R.b = b; R.dir = dir;
    rec_unit<3>(F, R);
}
__device__ __forceinline__ void hgrn_chunk_unit(const Frame& F, const Args& A, int unit) {
    const int es = unit & 3, dir = (unit >> 2) & 1, h = (unit >> 3) & 7, b = unit >> 6;
    RecP R; const size_t chain = (size_t)((dir * 4 + b) * 8 + h) * T * 128;
    R.qin = (const bf16*)(A.ws + WS_QIN) + chain; R.kin = (const bf16*)(A.ws + WS_KIN) + chain; R.qs = 128; R.eq = nullptr; R.ek = nullptr;
    R.vsrc = (const bf16*)(A.ws + WS_VINH) + (size_t)(((b * 8 + h) * 4 + es)) * T * 32; R.gtab = (const float*)(A.ws + WS_GTAB) + (size_t)((((b * 8 + h) * 2 + dir) * 64)) * 128;
    R.out = (bf16*)(A.ws + WS_HB) + (size_t)dir * M * 1024 + h * 128 + es * 32; R.b = b; R.dir = dir;
    rec_unit<2>(F, R);
}
#ifndef MK_ONE_LAUNCH
#define MK_ONE_LAUNCH 1
#endif
constexpr int N_PHASES = 21;
__global__ void __launch_bounds__(NWAVES * 64, 2) trunk_fwd(Args args) {
    extern __shared__ __attribute__((aligned(16))) unsigned char lds[];
    Frame F;
    F.lds = (LAS unsigned char*)lds;
    F.wave = __builtin_amdgcn_readfirstlane(threadIdx.x >> 6);
    F.G = gridDim.x;
    const Args& A = args;
    { const int tid0 = F.wave * 64 + lane_now(); for (int u = tid0; u < (LDS_BYTES - LDSCTL_OFF) / 4; u += NWAVES * 64) ((LAS unsigned*)(F.lds + LDSCTL_OFF))[u] = 0u; }
    __syncthreads();
    gu32* ctl = (gu32*)(args.ws + WS_CTL);
    const int lo = args.ph_lo, hi = args.ph_hi;
    XcdBarrier bar; bar.bar = (unsigned*)(ctl + CW_BAR); bar.x = 0; bar.st = nullptr;
    if (hi - lo > 1) bar = xcd_barrier_post((unsigned*)(ctl + CW_BAR), (volatile LAS unsigned*)(F.lds + MISC_OFF) + 8, F.wave);
#ifndef PROBE_MASK
#define PROBE_MASK 0u
#endif
#define IN(k) (lo <= (k) && (k) < hi)
#define REP(k) _Pragma("unroll") for (int rep_ = 0; rep_ < (((PROBE_MASK >> (k)) & 1u) ? 2 : 1); ++rep_)
#define RSEAM(k) do { if (((PROBE_MASK >> (k)) & 1u) && rep_ == 0) xcd_barrier(bar, F.wave); } while (0)
#ifndef TPROBE
#define TPROBE (-1)
#endif
#ifndef TPROBE_US
#define TPROBE_US 1000.0f
#endif
    unsigned long long tp_a = (TPROBE == 0) ? __builtin_amdgcn_s_memrealtime() : 0ull, tp_b = 0ull;
#define SEAM(k) do { if (IN(k) && IN((k) + 1)) xcd_barrier(bar, F.wave); if ((k) == TPROBE) tp_b = __builtin_amdgcn_s_memrealtime(); if ((k) + 1 == TPROBE) tp_a = __builtin_amdgcn_s_memrealtime(); } while (0)
    unsigned char* ws = args.ws;
    bf16* XB0 = (bf16*)(ws + WS_XB0); bf16* XB1 = (bf16*)(ws + WS_XB1); bf16* TBUF = (bf16*)A.out;
    const int bid = (int)blockIdx.x;
    const int kple = (args.ph_hi > 0) ? PLE_DIM : 0;

    REP(0) if (IN(0)) { p0_prologue(F, A); RSEAM(0); } SEAM(0);
    REP(1) if (IN(1)) {
        pg8::Gemm g{XB0, (const bf16*)(ws + WS_WRIN), M, UW, D}; pg8::StaticOrder S; S.init(M, UW, F.G, bid);
        pg8::EpiRecIn E{(bf16*)(ws + WS_U), UW, (bf16*)(ws + WS_VINM), (bf16*)(ws + WS_VINH), T};
        pg8::gemm_phase<pg8::EpiRecIn, pg8::StaticOrder, true, true>(F.lds + RING_OFF, g, S, E, F.wave);
        gates_mfma(F, A);
    RSEAM(1); } SEAM(1);
    REP(2) if (IN(2)) { rec_prep(F, A); xcd_barrier(bar, F.wave);
        for (int v = bid; v < 256; v += F.G) { const int x = v & 7, j = v >> 3; mlstm_chunk_unit(F, A, ((x + 8 * (j >> 3)) << 3) | (j & 7)); }
        for (int v = bid; v < 256; v += F.G) { const int x = v & 7, j = v >> 3; hgrn_chunk_unit(F, A, ((x + 8 * (j >> 2)) << 2) | (j & 3)); } RSEAM(2); } SEAM(2);
    REP(3) if (IN(3)) { p3_finalize(F, A); RSEAM(3); } SEAM(3);
    REP(4) if (IN(4)) {
        pg8::Gemm g{(const bf16*)(ws + WS_Y), (const bf16*)(ws + WS_WROUT), M, D, D}; pg8::StaticOrder S; S.init(M, D, F.G, bid);
        pg8::EpiResB E{nullptr, XB0, TBUF, D, ALPHA};
        pg8::gemm_phase<pg8::EpiResB, pg8::StaticOrder, true, true, true>(F.lds + RING_OFF, g, S, E, F.wave);
    RSEAM(4); } SEAM(4);
    REP(5) if (IN(5)) { ln_phase_b(F, A, A.in[I_LNW] + 0 * D, A.in[I_LNB] + 0 * D, TBUF, XB1); RSEAM(5); } SEAM(5);
    REP(6) if (IN(6)) {
        pg8::Gemm g{XB1, (const bf16*)(ws + WS_WFGU), M, 2 * FFN, D}; pg8::StaticOrder S; S.init(M, 2 * FFN, F.G, bid);
        pg8::EpiSwiglu E{(bf16*)(ws + WS_H), FFN, 2 * FFN / 256};
        pg8::gemm_phase<pg8::EpiSwiglu, pg8::StaticOrder, true, true>(F.lds + RING_OFF, g, S, E, F.wave);
    RSEAM(6); } SEAM(6);
    REP(7) if (IN(7)) {
        { pg8::Gemm g{(const bf16*)(ws + WS_H), (const bf16*)(ws + WS_WFDN), M, D, FFN}; pg8::StaticOrder S; S.init(M, D, F.G, bid);
          pg8::EpiResB E{nullptr, XB1, TBUF, D, ALPHA};
          pg8::gemm_phase<pg8::EpiResB, pg8::StaticOrder, true, true, true>(F.lds + RING_OFF, g, S, E, F.wave); }
        { pg8::Gemm g{(const bf16*)(ws + WS_PB), (const bf16*)(ws + WS_WPP0), M, D, kple}; pg8::StaticOrder S; S.init(M, D, F.G, bid);
          pg8::EpiStoreB E{(bf16*)(ws + WS_PP), D, D / 256};
          pg8::gemm_phase<pg8::EpiStoreB, pg8::StaticOrder, true, true, true>(F.lds + RING_OFF, g, S, E, F.wave); }
    RSEAM(7); } SEAM(7);
    REP(8) if (IN(8)) { ln_phase_b(F, A, A.in[I_LNW] + 1 * D, A.in[I_LNB] + 1 * D, TBUF, XB0); RSEAM(8); } SEAM(8);
    REP(10) if (IN(10)) {
        pg8::Gemm g{XB0, (const bf16*)(ws + WS_WPG0), M, D, D}; pg8::StaticOrder S; S.init(M, D, F.G, bid);
        pg8::EpiPleB E{XB0, (const bf16*)(ws + WS_PP), XB1, nullptr, D};
        pg8::gemm_phase<pg8::EpiPleB, pg8::StaticOrder, true, true>(F.lds + RING_OFF, g, S, E, F.wave);
    RSEAM(10); } SEAM(10);
#ifdef SLEEP_PROBE_US
    { const unsigned long long t0 = __builtin_amdgcn_s_memrealtime(); while (__builtin_amdgcn_s_memrealtime() - t0 < (unsigned long long)(SLEEP_PROBE_US * 100)) __builtin_amdgcn_s_sleep(32); }
#endif
    REP(11) if (IN(11)) {
        pg8::Gemm g{XB1, (const bf16*)(ws + WS_WQKV), M, NQKV, D}; pg8::StaticOrder S; S.init(M, NQKV, F.G, bid);
        pg8::EpiQKVHeads E{(bf16*)(ws + WS_QKV), T, 16};
        pg8::gemm_phase<pg8::EpiQKVHeads, pg8::StaticOrder, true, true>(F.lds + RING_OFF, g, S, E, F.wave);
    RSEAM(11); } SEAM(11);
    REP(12) if (IN(12)) { na_phase_mfma(F, A); RSEAM(12); } SEAM(12);
    REP(13) if (IN(13)) {
        pg8::Gemm g{(const bf16*)(ws + WS_AO), (const bf16*)(ws + WS_WNAO), M, D, D}; pg8::StaticOrder S; S.init(M, D, F.G, bid);
        pg8::EpiResBF E{XB1, A.out, D, ALPHA};
        pg8::gemm_phase<pg8::EpiResBF, pg8::StaticOrder, true, true, true>(F.lds + RING_OFF, g, S, E, F.wave);
    RSEAM(13); } SEAM(13);
    REP(14) if (IN(14)) { ln_router_phase(F, A, A.in[I_LNW] + 2 * D, A.in[I_LNB] + 2 * D, XB0); RSEAM(14); } SEAM(14);
    REP(15) if (IN(15)) { moe_route_phase(F, A); RSEAM(15); } SEAM(15);
    REP(16) if (IN(16)) {
        const int* TILEE = (const int*)(ws + WS_TILEE); const int nrt = __builtin_amdgcn_readfirstlane(TILEE[0]);
        pg8::Gemm g{XB0, (const bf16*)(ws + WS_WMGU), nrt * 256, 2 * MOE, D}; g.Ainv = (const int*)(ws + WS_INV);
        pg8::MoeOrder S; S.base.init(nrt * 256, 2 * MOE, F.G, bid); S.tile_e = TILEE + 1; S.nN = 2 * MOE / 256;
        pg8::EpiSwiglu E{(bf16*)(ws + WS_HM), MOE, 2 * MOE / 256};
        pg8::gemm_phase<pg8::EpiSwiglu, pg8::MoeOrder, true, true, false, true>(F.lds + RING_OFF, g, S, E, F.wave);
    RSEAM(16); } SEAM(16);
    REP(17) if (IN(17)) {
        { const int* TILEE = (const int*)(ws + WS_TILEE); const int nrt = __builtin_amdgcn_readfirstlane(TILEE[0]);
          const int nra = nrt < pg8::TAIL_PM0 ? nrt : pg8::TAIL_PM0;
          { pg8::Gemm g{(const bf16*)(ws + WS_HM), (const bf16*)(ws + WS_WMDN), nra * 256, D, MOE}; pg8::MoeOrder S; S.base.init(nra * 256, D, F.G, bid); S.tile_e = TILEE + 1; S.nN = D / 256;
            pg8::EpiStoreB E{(bf16*)(ws + WS_YS), D, D / 256};
            pg8::gemm_phase<pg8::EpiStoreB, pg8::MoeOrder, true, true, true>(F.lds + RING_OFF, g, S, E, F.wave); }
          if (nrt > pg8::TAIL_PM0) {
            pg8::Gemm g{(const bf16*)(ws + WS_HM), (const bf16*)(ws + WS_WMDN), nrt * 256, D, MOE, MOE / pg8::TAIL_KS}; pg8::MoeTailOrder S{TILEE + 1, nrt - pg8::TAIL_PM0, F.G, bid, D / 256, MOE / pg8::TAIL_KS / 64};
            pg8::EpiStorePart E{(bf16*)(ws + WS_PART), D, D / 256, MOE / pg8::TAIL_KS / 64};
            pg8::gemm_phase<pg8::EpiStorePart, pg8::MoeTailOrder, true, true, true>(F.lds + RING_OFF, g, S, E, F.wave); } }
        { pg8::Gemm g{(const bf16*)(ws + WS_PB) + (size_t)M * PLE_DIM, (const bf16*)(ws + WS_WPP1), M, D, kple}; pg8::StaticOrder S; S.init(M, D, F.G, bid);
          pg8::EpiStoreB E{(bf16*)(ws + WS_PP1), D, D / 256};
          pg8::gemm_phase<pg8::EpiStoreB, pg8::StaticOrder, true, true, true>(F.lds + RING_OFF, g, S, E, F.wave); }
    RSEAM(17); } SEAM(17);
    REP(18) if (IN(18)) { ln_moe_phase(F, A, A.in[I_LNW] + 3 * D, A.in[I_LNB] + 3 * D, XB0, XB1); RSEAM(18); } SEAM(18);
    REP(20) if (IN(20)) {
        pg8::Gemm g{XB1, (const bf16*)(ws + WS_WPG1), M, D, D}; pg8::StaticOrder S; S.init(M, D, F.G, bid);
        pg8::EpiPleB E{XB1, (const bf16*)(ws + WS_PP1), nullptr, A.out, D};
        pg8::gemm_phase<pg8::EpiPleB, pg8::StaticOrder, true, true>(F.lds + RING_OFF, g, S, E, F.wave);
    }
    if (TPROBE >= 0) {
        if (TPROBE == 20) tp_b = __builtin_amdgcn_s_memrealtime();
        float* dl = (float*)(ctl + 64);
        if (bid == 0 && F.wave == 0 && lane_now() == 0) *dl = (float)(long long)(tp_b - tp_a) * 0.01f / TPROBE_US;
        xcd_barrier(bar, F.wave);
        const float sc = 1.0f + __hip_atomic_load(dl, __ATOMIC_RELAXED, __HIP_MEMORY_SCOPE_AGENT);
        const size_t gt = (size_t)blockIdx.x * (NWAVES * 64) + F.wave * 64 + lane_now(), NGT = (size_t)F.G * NWAVES * 64;
        for (size_t i = gt; i < (size_t)M * D / 4; i += NGT) { f32x4 v = ((GAS f32x4*)A.out)[i]; ((GAS f32x4*)A.out)[i] = v * sc; }
    }
#undef IN
#undef SEAM
}

extern "C" void kernel_launch(void* const* d_in, const int* in_sizes, int n_in, void* d_out, int out_size, void* d_ws, size_t ws_size, hipStream_t stream) {
    static int grid = 0;
    if (grid == 0) {
        if (n_in != 23 || in_sizes[0] != M * D || out_size != M * D || ws_size < WS_END) { fprintf(stderr, "kernel_launch: unexpected shapes (n_in %d, in0 %d, out %d, ws %zu, need %zu)\n", n_in, n_in > 0 ? in_sizes[0] : -1, out_size, ws_size, (size_t)WS_END); grid = -1; return; }
        int dev = 0, cus = 0, per_cu = 0;
        if (hipGetDevice(&dev) != hipSuccess || hipDeviceGetAttribute(&cus, hipDeviceAttributeMultiprocessorCount, dev) != hipSuccess) { grid = -1; return; }
        if (hipFuncSetAttribute((const void*)trunk_fwd, hipFuncAttributeMaxDynamicSharedMemorySize, LDS_BYTES) != hipSuccess) { fprintf(stderr, "kernel_launch: hipFuncSetAttribute failed\n"); grid = -1; return; }
        if (hipOccupancyMaxActiveBlocksPerMultiprocessor(&per_cu, (const void*)trunk_fwd, NWAVES * 64, LDS_BYTES) != hipSuccess || per_cu < 1) { fprintf(stderr, "kernel_launch: occupancy query reports %d\n", per_cu); }
        (void)hipGetLastError();
        grid = cus;
    }
    if (grid < 0) return;
    (void)hipMemsetAsync((char*)d_ws + WS_CTL, 0, CTL_ZERO_BYTES, stream);
    Args a{};
    for (int i = 0; i < 23; ++i) a.in[i] = (const float*)d_in[i];
    a.out = (float*)d_out; a.ws = (unsigned char*)d_ws;
#if MK_ONE_LAUNCH
    a.ph_lo = 0; a.ph_hi = N_PHASES;
    hipLaunchKernelGGL(trunk_fwd, dim3(grid), dim3(NWAVES * 64), LDS_BYTES, stream, a);
#else
    for (int ph = 0; ph < N_PHASES; ++ph) { a.ph_lo = ph; a.ph_hi = ph + 1; hipLaunchKernelGGL(trunk_fwd, dim3(grid), dim3(NWAVES * 64), LDS_BYTES, stream, a); }
#endif
}
```

```cpp
#include <hip/hip_runtime.h>
#include <cstdio>
#include <cstdint>
__device__ __forceinline__ int lane_now() { int l; asm volatile("v_mbcnt_lo_u32_b32 %0, -1, 0\n\tv_mbcnt_hi_u32_b32 %0, -1, %0" : "=v"(l)); return l; }
namespace pg8 {
#define PG8_LAS __attribute__((address_space(3)))
typedef unsigned short bf16_t;
typedef short bf16x8 __attribute__((ext_vector_type(8)));
typedef float f32x4 __attribute__((ext_vector_type(4)));
typedef unsigned u32x4 __attribute__((ext_vector_type(4)));
constexpr int BM = 256, BK = 64, HALF = 128, HTB = HALF * BK * 2  , STAGE_BYTES = 8 * HTB, NXCD = 8, WGM = 8;

__host__ __device__ __forceinline__ int lds_byte(int r, int c) { const int st = (r >> 4) * 2 + (c >> 5), rr = r & 15, cc = c & 31, ob = rr * 64 + cc * 2; return st * 1024 + (ob ^ (((ob >> 9) & 1) << 5)); }
__host__ __device__ __forceinline__ void stage_rc(int b, int& R, int& C) { const int st = b / 1024, sb = b % 1024, swz = sb ^ (((sb >> 9) & 1) << 5); R = (st >> 1) * 16 + swz / 64; C = (st & 1) * 32 + (swz % 64) / 2; }
__host__ __device__ __forceinline__ int perm32(int rho) { const int n = rho >> 4, i = rho & 15; return 8 * (i >> 2) + 4 * n + (i & 3); }

__host__ __device__ __forceinline__ size_t bt_tiled_off(int n, int k, int K) {
    const int pn = n >> 8, hf = (n >> 7) & 1, nr = n & 127, v = nr & 31;
    const int R = (nr & ~31) + 16 * ((v >> 2) & 1) + 4 * (v >> 3) + (v & 3);
    return ((size_t)((pn * 2 + hf) * (K / 64) + (k >> 6))) * 16384 + (size_t)lds_byte(R, k & 63);
}
__host__ __device__ __forceinline__ size_t at_tiled_off(int m, int k, int K) {
    return ((size_t)(((m >> 8) * 2 + ((m >> 7) & 1)) * (K >> 6) + (k >> 6))) * 16384 + (size_t)lds_byte(m & 127, k & 63);
}
struct Unit { int pm, pn, koff; };
struct Gemm { const bf16_t* A; const bf16_t* Bt; int M, N, K; int Kloop = 0; const int* Ainv = nullptr; };

struct StaticOrder {
    int nM, nN, nwg, G, c;
    __host__ __device__ void init(int M, int N, int G_, int c_) { nM = M / BM; nN = N / BM; nwg = nM * nN; G = G_; c = c_; }
    __host__ __device__ bool next(int i, Unit& u) const {
        const long L = (long)i * G + c; if (L >= nwg) return false;
        int wgid = (int)L; { const int q = nwg / NXCD, r = nwg % NXCD, xcd = wgid % NXCD, off = wgid / NXCD; wgid = (xcd < r ? xcd * (q + 1) : r * (q + 1) + (xcd - r) * q) + off; }
        const int nig = WGM * nN, gid = wgid / nig, fm = gid * WGM, gsz = (nM - fm) < WGM ? (nM - fm) : WGM;
        u.pm = fm + ((wgid % nig) % gsz); u.pn = (wgid % nig) / gsz; u.koff = 0; return true;
    }
    __device__ __forceinline__ void a_ready(const Unit&) const {}
    __device__ __forceinline__ void done(const Unit&) const {}
};

typedef float f32x2c_t __attribute__((ext_vector_type(2))); typedef __bf16 bf16x2c_t __attribute__((ext_vector_type(2)));
__device__ __forceinline__ unsigned cvt_pk_bf16(float lo, float hi) { f32x2c_t v = {lo, hi}; bf16x2c_t b = __builtin_convertvector(v, bf16x2c_t); return __builtin_bit_cast(unsigned, b); }
__device__ __forceinline__ float fsigmoid(float x) { return __builtin_amdgcn_rcpf(1.0f + __expf(-x)); }
__device__ __forceinline__ float fsilu(float x) { return x * fsigmoid(x); }


struct EpiBf16G {
    static constexpr bool PERM = true, AFTER_DRAIN = false;
    bf16_t* O; int ldc; int gate_pn; float* Gt;
    __device__ __forceinline__ void operator()(const f32x4 (&acc)[2][2][4][2], const Unit& u, int wr, int wc, int fr, int fq) const {
        const int row0 = u.pm * BM + wr * 64 + fr;
        if (u.pn == gate_pn) {
            if (wc == 0 && fq < 2) {
#pragma unroll
                for (int ai = 0; ai < 2; ++ai)
#pragma unroll
                    for (int m = 0; m < 4; ++m) { float* gp = Gt + (size_t)(row0 + ai * HALF + m * 16) * 16 + 8 * fq;
                        *(f32x4*)(gp) = acc[ai][0][m][0]; *(f32x4*)(gp + 4) = acc[ai][0][m][1]; }
            }
            return;
        }
        const int col0 = u.pn * BM + wc * 32 + 8 * fq;
#pragma unroll
        for (int ai = 0; ai < 2; ++ai)
#pragma unroll
            for (int m = 0; m < 4; ++m) { bf16_t* rowp = O + (size_t)(row0 + ai * HALF + m * 16) * ldc + col0;
#pragma unroll
                for (int bj = 0; bj < 2; ++bj) { const f32x4 v0 = acc[ai][bj][m][0], v1 = acc[ai][bj][m][1];
                    u32x4 w; w.x = cvt_pk_bf16(v0[0], v0[1]); w.y = cvt_pk_bf16(v0[2], v0[3]); w.z = cvt_pk_bf16(v1[0], v1[1]); w.w = cvt_pk_bf16(v1[2], v1[3]);
                    *(u32x4*)(rowp + bj * HALF) = w; } }
    }
};

struct EpiQKVHeads {
    static constexpr bool PERM = true, AFTER_DRAIN = false;
    bf16_t* O; int Tlen, nheads;
    __device__ __forceinline__ void operator()(const f32x4 (&acc)[2][2][4][2], const Unit& u, int wr, int wc, int fr, int fq) const {
        const int which = u.pn >> 3, hp = u.pn & 7;
        const int row0 = u.pm * BM + wr * 64 + fr; const int b = (u.pm * BM) / Tlen; const int t0 = row0 - b * Tlen;
#pragma unroll
        for (int bj = 0; bj < 2; ++bj) { bf16_t* hb = O + ((size_t)which * 4 * nheads + (size_t)b * nheads + (2 * hp + bj)) * (size_t)Tlen * 128 + wc * 32 + 8 * fq;
#pragma unroll
            for (int ai = 0; ai < 2; ++ai)
#pragma unroll
                for (int m = 0; m < 4; ++m) { const f32x4 v0 = acc[ai][bj][m][0], v1 = acc[ai][bj][m][1];
                    u32x4 w; w.x = cvt_pk_bf16(v0[0], v0[1]); w.y = cvt_pk_bf16(v0[2], v0[3]); w.z = cvt_pk_bf16(v1[0], v1[1]); w.w = cvt_pk_bf16(v1[2], v1[3]);
                    *(u32x4*)(hb + (size_t)(t0 + ai * HALF + m * 16) * 128) = w; } }
    }
};

struct EpiRecIn {
    static constexpr bool PERM = true, AFTER_DRAIN = false;
    bf16_t* O; int ldc; bf16_t* VM; bf16_t* VH; int Tlen;
    __device__ __forceinline__ void operator()(const f32x4 (&acc)[2][2][4][2], const Unit& u, int wr, int wc, int fr, int fq) const {
        const int row0 = u.pm * BM + wr * 64 + fr;
        const bool isvm = (u.pn >= 4 && u.pn < 8), isvh = (u.pn >= 24 && u.pn < 28);
        if (isvm || isvh) {
            const int b = (u.pm * BM) / Tlen; const int t0 = row0 - b * Tlen;
#pragma unroll
            for (int bj = 0; bj < 2; ++bj) {
                bf16_t* base = isvm ? VM + ((size_t)((b * 4 + (u.pn - 4)) * 8 + 4 * bj + wc)) * (size_t)Tlen * 32 + 8 * fq
                                    : VH + ((size_t)((b * 8 + 2 * (u.pn - 24) + bj) * 4 + wc)) * (size_t)Tlen * 32 + 8 * fq;
#pragma unroll
                for (int ai = 0; ai < 2; ++ai)
#pragma unroll
                    for (int m = 0; m < 4; ++m) { const f32x4 v0 = acc[ai][bj][m][0], v1 = acc[ai][bj][m][1];
                        u32x4 w; w.x = cvt_pk_bf16(v0[0], v0[1]); w.y = cvt_pk_bf16(v0[2], v0[3]); w.z = cvt_pk_bf16(v1[0], v1[1]); w.w = cvt_pk_bf16(v1[2], v1[3]);
                        *(u32x4*)(base + (size_t)(t0 + ai * HALF + m * 16) * 32) = w; } }
            return;
        }
        const int col0 = u.pn * BM + wc * 32 + 8 * fq;
#pragma unroll
        for (int ai = 0; ai < 2; ++ai)
#pragma unroll
            for (int m = 0; m < 4; ++m) { bf16_t* rowp = O + (size_t)(row0 + ai * HALF + m * 16) * ldc + col0;
#pragma unroll
                for (int bj = 0; bj < 2; ++bj) { const f32x4 v0 = acc[ai][bj][m][0], v1 = acc[ai][bj][m][1];
                    u32x4 w; w.x = cvt_pk_bf16(v0[0], v0[1]); w.y = cvt_pk_bf16(v0[2], v0[3]); w.z = cvt_pk_bf16(v1[0], v1[1]); w.w = cvt_pk_bf16(v1[2], v1[3]);
                    *(u32x4*)(rowp + bj * HALF) = w; } }
    }
};
struct EpiSwiglu {
    static constexpr bool PERM = true, AFTER_DRAIN = false;
    bf16_t* H; int ldh; int npn;
    __device__ __forceinline__ void operator()(const f32x4 (&acc)[2][2][4][2], const Unit& u, int wr, int wc, int fr, int fq) const {
        const int row0 = u.pm * BM + wr * 64 + fr; const int pl = u.pn % npn; const int col0 = pl * HALF + wc * 32 + 8 * fq;
#pragma unroll
        for (int ai = 0; ai < 2; ++ai)
#pragma unroll
            for (int m = 0; m < 4; ++m) { bf16_t* rowp = (bf16_t*)((unsigned char*)H + at_tiled_off(row0 + ai * HALF + m * 16, col0, ldh));
                const f32x4 g0 = acc[ai][0][m][0], g1 = acc[ai][0][m][1], u0 = acc[ai][1][m][0], u1 = acc[ai][1][m][1];
                float o[8];
#pragma unroll
                for (int i = 0; i < 4; ++i) { o[i] = fsilu(g0[i]) * u0[i]; o[4 + i] = fsilu(g1[i]) * u1[i]; }
                u32x4 w; w.x = cvt_pk_bf16(o[0], o[1]); w.y = cvt_pk_bf16(o[2], o[3]); w.z = cvt_pk_bf16(o[4], o[5]); w.w = cvt_pk_bf16(o[6], o[7]);
                *(u32x4*)rowp = w; }
    }
};
struct EpiResF32 {
    static constexpr bool PERM = true, AFTER_DRAIN = false;
    const float* SRC; float* DST; int ldc; float alpha;
    __device__ __forceinline__ void operator()(const f32x4 (&acc)[2][2][4][2], const Unit& u, int wr, int wc, int fr, int fq) const {
        const int row0 = u.pm * BM + wr * 64 + fr; const int col0 = u.pn * BM + wc * 32 + 8 * fq;
#pragma unroll
        for (int ai = 0; ai < 2; ++ai)
#pragma unroll
            for (int m = 0; m < 4; ++m) { const size_t ro = (size_t)(row0 + ai * HALF + m * 16) * ldc + col0;
#pragma unroll
                for (int bj = 0; bj < 2; ++bj)
#pragma unroll
                    for (int n = 0; n < 2; ++n) { const size_t o = ro + bj * HALF + 4 * n; const f32x4 s = *(const f32x4*)(SRC + o); *(f32x4*)(DST + o) = s * alpha + acc[ai][bj][m][n]; } }
    }
};
struct EpiStoreF32 {
    static constexpr bool PERM = true, AFTER_DRAIN = false;
    float* O; int ldc; int npn;
    __device__ __forceinline__ void operator()(const f32x4 (&acc)[2][2][4][2], const Unit& u, int wr, int wc, int fr, int fq) const {
        const int row0 = u.pm * BM + wr * 64 + fr; const int col0 = (u.pn % npn) * BM + wc * 32 + 8 * fq;
#pragma unroll
        for (int ai = 0; ai < 2; ++ai)
#pragma unroll
            for (int m = 0; m < 4; ++m) { float* ro = O + (size_t)(row0 + ai * HALF + m * 16) * ldc + col0;
#pragma unroll
                for (int bj = 0; bj < 2; ++bj)
#pragma unroll
                    for (int n = 0; n < 2; ++n) *(f32x4*)(ro + bj * HALF + 4 * n) = acc[ai][bj][m][n]; }
    }
};
struct EpiPle {
    static constexpr bool PERM = true, AFTER_DRAIN = false;
    float* XF; const float* PP; bf16_t* XB; int ldc;
    __device__ __forceinline__ void operator()(const f32x4 (&acc)[2][2][4][2], const Unit& u, int wr, int wc, int fr, int fq) const {
        const int row0 = u.pm * BM + wr * 64 + fr; const int col0 = u.pn * BM + wc * 32 + 8 * fq;
#pragma unroll
        for (int ai = 0; ai < 2; ++ai)
#pragma unroll
            for (int m = 0; m < 4; ++m) { const size_t ro = (size_t)(row0 + ai * HALF + m * 16) * ldc + col0;
#pragma unroll
                for (int bj = 0; bj < 2; ++bj) { f32x4 o[2];
#pragma unroll
                    for (int n = 0; n < 2; ++n) { const size_t of = ro + bj * HALF + 4 * n; const f32x4 x = *(const f32x4*)(XF + of), pp = *(const f32x4*)(PP + of); const f32x4 a = acc[ai][bj][m][n];
                        f32x4 r; r[0] = x[0] + fsigmoid(a[0]) * pp[0]; r[1] = x[1] + fsigmoid(a[1]) * pp[1]; r[2] = x[2] + fsigmoid(a[2]) * pp[2]; r[3] = x[3] + fsigmoid(a[3]) * pp[3];
                        *(f32x4*)(XF + of) = r; o[n] = r; }
                    u32x4 w; w.x = cvt_pk_bf16(o[0][0], o[0][1]); w.y = cvt_pk_bf16(o[0][2], o[0][3]); w.z = cvt_pk_bf16(o[1][0], o[1][1]); w.w = cvt_pk_bf16(o[1][2], o[1][3]);
                    if (XB) *(u32x4*)(XB + ro + bj * HALF) = w; } }
    }
};

__device__ __forceinline__ float bf_lo(unsigned w) { return __builtin_bit_cast(float, w << 16); }
__device__ __forceinline__ float bf_hi(unsigned w) { return __builtin_bit_cast(float, w & 0xffff0000u); }
typedef unsigned u32x2 __attribute__((ext_vector_type(2)));
struct EpiResB {
    static constexpr bool PERM = true, AFTER_DRAIN = false;
    const float* SRCF_unused; const bf16_t* SRCB; bf16_t* DSTB; int ldc; float alpha;
    __device__ __forceinline__ void operator()(const f32x4 (&acc)[2][2][4][2], const Unit& u, int wr, int wc, int fr, int fq) const {
        const int row0 = u.pm * BM + wr * 64 + fr; const int col0 = u.pn * BM + wc * 32 + 8 * fq;
        u32x4 sv[2][4][2];
#pragma unroll
        for (int ai = 0; ai < 2; ++ai)
#pragma unroll
            for (int m = 0; m < 4; ++m)
#pragma unroll
                for (int bj = 0; bj < 2; ++bj) sv[ai][m][bj] = *(const u32x4*)(SRCB + (size_t)(row0 + ai * HALF + m * 16) * ldc + col0 + bj * HALF);
#pragma unroll
        for (int ai = 0; ai < 2; ++ai)
#pragma unroll
            for (int m = 0; m < 4; ++m)
#pragma unroll
                for (int bj = 0; bj < 2; ++bj) { const size_t o = (size_t)(row0 + ai * HALF + m * 16) * ldc + col0 + bj * HALF; const u32x4 w0 = sv[ai][m][bj];
                    const f32x4 s0 = (f32x4){bf_lo(w0.x), bf_hi(w0.x), bf_lo(w0.y), bf_hi(w0.y)}, s1 = (f32x4){bf_lo(w0.z), bf_hi(w0.z), bf_lo(w0.w), bf_hi(w0.w)};
                    const f32x4 v0 = s0 * alpha + acc[ai][bj][m][0], v1 = s1 * alpha + acc[ai][bj][m][1];
                    u32x4 w; w.x = cvt_pk_bf16(v0[0], v0[1]); w.y = cvt_pk_bf16(v0[2], v0[3]); w.z = cvt_pk_bf16(v1[0], v1[1]); w.w = cvt_pk_bf16(v1[2], v1[3]);
                    *(u32x4*)(DSTB + o) = w; }
    }
};
struct EpiResBF {
    static constexpr bool PERM = true, AFTER_DRAIN = false;
    const bf16_t* SRCB; float* DSTF; int ldc; float alpha;
    __device__ __forceinline__ void operator()(const f32x4 (&acc)[2][2][4][2], const Unit& u, int wr, int wc, int fr, int fq) const {
        const int row0 = u.pm * BM + wr * 64 + fr; const int col0 = u.pn * BM + wc * 32 + 8 * fq;
        u32x4 sv[2][4][2];
#pragma unroll
        for (int ai = 0; ai < 2; ++ai)
#pragma unroll
            for (int m = 0; m < 4; ++m)
#pragma unroll
                for (int bj = 0; bj < 2; ++bj) sv[ai][m][bj] = *(const u32x4*)(SRCB + (size_t)(row0 + ai * HALF + m * 16) * ldc + col0 + bj * HALF);
#pragma unroll
        for (int ai = 0; ai < 2; ++ai)
#pragma unroll
            for (int m = 0; m < 4; ++m)
#pragma unroll
                for (int bj = 0; bj < 2; ++bj) { const size_t o = (size_t)(row0 + ai * HALF + m * 16) * ldc + col0 + bj * HALF; const u32x4 w = sv[ai][m][bj];
                    const f32x4 s0 = (f32x4){bf_lo(w.x), bf_hi(w.x), bf_lo(w.y), bf_hi(w.y)}, s1 = (f32x4){bf_lo(w.z), bf_hi(w.z), bf_lo(w.w), bf_hi(w.w)};
                    *(f32x4*)(DSTF + o) = s0 * alpha + acc[ai][bj][m][0]; *(f32x4*)(DSTF + o + 4) = s1 * alpha + acc[ai][bj][m][1]; }
    }
};
struct EpiStoreB {
    static constexpr bool PERM = true, AFTER_DRAIN = false;
    bf16_t* O; int ldc; int npn;
    __device__ __forceinline__ void operator()(const f32x4 (&acc)[2][2][4][2], const Unit& u, int wr, int wc, int fr, int fq) const {
        const int row0 = u.pm * BM + wr * 64 + fr; const int col0 = (u.pn % npn) * BM + wc * 32 + 8 * fq;
#pragma unroll
        for (int ai = 0; ai < 2; ++ai)
#pragma unroll
            for (int m = 0; m < 4; ++m) { bf16_t* rowp = O + (size_t)(row0 + ai * HALF + m * 16) * ldc + col0;
#pragma unroll
                for (int bj = 0; bj < 2; ++bj) { const f32x4 v0 = acc[ai][bj][m][0], v1 = acc[ai][bj][m][1];
                    u32x4 w; w.x = cvt_pk_bf16(v0[0], v0[1]); w.y = cvt_pk_bf16(v0[2], v0[3]); w.z = cvt_pk_bf16(v1[0], v1[1]); w.w = cvt_pk_bf16(v1[2], v1[3]);
                    *(u32x4*)(rowp + bj * HALF) = w; } }
    }
};
struct EpiPleB {
    static constexpr bool PERM = true, AFTER_DRAIN = false;
    const bf16_t* XIN; const bf16_t* PP; bf16_t* XOUT; float* OUTF; int ldc;
    __device__ __forceinline__ void operator()(const f32x4 (&acc)[2][2][4][2], const Unit& u, int wr, int wc, int fr, int fq) const {
        const int row0 = u.pm * BM + wr * 64 + fr; const int col0 = u.pn * BM + wc * 32 + 8 * fq;
#pragma unroll
        for (int ai = 0; ai < 2; ++ai) {
            u32x4 xv[4][2], pv[4][2];
#pragma unroll
            for (int m = 0; m < 4; ++m)
#pragma unroll
                for (int bj = 0; bj < 2; ++bj) { const size_t o = (size_t)(row0 + ai * HALF + m * 16) * ldc + col0 + bj * HALF; xv[m][bj] = *(const u32x4*)(XIN + o); pv[m][bj] = *(const u32x4*)(PP + o); }
#pragma unroll
            for (int m = 0; m < 4; ++m)
#pragma unroll
                for (int bj = 0; bj < 2; ++bj) { const size_t o = (size_t)(row0 + ai * HALF + m * 16) * ldc + col0 + bj * HALF; const u32x4 xw = xv[m][bj], pw = pv[m][bj];
                    const float xs[8] = {bf_lo(xw.x), bf_hi(xw.x), bf_lo(xw.y), bf_hi(xw.y), bf_lo(xw.z), bf_hi(xw.z), bf_lo(xw.w), bf_hi(xw.w)};
                    const float ps[8] = {bf_lo(pw.x), bf_hi(pw.x), bf_lo(pw.y), bf_hi(pw.y), bf_lo(pw.z), bf_hi(pw.z), bf_lo(pw.w), bf_hi(pw.w)};
                    float r[8];
#pragma unroll
                    for (int i = 0; i < 4; ++i) { r[i] = xs[i] + fsigmoid(acc[ai][bj][m][0][i]) * ps[i]; r[4 + i] = xs[4 + i] + fsigmoid(acc[ai][bj][m][1][i]) * ps[4 + i]; }
                    if (XOUT) { u32x4 w; w.x = cvt_pk_bf16(r[0], r[1]); w.y = cvt_pk_bf16(r[2], r[3]); w.z = cvt_pk_bf16(r[4], r[5]); w.w = cvt_pk_bf16(r[6], r[7]); *(u32x4*)(XOUT + o) = w; }
                    if (OUTF) { *(f32x4*)(OUTF + o) = (f32x4){r[0], r[1], r[2], r[3]}; *(f32x4*)(OUTF + o + 4) = (f32x4){r[4], r[5], r[6], r[7]}; } }
        }
    }
};

constexpr int TAIL_PM0 = 128, TAIL_KS = 8, TAIL_ROWS = 8 * 256;
struct MoeTailOrder {
    const int* tile_e; int ntail, G, c, nN, ktiles;
    __device__ __forceinline__ bool next(int i, Unit& u) const {
        const int L = i * G + c; if (L >= ntail * nN * TAIL_KS) return false;
        const int ks = L & (TAIL_KS - 1), pn = (L >> 3) % nN, pm = TAIL_PM0 + (L >> 3) / nN;
        u.pm = pm; u.pn = tile_e[pm] * nN + pn; u.koff = ks * ktiles * 16384; return true; }
    __device__ __forceinline__ void a_ready(const Unit&) const {}
    __device__ __forceinline__ void done(const Unit&) const {}
};
struct EpiStorePart {
    static constexpr bool PERM = true, AFTER_DRAIN = false;
    bf16_t* O; int ldc; int npn; int ktiles;
    __device__ __forceinline__ void operator()(const f32x4 (&acc)[2][2][4][2], const Unit& u, int wr, int wc, int fr, int fq) const {
        const int ks = u.koff / (ktiles * 16384);
        const int row0 = (u.pm - TAIL_PM0) * BM + wr * 64 + fr; const int col0 = (u.pn % npn) * BM + wc * 32 + 8 * fq;
        bf16_t* base = O + (size_t)ks * TAIL_ROWS * ldc;
#pragma unroll
        for (int ai = 0; ai < 2; ++ai)
#pragma unroll
            for (int m = 0; m < 4; ++m) { bf16_t* ro = base + (size_t)(row0 + ai * HALF + m * 16) * ldc + col0;
#pragma unroll
                for (int bj = 0; bj < 2; ++bj) { const f32x4 v0 = acc[ai][bj][m][0], v1 = acc[ai][bj][m][1];
                    u32x4 w; w.x = cvt_pk_bf16(v0[0], v0[1]); w.y = cvt_pk_bf16(v0[2], v0[3]); w.z = cvt_pk_bf16(v1[0], v1[1]); w.w = cvt_pk_bf16(v1[2], v1[3]);
                    *(u32x4*)(ro + bj * HALF) = w; } }
    }
};
struct MoeOrder {
    StaticOrder base; const int* tile_e; int nN;
    __device__ __forceinline__ bool next(int i, Unit& u) const { if (!base.next(i, u)) return false; u.pn += tile_e[u.pm] * nN; return true; }
    __device__ __forceinline__ void a_ready(const Unit&) const {}
    __device__ __forceinline__ void done(const Unit&) const {}
};

template <class Epi, class Sched, bool ALIGN_EPI = false, bool SP2 = false, bool ATILED = false, bool AGATHER = false>
__device__ __forceinline__ void gemm_phase(PG8_LAS unsigned char* lds, const Gemm g, const Sched& S, const Epi& E, int wave_s) {
    const int lane = lane_now(), wid = wave_s, tid = wave_s * 64 + lane, wr = wid >> 2, wc = wid & 3, fr = lane & 15, fq = lane >> 4;
    const int K = g.K, nt = (g.Kloop ? g.Kloop : K) / BK;
    unsigned voffA[2], voffB[2];
    unsigned gP[2] = {0u, 0u}, gN[2] = {0u, 0u}, ridx2 = 0u, cC2 = 0u;
#pragma unroll
    for (int i = 0; i < 2; ++i) { int R, C; stage_rc(tid * 16 + i * 8192, R, C); const int Rb = Epi::PERM ? ((R & ~31) + perm32(R & 31)) : R;
        voffA[i] = ATILED ? (unsigned)(tid * 16 + i * 8192) : (unsigned)(R * K + C) * 2u;     voffB[i] = (unsigned)(tid * 16 + i * 8192); (void)Rb; if (i == 0) { ridx2 = (unsigned)R * 4u; cC2 = (unsigned)C * 2u; } }
    const size_t kstep = (size_t)(BK * 2);
    const size_t kstepB = (size_t)(HALF * BK * 2);
    const size_t kstepA = ATILED ? kstepB : kstep;
    const size_t hstep = (size_t)HALF * K * 2;
    const size_t tstep = 2 * hstep;
    const unsigned ldsw = (unsigned)wid * 1024u;
    const int aoff = lds_byte(wr * 64 + fr, fq * 8), boff = lds_byte(wc * 32 + fr, fq * 8);
#define PG8_SA(b, h) (((b) * 2 + (h)) * HTB)
#define PG8_SB(b, h) ((4 + (b) * 2 + (h)) * HTB)
#define PG8_STAGE(bufoff, gbase, voff) do { _Pragma("unroll") for (int _i = 0; _i < 2; ++_i) \
        __builtin_amdgcn_global_load_lds((const unsigned*)((const char*)(gbase) + (voff)[_i]), (PG8_LAS unsigned*)(lds + (bufoff) + ldsw + _i * 8192), 16, 0, 0); } while (0)
#define PG8_LDA(dst, b, h) do { _Pragma("unroll") for (int m = 0; m < 4; ++m) _Pragma("unroll") for (int k = 0; k < 2; ++k) dst[m][k] = *(const PG8_LAS bf16x8*)(lds + PG8_SA(b, h) + aoff + m * 2048 + k * 1024); } while (0)
#define PG8_LDB(dst, b, h) do { _Pragma("unroll") for (int n = 0; n < 2; ++n) _Pragma("unroll") for (int k = 0; k < 2; ++k) dst[n][k] = *(const PG8_LAS bf16x8*)(lds + PG8_SB(b, h) + boff + n * 2048 + k * 1024); } while (0)
#define PG8_GIDX(dst, pm_) do { const int* _ip = g.Ainv + (size_t)(pm_) * 128;        \
        asm volatile("global_load_dword %0, %1, %2" : "+v"(dst[0]) : "v"(ridx2), "s"(_ip) : "memory"); asm volatile("global_load_dword %0, %1, %2 offset:256" : "+v"(dst[1]) : "v"(ridx2), "s"(_ip) : "memory"); } while (0)
#define PG8_STA(bufoff, kptr, h_, nx_) do { if constexpr (AGATHER) { const unsigned _s = ((nx_) && last) ? gN[h_] : gP[h_]; unsigned _g[2] = { (_s & 0xffffu) * (unsigned)(K * 2) + cC2, (_s >> 16) * (unsigned)(K * 2) + cC2 }; PG8_STAGE(bufoff, kptr, _g); } \
        else PG8_STAGE(bufoff, (kptr) + (h_) * hstep, voffA); } while (0)
#define PG8_MMA(ai, bj, At, Bt) do { __builtin_amdgcn_s_setprio(1); _Pragma("unroll") for (int m = 0; m < 4; ++m) _Pragma("unroll") for (int n = 0; n < 2; ++n) _Pragma("unroll") for (int k = 0; k < 2; ++k) \
        acc[ai][bj][m][n] = __builtin_amdgcn_mfma_f32_16x16x32_bf16(Bt[n][k], At[m][k], acc[ai][bj][m][n], 0, 0, 0); __builtin_amdgcn_s_setprio(0); } while (0)
#define PG8_WAIT_V(n) asm volatile("s_waitcnt vmcnt(" #n ")" ::: "memory")
#define PG8_WAIT_L(n) asm volatile("s_waitcnt lgkmcnt(" #n ")" ::: "memory")
#define PG8_BAR __builtin_amdgcn_s_barrier()
#define PG8_SCHED __builtin_amdgcn_sched_barrier(0)
    Unit cur, nxt; int ui = 0;
    if (!S.next(0, cur)) return;
    f32x4 acc[2][2][4][2];
#pragma unroll
    for (int a = 0; a < 2; ++a)
#pragma unroll
        for (int b = 0; b < 2; ++b)
#pragma unroll
            for (int m = 0; m < 4; ++m)
#pragma unroll
                for (int n = 0; n < 2; ++n) acc[a][b][m][n] = (f32x4){0.f, 0.f, 0.f, 0.f};
    bf16x8 At[4][2], B0[2][2], B1[2][2];
    const char* cA = AGATHER ? (const char*)g.A : (const char*)g.A + (size_t)cur.pm * tstep + cur.koff; const char* cB = (const char*)g.Bt + (size_t)cur.pn * tstep + cur.koff;
    if constexpr (AGATHER) { static_assert(!AGATHER || (SP2 && !ATILED), "AGATHER: SP2, row-major A"); PG8_GIDX(gP, cur.pm); asm volatile("s_waitcnt vmcnt(0)" ::: "memory"); asm volatile("" : "+v"(gP[0]), "+v"(gP[1])); }
    S.a_ready(cur);
    if constexpr (SP2) {
        const bool last = false; (void)last;
        PG8_STAGE(PG8_SB(0, 0), cB, voffB); PG8_STAGE(PG8_SB(0, 1), cB + hstep, voffB); PG8_STA(PG8_SA(0, 0), cA, 0, false); PG8_STA(PG8_SA(0, 1), cA, 1, false);
        if (wr == 1) PG8_BAR;
        PG8_WAIT_V(2); PG8_BAR;
        PG8_STAGE(PG8_SB(1, 0), cB + kstepB, voffB); PG8_STA(PG8_SA(1, 0), cA + kstepA, 0, false); PG8_STAGE(PG8_SB(1, 1), cB + hstep + kstepB, voffB);
        PG8_WAIT_V(6); PG8_BAR;
    } else {
        PG8_STAGE(PG8_SB(0, 0), cB, voffB); PG8_STAGE(PG8_SA(0, 0), cA, voffA); PG8_STAGE(PG8_SB(0, 1), cB + hstep, voffB); PG8_STAGE(PG8_SA(0, 1), cA + hstep, voffA);
        if (wr == 1) PG8_BAR;
        PG8_WAIT_V(4); PG8_BAR;
        PG8_STAGE(PG8_SB(1, 0), cB + kstepB, voffB); PG8_STAGE(PG8_SA(1, 0), cA + kstepA, voffA); PG8_STAGE(PG8_SB(1, 1), cB + hstep + kstepB, voffB);
        PG8_WAIT_V(6); PG8_BAR;
    }
    for (;;) {
        const bool has_next = S.next(ui + 1, nxt);
        const char* nA = AGATHER ? cA : has_next ? (const char*)g.A + (size_t)nxt.pm * tstep + nxt.koff : cA; const char* nB = has_next ? (const char*)g.Bt + (size_t)nxt.pn * tstep + nxt.koff : cB;
        if constexpr (AGATHER) { if (!has_next) { gN[0] = gP[0]; gN[1] = gP[1]; } }
        for (int t = 0; t < nt; t += 2) {
            const bool last = (t == nt - 2);
            const bool gfetch = AGATHER && has_next && t == 2;
            if constexpr (AGATHER) { if (gfetch) PG8_GIDX(gN, nxt.pm); }
            const char* a1 = cA + (size_t)(t + 1) * kstepA;
            const char* a2 = last ? nA : cA + (size_t)(t + 2) * kstepA; const char* b2 = last ? nB : cB + (size_t)(t + 2) * kstepB;
            const char* a3 = a2 + kstepA; const char* b3 = b2 + kstepB;
            if (last && has_next) S.a_ready(nxt);
            if constexpr (SP2) {
            PG8_LDB(B0, 0, 0); PG8_LDB(B1, 0, 1); PG8_SCHED; PG8_LDA(At, 0, 0); PG8_STA(PG8_SA(1, 1), a1, 1, false);
            if (gfetch) PG8_WAIT_V(10); else PG8_WAIT_V(8);
            PG8_WAIT_L(0); PG8_BAR; PG8_MMA(0, 0, At, B0); PG8_MMA(0, 1, At, B1); PG8_BAR; PG8_SCHED;
            PG8_LDA(At, 0, 1); PG8_STAGE(PG8_SB(0, 0), b2, voffB); PG8_STAGE(PG8_SB(0, 1), b2 + hstep, voffB); PG8_STA(PG8_SA(0, 0), a2, 0, true);
            PG8_WAIT_V(8); PG8_WAIT_L(0); PG8_BAR; PG8_MMA(1, 0, At, B0); PG8_MMA(1, 1, At, B1); PG8_BAR; PG8_SCHED;
            PG8_LDB(B0, 1, 0); PG8_LDB(B1, 1, 1); PG8_SCHED; PG8_LDA(At, 1, 0); PG8_STA(PG8_SA(0, 1), a2, 1, true);
            PG8_WAIT_V(8); PG8_WAIT_L(0); PG8_BAR; PG8_MMA(0, 0, At, B0); PG8_MMA(0, 1, At, B1); PG8_BAR; PG8_SCHED;
            PG8_LDA(At, 1, 1); PG8_STAGE(PG8_SB(1, 0), b3, voffB); PG8_STAGE(PG8_SB(1, 1), b3 + hstep, voffB); PG8_STA(PG8_SA(1, 0), a3, 0, true);
            PG8_WAIT_V(8); PG8_WAIT_L(0); PG8_BAR; PG8_MMA(1, 0, At, B0); PG8_MMA(1, 1, At, B1); PG8_BAR; PG8_SCHED;
            } else {
            PG8_LDB(B0, 0, 0); PG8_SCHED; PG8_LDA(At, 0, 0); PG8_STAGE(PG8_SA(1, 1), a1 + hstep, voffA);
            PG8_WAIT_L(8); PG8_BAR; PG8_WAIT_L(0); PG8_MMA(0, 0, At, B0); PG8_BAR; PG8_SCHED;
            PG8_LDB(B1, 0, 1); PG8_STAGE(PG8_SB(0, 0), b2, voffB);
            PG8_BAR; PG8_WAIT_L(0); PG8_MMA(0, 1, At, B1); PG8_BAR;
            PG8_LDA(At, 0, 1); PG8_STAGE(PG8_SA(0, 0), a2, voffA);
            PG8_BAR; PG8_WAIT_L(0); PG8_MMA(1, 0, At, B0); PG8_BAR; PG8_SCHED;
            PG8_STAGE(PG8_SB(0, 1), b2 + hstep, voffB);
            PG8_WAIT_V(6); PG8_BAR; PG8_MMA(1, 1, At, B1); PG8_BAR;
            PG8_LDB(B0, 1, 0); PG8_SCHED; PG8_LDA(At, 1, 0); PG8_STAGE(PG8_SA(0, 1), a2 + hstep, voffA);
            PG8_WAIT_L(8); PG8_BAR; PG8_WAIT_L(0); PG8_MMA(0, 0, At, B0); PG8_BAR; PG8_SCHED;
            PG8_LDB(B1, 1, 1); PG8_STAGE(PG8_SB(1, 0), b3, voffB);
            PG8_BAR; PG8_WAIT_L(0); PG8_MMA(0, 1, At, B1); PG8_BAR;
            PG8_LDA(At, 1, 1); PG8_STAGE(PG8_SA(1, 0), a3, voffA);
            PG8_BAR; PG8_WAIT_L(0); PG8_MMA(1, 0, At, B0); PG8_BAR; PG8_SCHED;
            PG8_STAGE(PG8_SB(1, 1), b3 + hstep, voffB);
            PG8_WAIT_V(6); PG8_BAR; PG8_MMA(1, 1, At, B1); PG8_BAR;
            }
        }
        if constexpr (ALIGN_EPI) { if (wr == 0) PG8_BAR; }
        if constexpr (!Epi::AFTER_DRAIN) { E(acc, cur, wr, wc, fr, fq); S.done(cur); }
        if (!has_next) break;
#pragma unroll
        for (int a = 0; a < 2; ++a)
#pragma unroll
            for (int b = 0; b < 2; ++b)
#pragma unroll
                for (int m = 0; m < 4; ++m)
#pragma unroll
                    for (int n = 0; n < 2; ++n) acc[a][b][m][n] = (f32x4){0.f, 0.f, 0.f, 0.f};
        cur = nxt; cA = nA; cB = nB; ++ui;
        if constexpr (AGATHER) { gP[0] = gN[0]; gP[1] = gN[1]; }
        if constexpr (ALIGN_EPI) { if (wr == 1) PG8_BAR; }
    }
    PG8_WAIT_V(0);
    if constexpr (!ALIGN_EPI) { if (wr == 0) PG8_BAR; }
    PG8_BAR;
    if constexpr (Epi::AFTER_DRAIN) { E.fused(acc, cur, wr, wc, fr, fq, lds, wid, lane); S.done(cur); }
#undef PG8_SA
#undef PG8_SB
#undef PG8_STAGE
#undef PG8_LDA
#undef PG8_LDB
#undef PG8_GIDX
#undef PG8_STA
#undef PG8_MMA
#undef PG8_WAIT_V
#undef PG8_WAIT_L
#undef PG8_BAR
#undef PG8_SCHED
}
}
constexpr int NWAVES = 8;
constexpr int BATCH = 4, T = 4096, D = 2048, M = BATCH * T;
constexpr int PLE_DIM = 256, FFN = 5632, MOE = 7168, NE = 8;
constexpr int REC_IN = 8208, UW = 8192, NREC = 8448;
constexpr int U_QA = 0, U_KA = 512, U_VA = 1024, U_OA = 2048, U_QB = 3072, U_FF = 4096, U_FB = 5120, U_IB = 6144, U_GB = 7168;
constexpr int NQKV = 6144;
constexpr int XS_ROWS = 34816;
constexpr float LN_EPS = 1e-5f, RMS_EPS = 1e-6f, ALPHA = 1.41421356237f, GATE_CAP = 15.0f;

constexpr size_t MiB = 1u << 20;
constexpr size_t WS_CTL = 0, CTL_ZERO_BYTES = 1 * MiB;
constexpr size_t WS_INV = 2 * MiB;
constexpr size_t WS_TOKE = 1 * MiB, WS_TOKG = WS_TOKE + 256 * 1024, WS_DEST = WS_TOKG + 256 * 1024, WS_WGCNT = WS_DEST + 256 * 1024, WS_TILEE = WS_WGCNT + 64 * 1024;
constexpr size_t WS_WQKV = 4 * MiB, WS_WNAO = 28 * MiB, WS_WPG1 = 36 * MiB, WS_WPP1 = 44 * MiB, WS_WMGU = 48 * MiB, WS_WMDN = 496 * MiB;
constexpr size_t WS_XB0 = 720 * MiB, WS_XB1 = 784 * MiB, WS_PB = 848 * MiB, WS_G = 864 * MiB, WS_WGATE = 866 * MiB;
constexpr size_t WS_WRIN = 872 * MiB, WS_WROUT = 905 * MiB, WS_WFGU = 913 * MiB, WS_WFDN = 957 * MiB, WS_WPG0 = 979 * MiB, WS_WPP0 = 987 * MiB;
constexpr size_t WS_U = 992 * MiB, WS_HA = 1248 * MiB, WS_HB = 1376 * MiB, WS_Y = 1504 * MiB;
constexpr size_t WS_H = 992 * MiB;
constexpr size_t WS_PP = 1248 * MiB;
constexpr size_t WS_QKV = 992 * MiB;
constexpr size_t WS_AO = WS_Y;
constexpr size_t WS_HM = 872 * MiB;
constexpr size_t WS_YS = 1348 * MiB;
constexpr size_t WS_XS = 1348 * MiB;
constexpr size_t WS_PP1 = 1620 * MiB;
constexpr size_t WS_QIN = 1568 * MiB, WS_KIN = 1632 * MiB, WS_GTAB = 1696 * MiB, WS_GTABM = 1698 * MiB, WS_QINM = 1700 * MiB, WS_KINM = 1732 * MiB, WS_EQM = 1700 * MiB, WS_EKM = 1701 * MiB;
constexpr size_t WS_VINM = 1504 * MiB, WS_VINH = 1536 * MiB;
constexpr size_t WS_PART = 1484 * MiB;
constexpr size_t WS_END = 1764 * MiB;
static_assert(WS_WMGU + (size_t)NE * 2 * MOE * D * 2 <= WS_WMDN && WS_WMDN + (size_t)NE * D * MOE * 2 <= WS_XB0, "ws map 1");
static_assert(WS_WRIN + (size_t)NREC * D * 2 <= WS_WROUT && WS_WFGU + (size_t)2 * FFN * D * 2 <= WS_WFDN && WS_WFDN + (size_t)D * FFN * 2 <= WS_WPG0 && WS_WPP0 + (size_t)D * PLE_DIM * 2 <= WS_U, "ws map 2");
static_assert(WS_U + (size_t)M * UW * 2 <= WS_HA && WS_H + (size_t)M * FFN * 2 <= WS_HA && WS_QKV + (size_t)M * NQKV * 2 <= WS_HA, "ws map 3");
static_assert(WS_HM + (size_t)XS_ROWS * MOE * 2 <= WS_YS && WS_YS + (size_t)XS_ROWS * D * 4 <= WS_END && WS_XS + (size_t)XS_ROWS * D * 2 <= WS_Y, "ws map 4");
constexpr int CW_BAR = 4096;

constexpr int RING_OFF = 0, RING_BYTES = 131072;
constexpr int LDSCTL_OFF = RING_BYTES, MISC_OFF = LDSCTL_OFF + 320;
constexpr int LDS_BYTES = 147456;
static_assert(MISC_OFF + 128 <= LDS_BYTES, "LDS map");

#define GAS __attribute__((address_space(1)))
#define LAS __attribute__((address_space(3)))
typedef unsigned short bf16;
typedef unsigned v4u __attribute__((ext_vector_type(4)));
typedef unsigned v2u __attribute__((ext_vector_type(2)));
typedef float f32x4 __attribute__((ext_vector_type(4)));
typedef float f32x2 __attribute__((ext_vector_type(2)));
typedef GAS unsigned gu32;
#define RLX_AGENT __ATOMIC_RELAXED, __HIP_MEMORY_SCOPE_AGENT
#define LDS_WAIT() asm volatile("s_waitcnt lgkmcnt(0)" ::: "memory")
#define VM_WAIT() asm volatile("s_waitcnt vmcnt(0)" ::: "memory")
__device__ __forceinline__ unsigned f2bf(float f) { unsigned u = __builtin_bit_cast(unsigned, f); return (u + 0x7fffu + ((u >> 16) & 1u)) >> 16; }
typedef float f32x2_t __attribute__((ext_vector_type(2))); typedef __bf16 bf16x2_t __attribute__((ext_vector_type(2)));
__device__ __forceinline__ unsigned cvtpk(float lo, float hi) { f32x2_t v = {lo, hi}; bf16x2_t b = __builtin_convertvector(v, bf16x2_t); return __builtin_bit_cast(unsigned, b); }
__device__ __forceinline__ unsigned pk2(float lo, float hi) { return cvtpk(lo, hi); }
__device__ __forceinline__ float bflo(unsigned w) { return __builtin_bit_cast(float, w << 16); }
__device__ __forceinline__ float bfhi(unsigned w) { return __builtin_bit_cast(float, w & 0xffff0000u); }
__device__ __forceinline__ float bf1(bf16 h) { return __builtin_bit_cast(float, (unsigned)h << 16); }
typedef short bf16x8 __attribute__((ext_vector_type(8)));
typedef short s16x4 __attribute__((ext_vector_type(4)));
__device__ __forceinline__ s16x4 lds_tr(LAS unsigned char* p) { return __builtin_bit_cast(s16x4, __builtin_amdgcn_ds_read_tr16_b64_v4i16((LAS s16x4*)p)); }
__device__ __forceinline__ float sigm(float x) { return __builtin_amdgcn_rcpf(1.0f + __expf(-x)); }
#define AT(base, m, k, K) ((bf16*)((unsigned char*)(base) + pg8::at_tiled_off((int)(m), (int)(k), (K))))
#define XB_TMO      128
#define XB_XCNT(j)  (256  + 64 * (j))
#define XB_XSUB(j)  (1280 + 64 * (j))
#define XB_XGEN(j)  (2304 + 64 * (j))
#define XB_TOP      3328
#define XB_TOPGEN   3392
#define XCD_BAR_WORDS 3456
#define XB_SPIN_CAP (1u << 18)

__device__ __forceinline__ unsigned xb_ld(unsigned* p)              { return __hip_atomic_load(p, __ATOMIC_RELAXED, __HIP_MEMORY_SCOPE_AGENT); }
__device__ __forceinline__ unsigned xb_add(unsigned* p, unsigned v) { return __hip_atomic_fetch_add(p, v, __ATOMIC_RELAXED, __HIP_MEMORY_SCOPE_AGENT); }
__device__ __forceinline__ unsigned xb_xcc_id() { return (unsigned)__builtin_amdgcn_s_getreg((3 << 11) | 20) & 0xFu; }
#define XB_SPIN(cond, bar) do { unsigned _sp = 0; while (cond) { __builtin_amdgcn_s_sleep(1); \
    if ((++_sp & 255u) == 0u) { if (xb_ld(&(bar)[XB_TMO])) break; if (_sp > XB_SPIN_CAP) { atomicAdd(&(bar)[XB_TMO], 1u); break; } } } } while (0)

struct XcdBarrier {
    unsigned* bar; unsigned x;
    volatile LAS unsigned* st;
};

__device__ __forceinline__ XcdBarrier xcd_barrier_post(unsigned* bar, volatile LAS unsigned* st, int wave_s) {
    XcdBarrier b; b.bar = bar; b.x = xb_xcc_id(); b.st = st;
    if (wave_s == 0 && lane_now() == 0) (void)xb_add(&bar[XB_XCNT(b.x)], 1u);
    return b;
}
__device__ __forceinline__ void xcd_barrier_complete(unsigned* bar, unsigned x, unsigned& nloc, unsigned& nx) {
    const unsigned G = gridDim.x * gridDim.y * gridDim.z;
    unsigned sum, cnt, mine, sp = 0u;
    for (;;) {
        sum = 0u; cnt = 0u; mine = 0u;
#pragma unroll
        for (unsigned j = 0; j < 16; ++j) { const unsigned c = xb_ld(&bar[XB_XCNT(j)]); sum += c; cnt += (c > 0u) ? 1u : 0u; mine = (j == x) ? c : mine; }
        if (sum == G) break;
        __builtin_amdgcn_s_sleep(1);
        if ((++sp & 255u) == 0u) { if (xb_ld(&bar[XB_TMO])) break; if (sp > XB_SPIN_CAP) { atomicAdd(&bar[XB_TMO], 1u); break; } }
    }
    nloc = mine > 0u ? mine : 1u; nx = cnt > 0u ? cnt : 1u;
}

__device__ __forceinline__ void xcd_barrier(const XcdBarrier& b, int wave_s) {
    asm volatile("s_waitcnt vmcnt(0)" ::: "memory");
    __syncthreads();
    if (wave_s == 0 && lane_now() == 0) {
        unsigned* bar = b.bar;
        __builtin_amdgcn_s_waitcnt(0);
        unsigned nloc = b.st[0], nx = b.st[1];
        if (nloc == 0u) { xcd_barrier_complete(bar, b.x, nloc, nx); b.st[0] = nloc; b.st[1] = nx; }
        const unsigned old = xb_add(&bar[XB_XSUB(b.x)], 1u);
        const unsigned gen = old / nloc;
        if (old + 1u == (gen + 1u) * nloc) {
            __builtin_amdgcn_fence(__ATOMIC_RELEASE, "agent");
            asm volatile("s_waitcnt vmcnt(0)" ::: "memory");
            const unsigned og = xb_add(&bar[XB_TOP], 1u);
            const unsigned tg = og / nx;
            if (og + 1u == (tg + 1u) * nx) xb_add(&bar[XB_TOPGEN], 1u);
            else XB_SPIN(xb_ld(&bar[XB_TOPGEN]) == tg, bar);
            __builtin_amdgcn_fence(__ATOMIC_ACQUIRE, "agent");
            xb_add(&bar[XB_XGEN(b.x)], 1u);
            asm volatile("s_waitcnt vmcnt(0)" ::: "memory");
        } else {
            XB_SPIN(xb_ld(&bar[XB_XGEN(b.x)]) == gen, bar);
            __builtin_amdgcn_fence(__ATOMIC_ACQUIRE, "agent");
            asm volatile("s_waitcnt vmcnt(0)" ::: "memory");
        }
    }
    __syncthreads();
}

struct Frame {
    LAS unsigned char* lds;
    int wave, G;
};
struct Args { const float* in[23]; float* out; unsigned char* ws; int ph_lo, ph_hi; };
enum { I_X = 0, I_P, I_LNW, I_LNB, I_RECWIN, I_GBIAS, I_MNORM, I_LBLOG, I_HNORM, I_RECWOUT, I_FWG, I_FWU, I_FWD, I_NAQKV, I_RPB, I_NAOUT, I_WR, I_BR, I_MWG, I_MWU, I_MWD, I_PLEG, I_PLEP };

#define DPP_ADD(v, ctrl) ((v) + __builtin_bit_cast(float, __builtin_amdgcn_update_dpp(0, __builtin_bit_cast(int, (v)), (ctrl), 0xF, 0xF, true)))
__device__ __forceinline__ float row_sum16(float v) {
    v = DPP_ADD(v, 0xB1);
    v = DPP_ADD(v, 0x4E);
    v = DPP_ADD(v, 0x141);
    v = DPP_ADD(v, 0x140);
    return v;
}
__device__ __forceinline__ float wave_sum(float v) {
    v = row_sum16(v);
    const float r0 = __builtin_bit_cast(float, __builtin_amdgcn_readlane(__builtin_bit_cast(int, v), 0)), r1 = __builtin_bit_cast(float, __builtin_amdgcn_readlane(__builtin_bit_cast(int, v), 16));
    const float r2 = __builtin_bit_cast(float, __builtin_amdgcn_readlane(__builtin_bit_cast(int, v), 32)), r3 = __builtin_bit_cast(float, __builtin_amdgcn_readlane(__builtin_bit_cast(int, v), 48));
    return (r0 + r1) + (r2 + r3);
}
__device__ __forceinline__ float half_sum32(float v, int lane) {
    v = row_sum16(v);
    const float r0 = __builtin_bit_cast(float, __builtin_amdgcn_readlane(__builtin_bit_cast(int, v), 0)), r1 = __builtin_bit_cast(float, __builtin_amdgcn_readlane(__builtin_bit_cast(int, v), 16));
    const float r2 = __builtin_bit_cast(float, __builtin_amdgcn_readlane(__builtin_bit_cast(int, v), 32)), r3 = __builtin_bit_cast(float, __builtin_amdgcn_readlane(__builtin_bit_cast(int, v), 48));
    return (lane < 32) ? (r0 + r1) : (r2 + r3);
}
__device__ __forceinline__ float wave_max(float v) {
#pragma unroll
    for (int o = 1; o < 64; o <<= 1) v = fmaxf(v, __shfl_xor(v, o));
    return v;
}

__device__ __forceinline__ void tr_item(const float* W, int ldn, int K, int srcc, int nvalid, bf16* WT, size_t drow, int k0, LAS float* scr, int lane, bool tiled) {
    const int c = lane & 31;
    {   float tmp[32]; const float* wp = W + (size_t)(k0 + (lane >> 5)) * ldn + srcc + c; const bool ok = c < nvalid;
#pragma unroll
        for (int i = 0; i < 32; ++i) tmp[i] = ok ? __builtin_nontemporal_load(wp + (size_t)(2 * i) * ldn) : 0.f;
#pragma unroll
        for (int i = 0; i < 32; ++i) scr[(2 * i + (lane >> 5)) * 33 + c] = tmp[i]; }
    LDS_WAIT(); asm volatile("" ::: "memory");
    const int c8 = lane & 7;
#pragma unroll
    for (int j = 0; j < 4; ++j) { const int n = (lane >> 3) + 8 * j; const LAS float* s = scr + (8 * c8) * 33 + n;
        v4u o; o.x = pk2(s[0 * 33], s[1 * 33]); o.y = pk2(s[2 * 33], s[3 * 33]); o.z = pk2(s[4 * 33], s[5 * 33]); o.w = pk2(s[6 * 33], s[7 * 33]);
        if (tiled) *(GAS v4u*)((GAS unsigned char*)WT + pg8::bt_tiled_off((int)drow + n, k0 + 8 * c8, K)) = o; else *(GAS v4u*)(WT + (drow + n) * (size_t)K + k0 + 8 * c8) = o; }
    LDS_WAIT(); asm volatile("" ::: "memory");
}
constexpr int TR2_P = 288;
struct Tr2D { const float* W; unsigned char* WT; int ldn, K, srcc, drow, k0; };
__device__ __forceinline__ void tr2_load(f32x2 (&tmp)[32], const Tr2D& t, int lane) {
    const float* wp = t.W + (size_t)t.k0 * t.ldn + t.srcc + 2 * lane;
#pragma unroll
    for (int i = 0; i < 32; ++i) tmp[i] = __builtin_nontemporal_load((const GAS f32x2*)(wp + (size_t)i * t.ldn));
}
__device__ __forceinline__ void tr2_store(const f32x2 (&tmp)[32], const Tr2D& t, LAS unsigned char* scr, int lane) {
    {   const int n = 2 * lane, v = n & 31, slot = (n & ~31) + 16 * ((v >> 2) & 1) + 4 * (v >> 3) + (v & 3);
#pragma unroll
        for (int i = 0; i < 32; ++i) *(LAS unsigned*)(scr + i * TR2_P + slot * 2) = cvtpk(tmp[i][0], tmp[i][1]); }
    LDS_WAIT(); asm volatile("" ::: "memory");
    const int g = lane >> 4, i16 = lane & 15, q = i16 >> 2, p4 = lane & 3;
    unsigned char* blk = t.WT + ((size_t)(((t.drow >> 8) * 2 + ((t.drow >> 7) & 1)) * (t.K >> 6) + (t.k0 >> 6))) * 16384;
    const int C = (t.k0 & 63) + 8 * g;
#pragma unroll
    for (int s = 0; s < 8; ++s) { LAS unsigned char* tp = scr + (8 * g + q) * TR2_P + (16 * s + 4 * p4) * 2;
        const s16x4 x0 = lds_tr(tp), x1 = lds_tr(tp + 4 * TR2_P);
        v4u o = __builtin_bit_cast(v4u, (bf16x8){x0[0], x0[1], x0[2], x0[3], x1[0], x1[1], x1[2], x1[3]});
        *(GAS v4u*)(blk + pg8::lds_byte(16 * s + i16, C)) = o; }
    LDS_WAIT(); asm volatile("" ::: "memory");
}
constexpr int N2_RIN = 64 * (UW / 128), N2_ROUT = 64 * 16, N2_FGU = 64 * (2 * FFN / 128), N2_FDN = (FFN / 32) * 16, N2_PG = 64 * 16, N2_PP = 8 * 16, N2_QKV = 64 * (NQKV / 128), N2_NAO = 64 * 16;
constexpr int N2_MGU = 64 * (NE * 2 * MOE / 128), N2_MDN = (MOE / 32) * (NE * D / 128);
constexpr int N2_ITEMS = N2_RIN + N2_ROUT + N2_FGU + N2_FDN + 2 * N2_PG + 2 * N2_PP + N2_QKV + N2_NAO + N2_MGU + N2_MDN;
__device__ __forceinline__ Tr2D tr2_decode(const Args& A, int r) {
    unsigned char* ws = A.ws; const float* W; unsigned char* WT; int ldn, K; int srcc, kb, nb;
#define TR_KN() { const int nk2_ = K / 64, g8_ = r >> 3, w8_ = r & 7; kb = (g8_ % nk2_) * 2 + (w8_ & 1); nb = (g8_ / nk2_) * 4 + (w8_ >> 1); }
    if (r < N2_RIN) { W = A.in[I_RECWIN]; WT = ws + WS_WRIN; ldn = REC_IN; K = D; TR_KN(); srcc = (nb < 24) ? nb * 128 : nb * 128 + 16; }
    else if ((r -= N2_RIN) < N2_ROUT) { W = A.in[I_RECWOUT]; WT = ws + WS_WROUT; ldn = D; K = D; TR_KN(); srcc = nb * 128; }
    else if ((r -= N2_ROUT) < N2_FGU) { WT = ws + WS_WFGU; ldn = FFN; K = D; TR_KN(); W = (nb & 1) ? A.in[I_FWU] : A.in[I_FWG]; srcc = (nb >> 1) * 128; }
    else if ((r -= N2_FGU) < N2_FDN) { W = A.in[I_FWD]; WT = ws + WS_WFDN; ldn = D; K = FFN; TR_KN(); srcc = nb * 128; }
    else if ((r -= N2_FDN) < 2 * N2_PG) { const int l = r / N2_PG; r -= l * N2_PG; W = A.in[I_PLEG] + (size_t)l * D * D; WT = ws + (l ? WS_WPG1 : WS_WPG0); ldn = D; K = D; TR_KN(); srcc = nb * 128; }
    else if ((r -= 2 * N2_PG) < 2 * N2_PP) { const int l = r / N2_PP; r -= l * N2_PP; W = A.in[I_PLEP] + (size_t)l * PLE_DIM * D; WT = ws + (l ? WS_WPP1 : WS_WPP0); ldn = D; K = PLE_DIM; TR_KN(); srcc = nb * 128; }
    else if ((r -= 2 * N2_PP) < N2_QKV) { W = A.in[I_NAQKV]; WT = ws + WS_WQKV; ldn = NQKV; K = D; TR_KN(); srcc = nb * 128; }
    else if ((r -= N2_QKV) < N2_NAO) { W = A.in[I_NAOUT]; WT = ws + WS_WNAO; ldn = D; K = D; TR_KN(); srcc = nb * 128; }
    else if ((r -= N2_NAO) < N2_MGU) { WT = ws + WS_WMGU; ldn = MOE; K = D; TR_KN(); const int e = nb / (2 * MOE / 128), nl = nb % (2 * MOE / 128); W = ((nl & 1) ? A.in[I_MWU] : A.in[I_MWG]) + (size_t)e * D * MOE; srcc = (nl >> 1) * 128; }
    else { r -= N2_MGU; WT = ws + WS_WMDN; ldn = D; K = MOE; TR_KN(); const int e = nb / (D / 128), nl = nb % (D / 128); W = A.in[I_MWD] + (size_t)e * MOE * D; srcc = nl * 128; }
#undef TR_KN
    Tr2D t; t.W = W; t.WT = WT; t.ldn = ldn; t.K = K; t.srcc = srcc; t.drow = nb * 128; t.k0 = kb * 32; return t;
}
__device__ __forceinline__ void p0_prologue(const Frame& F, const Args& A) {
    const int lane = lane_now(), tid = F.wave * 64 + lane; (void)tid;
    LAS float* scr = (LAS float*)(F.lds + RING_OFF + F.wave * 16384);
    const int gw = blockIdx.x * NWAVES + F.wave, NGW = F.G * NWAVES;
    unsigned char* ws = A.ws;
    {
        f32x2 ra[32], rb[32]; Tr2D da, db; int it = gw;
        if (it < N2_ITEMS) { da = tr2_decode(A, it); tr2_load(ra, da, lane); }
        while (it < N2_ITEMS) {
            int nx = it + NGW; if (nx < N2_ITEMS) { db = tr2_decode(A, nx); tr2_load(rb, db, lane); }
            tr2_store(ra, da, (LAS unsigned char*)scr, lane);
            it = nx; if (it >= N2_ITEMS) break;
            nx = it + NGW; if (nx < N2_ITEMS) { da = tr2_decode(A, nx); tr2_load(ra, da, lane); }
            tr2_store(rb, db, (LAS unsigned char*)scr, lane);
            it = nx;
        }
    }
    for (int it = gw; it < 32 * 8; it += NGW) { const int kb = it >> 3, nb = it & 7; tr_item(A.in[I_RECWIN], REC_IN, D, 3072, (nb == 0) ? 16 : 0, (bf16*)(ws + WS_WGATE), (size_t)nb * 32, kb * 64, scr, lane, false); }
    const size_t gt = (size_t)blockIdx.x * (NWAVES * 64) + tid, NGT = (size_t)F.G * NWAVES * 64;
    { const GAS f32x4* src = (const GAS f32x4*)A.in[I_X]; GAS v4u* dst = (GAS v4u*)(ws + WS_XB0); const size_t NCH = (size_t)M * D / 8;
      for (size_t i = gt; i < NCH; i += 4 * NGT) { f32x4 a[4], b[4];
#pragma unroll
          for (int u = 0; u < 4; ++u) { const size_t iu = i + u * NGT; if (iu < NCH) { a[u] = __builtin_nontemporal_load(src + 2 * iu); b[u] = __builtin_nontemporal_load(src + 2 * iu + 1); } }
#pragma unroll
          for (int u = 0; u < 4; ++u) { const size_t iu = i + u * NGT; if (iu < NCH) { v4u o; o.x = pk2(a[u][0], a[u][1]); o.y = pk2(a[u][2], a[u][3]); o.z = pk2(b[u][0], b[u][1]); o.w = pk2(b[u][2], b[u][3]); dst[iu] = o; } } } }
    { const GAS f32x4* src = (const GAS f32x4*)A.in[I_P]; GAS v4u* dst = (GAS v4u*)(ws + WS_PB); const size_t NCH = (size_t)2 * M * PLE_DIM / 8;
      for (size_t i = gt; i < NCH; i += 4 * NGT) { f32x4 a[4], b[4];
#pragma unroll
          for (int u = 0; u < 4; ++u) { const size_t iu = i + u * NGT; if (iu < NCH) { a[u] = __builtin_nontemporal_load(src + 2 * iu); b[u] = __builtin_nontemporal_load(src + 2 * iu + 1); } }
#pragma unroll
          for (int u = 0; u < 4; ++u) { const size_t iu = i + u * NGT; if (iu < NCH) { v4u o; o.x = pk2(a[u][0], a[u][1]); o.y = pk2(a[u][2], a[u][3]); o.z = pk2(b[u][0], b[u][1]); o.w = pk2(b[u][2], b[u][3]);
              *(GAS v4u*)AT(dst, (iu * 8) / PLE_DIM, (iu * 8) % PLE_DIM, PLE_DIM) = o; } } } }
}

constexpr int RB = 32;
#define T0_OF(blk) (dir ? (T - RB - (blk) * RB) : (blk) * RB)
__device__ __forceinline__ void mlstm_unit(const Frame& F, const Args& A, int unit) {
    const int lane = lane_now(), tid = F.wave * 64 + lane; (void)tid;
    const int cg = unit & 3, dir = (unit >> 2) & 1, h = (unit >> 3) & 3, b = unit >> 5;
    LAS float* qs = (LAS float*)(F.lds + RING_OFF);
    LAS float* ks = qs + RB * 128;
    LAS float* vs = ks + RB * 128;
    LAS float* fi = vs + RB * 64;
    LAS float* ob = fi + RB * 2;
    const bf16* U = (const bf16*)(A.ws + WS_U); const float* Gt = (const float*)(A.ws + WS_G);
    float* HA = (float*)(A.ws + WS_HA) + (size_t)dir * M * 1024;
    const int e = lane & 7, dg = lane >> 3, colw = F.wave * 8 + e;
    const int srow = tid >> 4, sc = tid & 15;
    const float bias_i = A.in[I_GBIAS][(dir ? 2 : 0) * 4 + h], bias_f = A.in[I_GBIAS][(dir ? 3 : 1) * 4 + h];
    float C[16], n[16];
#pragma unroll
    for (int j = 0; j < 16; ++j) { C[j] = 0.f; n[j] = 0.f; }
    v4u rq, rk; v2u rv; float rgi = 0.f, rgf = 0.f;
    {   const size_t row = (size_t)b * T + T0_OF(0) + srow; const bf16* ur = U + row * UW;
        rq = *(const GAS v4u*)(ur + U_QA + h * 128 + sc * 8); rk = *(const GAS v4u*)(ur + U_KA + h * 128 + sc * 8); rv = *(const GAS v2u*)(ur + U_VA + h * 256 + cg * 64 + sc * 4);
        if (tid < RB) { const size_t r2 = (size_t)b * T + T0_OF(0) + tid; rgi = Gt[r2 * 16 + (dir ? 2 : 0) * 4 + h]; rgf = Gt[r2 * 16 + (dir ? 3 : 1) * 4 + h]; } }
    for (int blk = 0; blk < T / RB; ++blk) {
        const int t0 = T0_OF(blk);
        {   const float qsc = 0.08838834764831845f;
            LAS float* qd = qs + srow * 128 + sc * 8; LAS float* kd = ks + srow * 128 + sc * 8;
            *(LAS f32x4*)qd = (f32x4){bflo(rq.x) * qsc, bfhi(rq.x) * qsc, bflo(rq.y) * qsc, bfhi(rq.y) * qsc}; *(LAS f32x4*)(qd + 4) = (f32x4){bflo(rq.z) * qsc, bfhi(rq.z) * qsc, bflo(rq.w) * qsc, bfhi(rq.w) * qsc};
            *(LAS f32x4*)kd = (f32x4){bflo(rk.x), bfhi(rk.x), bflo(rk.y), bfhi(rk.y)}; *(LAS f32x4*)(kd + 4) = (f32x4){bflo(rk.z), bfhi(rk.z), bflo(rk.w), bfhi(rk.w)};
            *(LAS f32x4*)(vs + srow * 64 + sc * 4) = (f32x4){bflo(rv.x), bfhi(rv.x), bflo(rv.y), bfhi(rv.y)};
            if (tid < RB) { const float gi = GATE_CAP * tanhf((rgi + bias_i) * (1.0f / GATE_CAP)), gf = GATE_CAP * tanhf((rgf + bias_f) * (1.0f / GATE_CAP));
                fi[tid * 2] = sigm(gf); fi[tid * 2 + 1] = __expf(gi); } }
        __syncthreads();
        if (blk + 1 < T / RB) { const size_t row = (size_t)b * T + T0_OF(blk + 1) + srow; const bf16* ur = U + row * UW;
            rq = *(const GAS v4u*)(ur + U_QA + h * 128 + sc * 8); rk = *(const GAS v4u*)(ur + U_KA + h * 128 + sc * 8); rv = *(const GAS v2u*)(ur + U_VA + h * 256 + cg * 64 + sc * 4);
            if (tid < RB) { const size_t r2 = (size_t)b * T + T0_OF(blk + 1) + tid; rgi = Gt[r2 * 16 + (dir ? 2 : 0) * 4 + h]; rgf = Gt[r2 * 16 + (dir ? 3 : 1) * 4 + h]; } }
        for (int s = 0; s < RB; ++s) {
            const int tl = dir ? (RB - 1 - s) : s;
            const float f = fi[tl * 2], ii = fi[tl * 2 + 1], v = vs[tl * 64 + colw];
            const LAS f32x4* qp = (const LAS f32x4*)(qs + tl * 128 + dg * 16); const LAS f32x4* kp = (const LAS f32x4*)(ks + tl * 128 + dg * 16);
            float num = 0.f, den = 0.f;
#pragma unroll
            for (int j4 = 0; j4 < 4; ++j4) { const f32x4 q4 = qp[j4], k4 = kp[j4];
#pragma unroll
                for (int i = 0; i < 4; ++i) { const int j = j4 * 4 + i; const float kk = ii * k4[i]; C[j] = f * C[j] + kk * v; n[j] = f * n[j] + kk; num += C[j] * q4[i]; den += n[j] * q4[i]; } }
            num += __shfl_xor(num, 8); den += __shfl_xor(den, 8); num += __shfl_xor(num, 16); den += __shfl_xor(den, 16); num += __shfl_xor(num, 32); den += __shfl_xor(den, 32);
            if (dg == 0) ob[tl * 64 + colw] = num / fmaxf(fabsf(den), 1.0f);
        }
        __syncthreads();
        *(GAS f32x4*)(HA + ((size_t)b * T + t0 + srow) * 1024 + h * 256 + cg * 64 + sc * 4) = *(const LAS f32x4*)(ob + srow * 64 + sc * 4);
    }
    __syncthreads();
}
__device__ __forceinline__ void hgrn_unit(const Frame& F, const Args& A, int unit) {
    const int lane = lane_now(), tid = F.wave * 64 + lane; (void)tid;
    const int cg = unit & 1, dir = (unit >> 1) & 1, h = (unit >> 2) & 7, b = unit >> 5;
    LAS float* qs = (LAS float*)(F.lds + RING_OFF);
    LAS float* fs = qs + RB * 128;
    LAS float* vs = fs + RB * 128;
    LAS float* ob = vs + RB * 64;
    const bf16* U = (const bf16*)(A.ws + WS_U);
    float* HB = (float*)(A.ws + WS_HB) + (size_t)dir * M * 1024;
    const int e = lane & 7, dg = lane >> 3, colw = F.wave * 8 + e;
    const int srow = tid >> 4, sc = tid & 15;
    float lb[8];
#pragma unroll
    for (int i = 0; i < 8; ++i) { const float l0 = A.in[I_LBLOG][(dir * 2 + 0) * 1024 + h * 128 + sc * 8 + i], l1 = A.in[I_LBLOG][(dir * 2 + 1) * 1024 + h * 128 + sc * 8 + i]; lb[i] = 1.0f / (1.0f + __expf(l1 - l0)); }
    float S[16];
#pragma unroll
    for (int j = 0; j < 16; ++j) S[j] = 0.f;
    v4u rq, rf; v2u rv;
    {   const size_t row = (size_t)b * T + T0_OF(0) + srow; const bf16* ur = U + row * UW;
        rq = *(const GAS v4u*)(ur + U_QB + h * 128 + sc * 8); rf = *(const GAS v4u*)(ur + (dir ? U_FB : U_FF) + h * 128 + sc * 8); rv = *(const GAS v2u*)(ur + U_IB + h * 128 + cg * 64 + sc * 4); }
    for (int blk = 0; blk < T / RB; ++blk) {
        const int t0 = T0_OF(blk);
        {   LAS float* qd = qs + srow * 128 + sc * 8; LAS float* fd = fs + srow * 128 + sc * 8;
            float qv[8] = {bflo(rq.x), bfhi(rq.x), bflo(rq.y), bfhi(rq.y), bflo(rq.z), bfhi(rq.z), bflo(rq.w), bfhi(rq.w)};
            float fv[8] = {bflo(rf.x), bfhi(rf.x), bflo(rf.y), bfhi(rf.y), bflo(rf.z), bfhi(rf.z), bflo(rf.w), bfhi(rf.w)};
#pragma unroll
            for (int i = 0; i < 8; ++i) { qv[i] = qv[i] * sigm(qv[i]); fv[i] = lb[i] + (1.0f - lb[i]) * sigm(fv[i]); }
            *(LAS f32x4*)qd = (f32x4){qv[0], qv[1], qv[2], qv[3]}; *(LAS f32x4*)(qd + 4) = (f32x4){qv[4], qv[5], qv[6], qv[7]};
            *(LAS f32x4*)fd = (f32x4){fv[0], fv[1], fv[2], fv[3]}; *(LAS f32x4*)(fd + 4) = (f32x4){fv[4], fv[5], fv[6], fv[7]};
            *(LAS f32x4*)(vs + srow * 64 + sc * 4) = (f32x4){bflo(rv.x), bfhi(rv.x), bflo(rv.y), bfhi(rv.y)}; }
        __syncthreads();
        if (blk + 1 < T / RB) { const size_t row = (size_t)b * T + T0_OF(blk + 1) + srow; const bf16* ur = U + row * UW;
            rq = *(const GAS v4u*)(ur + U_QB + h * 128 + sc * 8); rf = *(const GAS v4u*)(ur + (dir ? U_FB : U_FF) + h * 128 + sc * 8); rv = *(const GAS v2u*)(ur + U_IB + h * 128 + cg * 64 + sc * 4); }
        for (int s = 0; s < RB; ++s) {
            const int tl = dir ? (RB - 1 - s) : s;
            const float v = vs[tl * 64 + colw];
            const LAS f32x4* qp = (const LAS f32x4*)(qs + tl * 128 + dg * 16); const LAS f32x4* fp = (const LAS f32x4*)(fs + tl * 128 + dg * 16);
            float o = 0.f;
#pragma unroll
            for (int j4 = 0; j4 < 4; ++j4) { const f32x4 q4 = qp[j4], f4 = fp[j4];
#pragma unroll
                for (int i = 0; i < 4; ++i) { const int j = j4 * 4 + i; S[j] = f4[i] * S[j] + (1.0f - f4[i]) * v; o += S[j] * q4[i]; } }
            o += __shfl_xor(o, 8); o += __shfl_xor(o, 16); o += __shfl_xor(o, 32);
            if (dg == 0) ob[tl * 64 + colw] = o;
        }
        __syncthreads();
        *(GAS f32x4*)(HB + ((size_t)b * T + t0 + srow) * 1024 + h * 128 + cg * 64 + sc * 4) = *(const LAS f32x4*)(ob + srow * 64 + sc * 4);
    }
    __syncthreads();
}
__device__ __forceinline__ void p3_finalize(const Frame& F, const Args& A) {
    const int lane = lane_now(), tid = F.wave * 64 + lane; (void)tid;
    const int gw = blockIdx.x * NWAVES + F.wave, NGW = F.G * NWAVES;
    const bf16* U = (const bf16*)(A.ws + WS_U); bf16* Y = (bf16*)(A.ws + WS_Y);
    const bf16* HA = (const bf16*)(A.ws + WS_HA); const bf16* HB = (const bf16*)(A.ws + WS_HB);
    f32x4 nw[8];
#pragma unroll
    for (int ps = 0; ps < 8; ++ps) nw[ps] = *(const GAS f32x4*)((ps < 4 ? A.in[I_MNORM] : A.in[I_HNORM]) + (ps & 3) * 256 + lane * 4);
    v2u ra[8], rb[8], rg[8];
#define P3_LOAD(row_) do { const size_t ro_ = (size_t)(row_) * 1024; const bf16* ur_ = U + (size_t)(row_) * UW; \
        _Pragma("unroll") for (int ps = 0; ps < 8; ++ps) { const int c = (ps & 3) * 256 + lane * 4; const bf16* hb_ = (ps < 4) ? HA : HB; \
            ra[ps] = *(const GAS v2u*)(hb_ + ro_ + c); rb[ps] = *(const GAS v2u*)(hb_ + (size_t)M * 1024 + ro_ + c); rg[ps] = *(const GAS v2u*)(ur_ + (ps < 4 ? U_OA : U_GB) + c); } } while (0)
    int row = gw; if (row < M) P3_LOAD(row);
    for (; row < M; row += NGW) {
        v2u out[8];
#pragma unroll
        for (int ps = 0; ps < 8; ++ps) { const v2u a2 = ra[ps], b2 = rb[ps], gg = rg[ps];
            const f32x4 s = (f32x4){bflo(a2.x) + bflo(b2.x), bfhi(a2.x) + bfhi(b2.x), bflo(a2.y) + bflo(b2.y), bfhi(a2.y) + bfhi(b2.y)}; float ss = (s[0] * s[0] + s[1] * s[1]) + (s[2] * s[2] + s[3] * s[3]);
            ss = (ps < 4) ? wave_sum(ss) : half_sum32(ss, lane);
            const float r = __builtin_amdgcn_rsqf(ss * (ps < 4 ? (1.0f / 256.0f) : (1.0f / 128.0f)) + RMS_EPS);
            const float g0 = bflo(gg.x), g1 = bfhi(gg.x), g2 = bflo(gg.y), g3 = bfhi(gg.y);
            float m0, m1, m2, m3;
            if (ps < 4) { m0 = sigm(g0); m1 = sigm(g1); m2 = sigm(g2); m3 = sigm(g3); } else { m0 = g0 * sigm(g0); m1 = g1 * sigm(g1); m2 = g2 * sigm(g2); m3 = g3 * sigm(g3); }
            out[ps].x = pk2(s[0] * r * nw[ps][0] * m0, s[1] * r * nw[ps][1] * m1); out[ps].y = pk2(s[2] * r * nw[ps][2] * m2, s[3] * r * nw[ps][3] * m3); }
        const int rown = row + NGW; if (rown < M) P3_LOAD(rown);
#pragma unroll
        for (int ps = 0; ps < 8; ++ps) *(GAS v2u*)AT(Y, row, ps * 256 + lane * 4, D) = out[ps];
    }
#undef P3_LOAD
}

struct LnAff { f32x4 w[8], b[8]; };
__device__ __forceinline__ LnAff ln_aff_load(const float* w, const float* bvec, int lane) { LnAff a;
#pragma unroll
    for (int j = 0; j < 8; ++j) { a.w[j] = *(const GAS f32x4*)(w + 256 * j + 4 * lane); a.b[j] = *(const GAS f32x4*)(bvec + 256 * j + 4 * lane); }
    return a; }
__device__ __forceinline__ void ln_row_regs(f32x4 (&v)[8], const LnAff& af, int lane) {
    float s = 0.f;
#pragma unroll
    for (int j = 0; j < 8; ++j) s += (v[j][0] + v[j][1]) + (v[j][2] + v[j][3]);
    const float mean = wave_sum(s) * (1.0f / D); float s2 = 0.f;
#pragma unroll
    for (int j = 0; j < 8; ++j) { v[j] = v[j] - mean; s2 += (v[j][0] * v[j][0] + v[j][1] * v[j][1]) + (v[j][2] * v[j][2] + v[j][3] * v[j][3]); }
    const float rstd = 1.0f / sqrtf(wave_sum(s2) * (1.0f / D) + LN_EPS);
#pragma unroll
    for (int j = 0; j < 8; ++j) v[j] = v[j] * rstd * af.w[j] + af.b[j];
}
__device__ __forceinline__ void store_row(const f32x4 (&v)[8], float* xf, bf16* xb, int lane) {
#pragma unroll
    for (int j = 0; j < 8; ++j) { *(GAS f32x4*)(xf + 256 * j + 4 * lane) = v[j]; v2u o; o.x = pk2(v[j][0], v[j][1]); o.y = pk2(v[j][2], v[j][3]); *(GAS v2u*)(xb + 256 * j + 4 * lane) = o; }
}

__device__ __forceinline__ void load_row_b(f32x4 (&v)[8], const bf16* xb, int lane) {
#pragma unroll
    for (int j = 0; j < 8; ++j) { const v2u w = *(const GAS v2u*)(xb + 256 * j + 4 * lane); v[j] = (f32x4){bflo(w.x), bfhi(w.x), bflo(w.y), bfhi(w.y)}; }
}
__device__ __forceinline__ void store_row_b(const f32x4 (&v)[8], bf16* xb, int lane) {
#pragma unroll
    for (int j = 0; j < 8; ++j) { v2u o; o.x = pk2(v[j][0], v[j][1]); o.y = pk2(v[j][2], v[j][3]); *(GAS v2u*)(xb + 256 * j + 4 * lane) = o; }
}
__device__ __forceinline__ void load_row_bt(f32x4 (&v)[8], const bf16* base, int row, int lane) {
#pragma unroll
    for (int j = 0; j < 8; ++j) { const v2u w = *(const GAS v2u*)AT(base, row, 256 * j + 4 * lane, D); v[j] = (f32x4){bflo(w.x), bfhi(w.x), bflo(w.y), bfhi(w.y)}; }
}
__device__ __forceinline__ void store_row_bt(const f32x4 (&v)[8], bf16* base, int row, int lane) {
#pragma unroll
    for (int j = 0; j < 8; ++j) { v2u o; o.x = pk2(v[j][0], v[j][1]); o.y = pk2(v[j][2], v[j][3]); *(GAS v2u*)AT(base, row, 256 * j + 4 * lane, D) = o; }
}
__device__ __forceinline__ void ln_phase_b(const Frame& F, const Args& A, const float* w, const float* bvec, const bf16* TB, bf16* XB) {
    const int lane = lane_now(); const int gw = blockIdx.x * NWAVES + F.wave, NGW = F.G * NWAVES;
    const LnAff af = ln_aff_load(w, bvec, lane);
    f32x4 v[8], vn[8]; int row = gw; if (row < M) load_row_b(v, TB + (size_t)row * D, lane);
    for (; row < M; row += NGW) {
        const int rn = row + NGW; if (rn < M) load_row_b(vn, TB + (size_t)rn * D, lane);
        ln_row_regs(v, af, lane); store_row_b(v, XB + (size_t)row * D, lane);
#pragma unroll
        for (int j = 0; j < 8; ++j) v[j] = vn[j]; }
}
__device__ __forceinline__ void ln_phase(const Frame& F, const Args& A, const float* w, const float* bvec, bf16* XB) {
    const int lane = lane_now(), tid = F.wave * 64 + lane; (void)tid;
    const LnAff af = ln_aff_load(w, bvec, lane);
    const int gw = blockIdx.x * NWAVES + F.wave, NGW = F.G * NWAVES;
    for (int row = gw; row < M; row += NGW) { float* xr = A.out + (size_t)row * D; f32x4 v[8];
#pragma unroll
        for (int j = 0; j < 8; ++j) v[j] = *(const GAS f32x4*)(xr + 256 * j + 4 * lane);
        ln_row_regs(v, af, lane); store_row(v, xr, XB + (size_t)row * D, lane); }
}
__device__ __forceinline__ void ln_router_phase(const Frame& F, const Args& A, const float* w, const float* bvec, bf16* XB) {
    const int lane = lane_now(), tid = F.wave * 64 + lane; (void)tid;
    const LnAff af = ln_aff_load(w, bvec, lane);
    LAS int* cnt = (LAS int*)(F.lds + RING_OFF);
    int* TOKE = (int*)(A.ws + WS_TOKE); float* TOKG = (float*)(A.ws + WS_TOKG); int* WGCNT = (int*)(A.ws + WS_WGCNT);
    const float* wr = A.in[I_WR]; const float* br = A.in[I_BR];
    LAS f32x4* wt = (LAS f32x4*)(F.lds + RING_OFF + 1024);
    for (int x = tid; x < 2048 * 2; x += NWAVES * 64) { const int col = x >> 1, half = x & 1; const int j = col >> 8, ln = (col & 255) >> 2, i = col & 3;
        wt[((j * 4 + i) * 2 + half) * 64 + ln] = *(const GAS f32x4*)(wr + (size_t)col * NE + 4 * half); }
    for (int vb = blockIdx.x; vb < M / 64; vb += F.G) {
        if (tid < 8) cnt[tid] = 0;
        __syncthreads();
        f32x4 v[8], vn[8];
        { const float* xr0 = A.out + (size_t)(vb * 64 + F.wave * 8) * D;
#pragma unroll
          for (int j = 0; j < 8; ++j) v[j] = *(const GAS f32x4*)(xr0 + 256 * j + 4 * lane); }
        for (int k = 0; k < 8; ++k) { const int row = vb * 64 + F.wave * 8 + k;
            if (k + 1 < 8) { const float* xn = A.out + (size_t)(row + 1) * D;
#pragma unroll
                for (int j = 0; j < 8; ++j) vn[j] = *(const GAS f32x4*)(xn + 256 * j + 4 * lane); }
            ln_row_regs(v, af, lane); store_row_b(v, XB + (size_t)row * D, lane);
            float lg[8];
#pragma unroll
            for (int e = 0; e < 8; ++e) lg[e] = 0.f;
#pragma unroll
            for (int j = 0; j < 8; ++j)
#pragma unroll
                for (int i = 0; i < 4; ++i) { const f32x4 w0 = wt[((j * 4 + i) * 2 + 0) * 64 + lane], w1 = wt[((j * 4 + i) * 2 + 1) * 64 + lane]; const float xv = v[j][i];
                    lg[0] += xv * w0[0]; lg[1] += xv * w0[1]; lg[2] += xv * w0[2]; lg[3] += xv * w0[3]; lg[4] += xv * w1[0]; lg[5] += xv * w1[1]; lg[6] += xv * w1[2]; lg[7] += xv * w1[3]; }
#pragma unroll
            for (int e = 0; e < 8; ++e) lg[e] = wave_sum(lg[e]) + br[e];
            int e1 = 0; float l1 = lg[0];
#pragma unroll
            for (int e = 1; e < 8; ++e) if (lg[e] > l1) { l1 = lg[e]; e1 = e; }
            int e2 = -1; float l2 = -3.0e38f;
#pragma unroll
            for (int e = 0; e < 8; ++e) if (e != e1 && lg[e] > l2) { l2 = lg[e]; e2 = e; }
            const float g2 = 1.0f / (1.0f + __expf(l1 - l2)), g1 = 1.0f - g2;
            if (lane == 0) { TOKE[2 * row] = e1; TOKE[2 * row + 1] = e2; TOKG[2 * row] = g1; TOKG[2 * row + 1] = g2; __hip_atomic_fetch_add(&cnt[e1], 1, __ATOMIC_RELAXED, __HIP_MEMORY_SCOPE_WORKGROUP); __hip_atomic_fetch_add(&cnt[e2], 1, __ATOMIC_RELAXED, __HIP_MEMORY_SCOPE_WORKGROUP); }
#pragma unroll
            for (int j = 0; j < 8; ++j) v[j] = vn[j];
        }
        __syncthreads();
        if (tid < 8) WGCNT[vb * 8 + tid] = cnt[tid];
        __syncthreads();
    }
}
__device__ __forceinline__ int inv_slot(int d) { const int rr = d & 127; return (((d >> 7) * 64 + (rr & 63)) << 1) + (rr >> 6); }
__device__ __forceinline__ void moe_route_phase(const Frame& F, const Args& A) {
    const int lane = lane_now(), tid = F.wave * 64 + lane; (void)lane;
    LAS int* sm = (LAS int*)(F.lds + RING_OFF);
    const int* TOKE = (const int*)(A.ws + WS_TOKE); int* DEST = (int*)(A.ws + WS_DEST); const int* WGCNT = (const int*)(A.ws + WS_WGCNT); int* TILEE = (int*)(A.ws + WS_TILEE); unsigned short* INV = (unsigned short*)(A.ws + WS_INV);
    for (int vb = blockIdx.x; vb < M / 64; vb += F.G) {
        if (tid < 16) sm[tid] = 0;
        if (tid >= 64 && tid < 192) sm[32 + tid - 64] = TOKE[vb * 128 + tid - 64];
        __syncthreads();
        {   const int e = tid & 7, wq = tid >> 3; int tot = 0, pre = 0;
#pragma unroll
            for (int i = 0; i < 4; ++i) { const int w = wq * 4 + i; const int c = WGCNT[w * 8 + e]; tot += c; pre += (w < vb) ? c : 0; }
            __hip_atomic_fetch_add(&sm[e], tot, __ATOMIC_RELAXED, __HIP_MEMORY_SCOPE_WORKGROUP); __hip_atomic_fetch_add(&sm[8 + e], pre, __ATOMIC_RELAXED, __HIP_MEMORY_SCOPE_WORKGROUP); }
        __syncthreads();
        if (tid == 0) { int base = 0; for (int e = 0; e < 8; ++e) { sm[16 + e] = base; base += ((sm[e] + 255) >> 8) << 8; }
            if (vb == 0) { int rt = 0; for (int e = 0; e < 8; ++e) { const int nt = (sm[e] + 255) >> 8; for (int i = 0; i < nt; ++i) TILEE[1 + rt++] = e; } TILEE[0] = rt; } }
        __syncthreads();
        if (tid < 128) { const int e = sm[32 + tid]; int rank = 0; for (int s = 0; s < tid; ++s) rank += (sm[32 + s] == e) ? 1 : 0; const int d = sm[16 + e] + sm[8 + e] + rank; DEST[vb * 128 + tid] = d; INV[inv_slot(d)] = (unsigned short)(vb * 64 + (tid >> 1)); }
        if (vb == 0) { for (int e = 0; e < 8; ++e) { const int tot = sm[e], pad = ((tot + 255) >> 8) << 8, base = sm[16 + e]; for (int i = tot + tid; i < pad; i += NWAVES * 64) INV[inv_slot(base + i)] = 0; } }
        __syncthreads();
    }
}
__device__ __forceinline__ void ln_moe_phase(const Frame& F, const Args& A, const float* w, const float* bvec, const bf16* XBin, bf16* XBout) {
    const int lane = lane_now(); const int gw = blockIdx.x * NWAVES + F.wave, NGW = F.G * NWAVES;
    const LnAff af = ln_aff_load(w, bvec, lane);
    const float* TOKG = (const float*)(A.ws + WS_TOKG); const int* DEST = (const int*)(A.ws + WS_DEST); const bf16* YS = (const bf16*)(A.ws + WS_YS);
    const bf16* PARTB = (const bf16*)(A.ws + WS_PART);
    f32x4 v[8], y1[8], y2[8]; int row = gw; int d1 = 0, d2 = 0; float g1 = 0.f, g2 = 0.f;
    if (row < M) { d1 = DEST[2 * row]; d2 = DEST[2 * row + 1]; g1 = TOKG[2 * row]; g2 = TOKG[2 * row + 1]; }
#define LD_YROW(dst, d_) do { if ((d_) < pg8::TAIL_PM0 * 256) load_row_b(dst, YS + (size_t)(d_) * D, lane); else { const bf16* pb_ = PARTB + (size_t)((d_) - pg8::TAIL_PM0 * 256) * D; \
        load_row_b(dst, pb_, lane); \
        for (int ks_ = 1; ks_ < pg8::TAIL_KS; ++ks_) { f32x4 t_[8]; load_row_b(t_, pb_ + (size_t)ks_ * pg8::TAIL_ROWS * D, lane); _Pragma("unroll") for (int j = 0; j < 8; ++j) dst[j] = dst[j] + t_[j]; } } } while (0)
    for (; row < M; row += NGW) {
        load_row_b(v, XBin + (size_t)row * D, lane); LD_YROW(y1, d1); LD_YROW(y2, d2);
        const float cg1 = g1, cg2 = g2; const int rn = row + NGW;
        if (rn < M) { d1 = DEST[2 * rn]; d2 = DEST[2 * rn + 1]; g1 = TOKG[2 * rn]; g2 = TOKG[2 * rn + 1]; }
#pragma unroll
        for (int j = 0; j < 8; ++j) v[j] = v[j] * ALPHA + y1[j] * cg1 + y2[j] * cg2;
        ln_row_regs(v, af, lane); store_row_b(v, XBout + (size_t)row * D, lane); }
#undef LD_YROW
}

__device__ __forceinline__ void na_phase_simple(const Frame& F, const Args& A) {
    const int lane = lane_now(), tid = F.wave * 64 + lane; (void)tid;
    const int gw = blockIdx.x * NWAVES + F.wave, NGW = F.G * NWAVES;
    const bf16* QKV = (const bf16*)(A.ws + WS_QKV); bf16* AO = (bf16*)(A.ws + WS_AO); const float* rpb = A.in[I_RPB];
    const float scale = 0.08838834764831845f;
    for (int task = gw; task < M * 16; task += NGW) {
        const int tok = task >> 4, h = task & 15, b = tok >> 12, r = (tok >> 6) & 63, c = tok & 63;
        const int rs = min(max(r - 4, 0), 56), cs = min(max(c - 8, 0), 48);
        const GAS v4u* qp = (const GAS v4u*)(QKV + (size_t)tok * NQKV + h * 128);
        float sc[2];
#pragma unroll
        for (int i = 0; i < 2; ++i) { const int kk = lane + 64 * i, jr = kk >> 4, jc = kk & 15; const int ktok = b * T + (rs + jr) * 64 + cs + jc;
            const GAS v4u* kp = (const GAS v4u*)(QKV + (size_t)ktok * NQKV + D + h * 128); float acc = 0.f;
#pragma unroll 4
            for (int j = 0; j < 16; ++j) { const v4u q = qp[j], k = kp[j];
                acc += bflo(q.x) * bflo(k.x) + bfhi(q.x) * bfhi(k.x) + bflo(q.y) * bflo(k.y) + bfhi(q.y) * bfhi(k.y) + bflo(q.z) * bflo(k.z) + bfhi(q.z) * bfhi(k.z) + bflo(q.w) * bflo(k.w) + bfhi(q.w) * bfhi(k.w); }
            sc[i] = acc * scale + rpb[(h * 15 + (rs + jr - r + 7)) * 31 + (cs + jc - c + 15)]; }
        const float mx = wave_max(fmaxf(sc[0], sc[1]));
        const float p0 = __expf(sc[0] - mx), p1 = __expf(sc[1] - mx);
        const float inv = 1.0f / wave_sum(p0 + p1);
        float a0 = 0.f, a1 = 0.f;
        const bf16* vbase = QKV + 2 * D + h * 128 + 2 * lane;
#pragma unroll
        for (int i = 0; i < 2; ++i) { const float pi = i ? p1 : p0;
#pragma unroll 8
            for (int l = 0; l < 64; ++l) { const int kk = l + 64 * i, jr = kk >> 4, jc = kk & 15; const int ktok = b * T + (rs + jr) * 64 + cs + jc;
                const float pk = __builtin_bit_cast(float, __builtin_amdgcn_readlane(__builtin_bit_cast(int, pi), l));
                const unsigned vv = *(const GAS unsigned*)(vbase + (size_t)ktok * NQKV); a0 += pk * bflo(vv); a1 += pk * bfhi(vv); } }
        *(GAS unsigned*)(AO + (size_t)tok * D + h * 128 + 2 * lane) = pk2(a0 * inv, a1 * inv);
    }
}
constexpr int NA_VP = 288, NA_KP = 272;
__device__ __forceinline__ void na_phase_mfma(const Frame& F, const Args& A) {
    const int lane = lane_now(), tid = F.wave * 64 + lane, i = lane & 15, fq = lane >> 4;
    const bf16* QKV = (const bf16*)(A.ws + WS_QKV); bf16* AO = (bf16*)(A.ws + WS_AO); const float* rpb = A.in[I_RPB];
    LAS unsigned char* vl = F.lds + RING_OFF;
    LAS float* rp = (LAS float*)(F.lds + RING_OFF + 5 * 64 * NA_VP);
    const int qsel = F.wave >> 2, qi = F.wave & 3, wc = min(max(16 * qi - 8, 0), 32);
    const int qc = 16 * qi + i, cs = min(max(qc - 8, 0), 48);
    const float scale = 0.08838834764831845f;
    const int q4 = (lane & 15) >> 2, p4 = lane & 3;
    v4u vreg[10];
#define NA_LOAD(NR, row0, moff, tokb_, h_) do { _Pragma("unroll") for (int k = 0; k < 2 * (NR); ++k) { const int ch = tid + 512 * k, row = ch >> 10, key = (ch >> 4) & 63, c16 = ch & 15; const int vr = min((row0) + row, 63); \
        vreg[k] = *(const GAS v4u*)(QKV + (size_t)(moff) * ((size_t)M * D) + ((tokb_) + vr * 64 + key) * 128 + c16 * 8); } } while (0)
#define NA_STORE(NR, pitch) do { _Pragma("unroll") for (int k = 0; k < 2 * (NR); ++k) { const int ch = tid + 512 * k, row = ch >> 10, key = (ch >> 4) & 63, c16 = ch & 15; *(LAS v4u*)(vl + (row * 64 + key) * (pitch) + c16 * 16) = vreg[k]; } } while (0)
    const int upw = (64 * 32 + F.G - 1) / F.G; int unit = blockIdx.x * upw; const int unit_end = min(unit + upw, 64 * 32);
    if (unit < 64 * 32) { const int rpi = unit & 31, bh = unit >> 5, h = bh & 15, b = bh >> 4; const int R0 = min(max(2 * rpi - 4, 0), 56); NA_LOAD(5, R0, 1, (size_t)(b * 16 + h) * T, h); }
    int hprev = -1;
    for (; unit < unit_end; unit += 1) {
        const int rpi = unit & 31, bh = unit >> 5, h = bh & 15, b = bh >> 4;
        const int r0 = 2 * rpi, qrow = r0 + qsel, R0 = min(max(r0 - 4, 0), 56), rsw = min(max(qrow - 4, 0), 56);
        const size_t tokb = (size_t)b * T, hrow = (size_t)(b * 16 + h) * T;
        bf16x8 bq[4];
        { const bf16* qp = QKV + (hrow + qrow * 64 + qc) * 128 + 8 * fq;
#pragma unroll
          for (int kk = 0; kk < 4; ++kk) bq[kk] = *(const GAS bf16x8*)(qp + 32 * kk); }
        __syncthreads();
        if (h != hprev) { if (tid < 465) rp[tid] = rpb[h * 465 + tid]; hprev = h; }
        NA_STORE(5, NA_KP); NA_LOAD(4, R0 + 5, 1, hrow, h);
        __syncthreads();
        f32x4 acc[16];
#pragma unroll
        for (int kt = 0; kt < 16; ++kt) acc[kt] = (f32x4){0.f, 0.f, 0.f, 0.f};
        LAS unsigned char* kb0 = vl + (wc + i) * NA_KP + 16 * fq;
#pragma unroll
        for (int jr = 0; jr < 8; ++jr) { const int la = rsw + jr - R0;
            if (la <= 4) { LAS unsigned char* kp = kb0 + la * 64 * NA_KP;
                bf16x8 ka[2][4];
#pragma unroll
                for (int kb2 = 0; kb2 < 2; ++kb2)
#pragma unroll
                    for (int kk = 0; kk < 4; ++kk) ka[kb2][kk] = *(const LAS bf16x8*)(kp + 16 * kb2 * NA_KP + 64 * kk);
#pragma unroll
                for (int kb2 = 0; kb2 < 2; ++kb2)
#pragma unroll
                    for (int kk = 0; kk < 4; ++kk) acc[2 * jr + kb2] = __builtin_amdgcn_mfma_f32_16x16x32_bf16(ka[kb2][kk], bq[kk], acc[2 * jr + kb2], 0, 0, 0); } }
        __syncthreads();
        NA_STORE(4, NA_KP); NA_LOAD(5, R0, 2, hrow, h);
        __syncthreads();
#pragma unroll
        for (int jr = 0; jr < 8; ++jr) { const int la = rsw + jr - R0 - 5;
            if (la >= 0) { LAS unsigned char* kp = kb0 + la * 64 * NA_KP;
                bf16x8 ka[2][4];
#pragma unroll
                for (int kb2 = 0; kb2 < 2; ++kb2)
#pragma unroll
                    for (int kk = 0; kk < 4; ++kk) ka[kb2][kk] = *(const LAS bf16x8*)(kp + 16 * kb2 * NA_KP + 64 * kk);
#pragma unroll
                for (int kb2 = 0; kb2 < 2; ++kb2)
#pragma unroll
                    for (int kk = 0; kk < 4; ++kk) acc[2 * jr + kb2] = __builtin_amdgcn_mfma_f32_16x16x32_bf16(ka[kb2][kk], bq[kk], acc[2 * jr + kb2], 0, 0, 0); } }
        float mx = -3.0e38f;
#pragma unroll
        for (int kt = 0; kt < 16; ++kt) { const int jr = kt >> 1, kb2 = kt & 1; const int dr = rsw + jr - qrow + 7;
#pragma unroll
            for (int r = 0; r < 4; ++r) { const int kc = wc + 16 * kb2 + 4 * fq + r; const int dc = min(max(kc - qc + 15, 0), 30); const bool ok = (kc >= cs) && (kc < cs + 16);
                const float s = ok ? acc[kt][r] * scale + rp[dr * 31 + dc] : -3.0e38f; acc[kt][r] = s; mx = fmaxf(mx, s); } }
        mx = fmaxf(mx, __shfl_xor(mx, 16)); mx = fmaxf(mx, __shfl_xor(mx, 32));
        float sum = 0.f;
#pragma unroll
        for (int kt = 0; kt < 16; ++kt)
#pragma unroll
            for (int r = 0; r < 4; ++r) { const float p = __expf(acc[kt][r] - mx); acc[kt][r] = p; sum += p; }
        sum += __shfl_xor(sum, 16); sum += __shfl_xor(sum, 32);
        const float inv = 1.0f / sum;
        bf16x8 pb[8];
#pragma unroll
        for (int ks = 0; ks < 8; ++ks) { v4u w; w.x = cvtpk(acc[2 * ks][0], acc[2 * ks][1]); w.y = cvtpk(acc[2 * ks][2], acc[2 * ks][3]); w.z = cvtpk(acc[2 * ks + 1][0], acc[2 * ks + 1][1]); w.w = cvtpk(acc[2 * ks + 1][2], acc[2 * ks + 1][3]);
            pb[ks] = __builtin_bit_cast(bf16x8, w); }
        __syncthreads();
        NA_STORE(5, NA_VP); NA_LOAD(4, R0 + 5, 2, hrow, h);
        __syncthreads();
        f32x4 o[8];
#pragma unroll
        for (int db = 0; db < 8; ++db) o[db] = (f32x4){0.f, 0.f, 0.f, 0.f};
        LAS unsigned char* vb0 = vl + (wc + 4 * fq + q4) * NA_VP + 8 * p4;
#pragma unroll
        for (int jr = 0; jr < 8; ++jr) { const int la = rsw + jr - R0;
            if (la <= 4) { LAS unsigned char* vp = vb0 + la * 64 * NA_VP;
                s16x4 x0[8], x1[8];
#pragma unroll
                for (int db = 0; db < 8; ++db) { x0[db] = lds_tr(vp + 32 * db); x1[db] = lds_tr(vp + 16 * NA_VP + 32 * db); }
#pragma unroll
                for (int db = 0; db < 8; ++db) { const bf16x8 a = (bf16x8){x0[db][0], x0[db][1], x0[db][2], x0[db][3], x1[db][0], x1[db][1], x1[db][2], x1[db][3]};
                    o[db] = __builtin_amdgcn_mfma_f32_16x16x32_bf16(a, pb[jr], o[db], 0, 0, 0); } } }
        __syncthreads();
        NA_STORE(4, NA_VP);
        { const int un = unit + 1; if (un < unit_end) { const int rpn = un & 31, bhn = un >> 5, hn = bhn & 15, bn = bhn >> 4; const int R0n = min(max(2 * rpn - 4, 0), 56); NA_LOAD(5, R0n, 1, (size_t)(bn * 16 + hn) * T, hn); } }
        __syncthreads();
#pragma unroll
        for (int jr = 0; jr < 8; ++jr) { const int la = rsw + jr - R0 - 5;
            if (la >= 0) { LAS unsigned char* vp = vb0 + la * 64 * NA_VP;
                s16x4 x0[8], x1[8];
#pragma unroll
                for (int db = 0; db < 8; ++db) { x0[db] = lds_tr(vp + 32 * db); x1[db] = lds_tr(vp + 16 * NA_VP + 32 * db); }
#pragma unroll
                for (int db = 0; db < 8; ++db) { const bf16x8 a = (bf16x8){x0[db][0], x0[db][1], x0[db][2], x0[db][3], x1[db][0], x1[db][1], x1[db][2], x1[db][3]};
                    o[db] = __builtin_amdgcn_mfma_f32_16x16x32_bf16(a, pb[jr], o[db], 0, 0, 0); } } }
        const int orow = (int)(tokb + qrow * 64 + qc);
#pragma unroll
        for (int db = 0; db < 8; ++db) { v2u w; w.x = cvtpk(o[db][0] * inv, o[db][1] * inv); w.y = cvtpk(o[db][2] * inv, o[db][3] * inv); *(GAS v2u*)AT(AO, orow, h * 128 + 16 * db + 4 * fq, D) = w; }
    }
#undef NA_LOAD
#undef NA_STORE
    __syncthreads();
}
__device__ __forceinline__ float wave_scan_incl(float v, int lane) {
#pragma unroll
    for (int off = 1; off < 64; off <<= 1) { const float t = __shfl_up(v, off); if (lane >= off) v += t; }
    return v;
}
__device__ __forceinline__ void rec_prep(const Frame& F, const Args& A) {
    const int lane = lane_now(); const int gw = blockIdx.x * NWAVES + F.wave, NGW = F.G * NWAVES;
    const bf16* U = (const bf16*)(A.ws + WS_U); const float* Gt = (const float*)(A.ws + WS_G);
    bf16* QIN = (bf16*)(A.ws + WS_QIN); bf16* KIN = (bf16*)(A.ws + WS_KIN); float* GTAB = (float*)(A.ws + WS_GTAB);
    float* EQM = (float*)(A.ws + WS_EQM); float* EKM = (float*)(A.ws + WS_EKM); float* GTABM = (float*)(A.ws + WS_GTABM);
    for (int item = gw; item < 2048; item += NGW) {
        const int c = item & 63, dir = (item >> 6) & 1, h = (item >> 7) & 3, b = item >> 9;
        const size_t tk = (size_t)b * T + (dir ? (T - 1 - (64 * c + lane)) : (64 * c + lane));
        const float bias_i = A.in[I_GBIAS][(dir ? 2 : 0) * 4 + h], bias_f = A.in[I_GBIAS][(dir ? 3 : 1) * 4 + h];
        const float gi = GATE_CAP * tanhf((Gt[tk * 16 + (dir ? 2 : 0) * 4 + h] + bias_i) * (1.0f / GATE_CAP)), gf = GATE_CAP * tanhf((Gt[tk * 16 + (dir ? 3 : 1) * 4 + h] + bias_f) * (1.0f / GATE_CAP));
        const float lf = -log1pf(__expf(-gf)); const float bb = wave_scan_incl(lf, lane);
        const float gg = __builtin_bit_cast(float, __builtin_amdgcn_readlane(__builtin_bit_cast(int, bb), 63));
        const float eq = 0.08838834764831845f * __expf(bb), ek = __expf(gi - bb);
        GTABM[(size_t)item * 128 + lane] = gg; GTABM[(size_t)item * 128 + 64 + lane] = gg;
        EQM[(size_t)item * 64 + lane] = eq; EKM[(size_t)item * 64 + lane] = ek;
    }
    for (int item = gw; item < 4096; item += NGW) {
        const int c = item & 63, dir = (item >> 6) & 1, h = (item >> 7) & 7, b = item >> 10;
        const int ch = h * 128 + 2 * lane;
        const float l00 = A.in[I_LBLOG][(dir * 2 + 0) * 1024 + ch], l01 = A.in[I_LBLOG][(dir * 2 + 1) * 1024 + ch], l10 = A.in[I_LBLOG][(dir * 2 + 0) * 1024 + ch + 1], l11 = A.in[I_LBLOG][(dir * 2 + 1) * 1024 + ch + 1];
        const float lb0 = 1.0f / (1.0f + __expf(l01 - l00)), lb1 = 1.0f / (1.0f + __expf(l11 - l10));
        float pr0 = 1.f, pr1 = 1.f;
        for (int tb = 0; tb < 64; tb += 16) {
            unsigned qw[16], fw[16];
#pragma unroll
            for (int u = 0; u < 16; ++u) { const int tau = tb + u; const size_t tk = (size_t)b * T + (dir ? (T - 1 - (64 * c + tau)) : (64 * c + tau));
                qw[u] = *(const GAS unsigned*)(U + tk * UW + U_QB + ch); fw[u] = *(const GAS unsigned*)(U + tk * UW + (dir ? U_FB : U_FF) + ch); }
#pragma unroll
            for (int u = 0; u < 16; ++u) { const int tau = tb + u; const int tl = dir ? (T - 1 - (64 * c + tau)) : (64 * c + tau);
                const float q0 = bflo(qw[u]), q1 = bfhi(qw[u]);
                const float f0 = lb0 + (1.0f - lb0) * sigm(bflo(fw[u])), f1 = lb1 + (1.0f - lb1) * sigm(bfhi(fw[u]));
                pr0 *= f0; pr1 *= f1;
                const size_t o = ((size_t)(((dir * 4 + b) * 8 + h)) * T + tl) * 128 + 2 * lane;
                *(GAS unsigned*)(QIN + o) = cvtpk(q0 * sigm(q0) * pr0, q1 * sigm(q1) * pr1);
                *(GAS unsigned*)(KIN + o) = cvtpk((1.0f - f0) * __builtin_amdgcn_rcpf(pr0), (1.0f - f1) * __builtin_amdgcn_rcpf(pr1)); }
        }
        *(GAS f32x2*)(GTAB + (size_t)item * 128 + 2 * lane) = (f32x2){__logf(pr0), __logf(pr1)};
    }
}

__device__ __forceinline__ void gates_mfma(const Frame& F, const Args& A) {
    const int lane = lane_now(), i = lane & 15, fq = lane >> 4; const int gw = blockIdx.x * NWAVES + F.wave, NGW = F.G * NWAVES;
    const bf16* X = (const bf16*)(A.ws + WS_XB0); const bf16* Wg = (const bf16*)(A.ws + WS_WGATE);
    float* Gt = (float*)(A.ws + WS_G);
    for (int blk = gw; blk < M / 16; blk += NGW) {
        const bf16* wp = Wg + (size_t)i * D + 8 * fq; const int xrow = 16 * blk + i;
        f32x4 acc0 = (f32x4){0.f, 0.f, 0.f, 0.f}, acc1 = (f32x4){0.f, 0.f, 0.f, 0.f};
#pragma unroll 4
        for (int kk = 0; kk < D / 32; kk += 2) {
            const bf16x8 a0 = *(const GAS bf16x8*)(wp + 32 * kk), b0 = *(const GAS bf16x8*)(X + (size_t)xrow * D + 32 * kk + 8 * fq), a1 = *(const GAS bf16x8*)(wp + 32 * kk + 32), b1 = *(const GAS bf16x8*)(X + (size_t)xrow * D + 32 * kk + 32 + 8 * fq);
            acc0 = __builtin_amdgcn_mfma_f32_16x16x32_bf16(a0, b0, acc0, 0, 0, 0); acc1 = __builtin_amdgcn_mfma_f32_16x16x32_bf16(a1, b1, acc1, 0, 0, 0);
        }
        *(GAS f32x4*)(Gt + (size_t)(16 * blk + i) * 16 + 4 * fq) = acc0 + acc1;
    }
}
constexpr int RQ_P = 272;
template <int NEB> struct RecMap {
    static constexpr int VP = NEB * 32 + 8, Q = 0, K = 17408, V = 34816, TB = V + 64 * VP, EQ = TB + 512, PAR = EQ + 256, SB = 2 * PAR, SBSZ = 128 * VP;
    static_assert(TB % 16 == 0 && PAR % 16 == 0 && SB + 2 * SBSZ <= RING_BYTES, "recurrence LDS map");
};
struct RecP { const bf16* qin; const bf16* kin;
              const bf16* vsrc;
              const float* gtab;
              bf16* out;
              int b, dir;
              int qs;
              const float* eq; const float* ek; };

template <int NEB>
__device__ __forceinline__ void rec_compute(int wave, int lane, LAS unsigned char* P, LAS unsigned char* SBc, LAS unsigned char* SBn, f32x4 (&Sst)[NEB][2], bf16* outrow  ) {
    typedef RecMap<NEB> Mp;
    const int i = lane & 15, fq = lane >> 4, q4 = i >> 2, p4 = lane & 3;
#define RC_TR2(dst, ptr, step) do { const s16x4 x0_ = lds_tr(ptr), x1_ = lds_tr((ptr) + (step)); dst = (bf16x8){x0_[0], x0_[1], x0_[2], x0_[3], x1_[0], x1_[1], x1_[2], x1_[3]}; } while (0)
    if (wave < 4) {
        __builtin_amdgcn_s_setprio(2);
        const int tbk = wave;
        bf16x8 qf[4], sf[4][NEB], kf[4][4], vf[2][NEB];
#pragma unroll
        for (int kk = 0; kk < 4; ++kk) qf[kk] = *(const LAS bf16x8*)(P + Mp::Q + (16 * tbk + i) * RQ_P + (32 * kk + 8 * fq) * 2);
#pragma unroll
        for (int kk = 0; kk < 4; ++kk)
#pragma unroll
            for (int eb = 0; eb < NEB; ++eb) RC_TR2(sf[kk][eb], SBc + (32 * kk + 8 * fq + q4) * Mp::VP + (16 * eb + 4 * p4) * 2, 4 * Mp::VP);
#pragma unroll
        for (int sb = 0; sb < 2; ++sb) if (sb <= tbk) {
#pragma unroll
            for (int kk = 0; kk < 4; ++kk) kf[sb][kk] = *(const LAS bf16x8*)(P + Mp::K + (16 * sb + i) * RQ_P + (32 * kk + 8 * fq) * 2); }
        f32x4 o[NEB];
#pragma unroll
        for (int eb = 0; eb < NEB; ++eb) o[eb] = (f32x4){0.f, 0.f, 0.f, 0.f};
#pragma unroll
        for (int kk = 0; kk < 4; ++kk)
#pragma unroll
            for (int eb = 0; eb < NEB; ++eb) o[eb] = __builtin_amdgcn_mfma_f32_16x16x32_bf16(sf[kk][eb], qf[kk], o[eb], 0, 0, 0);
        asm volatile("" ::: "memory");
#pragma unroll
        for (int sb = 2; sb < 4; ++sb) if (sb <= tbk) {
#pragma unroll
            for (int kk = 0; kk < 4; ++kk) kf[sb][kk] = *(const LAS bf16x8*)(P + Mp::K + (16 * sb + i) * RQ_P + (32 * kk + 8 * fq) * 2); }
#pragma unroll
        for (int ks = 0; ks < 2; ++ks) if (2 * ks <= tbk) {
#pragma unroll
            for (int eb = 0; eb < NEB; ++eb) RC_TR2(vf[ks][eb], P + Mp::V + (32 * ks + 4 * fq + q4) * Mp::VP + (16 * eb + 4 * p4) * 2, 16 * Mp::VP); }
        f32x4 pt[4];
#pragma unroll
        for (int sb = 0; sb < 4; ++sb) { pt[sb] = (f32x4){0.f, 0.f, 0.f, 0.f};
            if (sb <= tbk) { f32x4 acc = (f32x4){0.f, 0.f, 0.f, 0.f};
#pragma unroll
                for (int kk = 0; kk < 4; ++kk) acc = __builtin_amdgcn_mfma_f32_16x16x32_bf16(kf[sb][kk], qf[kk], acc, 0, 0, 0);
#pragma unroll
                for (int r = 0; r < 4; ++r) { const bool ok = (sb < tbk) || (4 * fq + r <= i); pt[sb][r] = ok ? acc[r] : 0.f; } } }
#pragma unroll
        for (int ks = 0; ks < 2; ++ks) if (2 * ks <= tbk) {
            v4u w; w.x = cvtpk(pt[2 * ks][0], pt[2 * ks][1]); w.y = cvtpk(pt[2 * ks][2], pt[2 * ks][3]); w.z = cvtpk(pt[2 * ks + 1][0], pt[2 * ks + 1][1]); w.w = cvtpk(pt[2 * ks + 1][2], pt[2 * ks + 1][3]);
            const bf16x8 pf = __builtin_bit_cast(bf16x8, w);
#pragma unroll
            for (int eb = 0; eb < NEB; ++eb) o[eb] = __builtin_amdgcn_mfma_f32_16x16x32_bf16(vf[ks][eb], pf, o[eb], 0, 0, 0); }
        bf16* hp = outrow + 4 * fq; float rden = 1.0f;
        if (NEB == 3) { const float eqt = ((const LAS float*)(P + Mp::EQ))[16 * tbk + i]; const float den = __shfl(o[NEB - 1][0], i) * eqt; rden = __builtin_amdgcn_rcpf(fmaxf(fabsf(den), 1.0f)) * eqt; }
        { v2u w; w.x = cvtpk(o[0][0] * rden, o[0][1] * rden); w.y = cvtpk(o[0][2] * rden, o[0][3] * rden); *(GAS v2u*)(hp) = w; w.x = cvtpk(o[1][0] * rden, o[1][1] * rden); w.y = cvtpk(o[1][2] * rden, o[1][3] * rden); *(GAS v2u*)(hp + 16) = w; }
        __builtin_amdgcn_s_setprio(0);
    } else {
        const int wq = wave - 4;
        bf16x8 af[2][NEB], bfr[2][2];
#pragma unroll
        for (int ks = 0; ks < 2; ++ks) {
#pragma unroll
            for (int eb = 0; eb < NEB; ++eb) RC_TR2(af[ks][eb], P + Mp::V + (32 * ks + 8 * fq + q4) * Mp::VP + (16 * eb + 4 * p4) * 2, 4 * Mp::VP);
#pragma unroll
            for (int dbi = 0; dbi < 2; ++dbi) RC_TR2(bfr[ks][dbi], P + Mp::K + (32 * ks + 8 * fq + q4) * RQ_P + (16 * (2 * wq + dbi) + 4 * p4) * 2, 4 * RQ_P); }
        float eg[2];
#pragma unroll
        for (int dbi = 0; dbi < 2; ++dbi) eg[dbi] = __expf(((const LAS float*)(P + Mp::TB))[16 * (2 * wq + dbi) + i]);
#pragma unroll
        for (int ks = 0; ks < 2; ++ks)
#pragma unroll
            for (int eb = 0; eb < NEB; ++eb)
#pragma unroll
                for (int dbi = 0; dbi < 2; ++dbi) Sst[eb][dbi] = __builtin_amdgcn_mfma_f32_16x16x32_bf16(af[ks][eb], bfr[ks][dbi], Sst[eb][dbi], 0, 0, 0);
#pragma unroll
        for (int dbi = 0; dbi < 2; ++dbi)
#pragma unroll
            for (int eb = 0; eb < NEB; ++eb) { Sst[eb][dbi] = Sst[eb][dbi] * eg[dbi]; v2u o; o.x = cvtpk(Sst[eb][dbi][0], Sst[eb][dbi][1]); o.y = cvtpk(Sst[eb][dbi][2], Sst[eb][dbi][3]);
                *(LAS v2u*)(SBn + (16 * (2 * wq + dbi) + i) * Mp::VP + (16 * eb + 4 * fq) * 2) = o; }
    }
#undef RC_TR2
}
template <int NEB>
__device__ __forceinline__ void rec_unit(const Frame& F, const RecP R) {
    typedef RecMap<NEB> Mp;
    const int lane = lane_now(), tid = F.wave * 64 + lane;
    LAS unsigned char* L = F.lds + RING_OFF;
    const int b = R.b, dir = R.dir;
#define RC_T(c, tau) (dir ? (T - 1 - (64 * (c) + (tau))) : (64 * (c) + (tau)))
#define RC_TOK(c, tau) ((size_t)b * T + RC_T(c, tau))
    for (int x = tid; x < Mp::SBSZ / 4; x += NWAVES * 64) ((LAS unsigned*)(L + Mp::SB))[x] = 0u;
    if (NEB == 3 && tid < 128) { LAS unsigned char* vr = L + (tid >> 6) * Mp::PAR + Mp::V + (tid & 63) * Mp::VP + 64;
        *(LAS unsigned short*)(vr + 2) = (unsigned short)0; *(LAS unsigned*)(vr + 4) = 0u; v2u o; o.x = 0u; o.y = 0u; *(LAS v2u*)(vr + 8) = o; *(LAS v2u*)(vr + 16) = o; *(LAS v2u*)(vr + 24) = o; }
    v4u rqA[2], rkA[2], rvA, rqB[2], rkB[2], rvB; float rgA, rgB, reA = 0.f, rsA = 0.f, reB = 0.f, rsB = 0.f;
#define RC_LOAD(cc, S) do { const int c_ = (cc) < T / 64 ? (cc) : T / 64 - 1; \
        _Pragma("unroll") for (int k = 0; k < 2; ++k) { const int ch = tid + 512 * k, row = ch >> 4, c16 = ch & 15; const size_t o = (size_t)RC_T(c_, row) * R.qs + c16 * 8; \
            rq##S[k] = *(const GAS v4u*)(R.qin + o); rk##S[k] = *(const GAS v4u*)(R.kin + o); } \
        rv##S = *(const GAS v4u*)(R.vsrc + (size_t)RC_T(c_, (tid & 255) >> 2) * 32 + (tid & 3) * 8); \
        rg##S = R.gtab[(size_t)c_ * 128 + (tid & 127)]; \
        if (NEB == 3) { re##S = R.eq[(size_t)c_ * 64 + (tid & 63)]; rs##S = R.ek[(size_t)c_ * 64 + ((tid & 255) >> 2)]; } } while (0)
#define RC_STAGE(par, S) do { LAS unsigned char* P = L + (par) * Mp::PAR; \
        _Pragma("unroll") for (int k = 0; k < 2; ++k) { const int ch = tid + 512 * k, row = ch >> 4, c16 = ch & 15; \
            *(LAS v4u*)(P + Mp::Q + row * RQ_P + c16 * 16) = rq##S[k]; *(LAS v4u*)(P + Mp::K + row * RQ_P + c16 * 16) = rk##S[k]; } \
        ((LAS float*)(P + Mp::TB))[tid & 127] = rg##S;     \
        if (NEB == 3) { const float sc_ = rs##S;       \
            rv##S.x = cvtpk(bflo(rv##S.x) * sc_, bfhi(rv##S.x) * sc_); rv##S.y = cvtpk(bflo(rv##S.y) * sc_, bfhi(rv##S.y) * sc_); rv##S.z = cvtpk(bflo(rv##S.z) * sc_, bfhi(rv##S.z) * sc_); rv##S.w = cvtpk(bflo(rv##S.w) * sc_, bfhi(rv##S.w) * sc_); \
            *(LAS unsigned short*)(P + Mp::V + ((tid & 255) >> 2) * Mp::VP + 64) = (unsigned short)(cvtpk(sc_, sc_) & 0xffffu); \
            ((LAS float*)(P + Mp::EQ))[tid & 63] = re##S; } \
        { v2u o; o.x = rv##S.x; o.y = rv##S.y; *(LAS v2u*)(P + Mp::V + ((tid & 255) >> 2) * Mp::VP + (tid & 3) * 16) = o; o.x = rv##S.z; o.y = rv##S.w; *(LAS v2u*)(P + Mp::V + ((tid & 255) >> 2) * Mp::VP + (tid & 3) * 16 + 8) = o; } } while (0)
    RC_LOAD(0, A);
    RC_STAGE(0, A);
    RC_LOAD(1, B);
    RC_LOAD(2, A);
    f32x4 Sst[NEB][2];
#pragma unroll
    for (int eb = 0; eb < NEB; ++eb)
#pragma unroll
        for (int dbi = 0; dbi < 2; ++dbi) Sst[eb][dbi] = (f32x4){0.f, 0.f, 0.f, 0.f};
    __syncthreads();
    LAS unsigned char* P0 = L; LAS unsigned char* P1 = L + Mp::PAR; LAS unsigned char* S0 = L + Mp::SB; LAS unsigned char* S1 = L + Mp::SB + Mp::SBSZ;
    const int orow = 16 * (F.wave & 3) + (lane & 15);
    for (int c = 0; c < T / 64; c += 2) {
        RC_STAGE(1, B); RC_LOAD(c + 3, B);
        rec_compute<NEB>(F.wave, lane, P0, S0, S1, Sst, R.out + RC_TOK(c, orow) * 1024);
        __syncthreads();
        RC_STAGE(0, A); RC_LOAD(c + 4, A);
        rec_compute<NEB>(F.wave, lane, P1, S1, S0, Sst, R.out + RC_TOK(c + 1, orow) * 1024);
        __syncthreads();
    }
#undef RC_LOAD
#undef RC_STAGE
#undef RC_TOK
#undef RC_T
}
__device__ __forceinline__ void mlstm_chunk_unit(const Frame& F, const Args& A, int unit) {
    const int es = unit & 7, dir = (unit >> 3) & 1, h = (unit >> 4) & 3, b = unit >> 6;
    RecP R; const size_t chain = (size_t)((dir * 4 + b) * 4 + h) * T * 128;
    (void)chain; const bf16* Ub = (const bf16*)(A.ws + WS_U) + (size_t)b * T * UW + h * 128;
    R.qin = Ub + U_QA; R.kin = Ub + U_KA; R.qs = UW;
    R.eq = (const float*)(A.ws + WS_EQM) + (size_t)(((b * 4 + h) * 2 + dir) * 64) * 64; R.ek = (const float*)(A.ws + WS_EKM) + (size_t)(((b * 4 + h) * 2 + dir) * 64) * 64;
    R.vsrc = (const bf16*)(A.ws + WS_VINM) + (size_t)(((b * 4 + h) * 8 + es)) * T * 32; R.gtab = (const float*)(A.ws + WS_GTABM) + (size_t)((((b * 4 + h) * 2 + dir) * 64)) * 128;
    R.out = (bf16*)(A.ws + WS_HA) + (size_t)dir * M * 1024 + h * 256 + es * 32; R.b = b; R.dir = dir;
    rec_unit<3>(F, R);
}
__device__ __forceinline__ void hgrn_chunk_unit(const Frame& F, const Args& A, int unit) {
    const int es = unit & 3, dir = (unit >> 2) & 1, h = (unit >> 3) & 7, b = unit >> 6;
    RecP R; const size_t chain = (size_t)((dir * 4 + b) * 8 + h) * T * 128;
    R.qin = (const bf16*)(A.ws + WS_QIN) + chain; R.kin = (const bf16*)(A.ws + WS_KIN) + chain; R.qs = 128; R.eq = nullptr; R.ek = nullptr;
    R.vsrc = (const bf16*)(A.ws + WS_VINH) + (size_t)(((b * 8 + h) * 4 + es)) * T * 32; R.gtab = (const float*)(A.ws + WS_GTAB) + (size_t)((((b * 8 + h) * 2 + dir) * 64)) * 128;
    R.out = (bf16*)(A.ws + WS_HB) + (size_t)dir * M * 1024 + h * 128 + es * 32; R.b = b; R.dir = dir;
    rec_unit<2>(F, R);
}
#ifndef MK_ONE_LAUNCH
#define MK_ONE_LAUNCH 1
#endif
constexpr int N_PHASES = 21;
__global__ void __launch_bounds__(NWAVES * 64, 2) trunk_fwd(Args args) {
    extern __shared__ __attribute__((aligned(16))) unsigned char lds[];
    Frame F;
    F.lds = (LAS unsigned char*)lds;
    F.wave = __builtin_amdgcn_readfirstlane(threadIdx.x >> 6);
    F.G = gridDim.x;
    const Args& A = args;
    { const int tid0 = F.wave * 64 + lane_now(); for (int u = tid0; u < (LDS_BYTES - LDSCTL_OFF) / 4; u += NWAVES * 64) ((LAS unsigned*)(F.lds + LDSCTL_OFF))[u] = 0u; }
    __syncthreads();
    gu32* ctl = (gu32*)(args.ws + WS_CTL);
    const int lo = args.ph_lo, hi = args.ph_hi;
    XcdBarrier bar; bar.bar = (unsigned*)(ctl + CW_BAR); bar.x = 0; bar.st = nullptr;
    if (hi - lo > 1) bar = xcd_barrier_post((unsigned*)(ctl + CW_BAR), (volatile LAS unsigned*)(F.lds + MISC_OFF) + 8, F.wave);
#ifndef PROBE_MASK
#define PROBE_MASK 0u
#endif
#define IN(k) (lo <= (k) && (k) < hi)
#define REP(k) _Pragma("unroll") for (int rep_ = 0; rep_ < (((PROBE_MASK >> (k)) & 1u) ? 2 : 1); ++rep_)
#define RSEAM(k) do { if (((PROBE_MASK >> (k)) & 1u) && rep_ == 0) xcd_barrier(bar, F.wave); } while (0)
#ifndef TPROBE
#define TPROBE (-1)
#endif
#ifndef TPROBE_US
#define TPROBE_US 1000.0f
#endif
    unsigned long long tp_a = (TPROBE == 0) ? __builtin_amdgcn_s_memrealtime() : 0ull, tp_b = 0ull;
#define SEAM(k) do { if (IN(k) && IN((k) + 1)) xcd_barrier(bar, F.wave); if ((k) == TPROBE) tp_b = __builtin_amdgcn_s_memrealtime(); if ((k) + 1 == TPROBE) tp_a = __builtin_amdgcn_s_memrealtime(); } while (0)
    unsigned char* ws = args.ws;
    bf16* XB0 = (bf16*)(ws + WS_XB0); bf16* XB1 = (bf16*)(ws + WS_XB1); bf16* TBUF = (bf16*)A.out;
    const int bid = (int)blockIdx.x;
    const int kple = (args.ph_hi > 0) ? PLE_DIM : 0;

    REP(0) if (IN(0)) { p0_prologue(F, A); RSEAM(0); } SEAM(0);
    REP(1) if (IN(1)) {
        pg8::Gemm g{XB0, (const bf16*)(ws + WS_WRIN), M, UW, D}; pg8::StaticOrder S; S.init(M, UW, F.G, bid);
        pg8::EpiRecIn E{(bf16*)(ws + WS_U), UW, (bf16*)(ws + WS_VINM), (bf16*)(ws + WS_VINH), T};
        pg8::gemm_phase<pg8::EpiRecIn, pg8::StaticOrder, true, true>(F.lds + RING_OFF, g, S, E, F.wave);
        gates_mfma(F, A);
    RSEAM(1); } SEAM(1);
    REP(2) if (IN(2)) { rec_prep(F, A); xcd_barrier(bar, F.wave);
        for (int v = bid; v < 256; v += F.G) { const int x = v & 7, j = v >> 3; mlstm_chunk_unit(F, A, ((x + 8 * (j >> 3)) << 3) | (j & 7)); }
        for (int v = bid; v < 256; v += F.G) { const int x = v & 7, j = v >> 3; hgrn_chunk_unit(F, A, ((x + 8 * (j >> 2)) << 2) | (j & 3)); } RSEAM(2); } SEAM(2);
    REP(3) if (IN(3)) { p3_finalize(F, A); RSEAM(3); } SEAM(3);
    REP(4) if (IN(4)) {
        pg8::Gemm g{(const bf16*)(ws + WS_Y), (const bf16*)(ws + WS_WROUT), M, D, D}; pg8::StaticOrder S; S.init(M, D, F.G, bid);
        pg8::EpiResB E{nullptr, XB0, TBUF, D, ALPHA};
        pg8::gemm_phase<pg8::EpiResB, pg8::StaticOrder, true, true, true>(F.lds + RING_OFF, g, S, E, F.wave);
    RSEAM(4); } SEAM(4);
    REP(5) if (IN(5)) { ln_phase_b(F, A, A.in[I_LNW] + 0 * D, A.in[I_LNB] + 0 * D, TBUF, XB1); RSEAM(5); } SEAM(5);
    REP(6) if (IN(6)) {
        pg8::Gemm g{XB1, (const bf16*)(ws + WS_WFGU), M, 2 * FFN, D}; pg8::StaticOrder S; S.init(M, 2 * FFN, F.G, bid);
        pg8::EpiSwiglu E{(bf16*)(ws + WS_H), FFN, 2 * FFN / 256};
        pg8::gemm_phase<pg8::EpiSwiglu, pg8::StaticOrder, true, true>(F.lds + RING_OFF, g, S, E, F.wave);
    RSEAM(6); } SEAM(6);
    REP(7) if (IN(7)) {
        { pg8::Gemm g{(const bf16*)(ws + WS_H), (const bf16*)(ws + WS_WFDN), M, D, FFN}; pg8::StaticOrder S; S.init(M, D, F.G, bid);
          pg8::EpiResB E{nullptr, XB1, TBUF, D, ALPHA};
          pg8::gemm_phase<pg8::EpiResB, pg8::StaticOrder, true, true, true>(F.lds + RING_OFF, g, S, E, F.wave); }
        { pg8::Gemm g{(const bf16*)(ws + WS_PB), (const bf16*)(ws + WS_WPP0), M, D, kple}; pg8::StaticOrder S; S.init(M, D, F.G, bid);
          pg8::EpiStoreB E{(bf16*)(ws + WS_PP), D, D / 256};
          pg8::gemm_phase<pg8::EpiStoreB, pg8::StaticOrder, true, true, true>(F.lds + RING_OFF, g, S, E, F.wave); }
    RSEAM(7); } SEAM(7);
    REP(8) if (IN(8)) { ln_phase_b(F, A, A.in[I_LNW] + 1 * D, A.in[I_LNB] + 1 * D, TBUF, XB0); RSEAM(8); } SEAM(8);
    REP(10) if (IN(10)) {
        pg8::Gemm g{XB0, (const bf16*)(ws + WS_WPG0), M, D, D}; pg8::StaticOrder S; S.init(M, D, F.G, bid);
        pg8::EpiPleB E{XB0, (const bf16*)(ws + WS_PP), XB1, nullptr, D};
        pg8::gemm_phase<pg8::EpiPleB, pg8::StaticOrder, true, true>(F.lds + RING_OFF, g, S, E, F.wave);
    RSEAM(10); } SEAM(10);
#ifdef SLEEP_PROBE_US
    { const unsigned long long t0 = __builtin_amdgcn_s_memrealtime(); while (__builtin_amdgcn_s_memrealtime() - t0 < (unsigned long long)(SLEEP_PROBE_US * 100)) __builtin_amdgcn_s_sleep(32); }
#endif
    REP(11) if (IN(11)) {
        pg8::Gemm g{XB1, (const bf16*)(ws + WS_WQKV), M, NQKV, D}; pg8::StaticOrder S; S.init(M, NQKV, F.G, bid);
        pg8::EpiQKVHeads E{(bf16*)(ws + WS_QKV), T, 16};
        pg8::gemm_phase<pg8::EpiQKVHeads, pg8::StaticOrder, true, true>(F.lds + RING_OFF, g, S, E, F.wave);
    RSEAM(11); } SEAM(11);
    REP(12) if (IN(12)) { na_phase_mfma(F, A); RSEAM(12); } SEAM(12);
    REP(13) if (IN(13)) {
        pg8::Gemm g{(const bf16*)(ws + WS_AO), (const bf16*)(ws + WS_WNAO), M, D, D}; pg8::StaticOrder S; S.init(M, D, F.G, bid);
        pg8::EpiResBF E{XB1, A.out, D, ALPHA};
        pg8::gemm_phase<pg8::EpiResBF, pg8::StaticOrder, true, true, true>(F.lds + RING_OFF, g, S, E, F.wave);
    RSEAM(13); } SEAM(13);
    REP(14) if (IN(14)) { ln_router_phase(F, A, A.in[I_LNW] + 2 * D, A.in[I_LNB] + 2 * D, XB0); RSEAM(14); } SEAM(14);
    REP(15) if (IN(15)) { moe_route_phase(F, A); RSEAM(15); } SEAM(15);
    REP(16) if (IN(16)) {
        const int* TILEE = (const int*)(ws + WS_TILEE); const int nrt = __builtin_amdgcn_readfirstlane(TILEE[0]);
        pg8::Gemm g{XB0, (const bf16*)(ws + WS_WMGU), nrt * 256, 2 * MOE, D}; g.Ainv = (const int*)(ws + WS_INV);
        pg8::MoeOrder S; S.base.init(nrt * 256, 2 * MOE, F.G, bid); S.tile_e = TILEE + 1; S.nN = 2 * MOE / 256;
        pg8::EpiSwiglu E{(bf16*)(ws + WS_HM), MOE, 2 * MOE / 256};
        pg8::gemm_phase<pg8::EpiSwiglu, pg8::MoeOrder, true, true, false, true>(F.lds + RING_OFF, g, S, E, F.wave);
    RSEAM(16); } SEAM(16);
    REP(17) if (IN(17)) {
        { const int* TILEE = (const int*)(ws + WS_TILEE); const int nrt = __builtin_amdgcn_readfirstlane(TILEE[0]);
          const int nra = nrt < pg8::TAIL_PM0 ? nrt : pg8::TAIL_PM0;
          { pg8::Gemm g{(const bf16*)(ws + WS_HM), (const bf16*)(ws + WS_WMDN), nra * 256, D, MOE}; pg8::MoeOrder S; S.base.init(nra * 256, D, F.G, bid); S.tile_e = TILEE + 1; S.nN = D / 256;
            pg8::EpiStoreB E{(bf16*)(ws + WS_YS), D, D / 256};
            pg8::gemm_phase<pg8::EpiStoreB, pg8::MoeOrder, true, true, true>(F.lds + RING_OFF, g, S, E, F.wave); }
          if (nrt > pg8::TAIL_PM0) {
            pg8::Gemm g{(const bf16*)(ws + WS_HM), (const bf16*)(ws + WS_WMDN), nrt * 256, D, MOE, MOE / pg8::TAIL_KS}; pg8::MoeTailOrder S{TILEE + 1, nrt - pg8::TAIL_PM0, F.G, bid, D / 256, MOE / pg8::TAIL_KS / 64};
            pg8::EpiStorePart E{(bf16*)(ws + WS_PART), D, D / 256, MOE / pg8::TAIL_KS / 64};
            pg8::gemm_phase<pg8::EpiStorePart, pg8::MoeTailOrder, true, true, true>(F.lds + RING_OFF, g, S, E, F.wave); } }
        { pg8::Gemm g{(const bf16*)(ws + WS_PB) + (size_t)M * PLE_DIM, (const bf16*)(ws + WS_WPP1), M, D, kple}; pg8::StaticOrder S; S.init(M, D, F.G, bid);
          pg8::EpiStoreB E{(bf16*)(ws + WS_PP1), D, D / 256};
          pg8::gemm_phase<pg8::EpiStoreB, pg8::StaticOrder, true, true, true>(F.lds + RING_OFF, g, S, E, F.wave); }
    RSEAM(17); } SEAM(17);
    REP(18) if (IN(18)) { ln_moe_phase(F, A, A.in[I_LNW] + 3 * D, A.in[I_LNB] + 3 * D, XB0, XB1); RSEAM(18); } SEAM(18);
    REP(20) if (IN(20)) {
        pg8::Gemm g{XB1, (const bf16*)(ws + WS_WPG1), M, D, D}; pg8::StaticOrder S; S.init(M, D, F.G, bid);
        pg8::EpiPleB E{XB1, (const bf16*)(ws + WS_PP1), nullptr, A.out, D};
        pg8::gemm_phase<pg8::EpiPleB, pg8::StaticOrder, true, true>(F.lds + RING_OFF, g, S, E, F.wave);
    }
    if (TPROBE >= 0) {
        if (TPROBE == 20) tp_b = __builtin_amdgcn_s_memrealtime();
        float* dl = (float*)(ctl + 64);
        if (bid == 0 && F.wave == 0 && lane_now() == 0) *dl = (float)(long long)(tp_b - tp_a) * 0.01f / TPROBE_US;
        xcd_barrier(bar, F.wave);
        const float sc = 1.0f + __hip_atomic_load(dl, __ATOMIC_RELAXED, __HIP_MEMORY_SCOPE_AGENT);
        const size_t gt = (size_t)blockIdx.x * (NWAVES * 64) + F.wave * 64 + lane_now(), NGT = (size_t)F.G * NWAVES * 64;
        for (size_t i = gt; i < (size_t)M * D / 4; i += NGT) { f32x4 v = ((GAS f32x4*)A.out)[i]; ((GAS f32x4*)A.out)[i] = v * sc; }
    }
#undef IN
#undef SEAM
}

extern "C" void kernel_launch(void* const* d_in, const int* in_sizes, int n_in, void* d_out, int out_size, void* d_ws, size_t ws_size, hipStream_t stream) {
    static int grid = 0;
    if (grid == 0) {
        if (n_in != 23 || in_sizes[0] != M * D || out_size != M * D || ws_size < WS_END) { fprintf(stderr, "kernel_launch: unexpected shapes (n_in %d, in0 %d, out %d, ws %zu, need %zu)\n", n_in, n_in > 0 ? in_sizes[0] : -1, out_size, ws_size, (size_t)WS_END); grid = -1; return; }
        int dev = 0, cus = 0, per_cu = 0;
        if (hipGetDevice(&dev) != hipSuccess || hipDeviceGetAttribute(&cus, hipDeviceAttributeMultiprocessorCount, dev) != hipSuccess) { grid = -1; return; }
        if (hipFuncSetAttribute((const void*)trunk_fwd, hipFuncAttributeMaxDynamicSharedMemorySize, LDS_BYTES) != hipSuccess) { fprintf(stderr, "kernel_launch: hipFuncSetAttribute failed\n"); grid = -1; return; }
        if (hipOccupancyMaxActiveBlocksPerMultiprocessor(&per_cu, (const void*)trunk_fwd, NWAVES * 64, LDS_BYTES) != hipSuccess || per_cu < 1) { fprintf(stderr, "kernel_launch: occupancy query reports %d\n", per_cu); }
        (void)hipGetLastError();
        grid = cus;
    }
    if (grid < 0) return;
    (void)hipMemsetAsync((char*)d_ws + WS_CTL, 0, CTL_ZERO_BYTES, stream);
    Args a{};
    for (int i = 0; i < 23; ++i) a.in[i] = (const float*)d_in[i];
    a.out = (float*)d_out; a.ws = (unsigned char*)d_ws;
#if MK_ONE_LAUNCH
    a.ph_lo = 0; a.ph_hi = N_PHASES;
    hipLaunchKernelGGL(trunk_fwd, dim3(grid), dim3(NWAVES * 64), LDS_BYTES, stream, a);
#else
    for (int ph = 0; ph < N_PHASES; ++ph) { a.ph_lo = ph; a.ph_hi = ph + 1; hipLaunchKernelGGL(trunk_fwd, dim3(grid), dim3(NWAVES * 64), LDS_BYTES, stream, a); }
#endif
}
```

```cpp
#include <hip/hip_runtime.h>
#include <cstdio>
#include <cstdint>
__device__ __forceinline__ int lane_now() { int l; asm volatile("v_mbcnt_lo_u32_b32 %0, -1, 0\n\tv_mbcnt_hi_u32_b32 %0, -1, %0" : "=v"(l)); return l; }
namespace pg8 {
#define PG8_LAS __attribute__((address_space(3)))
typedef unsigned short bf16_t;
typedef short bf16x8 __attribute__((ext_vector_type(8)));
typedef float f32x4 __attribute__((ext_vector_type(4)));
typedef unsigned u32x4 __attribute__((ext_vector_type(4)));
constexpr int BM = 256, BK = 64, HALF = 128, HTB = HALF * BK * 2  , STAGE_BYTES = 8 * HTB, NXCD = 8, WGM = 8;

__host__ __device__ __forceinline__ int lds_byte(int r, int c) { const int st = (r >> 4) * 2 + (c >> 5), rr = r & 15, cc = c & 31, ob = rr * 64 + cc * 2; return st * 1024 + (ob ^ (((ob >> 9) & 1) << 5)); }
__host__ __device__ __forceinline__ void stage_rc(int b, int& R, int& C) { const int st = b / 1024, sb = b % 1024, swz = sb ^ (((sb >> 9) & 1) << 5); R = (st >> 1) * 16 + swz / 64; C = (st & 1) * 32 + (swz % 64) / 2; }
__host__ __device__ __forceinline__ int perm32(int rho) { const int n = rho >> 4, i = rho & 15; return 8 * (i >> 2) + 4 * n + (i & 3); }

__host__ __device__ __forceinline__ size_t bt_tiled_off(int n, int k, int K) {
    const int pn = n >> 8, hf = (n >> 7) & 1, nr = n & 127, v = nr & 31;
    const int R = (nr & ~31) + 16 * ((v >> 2) & 1) + 4 * (v >> 3) + (v & 3);
    return ((size_t)((pn * 2 + hf) * (K / 64) + (k >> 6))) * 16384 + (size_t)lds_byte(R, k & 63);
}
__host__ __device__ __forceinline__ size_t at_tiled_off(int m, int k, int K) {
    return ((size_t)(((m >> 8) * 2 + ((m >> 7) & 1)) * (K >> 6) + (k >> 6))) * 16384 + (size_t)lds_byte(m & 127, k & 63);
}
struct Unit { int pm, pn, koff; };
struct Gemm { const bf16_t* A; const bf16_t* Bt; int M, N, K; int Kloop = 0; const int* Ainv = nullptr; };

struct StaticOrder {
    int nM, nN, nwg, G, c;
    __host__ __device__ void init(int M, int N, int G_, int c_) { nM = M / BM; nN = N / BM; nwg = nM * nN; G = G_; c = c_; }
    __host__ __device__ bool next(int i, Unit& u) const {
        const long L = (long)i * G + c; if (L >= nwg) return false;
        int wgid = (int)L; { const int q = nwg / NXCD, r = nwg % NXCD, xcd = wgid % NXCD, off = wgid / NXCD; wgid = (xcd < r ? xcd * (q + 1) : r * (q + 1) + (xcd - r) * q) + off; }
        const int nig = WGM * nN, gid = wgid / nig, fm = gid * WGM, gsz = (nM - fm) < WGM ? (nM - fm) : WGM;
        u.pm = fm + ((wgid % nig) % gsz); u.pn = (wgid % nig) / gsz; u.koff = 0; return true;
    }
    __device__ __forceinline__ void a_ready(const Unit&) const {}
    __device__ __forceinline__ void done(const Unit&) const {}
};

typedef float f32x2c_t __attribute__((ext_vector_type(2))); typedef __bf16 bf16x2c_t __attribute__((ext_vector_type(2)));
__device__ __forceinline__ unsigned cvt_pk_bf16(float lo, float hi) { f32x2c_t v = {lo, hi}; bf16x2c_t b = __builtin_convertvector(v, bf16x2c_t); return __builtin_bit_cast(unsigned, b); }
__device__ __forceinline__ float fsigmoid(float x) { return __builtin_amdgcn_rcpf(1.0f + __expf(-x)); }
__device__ __forceinline__ float fsilu(float x) { return x * fsigmoid(x); }


struct EpiBf16G {
    static constexpr bool PERM = true, AFTER_DRAIN = false;
    bf16_t* O; int ldc; int gate_pn; float* Gt;
    __device__ __forceinline__ void operator()(const f32x4 (&acc)[2][2][4][2], const Unit& u, int wr, int wc, int fr, int fq) const {
        const int row0 = u.pm * BM + wr * 64 + fr;
        if (u.pn == gate_pn) {
            if (wc == 0 && fq < 2) {
#pragma unroll
                for (int ai = 0; ai < 2; ++ai)
#pragma unroll
                    for (int m = 0; m < 4; ++m) { float* gp = Gt + (size_t)(row0 + ai * HALF + m * 16) * 16 + 8 * fq;
                        *(f32x4*)(gp) = acc[ai][0][m][0]; *(f32x4*)(gp + 4) = acc[ai][0][m][1]; }
            }
            return;
        }
        const int col0 = u.pn * BM + wc * 32 + 8 * fq;
#pragma unroll
        for (int ai = 0; ai < 2; ++ai)
#pragma unroll
            for (int m = 0; m < 4; ++m) { bf16_t* rowp = O + (size_t)(row0 + ai * HALF + m * 16) * ldc + col0;
#pragma unroll
                for (int bj = 0; bj < 2; ++bj) { const f32x4 v0 = acc[ai][bj][m][0], v1 = acc[ai][bj][m][1];
                    u32x4 w; w.x = cvt_pk_bf16(v0[0], v0[1]); w.y = cvt_pk_bf16(v0[2], v0[3]); w.z = cvt_pk_bf16(v1[0], v1[1]); w.w = cvt_pk_bf16(v1[2], v1[3]);
                    *(u32x4*)(rowp + bj * HALF) = w; } }
    }
};

struct EpiQKVHeads {
    static constexpr bool PERM = true, AFTER_DRAIN = false;
    bf16_t* O; int Tlen, nheads;
    __device__ __forceinline__ void operator()(const f32x4 (&acc)[2][2][4][2], const Unit& u, int wr, int wc, int fr, int fq) const {
        const int which = u.pn >> 3, hp = u.pn & 7;
        const int row0 = u.pm * BM + wr * 64 + fr; const int b = (u.pm * BM) / Tlen; const int t0 = row0 - b * Tlen;
#pragma unroll
        for (int bj = 0; bj < 2; ++bj) { bf16_t* hb = O + ((size_t)which * 4 * nheads + (size_t)b * nheads + (2 * hp + bj)) * (size_t)Tlen * 128 + wc * 32 + 8 * fq;
#pragma unroll
            for (int ai = 0; ai < 2; ++ai)
#pragma unroll
                for (int m = 0; m < 4; ++m) { const f32x4 v0 = acc[ai][bj][m][0], v1 = acc[ai][bj][m][1];
                    u32x4 w; w.x = cvt_pk_bf16(v0[0], v0[1]); w.y = cvt_pk_bf16(v0[2], v0[3]); w.z = cvt_pk_bf16(v1[0], v1[1]); w.w = cvt_pk_bf16(v1[2], v1[3]);
                    *(u32x4*)(hb + (size_t)(t0 + ai * HALF + m * 16) * 128) = w; } }
    }
};

struct EpiRecIn {
    static constexpr bool PERM = true, AFTER_DRAIN = false;
    bf16_t* O; int ldc; bf16_t* VM; bf16_t* VH; int Tlen;
    __device__ __forceinline__ void operator()(const f32x4 (&acc)[2][2][4][2], const Unit& u, int wr, int wc, int fr, int fq) const {
        const int row0 = u.pm * BM + wr * 64 + fr;
        const bool isvm = (u.pn >= 4 && u.pn < 8), isvh = (u.pn >= 24 && u.pn < 28);
        if (isvm || isvh) {
            const int b = (u.pm * BM) / Tlen; const int t0 = row0 - b * Tlen;
#pragma unroll
            for (int bj = 0; bj < 2; ++bj) {
                bf16_t* base = isvm ? VM + ((size_t)((b * 4 + (u.pn - 4)) * 8 + 4 * bj + wc)) * (size_t)Tlen * 32 + 8 * fq
                                    : VH + ((size_t)((b * 8 + 2 * (u.pn - 24) + bj) * 4 + wc)) * (size_t)Tlen * 32 + 8 * fq;
#pragma unroll
                for (int ai = 0; ai < 2; ++ai)
#pragma unroll
                    for (int m = 0; m < 4; ++m) { const f32x4 v0 = acc[ai][bj][m][0], v1 = acc[ai][bj][m][1];
                        u32x4 w; w.x = cvt_pk_bf16(v0[0], v0[1]); w.y = cvt_pk_bf16(v0[2], v0[3]); w.z = cvt_pk_bf16(v1[0], v1[1]); w.w = cvt_pk_bf16(v1[2], v1[3]);
                        *(u32x4*)(base + (size_t)(t0 + ai * HALF + m * 16) * 32) = w; } }
            return;
        }
        const int col0 = u.pn * BM + wc * 32 + 8 * fq;
#pragma unroll
        for (int ai = 0; ai < 2; ++ai)
#pragma unroll
            for (int m = 0; m < 4; ++m) { bf16_t* rowp = O + (size_t)(row0 + ai * HALF + m * 16) * ldc + col0;
#pragma unroll
                for (int bj = 0; bj < 2; ++bj) { const f32x4 v0 = acc[ai][bj][m][0], v1 = acc[ai][bj][m][1];
                    u32x4 w; w.x = cvt_pk_bf16(v0[0], v0[1]); w.y = cvt_pk_bf16(v0[2], v0[3]); w.z = cvt_pk_bf16(v1[0], v1[1]); w.w = cvt_pk_bf16(v1[2], v1[3]);
                    *(u32x4*)(rowp + bj * HALF) = w; } }
    }
};
struct EpiSwiglu {
    static constexpr bool PERM = true, AFTER_DRAIN = false;
    bf16_t* H; int ldh; int npn;
    __device__ __forceinline__ void operator()(const f32x4 (&acc)[2][2][4][2], const Unit& u, int wr, int wc, int fr, int fq) const {
        const int row0 = u.pm * BM + wr * 64 + fr; const int pl = u.pn % npn; const int col0 = pl * HALF + wc * 32 + 8 * fq;
#pragma unroll
        for (int ai = 0; ai < 2; ++ai)
#pragma unroll
            for (int m = 0; m < 4; ++m) { bf16_t* rowp = (bf16_t*)((unsigned char*)H + at_tiled_off(row0 + ai * HALF + m * 16, col0, ldh));
                const f32x4 g0 = acc[ai][0][m][0], g1 = acc[ai][0][m][1], u0 = acc[ai][1][m][0], u1 = acc[ai][1][m][1];
                float o[8];
#pragma unroll
                for (int i = 0; i < 4; ++i) { o[i] = fsilu(g0[i]) * u0[i]; o[4 + i] = fsilu(g1[i]) * u1[i]; }
                u32x4 w; w.x = cvt_pk_bf16(o[0], o[1]); w.y = cvt_pk_bf16(o[2], o[3]); w.z = cvt_pk_bf16(o[4], o[5]); w.w = cvt_pk_bf16(o[6], o[7]);
                *(u32x4*)rowp = w; }
    }
};
struct EpiResF32 {
    static constexpr bool PERM = true, AFTER_DRAIN = false;
    const float* SRC; float* DST; int ldc; float alpha;
    __device__ __forceinline__ void operator()(const f32x4 (&acc)[2][2][4][2], const Unit& u, int wr, int wc, int fr, int fq) const {
        const int row0 = u.pm * BM + wr * 64 + fr; const int col0 = u.pn * BM + wc * 32 + 8 * fq;
#pragma unroll
        for (int ai = 0; ai < 2; ++ai)
#pragma unroll
            for (int m = 0; m < 4; ++m) { const size_t ro = (size_t)(row0 + ai * HALF + m * 16) * ldc + col0;
#pragma unroll
                for (int bj = 0; bj < 2; ++bj)
#pragma unroll
                    for (int n = 0; n < 2; ++n) { const size_t o = ro + bj * HALF + 4 * n; const f32x4 s = *(const f32x4*)(SRC + o); *(f32x4*)(DST + o) = s * alpha + acc[ai][bj][m][n]; } }
    }
};
struct EpiStoreF32 {
    static constexpr bool PERM = true, AFTER_DRAIN = false;
    float* O; int ldc; int npn;
    __device__ __forceinline__ void operator()(const f32x4 (&acc)[2][2][4][2], const Unit& u, int wr, int wc, int fr, int fq) const {
        const int row0 = u.pm * BM + wr * 64 + fr; const int col0 = (u.pn % npn) * BM + wc * 32 + 8 * fq;
#pragma unroll
        for (int ai = 0; ai < 2; ++ai)
#pragma unroll
            for (int m = 0; m < 4; ++m) { float* ro = O + (size_t)(row0 + ai * HALF + m * 16) * ldc + col0;
#pragma unroll
                for (int bj = 0; bj < 2; ++bj)
#pragma unroll
                    for (int n = 0; n < 2; ++n) *(f32x4*)(ro + bj * HALF + 4 * n) = acc[ai][bj][m][n]; }
    }
};
struct EpiPle {
    static constexpr bool PERM = true, AFTER_DRAIN = false;
    float* XF; const float* PP; bf16_t* XB; int ldc;
    __device__ __forceinline__ void operator()(const f32x4 (&acc)[2][2][4][2], const Unit& u, int wr, int wc, int fr, int fq) const {
        const int row0 = u.pm * BM + wr * 64 + fr; const int col0 = u.pn * BM + wc * 32 + 8 * fq;
#pragma unroll
        for (int ai = 0; ai < 2; ++ai)
#pragma unroll
            for (int m = 0; m < 4; ++m) { const size_t ro = (size_t)(row0 + ai * HALF + m * 16) * ldc + col0;
#pragma unroll
                for (int bj = 0; bj < 2; ++bj) { f32x4 o[2];
#pragma unroll
                    for (int n = 0; n < 2; ++n) { const size_t of = ro + bj * HALF + 4 * n; const f32x4 x = *(const f32x4*)(XF + of), pp = *(const f32x4*)(PP + of); const f32x4 a = acc[ai][bj][m][n];
                        f32x4 r; r[0] = x[0] + fsigmoid(a[0]) * pp[0]; r[1] = x[1] + fsigmoid(a[1]) * pp[1]; r[2] = x[2] + fsigmoid(a[2]) * pp[2]; r[3] = x[3] + fsigmoid(a[3]) * pp[3];
                        *(f32x4*)(XF + of) = r; o[n] = r; }
                    u32x4 w; w.x = cvt_pk_bf16(o[0][0], o[0][1]); w.y = cvt_pk_bf16(o[0][2], o[0][3]); w.z = cvt_pk_bf16(o[1][0], o[1][1]); w.w = cvt_pk_bf16(o[1][2], o[1][3]);
                    if (XB) *(u32x4*)(XB + ro + bj * HALF) = w; } }
    }
};

__device__ __forceinline__ float bf_lo(unsigned w) { return __builtin_bit_cast(float, w << 16); }
__device__ __forceinline__ float bf_hi(unsigned w) { return __builtin_bit_cast(float, w & 0xffff0000u); }
typedef unsigned u32x2 __attribute__((ext_vector_type(2)));
struct EpiResB {
    static constexpr bool PERM = true, AFTER_DRAIN = false;
    const float* SRCF_unused; const bf16_t* SRCB; bf16_t* DSTB; int ldc; float alpha;
    __device__ __forceinline__ void operator()(const f32x4 (&acc)[2][2][4][2], const Unit& u, int wr, int wc, int fr, int fq) const {
        const int row0 = u.pm * BM + wr * 64 + fr; const int col0 = u.pn * BM + wc * 32 + 8 * fq;
        u32x4 sv[2][4][2];
#pragma unroll
        for (int ai = 0; ai < 2; ++ai)
#pragma unroll
            for (int m = 0; m < 4; ++m)
#pragma unroll
                for (int bj = 0; bj < 2; ++bj) sv[ai][m][bj] = *(const u32x4*)(SRCB + (size_t)(row0 + ai * HALF + m * 16) * ldc + col0 + bj * HALF);
#pragma unroll
        for (int ai = 0; ai < 2; ++ai)
#pragma unroll
            for (int m = 0; m < 4; ++m)
#pragma unroll
                for (int bj = 0; bj < 2; ++bj) { const size_t o = (size_t)(row0 + ai * HALF + m * 16) * ldc + col0 + bj * HALF; const u32x4 w0 = sv[ai][m][bj];
                    const f32x4 s0 = (f32x4){bf_lo(w0.x), bf_hi(w0.x), bf_lo(w0.y), bf_hi(w0.y)}, s1 = (f32x4){bf_lo(w0.z), bf_hi(w0.z), bf_lo(w0.w), bf_hi(w0.w)};
                    const f32x4 v0 = s0 * alpha + acc[ai][bj][m][0], v1 = s1 * alpha + acc[ai][bj][m][1];
                    u32x4 w; w.x = cvt_pk_bf16(v0[0], v0[1]); w.y = cvt_pk_bf16(v0[2], v0[3]); w.z = cvt_pk_bf16(v1[0], v1[1]); w.w = cvt_pk_bf16(v1[2], v1[3]);
                    *(u32x4*)(DSTB + o) = w; }
    }
};
struct EpiResBF {
    static constexpr bool PERM = true, AFTER_DRAIN = false;
    const bf16_t* SRCB; float* DSTF; int ldc; float alpha;
    __device__ __forceinline__ void operator()(const f32x4 (&acc)[2][2][4][2], const Unit& u, int wr, int wc, int fr, int fq) const {
        const int row0 = u.pm * BM + wr * 64 + fr; const int col0 = u.pn * BM + wc * 32 + 8 * fq;
        u32x4 sv[2][4][2];
#pragma unroll
        for (int ai = 0; ai < 2; ++ai)
#pragma unroll
            for (int m = 0; m < 4; ++m)
#pragma unroll
                for (int bj = 0; bj < 2; ++bj) sv[ai][m][bj] = *(const u32x4*)(SRCB + (size_t)(row0 + ai * HALF + m * 16) * ldc + col0 + bj * HALF);
#pragma unroll
        for (int ai = 0; ai < 2; ++ai)
#pragma unroll
            for (int m = 0; m < 4; ++m)
#pragma unroll
                for (int bj = 0; bj < 2; ++bj) { const size_t o = (size_t)(row0 + ai * HALF + m * 16) * ldc + col0 + bj * HALF; const u32x4 w = sv[ai][m][bj];
                    const f32x4 s0 = (f32x4){bf_lo(w.x), bf_hi(w.x), bf_lo(w.y), bf_hi(w.y)}, s1 = (f32x4){bf_lo(w.z), bf_hi(w.z), bf_lo(w.w), bf_hi(w.w)};
                    *(f32x4*)(DSTF + o) = s0 * alpha + acc[ai][bj][m][0]; *(f32x4*)(DSTF + o + 4) = s1 * alpha + acc[ai][bj][m][1]; }
    }
};
struct EpiStoreB {
    static constexpr bool PERM = true, AFTER_DRAIN = false;
    bf16_t* O; int ldc; int npn;
    __device__ __forceinline__ void operator()(const f32x4 (&acc)[2][2][4][2], const Unit& u, int wr, int wc, int fr, int fq) const {
        const int row0 = u.pm * BM + wr * 64 + fr; const int col0 = (u.pn % npn) * BM + wc * 32 + 8 * fq;
#pragma unroll
        for (int ai = 0; ai < 2; ++ai)
#pragma unroll
            for (int m = 0; m < 4; ++m) { bf16_t* rowp = O + (size_t)(row0 + ai * HALF + m * 16) * ldc + col0;
#pragma unroll
                for (int bj = 0; bj < 2; ++bj) { const f32x4 v0 = acc[ai][bj][m][0], v1 = acc[ai][bj][m][1];
                    u32x4 w; w.x = cvt_pk_bf16(v0[0], v0[1]); w.y = cvt_pk_bf16(v0[2], v0[3]); w.z = cvt_pk_bf16(v1[0], v1[1]); w.w = cvt_pk_bf16(v1[2], v1[3]);
                    *(u32x4*)(rowp + bj * HALF) = w; } }
    }
};
struct EpiPleB {
    static constexpr bool PERM = true, AFTER_DRAIN = false;
    const bf16_t* XIN; const bf16_t* PP; bf16_t* XOUT; float* OUTF; int ldc;
    __device__ __forceinline__ void operator()(const f32x4 (&acc)[2][2][4][2], const Unit& u, int wr, int wc, int fr, int fq) const {
        const int row0 = u.pm * BM + wr * 64 + fr; const int col0 = u.pn * BM + wc * 32 + 8 * fq;
#pragma unroll
        for (int ai = 0; ai < 2; ++ai) {
            u32x4 xv[4][2], pv[4][2];
#pragma unroll
            for (int m = 0; m < 4; ++m)
#pragma unroll
                for (int bj = 0; bj < 2; ++bj) { const size_t o = (size_t)(row0 + ai * HALF + m * 16) * ldc + col0 + bj * HALF; xv[m][bj] = *(const u32x4*)(XIN + o); pv[m][bj] = *(const u32x4*)(PP + o); }
#pragma unroll
            for (int m = 0; m < 4; ++m)
#pragma unroll
                for (int bj = 0; bj < 2; ++bj) { const size_t o = (size_t)(row0 + ai * HALF + m * 16) * ldc + col0 + bj * HALF; const u32x4 xw = xv[m][bj], pw = pv[m][bj];
                    const float xs[8] = {bf_lo(xw.x), bf_hi(xw.x), bf_lo(xw.y), bf_hi(xw.y), bf_lo(xw.z), bf_hi(xw.z), bf_lo(xw.w), bf_hi(xw.w)};
                    const float ps[8] = {bf_lo(pw.x), bf_hi(pw.x), bf_lo(pw.y), bf_hi(pw.y), bf_lo(pw.z), bf_hi(pw.z), bf_lo(pw.w), bf_hi(pw.w)};
                    float r[8];
#pragma unroll
                    for (int i = 0; i < 4; ++i) { r[i] = xs[i] + fsigmoid(acc[ai][bj][m][0][i]) * ps[i]; r[4 + i] = xs[4 + i] + fsigmoid(acc[ai][bj][m][1][i]) * ps[4 + i]; }
                    if (XOUT) { u32x4 w; w.x = cvt_pk_bf16(r[0], r[1]); w.y = cvt_pk_bf16(r[2], r[3]); w.z = cvt_pk_bf16(r[4], r[5]); w.w = cvt_pk_bf16(r[6], r[7]); *(u32x4*)(XOUT + o) = w; }
                    if (OUTF) { *(f32x4*)(OUTF + o) = (f32x4){r[0], r[1], r[2], r[3]}; *(f32x4*)(OUTF + o + 4) = (f32x4){r[4], r[5], r[6], r[7]}; } }
        }
    }
};

constexpr int TAIL_PM0 = 128, TAIL_KS = 8, TAIL_ROWS = 8 * 256;
struct MoeTailOrder {
    const int* tile_e; int ntail, G, c, nN, ktiles;
    __device__ __forceinline__ bool next(int i, Unit& u) const {
        const int L = i * G + c; if (L >= ntail * nN * TAIL_KS) return false;
        const int ks = L & (TAIL_KS - 1), pn = (L >> 3) % nN, pm = TAIL_PM0 + (L >> 3) / nN;
        u.pm = pm; u.pn = tile_e[pm] * nN + pn; u.koff = ks * ktiles * 16384; return true; }
    __device__ __forceinline__ void a_ready(const Unit&) const {}
    __device__ __forceinline__ void done(const Unit&) const {}
};
struct EpiStorePart {
    static constexpr bool PERM = true, AFTER_DRAIN = false;
    bf16_t* O; int ldc; int npn; int ktiles;
    __device__ __forceinline__ void operator()(const f32x4 (&acc)[2][2][4][2], const Unit& u, int wr, int wc, int fr, int fq) const {
        const int ks = u.koff / (ktiles * 16384);
        const int row0 = (u.pm - TAIL_PM0) * BM + wr * 64 + fr; const int col0 = (u.pn % npn) * BM + wc * 32 + 8 * fq;
        bf16_t* base = O + (size_t)ks * TAIL_ROWS * ldc;
#pragma unroll
        for (int ai = 0; ai < 2; ++ai)
#pragma unroll
            for (int m = 0; m < 4; ++m) { bf16_t* ro = base + (size_t)(row0 + ai * HALF + m * 16) * ldc + col0;
#pragma unroll
                for (int bj = 0; bj < 2; ++bj) { const f32x4 v0 = acc[ai][bj][m][0], v1 = acc[ai][bj][m][1];
                    u32x4 w; w.x = cvt_pk_bf16(v0[0], v0[1]); w.y = cvt_pk_bf16(v0[2], v0[3]); w.z = cvt_pk_bf16(v1[0], v1[1]); w.w = cvt_pk_bf16(v1[2], v1[3]);
                    *(u32x4*)(ro + bj * HALF) = w; } }
    }
};
struct MoeOrder {
    StaticOrder base; const int* tile_e; int nN;
    __device__ __forceinline__ bool next(int i, Unit& u) const { if (!base.next(i, u)) return false; u.pn += tile_e[u.pm] * nN; return true; }
    __device__ __forceinline__ void a_ready(const Unit&) const {}
    __device__ __forceinline__ void done(const Unit&) const {}
};

template <class Epi, class Sched, bool ALIGN_EPI = false, bool SP2 = false, bool ATILED = false, bool AGATHER = false>
__device__ __forceinline__ void gemm_phase(PG8_LAS unsigned char* lds, const Gemm g, const Sched& S, const Epi& E, int wave_s) {
    const int lane = lane_now(), wid = wave_s, tid = wave_s * 64 + lane, wr = wid >> 2, wc = wid & 3, fr = lane & 15, fq = lane >> 4;
    const int K = g.K, nt = (g.Kloop ? g.Kloop : K) / BK;
    unsigned voffA[2], voffB[2];
    unsigned gP[2] = {0u, 0u}, gN[2] = {0u, 0u}, ridx2 = 0u, cC2 = 0u;
#pragma unroll
    for (int i = 0; i < 2; ++i) { int R, C; stage_rc(tid * 16 + i * 8192, R, C); const int Rb = Epi::PERM ? ((R & ~31) + perm32(R & 31)) : R;
        voffA[i] = ATILED ? (unsigned)(tid * 16 + i * 8192) : (unsigned)(R * K + C) * 2u;     voffB[i] = (unsigned)(tid * 16 + i * 8192); (void)Rb; if (i == 0) { ridx2 = (unsigned)R * 4u; cC2 = (unsigned)C * 2u; } }
    const size_t kstep = (size_t)(BK * 2);
    const size_t kstepB = (size_t)(HALF * BK * 2);
    const size_t kstepA = ATILED ? kstepB : kstep;
    const size_t hstep = (size_t)HALF * K * 2;
    const size_t tstep = 2 * hstep;
    const unsigned ldsw = (unsigned)wid * 1024u;
    const int aoff = lds_byte(wr * 64 + fr, fq * 8), boff = lds_byte(wc * 32 + fr, fq * 8);
#define PG8_SA(b, h) (((b) * 2 + (h)) * HTB)
#define PG8_SB(b, h) ((4 + (b) * 2 + (h)) * HTB)
#define PG8_STAGE(bufoff, gbase, voff) do { _Pragma("unroll") for (int _i = 0; _i < 2; ++_i) \
        __builtin_amdgcn_global_load_lds((const unsigned*)((const char*)(gbase) + (voff)[_i]), (PG8_LAS unsigned*)(lds + (bufoff) + ldsw + _i * 8192), 16, 0, 0); } while (0)
#define PG8_LDA(dst, b, h) do { _Pragma("unroll") for (int m = 0; m < 4; ++m) _Pragma("unroll") for (int k = 0; k < 2; ++k) dst[m][k] = *(const PG8_LAS bf16x8*)(lds + PG8_SA(b, h) + aoff + m * 2048 + k * 1024); } while (0)
#define PG8_LDB(dst, b, h) do { _Pragma("unroll") for (int n = 0; n < 2; ++n) _Pragma("unroll") for (int k = 0; k < 2; ++k) dst[n][k] = *(const PG8_LAS bf16x8*)(lds + PG8_SB(b, h) + boff + n * 2048 + k * 1024); } while (0)
#define PG8_GIDX(dst, pm_) do { const int* _ip = g.Ainv + (size_t)(pm_) * 128;        \
        asm volatile("global_load_dword %0, %1, %2" : "+v"(dst[0]) : "v"(ridx2), "s"(_ip) : "memory"); asm volatile("global_load_dword %0, %1, %2 offset:256" : "+v"(dst[1]) : "v"(ridx2), "s"(_ip) : "memory"); } while (0)
#define PG8_STA(bufoff, kptr, h_, nx_) do { if constexpr (AGATHER) { const unsigned _s = ((nx_) && last) ? gN[h_] : gP[h_]; unsigned _g[2] = { (_s & 0xffffu) * (unsigned)(K * 2) + cC2, (_s >> 16) * (unsigned)(K * 2) + cC2 }; PG8_STAGE(bufoff, kptr, _g); } \
        else PG8_STAGE(bufoff, (kptr) + (h_) * hstep, voffA); } while (0)
#define PG8_MMA(ai, bj, At, Bt) do { __builtin_amdgcn_s_setprio(1); _Pragma("unroll") for (int m = 0; m < 4; ++m) _Pragma("unroll") for (int n = 0; n < 2; ++n) _Pragma("unroll") for (int k = 0; k < 2; ++k) \
        acc[ai][bj][m][n] = __builtin_amdgcn_mfma_f32_16x16x32_bf16(Bt[n][k], At[m][k], acc[ai][bj][m][n], 0, 0, 0); __builtin_amdgcn_s_setprio(0); } while (0)
#define PG8_WAIT_V(n) asm volatile("s_waitcnt vmcnt(" #n ")" ::: "memory")
#define PG8_WAIT_L(n) asm volatile("s_waitcnt lgkmcnt(" #n ")" ::: "memory")
#define PG8_BAR __builtin_amdgcn_s_barrier()
#define PG8_SCHED __builtin_amdgcn_sched_barrier(0)
    Unit cur, nxt; int ui = 0;
    if (!S.next(0, cur)) return;
    f32x4 acc[2][2][4][2];
#pragma unroll
    for (int a = 0; a < 2; ++a)
#pragma unroll
        for (int b = 0; b < 2; ++b)
#pragma unroll
            for (int m = 0; m < 4; ++m)
#pragma unroll
                for (int n = 0; n < 2; ++n) acc[a][b][m][n] = (f32x4){0.f, 0.f, 0.f, 0.f};
    bf16x8 At[4][2], B0[2][2], B1[2][2];
    const char* cA = AGATHER ? (const char*)g.A : (const char*)g.A + (size_t)cur.pm * tstep + cur.koff; const char* cB = (const char*)g.Bt + (size_t)cur.pn * tstep + cur.koff;
    if constexpr (AGATHER) { static_assert(!AGATHER || (SP2 && !ATILED), "AGATHER: SP2, row-major A"); PG8_GIDX(gP, cur.pm); asm volatile("s_waitcnt vmcnt(0)" ::: "memory"); asm volatile("" : "+v"(gP[0]), "+v"(gP[1])); }
    S.a_ready(cur);
    if constexpr (SP2) {
        const bool last = false; (void)last;
        PG8_STAGE(PG8_SB(0, 0), cB, voffB); PG8_STAGE(PG8_SB(0, 1), cB + hstep, voffB); PG8_STA(PG8_SA(0, 0), cA, 0, false); PG8_STA(PG8_SA(0, 1), cA, 1, false);
        if (wr == 1) PG8_BAR;
        PG8_WAIT_V(2); PG8_BAR;
        PG8_STAGE(PG8_SB(1, 0), cB + kstepB, voffB); PG8_STA(PG8_SA(1, 0), cA + kstepA, 0, false); PG8_STAGE(PG8_SB(1, 1), cB + hstep + kstepB, voffB);
        PG8_WAIT_V(6); PG8_BAR;
    } else {
        PG8_STAGE(PG8_SB(0, 0), cB, voffB); PG8_STAGE(PG8_SA(0, 0), cA, voffA); PG8_STAGE(PG8_SB(0, 1), cB + hstep, voffB); PG8_STAGE(PG8_SA(0, 1), cA + hstep, voffA);
        if (wr == 1) PG8_BAR;
        PG8_WAIT_V(4); PG8_BAR;
        PG8_STAGE(PG8_SB(1, 0), cB + kstepB, voffB); PG8_STAGE(PG8_SA(1, 0), cA + kstepA, voffA); PG8_STAGE(PG8_SB(1, 1), cB + hstep + kstepB, voffB);
        PG8_WAIT_V(6); PG8_BAR;
    }
    for (;;) {
        const bool has_next = S.next(ui + 1, nxt);
        const char* nA = AGATHER ? cA : has_next ? (const char*)g.A + (size_t)nxt.pm * tstep + nxt.koff : cA; const char* nB = has_next ? (const char*)g.Bt + (size_t)nxt.pn * tstep + nxt.koff : cB;
        if constexpr (AGATHER) { if (!has_next) { gN[0] = gP[0]; gN[1] = gP[1]; } }
        for (int t = 0; t < nt; t += 2) {
            const bool last = (t == nt - 2);
            const bool gfetch = AGATHER && has_next && t == 2;
            if constexpr (AGATHER) { if (gfetch) PG8_GIDX(gN, nxt.pm); }
            const char* a1 = cA + (size_t)(t + 1) * kstepA;
            const char* a2 = last ? nA : cA + (size_t)(t + 2) * kstepA; const char* b2 = last ? nB : cB + (size_t)(t + 2) * kstepB;
            const char* a3 = a2 + kstepA; const char* b3 = b2 + kstepB;
            if (last && has_next) S.a_ready(nxt);
            if constexpr (SP2) {
            PG8_LDB(B0, 0, 0); PG8_LDB(B1, 0, 1); PG8_SCHED; PG8_LDA(At, 0, 0); PG8_STA(PG8_SA(1, 1), a1, 1, false);
            if (gfetch) PG8_WAIT_V(10); else PG8_WAIT_V(8);
            PG8_WAIT_L(0); PG8_BAR; PG8_MMA(0, 0, At, B0); PG8_MMA(0, 1, At, B1); PG8_BAR; PG8_SCHED;
            PG8_LDA(At, 0, 1); PG8_STAGE(PG8_SB(0, 0), b2, voffB); PG8_STAGE(PG8_SB(0, 1), b2 + hstep, voffB); PG8_STA(PG8_SA(0, 0), a2, 0, true);
            PG8_WAIT_V(8); PG8_WAIT_L(0); PG8_BAR; PG8_MMA(1, 0, At, B0); PG8_MMA(1, 1, At, B1); PG8_BAR; PG8_SCHED;
            PG8_LDB(B0, 1, 0); PG8_LDB(B1, 1, 1); PG8_SCHED; PG8_LDA(At, 1, 0); PG8_STA(PG8_SA(0, 1), a2, 1, true);
            PG8_WAIT_V(8); PG8_WAIT_L(0); PG8_BAR; PG8_MMA(0, 0, At, B0); PG8_MMA(0, 1, At, B1); PG8_BAR; PG8_SCHED;
            PG8_LDA(At, 1, 1); PG8_STAGE(PG8_SB(1, 0), b3, voffB); PG8_STAGE(PG8_SB(1, 1), b3 + hstep, voffB); PG8_STA(PG8_SA(1, 0), a3, 0, true);
            PG8_WAIT_V(8); PG8_WAIT_L(0); PG8_BAR; PG8_MMA(1, 0, At, B0); PG8_MMA(1, 1, At, B1); PG8_BAR; PG8_SCHED;
            } else {
            PG8_LDB(B0, 0, 0); PG8_SCHED; PG8_LDA(At, 0, 0); PG8_STAGE(PG8_SA(1, 1), a1 + hstep, voffA);
            PG8_WAIT_L(8); PG8_BAR; PG8_WAIT_L(0); PG8_MMA(0, 0, At, B0); PG8_BAR; PG8_SCHED;
            PG8_LDB(B1, 0, 1); PG8_STAGE(PG8_SB(0, 0), b2, voffB);
            PG8_BAR; PG8_WAIT_L(0); PG8_MMA(0, 1, At, B1); PG8_BAR;
            PG8_LDA(At, 0, 1); PG8_STAGE(PG8_SA(0, 0), a2, voffA);
            PG8_BAR; PG8_WAIT_L(0); PG8_MMA(1, 0, At, B0); PG8_BAR; PG8_SCHED;
            PG8_STAGE(PG8_SB(0, 1), b2 + hstep, voffB);
            PG8_WAIT_V(6); PG8_BAR; PG8_MMA(1, 1, At, B1); PG8_BAR;
            PG8_LDB(B0, 1, 0); PG8_SCHED; PG8_LDA(At, 1, 0); PG8_STAGE(PG8_SA(0, 1), a2 + hstep, voffA);
            PG8_WAIT_L(8); PG8_BAR; PG8_WAIT_L(0); PG8_MMA(0, 0, At, B0); PG8_BAR; PG8_SCHED;
            PG8_LDB(B1, 1, 1); PG8_STAGE(PG8_SB(1, 0), b3, voffB);
            PG8_BAR; PG8_WAIT_L(0); PG8_MMA(0, 1, At, B1); PG8_BAR;
            PG8_LDA(At, 1, 1); PG8_STAGE(PG8_SA(1, 0), a3, voffA);
            PG8_BAR; PG8_WAIT_L(0); PG8_MMA(1, 0, At, B0); PG8_BAR; PG8_SCHED;
            PG8_STAGE(PG8_SB(1, 1), b3 + hstep, voffB);
            PG8_WAIT_V(6); PG8_BAR; PG8_MMA(1, 1, At, B1); PG8_BAR;
            }
        }
        if constexpr (ALIGN_EPI) { if (wr == 0) PG8_BAR; }
        if constexpr (!Epi::AFTER_DRAIN) { E(acc, cur, wr, wc, fr, fq); S.done(cur); }
        if (!has_next) break;
#pragma unroll
        for (int a = 0; a < 2; ++a)
#pragma unroll
            for (int b = 0; b < 2; ++b)
#pragma unroll
                for (int m = 0; m < 4; ++m)
#pragma unroll
                    for (int n = 0; n < 2; ++n) acc[a][b][m][n] = (f32x4){0.f, 0.f, 0.f, 0.f};
        cur = nxt; cA = nA; cB = nB; ++ui;
        if constexpr (AGATHER) { gP[0] = gN[0]; gP[1] = gN[1]; }
        if constexpr (ALIGN_EPI) { if (wr == 1) PG8_BAR; }
    }
    PG8_WAIT_V(0);
    if constexpr (!ALIGN_EPI) { if (wr == 0) PG8_BAR; }
    PG8_BAR;
    if constexpr (Epi::AFTER_DRAIN) { E.fused(acc, cur, wr, wc, fr, fq, lds, wid, lane); S.done(cur); }
#undef PG8_SA
#undef PG8_SB
#undef PG8_STAGE
#undef PG8_LDA
#undef PG8_LDB
#undef PG8_GIDX
#undef PG8_STA
#undef PG8_MMA
#undef PG8_WAIT_V
#undef PG8_WAIT_L
#undef PG8_BAR
#undef PG8_SCHED
}
}
constexpr int NWAVES = 8;
constexpr int BATCH = 4, T = 4096, D = 2048, M = BATCH * T;
constexpr int PLE_DIM = 256, FFN = 5632, MOE = 7168, NE = 8;
constexpr int REC_IN = 8208, UW = 8192, NREC = 8448;
constexpr int U_QA = 0, U_KA = 512, U_VA = 1024, U_OA = 2048, U_QB = 3072, U_FF = 4096, U_FB = 5120, U_IB = 6144, U_GB = 7168;
constexpr int NQKV = 6144;
constexpr int XS_ROWS = 34816;
constexpr float LN_EPS = 1e-5f, RMS_EPS = 1e-6f, ALPHA = 1.41421356237f, GATE_CAP = 15.0f;

constexpr size_t MiB = 1u << 20;
constexpr size_t WS_CTL = 0, CTL_ZERO_BYTES = 1 * MiB;
constexpr size_t WS_INV = 2 * MiB;
constexpr size_t WS_TOKE = 1 * MiB, WS_TOKG = WS_TOKE + 256 * 1024, WS_DEST = WS_TOKG + 256 * 1024, WS_WGCNT = WS_DEST + 256 * 1024, WS_TILEE = WS_WGCNT + 64 * 1024;
constexpr size_t WS_WQKV = 4 * MiB, WS_WNAO = 28 * MiB, WS_WPG1 = 36 * MiB, WS_WPP1 = 44 * MiB, WS_WMGU = 48 * MiB, WS_WMDN = 496 * MiB;
constexpr size_t WS_XB0 = 720 * MiB, WS_XB1 = 784 * MiB, WS_PB = 848 * MiB, WS_G = 864 * MiB, WS_WGATE = 866 * MiB;
constexpr size_t WS_WRIN = 872 * MiB, WS_WROUT = 905 * MiB, WS_WFGU = 913 * MiB, WS_WFDN = 957 * MiB, WS_WPG0 = 979 * MiB, WS_WPP0 = 987 * MiB;
constexpr size_t WS_U = 992 * MiB, WS_HA = 1248 * MiB, WS_HB = 1376 * MiB, WS_Y = 1504 * MiB;
constexpr size_t WS_H = 992 * MiB;
constexpr size_t WS_PP = 1248 * MiB;
constexpr size_t WS_QKV = 992 * MiB;
constexpr size_t WS_AO = WS_Y;
constexpr size_t WS_HM = 872 * MiB;
constexpr size_t WS_YS = 1348 * MiB;
constexpr size_t WS_XS = 1348 * MiB;
constexpr size_t WS_PP1 = 1620 * MiB;
constexpr size_t WS_QIN = 1568 * MiB, WS_KIN = 1632 * MiB, WS_GTAB = 1696 * MiB, WS_GTABM = 1698 * MiB, WS_QINM = 1700 * MiB, WS_KINM = 1732 * MiB, WS_EQM = 1700 * MiB, WS_EKM = 1701 * MiB;
constexpr size_t WS_VINM = 1504 * MiB, WS_VINH = 1536 * MiB;
constexpr size_t WS_PART = 1484 * MiB;
constexpr size_t WS_END = 1764 * MiB;
static_assert(WS_WMGU + (size_t)NE * 2 * MOE * D * 2 <= WS_WMDN && WS_WMDN + (size_t)NE * D * MOE * 2 <= WS_XB0, "ws map 1");
static_assert(WS_WRIN + (size_t)NREC * D * 2 <= WS_WROUT && WS_WFGU + (size_t)2 * FFN * D * 2 <= WS_WFDN && WS_WFDN + (size_t)D * FFN * 2 <= WS_WPG0 && WS_WPP0 + (size_t)D * PLE_DIM * 2 <= WS_U, "ws map 2");
static_assert(WS_U + (size_t)M * UW * 2 <= WS_HA && WS_H + (size_t)M * FFN * 2 <= WS_HA && WS_QKV + (size_t)M * NQKV * 2 <= WS_HA, "ws map 3");
static_assert(WS_HM + (size_t)XS_ROWS * MOE * 2 <= WS_YS && WS_YS + (size_t)XS_ROWS * D * 4 <= WS_END && WS_XS + (size_t)XS_ROWS * D * 2 <= WS_Y, "ws map 4");
constexpr int CW_BAR = 4096;

constexpr int RING_OFF = 0, RING_BYTES = 131072;
constexpr int LDSCTL_OFF = RING_BYTES, MISC_OFF = LDSCTL_OFF + 320;
constexpr int LDS_BYTES = 147456;
static_assert(MISC_OFF + 128 <= LDS_BYTES, "LDS map");

#define GAS __attribute__((address_space(1)))
#define LAS __attribute__((address_space(3)))
typedef unsigned short bf16;
typedef unsigned v4u __attribute__((ext_vector_type(4)));
typedef unsigned v2u __attribute__((ext_vector_type(2)));
typedef float f32x4 __attribute__((ext_vector_type(4)));
typedef float f32x2 __attribute__((ext_vector_type(2)));
typedef GAS unsigned gu32;
#define RLX_AGENT __ATOMIC_RELAXED, __HIP_MEMORY_SCOPE_AGENT
#define LDS_WAIT() asm volatile("s_waitcnt lgkmcnt(0)" ::: "memory")
#define VM_WAIT() asm volatile("s_waitcnt vmcnt(0)" ::: "memory")
__device__ __forceinline__ unsigned f2bf(float f) { unsigned u = __builtin_bit_cast(unsigned, f); return (u + 0x7fffu + ((u >> 16) & 1u)) >> 16; }
typedef float f32x2_t __attribute__((ext_vector_type(2))); typedef __bf16 bf16x2_t __attribute__((ext_vector_type(2)));
__device__ __forceinline__ unsigned cvtpk(float lo, float hi) { f32x2_t v = {lo, hi}; bf16x2_t b = __builtin_convertvector(v, bf16x2_t); return __builtin_bit_cast(unsigned, b); }
__device__ __forceinline__ unsigned pk2(float lo, float hi) { return cvtpk(lo, hi); }
__device__ __forceinline__ float bflo(unsigned w) { return __builtin_bit_cast(float, w << 16); }
__device__ __forceinline__ float bfhi(unsigned w) { return __builtin_bit_cast(float, w & 0xffff0000u); }
__device__ __forceinline__ float bf1(bf16 h) { return __builtin_bit_cast(float, (unsigned)h << 16); }
typedef short bf16x8 __attribute__((ext_vector_type(8)));
typedef short s16x4 __attribute__((ext_vector_type(4)));
__device__ __forceinline__ s16x4 lds_tr(LAS unsigned char* p) { return __builtin_bit_cast(s16x4, __builtin_amdgcn_ds_read_tr16_b64_v4i16((LAS s16x4*)p)); }
__device__ __forceinline__ float sigm(float x) { return __builtin_amdgcn_rcpf(1.0f + __expf(-x)); }
#define AT(base, m, k, K) ((bf16*)((unsigned char*)(base) + pg8::at_tiled_off((int)(m), (int)(k), (K))))
#define XB_TMO      128
#define XB_XCNT(j)  (256  + 64 * (j))
#define XB_XSUB(j)  (1280 + 64 * (j))
#define XB_XGEN(j)  (2304 + 64 * (j))
#define XB_TOP      3328
#define XB_TOPGEN   3392
#define XCD_BAR_WORDS 3456
#define XB_SPIN_CAP (1u << 18)

__device__ __forceinline__ unsigned xb_ld(unsigned* p)              { return __hip_atomic_load(p, __ATOMIC_RELAXED, __HIP_MEMORY_SCOPE_AGENT); }
__device__ __forceinline__ unsigned xb_add(unsigned* p, unsigned v) { return __hip_atomic_fetch_add(p, v, __ATOMIC_RELAXED, __HIP_MEMORY_SCOPE_AGENT); }
__device__ __forceinline__ unsigned xb_xcc_id() { return (unsigned)__builtin_amdgcn_s_getreg((3 << 11) | 20) & 0xFu; }
#define XB_SPIN(cond, bar) do { unsigned _sp = 0; while (cond) { __builtin_amdgcn_s_sleep(1); \
    if ((++_sp & 255u) == 0u) { if (xb_ld(&(bar)[XB_TMO])) break; if (_sp > XB_SPIN_CAP) { atomicAdd(&(bar)[XB_TMO], 1u); break; } } } } while (0)

struct XcdBarrier {
    unsigned* bar; unsigned x;
    volatile LAS unsigned* st;
};

__device__ __forceinline__ XcdBarrier xcd_barrier_post(unsigned* bar, volatile LAS unsigned* st, int wave_s) {
    XcdBarrier b; b.bar = bar; b.x = xb_xcc_id(); b.st = st;
    if (wave_s == 0 && lane_now() == 0) (void)xb_add(&bar[XB_XCNT(b.x)], 1u);
    return b;
}
__device__ __forceinline__ void xcd_barrier_complete(unsigned* bar, unsigned x, unsigned& nloc, unsigned& nx) {
    const unsigned G = gridDim.x * gridDim.y * gridDim.z;
    unsigned sum, cnt, mine, sp = 0u;
    for (;;) {
        sum = 0u; cnt = 0u; mine = 0u;
#pragma unroll
        for (unsigned j = 0; j < 16; ++j) { const unsigned c = xb_ld(&bar[XB_XCNT(j)]); sum += c; cnt += (c > 0u) ? 1u : 0u; mine = (j == x) ? c : mine; }
        if (sum == G) break;
        __builtin_amdgcn_s_sleep(1);
        if ((++sp & 255u) == 0u) { if (xb_ld(&bar[XB_TMO])) break; if (sp > XB_SPIN_CAP) { atomicAdd(&bar[XB_TMO], 1u); break; } }
    }
    nloc = mine > 0u ? mine : 1u; nx = cnt > 0u ? cnt : 1u;
}

__device__ __forceinline__ void xcd_barrier(const XcdBarrier& b, int wave_s) {
    asm volatile("s_waitcnt vmcnt(0)" ::: "memory");
    __syncthreads();
    if (wave_s == 0 && lane_now() == 0) {
        unsigned* bar = b.bar;
        __builtin_amdgcn_s_waitcnt(0);
        unsigned nloc = b.st[0], nx = b.st[1];
        if (nloc == 0u) { xcd_barrier_complete(bar, b.x, nloc, nx); b.st[0] = nloc; b.st[1] = nx; }
        const unsigned old = xb_add(&bar[XB_XSUB(b.x)], 1u);
        const unsigned gen = old / nloc;
        if (old + 1u == (gen + 1u) * nloc) {
            __builtin_amdgcn_fence(__ATOMIC_RELEASE, "agent");
            asm volatile("s_waitcnt vmcnt(0)" ::: "memory");
            const unsigned og = xb_add(&bar[XB_TOP], 1u);
            const unsigned tg = og / nx;
            if (og + 1u == (tg + 1u) * nx) xb_add(&bar[XB_TOPGEN], 1u);
            else XB_SPIN(xb_ld(&bar[XB_TOPGEN]) == tg, bar);
            __builtin_amdgcn_fence(__ATOMIC_ACQUIRE, "agent");
            xb_add(&bar[XB_XGEN(b.x)], 1u);
            asm volatile("s_waitcnt vmcnt(0)" ::: "memory");
        } else {
            XB_SPIN(xb_ld(&bar[XB_XGEN(b.x)]) == gen, bar);
            __builtin_amdgcn_fence(__ATOMIC_ACQUIRE, "agent");
            asm volatile("s_waitcnt vmcnt(0)" ::: "memory");
        }
    }
    __syncthreads();
}

struct Frame {
    LAS unsigned char* lds;
    int wave, G;
};
struct Args { const float* in[23]; float* out; unsigned char* ws; int ph_lo, ph_hi; };
enum { I_X = 0, I_P, I_LNW, I_LNB, I_RECWIN, I_GBIAS, I_MNORM, I_LBLOG, I_HNORM, I_RECWOUT, I_FWG, I_FWU, I_FWD, I_NAQKV, I_RPB, I_NAOUT, I_WR, I_BR, I_MWG, I_MWU, I_MWD, I_PLEG, I_PLEP };

#define DPP_ADD(v, ctrl) ((v) + __builtin_bit_cast(float, __builtin_amdgcn_update_dpp(0, __builtin_bit_cast(int, (v)), (ctrl), 0xF, 0xF, true)))
__device__ __forceinline__ float row_sum16(float v) {
    v = DPP_ADD(v, 0xB1);
    v = DPP_ADD(v, 0x4E);
    v = DPP_ADD(v, 0x141);
    v = DPP_ADD(v, 0x140);
    return v;
}
__device__ __forceinline__ float wave_sum(float v) {
    v = row_sum16(v);
    const float r0 = __builtin_bit_cast(float, __builtin_amdgcn_readlane(__builtin_bit_cast(int, v), 0)), r1 = __builtin_bit_cast(float, __builtin_amdgcn_readlane(__builtin_bit_cast(int, v), 16));
    const float r2 = __builtin_bit_cast(float, __builtin_amdgcn_readlane(__builtin_bit_cast(int, v), 32)), r3 = __builtin_bit_cast(float, __builtin_amdgcn_readlane(__builtin_bit_cast(int, v), 48));
    return (r0 + r1) + (r2 + r3);
}
__device__ __forceinline__ float half_sum32(float v, int lane) {
    v = row_sum16(v);
    const float r0 = __builtin_bit_cast(float, __builtin_amdgcn_readlane(__builtin_bit_cast(int, v), 0)), r1 = __builtin_bit_cast(float, __builtin_amdgcn_readlane(__builtin_bit_cast(int, v), 16));
    const float r2 = __builtin_bit_cast(float, __builtin_amdgcn_readlane(__builtin_bit_cast(int, v), 32)), r3 = __builtin_bit_cast(float, __builtin_amdgcn_readlane(__builtin_bit_cast(int, v), 48));
    return (lane < 32) ? (r0 + r1) : (r2 + r3);
}
__device__ __forceinline__ float wave_max(float v) {
#pragma unroll
    for (int o = 1; o < 64; o <<= 1) v = fmaxf(v, __shfl_xor(v, o));
    return v;
}

__device__ __forceinline__ void tr_item(const float* W, int ldn, int K, int srcc, int nvalid, bf16* WT, size_t drow, int k0, LAS float* scr, int lane, bool tiled) {
    const int c = lane & 31;
    {   float tmp[32]; const float* wp = W + (size_t)(k0 + (lane >> 5)) * ldn + srcc + c; const bool ok = c < nvalid;
#pragma unroll
        for (int i = 0; i < 32; ++i) tmp[i] = ok ? __builtin_nontemporal_load(wp + (size_t)(2 * i) * ldn) : 0.f;
#pragma unroll
        for (int i = 0; i < 32; ++i) scr[(2 * i + (lane >> 5)) * 33 + c] = tmp[i]; }
    LDS_WAIT(); asm volatile("" ::: "memory");
    const int c8 = lane & 7;
#pragma unroll
    for (int j = 0; j < 4; ++j) { const int n = (lane >> 3) + 8 * j; const LAS float* s = scr + (8 * c8) * 33 + n;
        v4u o; o.x = pk2(s[0 * 33], s[1 * 33]); o.y = pk2(s[2 * 33], s[3 * 33]); o.z = pk2(s[4 * 33], s[5 * 33]); o.w = pk2(s[6 * 33], s[7 * 33]);
        if (tiled) *(GAS v4u*)((GAS unsigned char*)WT + pg8::bt_tiled_off((int)drow + n, k0 + 8 * c8, K)) = o; else *(GAS v4u*)(WT + (drow + n) * (size_t)K + k0 + 8 * c8) = o; }
    LDS_WAIT(); asm volatile("" ::: "memory");
}
constexpr int TR2_P = 288;
struct Tr2D { const float* W; unsigned char* WT; int ldn, K, srcc, drow, k0; };
__device__ __forceinline__ void tr2_load(f32x2 (&tmp)[32], const Tr2D& t, int lane) {
    const float* wp = t.W + (size_t)t.k0 * t.ldn + t.srcc + 2 * lane;
#pragma unroll
    for (int i = 0; i < 32; ++i) tmp[i] = __builtin_nontemporal_load((const GAS f32x2*)(wp + (size_t)i * t.ldn));
}
__device__ __forceinline__ void tr2_store(const f32x2 (&tmp)[32], const Tr2D& t, LAS unsigned char* scr, int lane) {
    {   const int n = 2 * lane, v = n & 31, slot = (n & ~31) + 16 * ((v >> 2) & 1) + 4 * (v >> 3) + (v & 3);
#pragma unroll
        for (int i = 0; i < 32; ++i) *(LAS unsigned*)(scr + i * TR2_P + slot * 2) = cvtpk(tmp[i][0], tmp[i][1]); }
    LDS_WAIT(); asm volatile("" ::: "memory");
    const int g = lane >> 4, i16 = lane & 15, q = i16 >> 2, p4 = lane & 3;
    unsigned char* blk = t.WT + ((size_t)(((t.drow >> 8) * 2 + ((t.drow >> 7) & 1)) * (t.K >> 6) + (t.k0 >> 6))) * 16384;
    const int C = (t.k0 & 63) + 8 * g;
#pragma unroll
    for (int s = 0; s < 8; ++s) { LAS unsigned char* tp = scr + (8 * g + q) * TR2_P + (16 * s + 4 * p4) * 2;
        const s16x4 x0 = lds_tr(tp), x1 = lds_tr(tp + 4 * TR2_P);
        v4u o = __builtin_bit_cast(v4u, (bf16x8){x0[0], x0[1], x0[2], x0[3], x1[0], x1[1], x1[2], x1[3]});
        *(GAS v4u*)(blk + pg8::lds_byte(16 * s + i16, C)) = o; }
    LDS_WAIT(); asm volatile("" ::: "memory");
}
constexpr int N2_RIN = 64 * (UW / 128), N2_ROUT = 64 * 16, N2_FGU = 64 * (2 * FFN / 128), N2_FDN = (FFN / 32) * 16, N2_PG = 64 * 16, N2_PP = 8 * 16, N2_QKV = 64 * (NQKV / 128), N2_NAO = 64 * 16;
constexpr int N2_MGU = 64 * (NE * 2 * MOE / 128), N2_MDN = (MOE / 32) * (NE * D / 128);
constexpr int N2_ITEMS = N2_RIN + N2_ROUT + N2_FGU + N2_FDN + 2 * N2_PG + 2 * N2_PP + N2_QKV + N2_NAO + N2_MGU + N2_MDN;
__device__ __forceinline__ Tr2D tr2_decode(const Args& A, int r) {
    unsigned char* ws = A.ws; const float* W; unsigned char* WT; int ldn, K; int srcc, kb, nb;
#define TR_KN() { const int nk2_ = K / 64, g8_ = r >> 3, w8_ = r & 7; kb = (g8_ % nk2_) * 2 + (w8_ & 1); nb = (g8_ / nk2_) * 4 + (w8_ >> 1); }
    if (r < N2_RIN) { W = A.in[I_RECWIN]; WT = ws + WS_WRIN; ldn = REC_IN; K = D; TR_KN(); srcc = (nb < 24) ? nb * 128 : nb * 128 + 16; }
    else if ((r -= N2_RIN) < N2_ROUT) { W = A.in[I_RECWOUT]; WT = ws + WS_WROUT; ldn = D; K = D; TR_KN(); srcc = nb * 128; }
    else if ((r -= N2_ROUT) < N2_FGU) { WT = ws + WS_WFGU; ldn = FFN; K = D; TR_KN(); W = (nb & 1) ? A.in[I_FWU] : A.in[I_FWG]; srcc = (nb >> 1) * 128; }
    else if ((r -= N2_FGU) < N2_FDN) { W = A.in[I_FWD]; WT = ws + WS_WFDN; ldn = D; K = FFN; TR_KN(); srcc = nb * 128; }
    else if ((r -= N2_FDN) < 2 * N2_PG) { const int l = r / N2_PG; r -= l * N2_PG; W = A.in[I_PLEG] + (size_t)l * D * D; WT = ws + (l ? WS_WPG1 : WS_WPG0); ldn = D; K = D; TR_KN(); srcc = nb * 128; }
    else if ((r -= 2 * N2_PG) < 2 * N2_PP) { const int l = r / N2_PP; r -= l * N2_PP; W = A.in[I_PLEP] + (size_t)l * PLE_DIM * D; WT = ws + (l ? WS_WPP1 : WS_WPP0); ldn = D; K = PLE_DIM; TR_KN(); srcc = nb * 128; }
    else if ((r -= 2 * N2_PP) < N2_QKV) { W = A.in[I_NAQKV]; WT = ws + WS_WQKV; ldn = NQKV; K = D; TR_KN(); srcc = nb * 128; }
    else if ((r -= N2_QKV) < N2_NAO) { W = A.in[I_NAOUT]; WT = ws + WS_WNAO; ldn = D; K = D; TR_KN(); srcc = nb * 128; }
    else if ((r -= N2_NAO) < N2_MGU) { WT = ws + WS_WMGU; ldn = MOE; K = D; TR_KN(); const int e = nb / (2 * MOE / 128), nl = nb % (2 * MOE / 128); W = ((nl & 1) ? A.in[I_MWU] : A.in[I_MWG]) + (size_t)e * D * MOE; srcc = (nl >> 1) * 128; }
    else { r -= N2_MGU; WT = ws + WS_WMDN; ldn = D; K = MOE; TR_KN(); const int e = nb / (D / 128), nl = nb % (D / 128); W = A.in[I_MWD] + (size_t)e * MOE * D; srcc = nl * 128; }
#undef TR_KN
    Tr2D t; t.W = W; t.WT = WT; t.ldn = ldn; t.K = K; t.srcc = srcc; t.drow = nb * 128; t.k0 = kb * 32; return t;
}
__device__ __forceinline__ void p0_prologue(const Frame& F, const Args& A) {
    const int lane = lane_now(), tid = F.wave * 64 + lane; (void)tid;
    LAS float* scr = (LAS float*)(F.lds + RING_OFF + F.wave * 16384);
    const int gw = blockIdx.x * NWAVES + F.wave, NGW = F.G * NWAVES;
    unsigned char* ws = A.ws;
    {
        f32x2 ra[32], rb[32]; Tr2D da, db; int it = gw;
        if (it < N2_ITEMS) { da = tr2_decode(A, it); tr2_load(ra, da, lane); }
        while (it < N2_ITEMS) {
            int nx = it + NGW; if (nx < N2_ITEMS) { db = tr2_decode(A, nx); tr2_load(rb, db, lane); }
            tr2_store(ra, da, (LAS unsigned char*)scr, lane);
            it = nx; if (it >= N2_ITEMS) break;
            nx = it + NGW; if (nx < N2_ITEMS) { da = tr2_decode(A, nx); tr2_load(ra, da, lane); }
            tr2_store(rb, db, (LAS unsigned char*)scr, lane);
            it = nx;
        }
    }
    for (int it = gw; it < 32 * 8; it += NGW) { const int kb = it >> 3, nb = it & 7; tr_item(A.in[I_RECWIN], REC_IN, D, 3072, (nb == 0) ? 16 : 0, (bf16*)(ws + WS_WGATE), (size_t)nb * 32, kb * 64, scr, lane, false); }
    const size_t gt = (size_t)blockIdx.x * (NWAVES * 64) + tid, NGT = (size_t)F.G * NWAVES * 64;
    { const GAS f32x4* src = (const GAS f32x4*)A.in[I_X]; GAS v4u* dst = (GAS v4u*)(ws + WS_XB0); const size_t NCH = (size_t)M * D / 8;
      for (size_t i = gt; i < NCH; i += 4 * NGT) { f32x4 a[4], b[4];
#pragma unroll
          for (int u = 0; u < 4; ++u) { const size_t iu = i + u * NGT; if (iu < NCH) { a[u] = __builtin_nontemporal_load(src + 2 * iu); b[u] = __builtin_nontemporal_load(src + 2 * iu + 1); } }
#pragma unroll
          for (int u = 0; u < 4; ++u) { const size_t iu = i + u * NGT; if (iu < NCH) { v4u o; o.x = pk2(a[u][0], a[u][1]); o.y = pk2(a[u][2], a[u][3]); o.z = pk2(b[u][0], b[u][1]); o.w = pk2(b[u][2], b[u][3]); dst[iu] = o; } } } }
    { const GAS f32x4* src = (const GAS f32x4*)A.in[I_P]; GAS v4u* dst = (GAS v4u*)(ws + WS_PB); const size_t NCH = (size_t)2 * M * PLE_DIM / 8;
      for (size_t i = gt; i < NCH; i += 4 * NGT) { f32x4 a[4], b[4];
#pragma unroll
          for (int u = 0; u < 4; ++u) { const size_t iu = i + u * NGT; if (iu < NCH) { a[u] = __builtin_nontemporal_load(src + 2 * iu); b[u] = __builtin_nontemporal_load(src + 2 * iu + 1); } }
#pragma unroll
          for (int u = 0; u < 4; ++u) { const size_t iu = i + u * NGT; if (iu < NCH) { v4u o; o.x = pk2(a[u][0], a[u][1]); o.y = pk2(a[u][2], a[u][3]); o.z = pk2(b[u][0], b[u][1]); o.w = pk2(b[u][2], b[u][3]);
              *(GAS v4u*)AT(dst, (iu * 8) / PLE_DIM, (iu * 8) % PLE_DIM, PLE_DIM) = o; } } } }
}

constexpr int RB = 32;
#define T0_OF(blk) (dir ? (T - RB - (blk) * RB) : (blk) * RB)
__device__ __forceinline__ void mlstm_unit(const Frame& F, const Args& A, int unit) {
    const int lane = lane_now(), tid = F.wave * 64 + lane; (void)tid;
    const int cg = unit & 3, dir = (unit >> 2) & 1, h = (unit >> 3) & 3, b = unit >> 5;
    LAS float* qs = (LAS float*)(F.lds + RING_OFF);
    LAS float* ks = qs + RB * 128;
    LAS float* vs = ks + RB * 128;
    LAS float* fi = vs + RB * 64;
    LAS float* ob = fi + RB * 2;
    const bf16* U = (const bf16*)(A.ws + WS_U); const float* Gt = (const float*)(A.ws + WS_G);
    float* HA = (float*)(A.ws + WS_HA) + (size_t)dir * M * 1024;
    const int e = lane & 7, dg = lane >> 3, colw = F.wave * 8 + e;
    const int srow = tid >> 4, sc = tid & 15;
    const float bias_i = A.in[I_GBIAS][(dir ? 2 : 0) * 4 + h], bias_f = A.in[I_GBIAS][(dir ? 3 : 1) * 4 + h];
    float C[16], n[16];
#pragma unroll
    for (int j = 0; j < 16; ++j) { C[j] = 0.f; n[j] = 0.f; }
    v4u rq, rk; v2u rv; float rgi = 0.f, rgf = 0.f;
    {   const size_t row = (size_t)b * T + T0_OF(0) + srow; const bf16* ur = U + row * UW;
        rq = *(const GAS v4u*)(ur + U_QA + h * 128 + sc * 8); rk = *(const GAS v4u*)(ur + U_KA + h * 128 + sc * 8); rv = *(const GAS v2u*)(ur + U_VA + h * 256 + cg * 64 + sc * 4);
        if (tid < RB) { const size_t r2 = (size_t)b * T + T0_OF(0) + tid; rgi = Gt[r2 * 16 + (dir ? 2 : 0) * 4 + h]; rgf = Gt[r2 * 16 + (dir ? 3 : 1) * 4 + h]; } }
    for (int blk = 0; blk < T / RB; ++blk) {
        const int t0 = T0_OF(blk);
        {   const float qsc = 0.08838834764831845f;
            LAS float* qd = qs + srow * 128 + sc * 8; LAS float* kd = ks + srow * 128 + sc * 8;
            *(LAS f32x4*)qd = (f32x4){bflo(rq.x) * qsc, bfhi(rq.x) * qsc, bflo(rq.y) * qsc, bfhi(rq.y) * qsc}; *(LAS f32x4*)(qd + 4) = (f32x4){bflo(rq.z) * qsc, bfhi(rq.z) * qsc, bflo(rq.w) * qsc, bfhi(rq.w) * qsc};
            *(LAS f32x4*)kd = (f32x4){bflo(rk.x), bfhi(rk.x), bflo(rk.y), bfhi(rk.y)}; *(LAS f32x4*)(kd + 4) = (f32x4){bflo(rk.z), bfhi(rk.z), bflo(rk.w), bfhi(rk.w)};
            *(LAS f32x4*)(vs + srow * 64 + sc * 4) = (f32x4){bflo(rv.x), bfhi(rv.x), bflo(rv.y), bfhi(rv.y)};
            if (tid < RB) { const float gi = GATE_CAP * tanhf((rgi + bias_i) * (1.0f / GATE_CAP)), gf = GATE_CAP * tanhf((rgf + bias_f) * (1.0f / GATE_CAP));
                fi[tid * 2] = sigm(gf); fi[tid * 2 + 1] = __expf(gi); } }
        __syncthreads();
        if (blk + 1 < T / RB) { const size_t row = (size_t)b * T + T0_OF(blk + 1) + srow; const bf16* ur = U + row * UW;
            rq = *(const GAS v4u*)(ur + U_QA + h * 128 + sc * 8); rk = *(const GAS v4u*)(ur + U_KA + h * 128 + sc * 8); rv = *(const GAS v2u*)(ur + U_VA + h * 256 + cg * 64 + sc * 4);
            if (tid < RB) { const size_t r2 = (size_t)b * T + T0_OF(blk + 1) + tid; rgi = Gt[r2 * 16 + (dir ? 2 : 0) * 4 + h]; rgf = Gt[r2 * 16 + (dir ? 3 : 1) * 4 + h]; } }
        for (int s = 0; s < RB; ++s) {
            const int tl = dir ? (RB - 1 - s) : s;
            const float f = fi[tl * 2], ii = fi[tl * 2 + 1], v = vs[tl * 64 + colw];
            const LAS f32x4* qp = (const LAS f32x4*)(qs + tl * 128 + dg * 16); const LAS f32x4* kp = (const LAS f32x4*)(ks + tl * 128 + dg * 16);
            float num = 0.f, den = 0.f;
#pragma unroll
            for (int j4 = 0; j4 < 4; ++j4) { const f32x4 q4 = qp[j4], k4 = kp[j4];
#pragma unroll
                for (int i = 0; i < 4; ++i) { const int j = j4 * 4 + i; const float kk = ii * k4[i]; C[j] = f * C[j] + kk * v; n[j] = f * n[j] + kk; num += C[j] * q4[i]; den += n[j] * q4[i]; } }
            num += __shfl_xor(num, 8); den += __shfl_xor(den, 8); num += __shfl_xor(num, 16); den += __shfl_xor(den, 16); num += __shfl_xor(num, 32); den += __shfl_xor(den, 32);
            if (dg == 0) ob[tl * 64 + colw] = num / fmaxf(fabsf(den), 1.0f);
        }
        __syncthreads();
        *(GAS f32x4*)(HA + ((size_t)b * T + t0 + srow) * 1024 + h * 256 + cg * 64 + sc * 4) = *(const LAS f32x4*)(ob + srow * 64 + sc * 4);
    }
    __syncthreads();
}
__device__ __forceinline__ void hgrn_unit(const Frame& F, const Args& A, int unit) {
    const int lane = lane_now(), tid = F.wave * 64 + lane; (void)tid;
    const int cg = unit & 1, dir = (unit >> 1) & 1, h = (unit >> 2) & 7, b = unit >> 5;
    LAS float* qs = (LAS float*)(F.lds + RING_OFF);
    LAS float* fs = qs + RB * 128;
    LAS float* vs = fs + RB * 128;
    LAS float* ob = vs + RB * 64;
    const bf16* U = (const bf16*)(A.ws + WS_U);
    float* HB = (float*)(A.ws + WS_HB) + (size_t)dir * M * 1024;
    const int e = lane & 7, dg = lane >> 3, colw = F.wave * 8 + e;
    const int srow = tid >> 4, sc = tid & 15;
    float lb[8];
#pragma unroll
    for (int i = 0; i < 8; ++i) { const float l0 = A.in[I_LBLOG][(dir * 2 + 0) * 1024 + h * 128 + sc * 8 + i], l1 = A.in[I_LBLOG][(dir * 2 + 1) * 1024 + h * 128 + sc * 8 + i]; lb[i] = 1.0f / (1.0f + __expf(l1 - l0)); }
    float S[16];
#pragma unroll
    for (int j = 0; j < 16; ++j) S[j] = 0.f;
    v4u rq, rf; v2u rv;
    {   const size_t row = (size_t)b * T + T0_OF(0) + srow; const bf16* ur = U + row * UW;
        rq = *(const GAS v4u*)(ur + U_QB + h * 128 + sc * 8); rf = *(const GAS v4u*)(ur + (dir ? U_FB : U_FF) + h * 128 + sc * 8); rv = *(const GAS v2u*)(ur + U_IB + h * 128 + cg * 64 + sc * 4); }
    for (int blk = 0; blk < T / RB; ++blk) {
        const int t0 = T0_OF(blk);
        {   LAS float* qd = qs + srow * 128 + sc * 8; LAS float* fd = fs + srow * 128 + sc * 8;
            float qv[8] = {bflo(rq.x), bfhi(rq.x), bflo(rq.y), bfhi(rq.y), bflo(rq.z), bfhi(rq.z), bflo(rq.w), bfhi(rq.w)};
            float fv[8] = {bflo(rf.x), bfhi(rf.x), bflo(rf.y), bfhi(rf.y), bflo(rf.z), bfhi(rf.z), bflo(rf.w), bfhi(rf.w)};
#pragma unroll
            for (int i = 0; i < 8; ++i) { qv[i] = qv[i] * sigm(qv[i]); fv[i] = lb[i] + (1.0f - lb[i]) * sigm(fv[i]); }
            *(LAS f32x4*)qd = (f32x4){qv[0], qv[1], qv[2], qv[3]}; *(LAS f32x4*)(qd + 4) = (f32x4){qv[4], qv[5], qv[6], qv[7]};
            *(LAS f32x4*)fd = (f32x4){fv[0], fv[1], fv[2], fv[3]}; *(LAS f32x4*)(fd + 4) = (f32x4){fv[4], fv[5], fv[6], fv[7]};
            *(LAS f32x4*)(vs + srow * 64 + sc * 4) = (f32x4){bflo(rv.x), bfhi(rv.x), bflo(rv.y), bfhi(rv.y)}; }
        __syncthreads();
        if (blk + 1 < T / RB) { const size_t row = (size_t)b * T + T0_OF(blk + 1) + srow; const bf16* ur = U + row * UW;
            rq = *(const GAS v4u*)(ur + U_QB + h * 128 + sc * 8); rf = *(const GAS v4u*)(ur + (dir ? U_FB : U_FF) + h * 128 + sc * 8); rv = *(const GAS v2u*)(ur + U_IB + h * 128 + cg * 64 + sc * 4); }
        for (int s = 0; s < RB; ++s) {
            const int tl = dir ? (RB - 1 - s) : s;
            const float v = vs[tl * 64 + colw];
            const LAS f32x4* qp = (const LAS f32x4*)(qs + tl * 128 + dg * 16); const LAS f32x4* fp = (const LAS f32x4*)(fs + tl * 128 + dg * 16);
            float o = 0.f;
#pragma unroll
            for (int j4 = 0; j4 < 4; ++j4) { const f32x4 q4 = qp[j4], f4 = fp[j4];
#pragma unroll
                for (int i = 0; i < 4; ++i) { const int j = j4 * 4 + i; S[j] = f4[i] * S[j] + (1.0f - f4[i]) * v; o += S[j] * q4[i]; } }
            o += __shfl_xor(o, 8); o += __shfl_xor(o, 16); o += __shfl_xor(o, 32);
            if (dg == 0) ob[tl * 64 + colw] = o;
        }
        __syncthreads();
        *(GAS f32x4*)(HB + ((size_t)b * T + t0 + srow) * 1024 + h * 128 + cg * 64 + sc * 4) = *(const LAS f32x4*)(ob + srow * 64 + sc * 4);
    }
    __syncthreads();
}
__device__ __forceinline__ void p3_finalize(const Frame& F, const Args& A) {
    const int lane = lane_now(), tid = F.wave * 64 + lane; (void)tid;
    const int gw = blockIdx.x * NWAVES + F.wave, NGW = F.G * NWAVES;
    const bf16* U = (const bf16*)(A.ws + WS_U); bf16* Y = (bf16*)(A.ws + WS_Y);
    const bf16* HA = (const bf16*)(A.ws + WS_HA); const bf16* HB = (const bf16*)(A.ws + WS_HB);
    f32x4 nw[8];
#pragma unroll
    for (int ps = 0; ps < 8; ++ps) nw[ps] = *(const GAS f32x4*)((ps < 4 ? A.in[I_MNORM] : A.in[I_HNORM]) + (ps & 3) * 256 + lane * 4);
    v2u ra[8], rb[8], rg[8];
#define P3_LOAD(row_) do { const size_t ro_ = (size_t)(row_) * 1024; const bf16* ur_ = U + (size_t)(row_) * UW; \
        _Pragma("unroll") for (int ps = 0; ps < 8; ++ps) { const int c = (ps & 3) * 256 + lane * 4; const bf16* hb_ = (ps < 4) ? HA : HB; \
            ra[ps] = *(const GAS v2u*)(hb_ + ro_ + c); rb[ps] = *(const GAS v2u*)(hb_ + (size_t)M * 1024 + ro_ + c); rg[ps] = *(const GAS v2u*)(ur_ + (ps < 4 ? U_OA : U_GB) + c); } } while (0)
    int row = gw; if (row < M) P3_LOAD(row);
    for (; row < M; row += NGW) {
        v2u out[8];
#pragma unroll
        for (int ps = 0; ps < 8; ++ps) { const v2u a2 = ra[ps], b2 = rb[ps], gg = rg[ps];
            const f32x4 s = (f32x4){bflo(a2.x) + bflo(b2.x), bfhi(a2.x) + bfhi(b2.x), bflo(a2.y) + bflo(b2.y), bfhi(a2.y) + bfhi(b2.y)}; float ss = (s[0] * s[0] + s[1] * s[1]) + (s[2] * s[2] + s[3] * s[3]);
            ss = (ps < 4) ? wave_sum(ss) : half_sum32(ss, lane);
            const float r = __builtin_amdgcn_rsqf(ss * (ps < 4 ? (1.0f / 256.0f) : (1.0f / 128.0f)) + RMS_EPS);
            const float g0 = bflo(gg.x), g1 = bfhi(gg.x), g2 = bflo(gg.y), g3 = bfhi(gg.y);
            float m0, m1, m2, m3;
            if (ps < 4) { m0 = sigm(g0); m1 = sigm(g1); m2 = sigm(g2); m3 = sigm(g3); } else { m0 = g0 * sigm(g0); m1 = g1 * sigm(g1); m2 = g2 * sigm(g2); m3 = g3 * sigm(g3); }
            out[ps].x = pk2(s[0] * r * nw[ps][0] * m0, s[1] * r * nw[ps][1] * m1); out[ps].y = pk2(s[2] * r * nw[ps][2] * m2, s[3] * r * nw[ps][3] * m3); }
        const int rown = row + NGW; if (rown < M) P3_LOAD(rown);
#pragma unroll
        for (int ps = 0; ps < 8; ++ps) *(GAS v2u*)AT(Y, row, ps * 256 + lane * 4, D) = out[ps];
    }
#undef P3_LOAD
}

struct LnAff { f32x4 w[8], b[8]; };
__device__ __forceinline__ LnAff ln_aff_load(const float* w, const float* bvec, int lane) { LnAff a;
#pragma unroll
    for (int j = 0; j < 8; ++j) { a.w[j] = *(const GAS f32x4*)(w + 256 * j + 4 * lane); a.b[j] = *(const GAS f32x4*)(bvec + 256 * j + 4 * lane); }
    return a; }
__device__ __forceinline__ void ln_row_regs(f32x4 (&v)[8], const LnAff& af, int lane) {
    float s = 0.f;
#pragma unroll
    for (int j = 0; j < 8; ++j) s += (v[j][0] + v[j][1]) + (v[j][2] + v[j][3]);
    const float mean = wave_sum(s) * (1.0f / D); float s2 = 0.f;
#pragma unroll
    for (int j = 0; j < 8; ++j) { v[j] = v[j] - mean; s2 += (v[j][0] * v[j][0] + v[j][1] * v[j][1]) + (v[j][2] * v[j][2] + v[j][3] * v[j][3]); }
    const float rstd = 1.0f / sqrtf(wave_sum(s2) * (1.0f / D) + LN_EPS);
#pragma unroll
    for (int j = 0; j < 8; ++j) v[j] = v[j] * rstd * af.w[j] + af.b[j];
}
__device__ __forceinline__ void store_row(const f32x4 (&v)[8], float* xf, bf16* xb, int lane) {
#pragma unroll
    for (int j = 0; j < 8; ++j) { *(GAS f32x4*)(xf + 256 * j + 4 * lane) = v[j]; v2u o; o.x = pk2(v[j][0], v[j][1]); o.y = pk2(v[j][2], v[j][3]); *(GAS v2u*)(xb + 256 * j + 4 * lane) = o; }
}

__device__ __forceinline__ void load_row_b(f32x4 (&v)[8], const bf16* xb, int lane) {
#pragma unroll
    for (int j = 0; j < 8; ++j) { const v2u w = *(const GAS v2u*)(xb + 256 * j + 4 * lane); v[j] = (f32x4){bflo(w.x), bfhi(w.x), bflo(w.y), bfhi(w.y)}; }
}
__device__ __forceinline__ void store_row_b(const f32x4 (&v)[8], bf16* xb, int lane) {
#pragma unroll
    for (int j = 0; j < 8; ++j) { v2u o; o.x = pk2(v[j][0], v[j][1]); o.y = pk2(v[j][2], v[j][3]); *(GAS v2u*)(xb + 256 * j + 4 * lane) = o; }
}
__device__ __forceinline__ void load_row_bt(f32x4 (&v)[8], const bf16* base, int row, int lane) {
#pragma unroll
    for (int j = 0; j < 8; ++j) { const v2u w = *(const GAS v2u*)AT(base, row, 256 * j + 4 * lane, D); v[j] = (f32x4){bflo(w.x), bfhi(w.x), bflo(w.y), bfhi(w.y)}; }
}
__device__ __forceinline__ void store_row_bt(const f32x4 (&v)[8], bf16* base, int row, int lane) {
#pragma unroll
    for (int j = 0; j < 8; ++j) { v2u o; o.x = pk2(v[j][0], v[j][1]); o.y = pk2(v[j][2], v[j][3]); *(GAS v2u*)AT(base, row, 256 * j + 4 * lane, D) = o; }
}
__device__ __forceinline__ void ln_phase_b(const Frame& F, const Args& A, const float* w, const float* bvec, const bf16* TB, bf16* XB) {
    const int lane = lane_now(); const int gw = blockIdx.x * NWAVES + F.wave, NGW = F.G * NWAVES;
    const LnAff af = ln_aff_load(w, bvec, lane);
    f32x4 v[8], vn[8]; int row = gw; if (row < M) load_row_b(v, TB + (size_t)row * D, lane);
    for (; row < M; row += NGW) {
        const int rn = row + NGW; if (rn < M) load_row_b(vn, TB + (size_t)rn * D, lane);
        ln_row_regs(v, af, lane); store_row_b(v, XB + (size_t)row * D, lane);
#pragma unroll
        for (int j = 0; j < 8; ++j) v[j] = vn[j]; }
}
__device__ __forceinline__ void ln_phase(const Frame& F, const Args& A, const float* w, const float* bvec, bf16* XB) {
    const int lane = lane_now(), tid = F.wave * 64 + lane; (void)tid;
    const LnAff af = ln_aff_load(w, bvec, lane);
    const int gw = blockIdx.x * NWAVES + F.wave, NGW = F.G * NWAVES;
    for (int row = gw; row < M; row += NGW) { float* xr = A.out + (size_t)row * D; f32x4 v[8];
#pragma unroll
        for (int j = 0; j < 8; ++j) v[j] = *(const GAS f32x4*)(xr + 256 * j + 4 * lane);
        ln_row_regs(v, af, lane); store_row(v, xr, XB + (size_t)row * D, lane); }
}
__device__ __forceinline__ void ln_router_phase(const Frame& F, const Args& A, const float* w, const float* bvec, bf16* XB) {
    const int lane = lane_now(), tid = F.wave * 64 + lane; (void)tid;
    const LnAff af = ln_aff_load(w, bvec, lane);
    LAS int* cnt = (LAS int*)(F.lds + RING_OFF);
    int* TOKE = (int*)(A.ws + WS_TOKE); float* TOKG = (float*)(A.ws + WS_TOKG); int* WGCNT = (int*)(A.ws + WS_WGCNT);
    const float* wr = A.in[I_WR]; const float* br = A.in[I_BR];
    LAS f32x4* wt = (LAS f32x4*)(F.lds + RING_OFF + 1024);
    for (int x = tid; x < 2048 * 2; x += NWAVES * 64) { const int col = x >> 1, half = x & 1; const int j = col >> 8, ln = (col & 255) >> 2, i = col & 3;
        wt[((j * 4 + i) * 2 + half) * 64 + ln] = *(const GAS f32x4*)(wr + (size_t)col * NE + 4 * half); }
    for (int vb = blockIdx.x; vb < M / 64; vb += F.G) {
        if (tid < 8) cnt[tid] = 0;
        __syncthreads();
        f32x4 v[8], vn[8];
        { const float* xr0 = A.out + (size_t)(vb * 64 + F.wave * 8) * D;
#pragma unroll
          for (int j = 0; j < 8; ++j) v[j] = *(const GAS f32x4*)(xr0 + 256 * j + 4 * lane); }
        for (int k = 0; k < 8; ++k) { const int row = vb * 64 + F.wave * 8 + k;
            if (k + 1 < 8) { const float* xn = A.out + (size_t)(row + 1) * D;
#pragma unroll
                for (int j = 0; j < 8; ++j) vn[j] = *(const GAS f32x4*)(xn + 256 * j + 4 * lane); }
            ln_row_regs(v, af, lane); store_row_b(v, XB + (size_t)row * D, lane);
            float lg[8];
#pragma unroll
            for (int e = 0; e < 8; ++e) lg[e] = 0.f;
#pragma unroll
            for (int j = 0; j < 8; ++j)
#pragma unroll
                for (int i = 0; i < 4; ++i) { const f32x4 w0 = wt[((j * 4 + i) * 2 + 0) * 64 + lane], w1 = wt[((j * 4 + i) * 2 + 1) * 64 + lane]; const float xv = v[j][i];
                    lg[0] += xv * w0[0]; lg[1] += xv * w0[1]; lg[2] += xv * w0[2]; lg[3] += xv * w0[3]; lg[4] += xv * w1[0]; lg[5] += xv * w1[1]; lg[6] += xv * w1[2]; lg[7] += xv * w1[3]; }
#pragma unroll
            for (int e = 0; e < 8; ++e) lg[e] = wave_sum(lg[e]) + br[e];
            int e1 = 0; float l1 = lg[0];
#pragma unroll
            for (int e = 1; e < 8; ++e) if (lg[e] > l1) { l1 = lg[e]; e1 = e; }
            int e2 = -1; float l2 = -3.0e38f;
#pragma unroll
            for (int e = 0; e < 8; ++e) if (e != e1 && lg[e] > l2) { l2 = lg[e]; e2 = e; }
            const float g2 = 1.0f / (1.0f + __expf(l1 - l2)), g1 = 1.0f - g2;
            if (lane == 0) { TOKE[2 * row] = e1; TOKE[2 * row + 1] = e2; TOKG[2 * row] = g1; TOKG[2 * row + 1] = g2; __hip_atomic_fetch_add(&cnt[e1], 1, __ATOMIC_RELAXED, __HIP_MEMORY_SCOPE_WORKGROUP); __hip_atomic_fetch_add(&cnt[e2], 1, __ATOMIC_RELAXED, __HIP_MEMORY_SCOPE_WORKGROUP); }
#pragma unroll
            for (int j = 0; j < 8; ++j) v[j] = vn[j];
        }
        __syncthreads();
        if (tid < 8) WGCNT[vb * 8 + tid] = cnt[tid];
        __syncthreads();
    }
}
__device__ __forceinline__ int inv_slot(int d) { const int rr = d & 127; return (((d >> 7) * 64 + (rr & 63)) << 1) + (rr >> 6); }
__device__ __forceinline__ void moe_route_phase(const Frame& F, const Args& A) {
    const int lane = lane_now(), tid = F.wave * 64 + lane; (void)lane;
    LAS int* sm = (LAS int*)(F.lds + RING_OFF);
    const int* TOKE = (const int*)(A.ws + WS_TOKE); int* DEST = (int*)(A.ws + WS_DEST); const int* WGCNT = (const int*)(A.ws + WS_WGCNT); int* TILEE = (int*)(A.ws + WS_TILEE); unsigned short* INV = (unsigned short*)(A.ws + WS_INV);
    for (int vb = blockIdx.x; vb < M / 64; vb += F.G) {
        if (tid < 16) sm[tid] = 0;
        if (tid >= 64 && tid < 192) sm[32 + tid - 64] = TOKE[vb * 128 + tid - 64];
        __syncthreads();
        {   const int e = tid & 7, wq = tid >> 3; int tot = 0, pre = 0;
#pragma unroll
            for (int i = 0; i < 4; ++i) { const int w = wq * 4 + i; const int c = WGCNT[w * 8 + e]; tot += c; pre += (w < vb) ? c : 0; }
            __hip_atomic_fetch_add(&sm[e], tot, __ATOMIC_RELAXED, __HIP_MEMORY_SCOPE_WORKGROUP); __hip_atomic_fetch_add(&sm[8 + e], pre, __ATOMIC_RELAXED, __HIP_MEMORY_SCOPE_WORKGROUP); }
        __syncthreads();
        if (tid == 0) { int base = 0; for (int e = 0; e < 8; ++e) { sm[16 + e] = base; base += ((sm[e] + 255) >> 8) << 8; }
            if (vb == 0) { int rt = 0; for (int e = 0; e < 8; ++e) { const int nt = (sm[e] + 255) >> 8; for (int i = 0; i < nt; ++i) TILEE[1 + rt++] = e; } TILEE[0] = rt; } }
        __syncthreads();
        if (tid < 128) { const int e = sm[32 + tid]; int rank = 0; for (int s = 0; s < tid; ++s) rank += (sm[32 + s] == e) ? 1 : 0; const int d = sm[16 + e] + sm[8 + e] + rank; DEST[vb * 128 + tid] = d; INV[inv_slot(d)] = (unsigned short)(vb * 64 + (tid >> 1)); }
        if (vb == 0) { for (int e = 0; e < 8; ++e) { const int tot = sm[e], pad = ((tot + 255) >> 8) << 8, base = sm[16 + e]; for (int i = tot + tid; i < pad; i += NWAVES * 64) INV[inv_slot(base + i)] = 0; } }
        __syncthreads();
    }
}
__device__ __forceinline__ void ln_moe_phase(const Frame& F, const Args& A, const float* w, const float* bvec, const bf16* XBin, bf16* XBout) {
    const int lane = lane_now(); const int gw = blockIdx.x * NWAVES + F.wave, NGW = F.G * NWAVES;
    const LnAff af = ln_aff_load(w, bvec, lane);
    const float* TOKG = (const float*)(A.ws + WS_TOKG); const int* DEST = (const int*)(A.ws + WS_DEST); const bf16* YS = (const bf16*)(A.ws + WS_YS);
    const bf16* PARTB = (const bf16*)(A.ws + WS_PART);
    f32x4 v[8], y1[8], y2[8]; int row = gw; int d1 = 0, d2 = 0; float g1 = 0.f, g2 = 0.f;
    if (row < M) { d1 = DEST[2 * row]; d2 = DEST[2 * row + 1]; g1 = TOKG[2 * row]; g2 = TOKG[2 * row + 1]; }
#define LD_YROW(dst, d_) do { if ((d_) < pg8::TAIL_PM0 * 256) load_row_b(dst, YS + (size_t)(d_) * D, lane); else { const bf16* pb_ = PARTB + (size_t)((d_) - pg8::TAIL_PM0 * 256) * D; \
          \
        _Pragma("unroll") for (int hb_ = 0; hb_ < 2; ++hb_) { v2u r_[4][8]; \
            _Pragma("unroll") for (int q_ = 0; q_ < 4; ++q_) _Pragma("unroll") for (int j = 0; j < 8; ++j) r_[q_][j] = *(const GAS v2u*)(pb_ + (size_t)(4 * hb_ + q_) * pg8::TAIL_ROWS * D + 256 * j + 4 * lane); \
            _Pragma("unroll") for (int q_ = 0; q_ < 4; ++q_) _Pragma("unroll") for (int j = 0; j < 8; ++j) { const f32x4 t_ = (f32x4){bflo(r_[q_][j].x), bfhi(r_[q_][j].x), bflo(r_[q_][j].y), bfhi(r_[q_][j].y)}; \
                dst[j] = (hb_ == 0 && q_ == 0) ? t_ : dst[j] + t_; } } } } while (0)
    for (; row < M; row += NGW) {
        load_row_b(v, XBin + (size_t)row * D, lane); LD_YROW(y1, d1); LD_YROW(y2, d2);
        const float cg1 = g1, cg2 = g2; const int rn = row + NGW;
        if (rn < M) { d1 = DEST[2 * rn]; d2 = DEST[2 * rn + 1]; g1 = TOKG[2 * rn]; g2 = TOKG[2 * rn + 1]; }
#pragma unroll
        for (int j = 0; j < 8; ++j) v[j] = v[j] * ALPHA + y1[j] * cg1 + y2[j] * cg2;
        ln_row_regs(v, af, lane); store_row_b(v, XBout + (size_t)row * D, lane); }
#undef LD_YROW
}

__device__ __forceinline__ void na_phase_simple(const Frame& F, const Args& A) {
    const int lane = lane_now(), tid = F.wave * 64 + lane; (void)tid;
    const int gw = blockIdx.x * NWAVES + F.wave, NGW = F.G * NWAVES;
    const bf16* QKV = (const bf16*)(A.ws + WS_QKV); bf16* AO = (bf16*)(A.ws + WS_AO); const float* rpb = A.in[I_RPB];
    const float scale = 0.08838834764831845f;
    for (int task = gw; task < M * 16; task += NGW) {
        const int tok = task >> 4, h = task & 15, b = tok >> 12, r = (tok >> 6) & 63, c = tok & 63;
        const int rs = min(max(r - 4, 0), 56), cs = min(max(c - 8, 0), 48);
        const GAS v4u* qp = (const GAS v4u*)(QKV + (size_t)tok * NQKV + h * 128);
        float sc[2];
#pragma unroll
        for (int i = 0; i < 2; ++i) { const int kk = lane + 64 * i, jr = kk >> 4, jc = kk & 15; const int ktok = b * T + (rs + jr) * 64 + cs + jc;
            const GAS v4u* kp = (const GAS v4u*)(QKV + (size_t)ktok * NQKV + D + h * 128); float acc = 0.f;
#pragma unroll 4
            for (int j = 0; j < 16; ++j) { const v4u q = qp[j], k = kp[j];
                acc += bflo(q.x) * bflo(k.x) + bfhi(q.x) * bfhi(k.x) + bflo(q.y) * bflo(k.y) + bfhi(q.y) * bfhi(k.y) + bflo(q.z) * bflo(k.z) + bfhi(q.z) * bfhi(k.z) + bflo(q.w) * bflo(k.w) + bfhi(q.w) * bfhi(k.w); }
            sc[i] = acc * scale + rpb[(h * 15 + (rs + jr - r + 7)) * 31 + (cs + jc - c + 15)]; }
        const float mx = wave_max(fmaxf(sc[0], sc[1]));
        const float p0 = __expf(sc[0] - mx), p1 = __expf(sc[1] - mx);
        const float inv = 1.0f / wave_sum(p0 + p1);
        float a0 = 0.f, a1 = 0.f;
        const bf16* vbase = QKV + 2 * D + h * 128 + 2 * lane;
#pragma unroll
        for (int i = 0; i < 2; ++i) { const float pi = i ? p1 : p0;
#pragma unroll 8
            for (int l = 0; l < 64; ++l) { const int kk = l + 64 * i, jr = kk >> 4, jc = kk & 15; const int ktok = b * T + (rs + jr) * 64 + cs + jc;
                const float pk = __builtin_bit_cast(float, __builtin_amdgcn_readlane(__builtin_bit_cast(int, pi), l));
                const unsigned vv = *(const GAS unsigned*)(vbase + (size_t)ktok * NQKV); a0 += pk * bflo(vv); a1 += pk * bfhi(vv); } }
        *(GAS unsigned*)(AO + (size_t)tok * D + h * 128 + 2 * lane) = pk2(a0 * inv, a1 * inv);
    }
}
constexpr int NA_VP = 288, NA_KP = 272;
__device__ __forceinline__ void na_phase_mfma(const Frame& F, const Args& A) {
    const int lane = lane_now(), tid = F.wave * 64 + lane, i = lane & 15, fq = lane >> 4;
    const bf16* QKV = (const bf16*)(A.ws + WS_QKV); bf16* AO = (bf16*)(A.ws + WS_AO); const float* rpb = A.in[I_RPB];
    LAS unsigned char* vl = F.lds + RING_OFF;
    LAS float* rp = (LAS float*)(F.lds + RING_OFF + 5 * 64 * NA_VP);
    const int qsel = F.wave >> 2, qi = F.wave & 3, wc = min(max(16 * qi - 8, 0), 32);
    const int qc = 16 * qi + i, cs = min(max(qc - 8, 0), 48);
    const float scale = 0.08838834764831845f;
    const int q4 = (lane & 15) >> 2, p4 = lane & 3;
    v4u vreg[10];
#define NA_LOAD(NR, row0, moff, tokb_, h_) do { _Pragma("unroll") for (int k = 0; k < 2 * (NR); ++k) { const int ch = tid + 512 * k, row = ch >> 10, key = (ch >> 4) & 63, c16 = ch & 15; const int vr = min((row0) + row, 63); \
        vreg[k] = *(const GAS v4u*)(QKV + (size_t)(moff) * ((size_t)M * D) + ((tokb_) + vr * 64 + key) * 128 + c16 * 8); } } while (0)
#define NA_STORE(NR, pitch) do { _Pragma("unroll") for (int k = 0; k < 2 * (NR); ++k) { const int ch = tid + 512 * k, row = ch >> 10, key = (ch >> 4) & 63, c16 = ch & 15; *(LAS v4u*)(vl + (row * 64 + key) * (pitch) + c16 * 16) = vreg[k]; } } while (0)
    const int upw = (64 * 32 + F.G - 1) / F.G; int unit = blockIdx.x * upw; const int unit_end = min(unit + upw, 64 * 32);
    if (unit < 64 * 32) { const int rpi = unit & 31, bh = unit >> 5, h = bh & 15, b = bh >> 4; const int R0 = min(max(2 * rpi - 4, 0), 56); NA_LOAD(5, R0, 1, (size_t)(b * 16 + h) * T, h); }
    int hprev = -1;
    for (; unit < unit_end; unit += 1) {
        const int rpi = unit & 31, bh = unit >> 5, h = bh & 15, b = bh >> 4;
        const int r0 = 2 * rpi, qrow = r0 + qsel, R0 = min(max(r0 - 4, 0), 56), rsw = min(max(qrow - 4, 0), 56);
        const size_t tokb = (size_t)b * T, hrow = (size_t)(b * 16 + h) * T;
        bf16x8 bq[4];
        { const bf16* qp = QKV + (hrow + qrow * 64 + qc) * 128 + 8 * fq;
#pragma unroll
          for (int kk = 0; kk < 4; ++kk) bq[kk] = *(const GAS bf16x8*)(qp + 32 * kk); }
        __syncthreads();
        if (h != hprev) { if (tid < 465) rp[tid] = rpb[h * 465 + tid]; hprev = h; }
        NA_STORE(5, NA_KP); NA_LOAD(4, R0 + 5, 1, hrow, h);
        __syncthreads();
        f32x4 acc[16];
#pragma unroll
        for (int kt = 0; kt < 16; ++kt) acc[kt] = (f32x4){0.f, 0.f, 0.f, 0.f};
        LAS unsigned char* kb0 = vl + (wc + i) * NA_KP + 16 * fq;
#pragma unroll
        for (int jr = 0; jr < 8; ++jr) { const int la = rsw + jr - R0;
            if (la <= 4) { LAS unsigned char* kp = kb0 + la * 64 * NA_KP;
                bf16x8 ka[2][4];
#pragma unroll
                for (int kb2 = 0; kb2 < 2; ++kb2)
#pragma unroll
                    for (int kk = 0; kk < 4; ++kk) ka[kb2][kk] = *(const LAS bf16x8*)(kp + 16 * kb2 * NA_KP + 64 * kk);
#pragma unroll
                for (int kb2 = 0; kb2 < 2; ++kb2)
#pragma unroll
                    for (int kk = 0; kk < 4; ++kk) acc[2 * jr + kb2] = __builtin_amdgcn_mfma_f32_16x16x32_bf16(ka[kb2][kk], bq[kk], acc[2 * jr + kb2], 0, 0, 0); } }
        __syncthreads();
        NA_STORE(4, NA_KP); NA_LOAD(5, R0, 2, hrow, h);
        __syncthreads();
#pragma unroll
        for (int jr = 0; jr < 8; ++jr) { const int la = rsw + jr - R0 - 5;
            if (la >= 0) { LAS unsigned char* kp = kb0 + la * 64 * NA_KP;
                bf16x8 ka[2][4];
#pragma unroll
                for (int kb2 = 0; kb2 < 2; ++kb2)
#pragma unroll
                    for (int kk = 0; kk < 4; ++kk) ka[kb2][kk] = *(const LAS bf16x8*)(kp + 16 * kb2 * NA_KP + 64 * kk);
#pragma unroll
                for (int kb2 = 0; kb2 < 2; ++kb2)
#pragma unroll
                    for (int kk = 0; kk < 4; ++kk) acc[2 * jr + kb2] = __builtin_amdgcn_mfma_f32_16x16x32_bf16(ka[kb2][kk], bq[kk], acc[2 * jr + kb2], 0, 0, 0); } }
        float mx = -3.0e38f;
#pragma unroll
        for (int kt = 0; kt < 16; ++kt) { const int jr = kt >> 1, kb2 = kt & 1; const int dr = rsw + jr - qrow + 7;
#pragma unroll
            for (int r = 0; r < 4; ++r) { const int kc = wc + 16 * kb2 + 4 * fq + r; const int dc = min(max(kc - qc + 15, 0), 30); const bool ok = (kc >= cs) && (kc < cs + 16);
                const float s = ok ? acc[kt][r] * scale + rp[dr * 31 + dc] : -3.0e38f; acc[kt][r] = s; mx = fmaxf(mx, s); } }
        mx = fmaxf(mx, __shfl_xor(mx, 16)); mx = fmaxf(mx, __shfl_xor(mx, 32));
        float sum = 0.f;
#pragma unroll
        for (int kt = 0; kt < 16; ++kt)
#pragma unroll
            for (int r = 0; r < 4; ++r) { const float p = __expf(acc[kt][r] - mx); acc[kt][r] = p; sum += p; }
        sum += __shfl_xor(sum, 16); sum += __shfl_xor(sum, 32);
        const float inv = 1.0f / sum;
        bf16x8 pb[8];
#pragma unroll
        for (int ks = 0; ks < 8; ++ks) { v4u w; w.x = cvtpk(acc[2 * ks][0], acc[2 * ks][1]); w.y = cvtpk(acc[2 * ks][2], acc[2 * ks][3]); w.z = cvtpk(acc[2 * ks + 1][0], acc[2 * ks + 1][1]); w.w = cvtpk(acc[2 * ks + 1][2], acc[2 * ks + 1][3]);
            pb[ks] = __builtin_bit_cast(bf16x8, w); }
        __syncthreads();
        NA_STORE(5, NA_VP); NA_LOAD(4, R0 + 5, 2, hrow, h);
        __syncthreads();
        f32x4 o[8];
#pragma unroll
        for (int db = 0; db < 8; ++db) o[db] = (f32x4){0.f, 0.f, 0.f, 0.f};
        LAS unsigned char* vb0 = vl + (wc + 4 * fq + q4) * NA_VP + 8 * p4;
#pragma unroll
        for (int jr = 0; jr < 8; ++jr) { const int la = rsw + jr - R0;
            if (la <= 4) { LAS unsigned char* vp = vb0 + la * 64 * NA_VP;
                s16x4 x0[8], x1[8];
#pragma unroll
                for (int db = 0; db < 8; ++db) { x0[db] = lds_tr(vp + 32 * db); x1[db] = lds_tr(vp + 16 * NA_VP + 32 * db); }
#pragma unroll
                for (int db = 0; db < 8; ++db) { const bf16x8 a = (bf16x8){x0[db][0], x0[db][1], x0[db][2], x0[db][3], x1[db][0], x1[db][1], x1[db][2], x1[db][3]};
                    o[db] = __builtin_amdgcn_mfma_f32_16x16x32_bf16(a, pb[jr], o[db], 0, 0, 0); } } }
        __syncthreads();
        NA_STORE(4, NA_VP);
        { const int un = unit + 1; if (un < unit_end) { const int rpn = un & 31, bhn = un >> 5, hn = bhn & 15, bn = bhn >> 4; const int R0n = min(max(2 * rpn - 4, 0), 56); NA_LOAD(5, R0n, 1, (size_t)(bn * 16 + hn) * T, hn); } }
        __syncthreads();
#pragma unroll
        for (int jr = 0; jr < 8; ++jr) { const int la = rsw + jr - R0 - 5;
            if (la >= 0) { LAS unsigned char* vp = vb0 + la * 64 * NA_VP;
                s16x4 x0[8], x1[8];
#pragma unroll
                for (int db = 0; db < 8; ++db) { x0[db] = lds_tr(vp + 32 * db); x1[db] = lds_tr(vp + 16 * NA_VP + 32 * db); }
#pragma unroll
                for (int db = 0; db < 8; ++db) { const bf16x8 a = (bf16x8){x0[db][0], x0[db][1], x0[db][2], x0[db][3], x1[db][0], x1[db][1], x1[db][2], x1[db][3]};
                    o[db] = __builtin_amdgcn_mfma_f32_16x16x32_bf16(a, pb[jr], o[db], 0, 0, 0); } } }
        const int orow = (int)(tokb + qrow * 64 + qc);
#pragma unroll
        for (int db = 0; db < 8; ++db) { v2u w; w.x = cvtpk(o[db][0] * inv, o[db][1] * inv); w.y = cvtpk(o[db][2] * inv, o[db][3] * inv); *(GAS v2u*)AT(AO, orow, h * 128 + 16 * db + 4 * fq, D) = w; }
    }
#undef NA_LOAD
#undef NA_STORE
    __syncthreads();
}
__device__ __forceinline__ float wave_scan_incl(float v, int lane) {
#pragma unroll
    for (int off = 1; off < 64; off <<= 1) { const float t = __shfl_up(v, off); if (lane >= off) v += t; }
    return v;
}
__device__ __forceinline__ void rec_prep(const Frame& F, const Args& A) {
    const int lane = lane_now(); const int gw = blockIdx.x * NWAVES + F.wave, NGW = F.G * NWAVES;
    const bf16* U = (const bf16*)(A.ws + WS_U); const float* Gt = (const float*)(A.ws + WS_G);
    bf16* QIN = (bf16*)(A.ws + WS_QIN); bf16* KIN = (bf16*)(A.ws + WS_KIN); float* GTAB = (float*)(A.ws + WS_GTAB);
    float* EQM = (float*)(A.ws + WS_EQM); float* EKM = (float*)(A.ws + WS_EKM); float* GTABM = (float*)(A.ws + WS_GTABM);
    for (int item = gw; item < 2048; item += NGW) {
        const int c = item & 63, dir = (item >> 6) & 1, h = (item >> 7) & 3, b = item >> 9;
        const size_t tk = (size_t)b * T + (dir ? (T - 1 - (64 * c + lane)) : (64 * c + lane));
        const float bias_i = A.in[I_GBIAS][(dir ? 2 : 0) * 4 + h], bias_f = A.in[I_GBIAS][(dir ? 3 : 1) * 4 + h];
        const float gi = GATE_CAP * tanhf((Gt[tk * 16 + (dir ? 2 : 0) * 4 + h] + bias_i) * (1.0f / GATE_CAP)), gf = GATE_CAP * tanhf((Gt[tk * 16 + (dir ? 3 : 1) * 4 + h] + bias_f) * (1.0f / GATE_CAP));
        const float lf = -log1pf(__expf(-gf)); const float bb = wave_scan_incl(lf, lane);
        const float gg = __builtin_bit_cast(float, __builtin_amdgcn_readlane(__builtin_bit_cast(int, bb), 63));
        const float eq = 0.08838834764831845f * __expf(bb), ek = __expf(gi - bb);
        GTABM[(size_t)item * 128 + lane] = gg; GTABM[(size_t)item * 128 + 64 + lane] = gg;
        EQM[(size_t)item * 64 + lane] = eq; EKM[(size_t)item * 64 + lane] = ek;
    }
    for (int item = gw; item < 4096; item += NGW) {
        const int c = item & 63, dir = (item >> 6) & 1, h = (item >> 7) & 7, b = item >> 10;
        const int ch = h * 128 + 2 * lane;
        const float l00 = A.in[I_LBLOG][(dir * 2 + 0) * 1024 + ch], l01 = A.in[I_LBLOG][(dir * 2 + 1) * 1024 + ch], l10 = A.in[I_LBLOG][(dir * 2 + 0) * 1024 + ch + 1], l11 = A.in[I_LBLOG][(dir * 2 + 1) * 1024 + ch + 1];
        const float lb0 = 1.0f / (1.0f + __expf(l01 - l00)), lb1 = 1.0f / (1.0f + __expf(l11 - l10));
        float pr0 = 1.f, pr1 = 1.f;
        for (int tb = 0; tb < 64; tb += 16) {
            unsigned qw[16], fw[16];
#pragma unroll
            for (int u = 0; u < 16; ++u) { const int tau = tb + u; const size_t tk = (size_t)b * T + (dir ? (T - 1 - (64 * c + tau)) : (64 * c + tau));
                qw[u] = *(const GAS unsigned*)(U + tk * UW + U_QB + ch); fw[u] = *(const GAS unsigned*)(U + tk * UW + (dir ? U_FB : U_FF) + ch); }
#pragma unroll
            for (int u = 0; u < 16; ++u) { const int tau = tb + u; const int tl = dir ? (T - 1 - (64 * c + tau)) : (64 * c + tau);
                const float q0 = bflo(qw[u]), q1 = bfhi(qw[u]);
                const float f0 = lb0 + (1.0f - lb0) * sigm(bflo(fw[u])), f1 = lb1 + (1.0f - lb1) * sigm(bfhi(fw[u]));
                pr0 *= f0; pr1 *= f1;
                const size_t o = ((size_t)(((dir * 4 + b) * 8 + h)) * T + tl) * 128 + 2 * lane;
                *(GAS unsigned*)(QIN + o) = cvtpk(q0 * sigm(q0) * pr0, q1 * sigm(q1) * pr1);
                *(GAS unsigned*)(KIN + o) = cvtpk((1.0f - f0) * __builtin_amdgcn_rcpf(pr0), (1.0f - f1) * __builtin_amdgcn_rcpf(pr1)); }
        }
        *(GAS f32x2*)(GTAB + (size_t)item * 128 + 2 * lane) = (f32x2){__logf(pr0), __logf(pr1)};
    }
}

__device__ __forceinline__ void gates_mfma(const Frame& F, const Args& A) {
    const int lane = lane_now(), i = lane & 15, fq = lane >> 4; const int gw = blockIdx.x * NWAVES + F.wave, NGW = F.G * NWAVES;
    const bf16* X = (const bf16*)(A.ws + WS_XB0); const bf16* Wg = (const bf16*)(A.ws + WS_WGATE);
    float* Gt = (float*)(A.ws + WS_G);
    for (int blk = gw; blk < M / 16; blk += NGW) {
        const bf16* wp = Wg + (size_t)i * D + 8 * fq; const int xrow = 16 * blk + i;
        f32x4 acc0 = (f32x4){0.f, 0.f, 0.f, 0.f}, acc1 = (f32x4){0.f, 0.f, 0.f, 0.f};
#pragma unroll 4
        for (int kk = 0; kk < D / 32; kk += 2) {
            const bf16x8 a0 = *(const GAS bf16x8*)(wp + 32 * kk), b0 = *(const GAS bf16x8*)(X + (size_t)xrow * D + 32 * kk + 8 * fq), a1 = *(const GAS bf16x8*)(wp + 32 * kk + 32), b1 = *(const GAS bf16x8*)(X + (size_t)xrow * D + 32 * kk + 32 + 8 * fq);
            acc0 = __builtin_amdgcn_mfma_f32_16x16x32_bf16(a0, b0, acc0, 0, 0, 0); acc1 = __builtin_amdgcn_mfma_f32_16x16x32_bf16(a1, b1, acc1, 0, 0, 0);
        }
        *(GAS f32x4*)(Gt + (size_t)(16 * blk + i) * 16 + 4 * fq) = acc0 + acc1;
    }
}
constexpr int RQ_P = 272;
template <int NEB> struct RecMap {
    static constexpr int VP = NEB * 32 + 8, Q = 0, K = 17408, V = 34816, TB = V + 64 * VP, EQ = TB + 512, PAR = EQ + 256, SB = 2 * PAR, SBSZ = 128 * VP;
    static_assert(TB % 16 == 0 && PAR % 16 == 0 && SB + 2 * SBSZ <= RING_BYTES, "recurrence LDS map");
};
struct RecP { const bf16* qin; const bf16* kin;
              const bf16* vsrc;
              const float* gtab;
              bf16* out;
              int b, dir;
              int qs;
              const float* eq; const float* ek; };

template <int NEB>
__device__ __forceinline__ void rec_compute(int wave, int lane, LAS unsigned char* P, LAS unsigned char* SBc, LAS unsigned char* SBn, f32x4 (&Sst)[NEB][2], bf16* outrow  ) {
    typedef RecMap<NEB> Mp;
    const int i = lane & 15, fq = lane >> 4, q4 = i >> 2, p4 = lane & 3;
#define RC_TR2(dst, ptr, step) do { const s16x4 x0_ = lds_tr(ptr), x1_ = lds_tr((ptr) + (step)); dst = (bf16x8){x0_[0], x0_[1], x0_[2], x0_[3], x1_[0], x1_[1], x1_[2], x1_[3]}; } while (0)
    if (wave < 4) {
        __builtin_amdgcn_s_setprio(2);
        const int tbk = wave;
        bf16x8 qf[4], sf[4][NEB], kf[4][4], vf[2][NEB];
#pragma unroll
        for (int kk = 0; kk < 4; ++kk) qf[kk] = *(const LAS bf16x8*)(P + Mp::Q + (16 * tbk + i) * RQ_P + (32 * kk + 8 * fq) * 2);
#pragma unroll
        for (int kk = 0; kk < 4; ++kk)
#pragma unroll
            for (int eb = 0; eb < NEB; ++eb) RC_TR2(sf[kk][eb], SBc + (32 * kk + 8 * fq + q4) * Mp::VP + (16 * eb + 4 * p4) * 2, 4 * Mp::VP);
#pragma unroll
        for (int sb = 0; sb < 2; ++sb) if (sb <= tbk) {
#pragma unroll
            for (int kk = 0; kk < 4; ++kk) kf[sb][kk] = *(const LAS bf16x8*)(P + Mp::K + (16 * sb + i) * RQ_P + (32 * kk + 8 * fq) * 2); }
        f32x4 o[NEB];
#pragma unroll
        for (int eb = 0; eb < NEB; ++eb) o[eb] = (f32x4){0.f, 0.f, 0.f, 0.f};
#pragma unroll
        for (int kk = 0; kk < 4; ++kk)
#pragma unroll
            for (int eb = 0; eb < NEB; ++eb) o[eb] = __builtin_amdgcn_mfma_f32_16x16x32_bf16(sf[kk][eb], qf[kk], o[eb], 0, 0, 0);
        asm volatile("" ::: "memory");
#pragma unroll
        for (int sb = 2; sb < 4; ++sb) if (sb <= tbk) {
#pragma unroll
            for (int kk = 0; kk < 4; ++kk) kf[sb][kk] = *(const LAS bf16x8*)(P + Mp::K + (16 * sb + i) * RQ_P + (32 * kk + 8 * fq) * 2); }
#pragma unroll
        for (int ks = 0; ks < 2; ++ks) if (2 * ks <= tbk) {
#pragma unroll
            for (int eb = 0; eb < NEB; ++eb) RC_TR2(vf[ks][eb], P + Mp::V + (32 * ks + 4 * fq + q4) * Mp::VP + (16 * eb + 4 * p4) * 2, 16 * Mp::VP); }
        f32x4 pt[4];
#pragma unroll
        for (int sb = 0; sb < 4; ++sb) { pt[sb] = (f32x4){0.f, 0.f, 0.f, 0.f};
            if (sb <= tbk) { f32x4 acc = (f32x4){0.f, 0.f, 0.f, 0.f};
#pragma unroll
                for (int kk = 0; kk < 4; ++kk) acc = __builtin_amdgcn_mfma_f32_16x16x32_bf16(kf[sb][kk], qf[kk], acc, 0, 0, 0);
#pragma unroll
                for (int r = 0; r < 4; ++r) { const bool ok = (sb < tbk) || (4 * fq + r <= i); pt[sb][r] = ok ? acc[r] : 0.f; } } }
#pragma unroll
        for (int ks = 0; ks < 2; ++ks) if (2 * ks <= tbk) {
            v4u w; w.x = cvtpk(pt[2 * ks][0], pt[2 * ks][1]); w.y = cvtpk(pt[2 * ks][2], pt[2 * ks][3]); w.z = cvtpk(pt[2 * ks + 1][0], pt[2 * ks + 1][1]); w.w = cvtpk(pt[2 * ks + 1][2], pt[2 * ks + 1][3]);
            const bf16x8 pf = __builtin_bit_cast(bf16x8, w);
#pragma unroll
            for (int eb = 0; eb < NEB; ++eb) o[eb] = __builtin_amdgcn_mfma_f32_16x16x32_bf16(vf[ks][eb], pf, o[eb], 0, 0, 0); }
        bf16* hp = outrow + 4 * fq; float rden = 1.0f;
        if (NEB == 3) { const float eqt = ((const LAS float*)(P + Mp::EQ))[16 * tbk + i]; const float den = __shfl(o[NEB - 1][0], i) * eqt; rden = __builtin_amdgcn_rcpf(fmaxf(fabsf(den), 1.0f)) * eqt; }
        { v2u w; w.x = cvtpk(o[0][0] * rden, o[0][1] * rden); w.y = cvtpk(o[0][2] * rden, o[0][3] * rden); *(GAS v2u*)(hp) = w; w.x = cvtpk(o[1][0] * rden, o[1][1] * rden); w.y = cvtpk(o[1][2] * rden, o[1][3] * rden); *(GAS v2u*)(hp + 16) = w; }
        __builtin_amdgcn_s_setprio(0);
    } else {
        const int wq = wave - 4;
        bf16x8 af[2][NEB], bfr[2][2];
#pragma unroll
        for (int ks = 0; ks < 2; ++ks) {
#pragma unroll
            for (int eb = 0; eb < NEB; ++eb) RC_TR2(af[ks][eb], P + Mp::V + (32 * ks + 8 * fq + q4) * Mp::VP + (16 * eb + 4 * p4) * 2, 4 * Mp::VP);
#pragma unroll
            for (int dbi = 0; dbi < 2; ++dbi) RC_TR2(bfr[ks][dbi], P + Mp::K + (32 * ks + 8 * fq + q4) * RQ_P + (16 * (2 * wq + dbi) + 4 * p4) * 2, 4 * RQ_P); }
        float eg[2];
#pragma unroll
        for (int dbi = 0; dbi < 2; ++dbi) eg[dbi] = __expf(((const LAS float*)(P + Mp::TB))[16 * (2 * wq + dbi) + i]);
#pragma unroll
        for (int ks = 0; ks < 2; ++ks)
#pragma unroll
            for (int eb = 0; eb < NEB; ++eb)
#pragma unroll
                for (int dbi = 0; dbi < 2; ++dbi) Sst[eb][dbi] = __builtin_amdgcn_mfma_f32_16x16x32_bf16(af[ks][eb], bfr[ks][dbi], Sst[eb][dbi], 0, 0, 0);
#pragma unroll
        for (int dbi = 0; dbi < 2; ++dbi)
#pragma unroll
            for (int eb = 0; eb < NEB; ++eb) { Sst[eb][dbi] = Sst[eb][dbi] * eg[dbi]; v2u o; o.x = cvtpk(Sst[eb][dbi][0], Sst[eb][dbi][1]); o.y = cvtpk(Sst[eb][dbi][2], Sst[eb][dbi][3]);
                *(LAS v2u*)(SBn + (16 * (2 * wq + dbi) + i) * Mp::VP + (16 * eb + 4 * fq) * 2) = o; }
    }
#undef RC_TR2
}
template <int NEB>
__device__ __forceinline__ void rec_unit(const Frame& F, const RecP R) {
    typedef RecMap<NEB> Mp;
    const int lane = lane_now(), tid = F.wave * 64 + lane;
    LAS unsigned char* L = F.lds + RING_OFF;
    const int b = R.b, dir = R.dir;
#define RC_T(c, tau) (dir ? (T - 1 - (64 * (c) + (tau))) : (64 * (c) + (tau)))
#define RC_TOK(c, tau) ((size_t)b * T + RC_T(c, tau))
    for (int x = tid; x < Mp::SBSZ / 4; x += NWAVES * 64) ((LAS unsigned*)(L + Mp::SB))[x] = 0u;
    if (NEB == 3 && tid < 128) { LAS unsigned char* vr = L + (tid >> 6) * Mp::PAR + Mp::V + (tid & 63) * Mp::VP + 64;
        *(LAS unsigned short*)(vr + 2) = (unsigned short)0; *(LAS unsigned*)(vr + 4) = 0u; v2u o; o.x = 0u; o.y = 0u; *(LAS v2u*)(vr + 8) = o; *(LAS v2u*)(vr + 16) = o; *(LAS v2u*)(vr + 24) = o; }
    v4u rqA[2], rkA[2], rvA, rqB[2], rkB[2], rvB; float rgA, rgB, reA = 0.f, rsA = 0.f, reB = 0.f, rsB = 0.f;
#define RC_LOAD(cc, S) do { const int c_ = (cc) < T / 64 ? (cc) : T / 64 - 1; \
        _Pragma("unroll") for (int k = 0; k < 2; ++k) { const int ch = tid + 512 * k, row = ch >> 4, c16 = ch & 15; const size_t o = (size_t)RC_T(c_, row) * R.qs + c16 * 8; \
            rq##S[k] = *(const GAS v4u*)(R.qin + o); rk##S[k] = *(const GAS v4u*)(R.kin + o); } \
        rv##S = *(const GAS v4u*)(R.vsrc + (size_t)RC_T(c_, (tid & 255) >> 2) * 32 + (tid & 3) * 8); \
        rg##S = R.gtab[(size_t)c_ * 128 + (tid & 127)]; \
        if (NEB == 3) { re##S = R.eq[(size_t)c_ * 64 + (tid & 63)]; rs##S = R.ek[(size_t)c_ * 64 + ((tid & 255) >> 2)]; } } while (0)
#define RC_STAGE(par, S) do { LAS unsigned char* P = L + (par) * Mp::PAR; \
        _Pragma("unroll") for (int k = 0; k < 2; ++k) { const int ch = tid + 512 * k, row = ch >> 4, c16 = ch & 15; \
            *(LAS v4u*)(P + Mp::Q + row * RQ_P + c16 * 16) = rq##S[k]; *(LAS v4u*)(P + Mp::K + row * RQ_P + c16 * 16) = rk##S[k]; } \
        ((LAS float*)(P + Mp::TB))[tid & 127] = rg##S;     \
        if (NEB == 3) { const float sc_ = rs##S;       \
            rv##S.x = cvtpk(bflo(rv##S.x) * sc_, bfhi(rv##S.x) * sc_); rv##S.y = cvtpk(bflo(rv##S.y) * sc_, bfhi(rv##S.y) * sc_); rv##S.z = cvtpk(bflo(rv##S.z) * sc_, bfhi(rv##S.z) * sc_); rv##S.w = cvtpk(bflo(rv##S.w) * sc_, bfhi(rv##S.w) * sc_); \
            *(LAS unsigned short*)(P + Mp::V + ((tid & 255) >> 2) * Mp::VP + 64) = (unsigned short)(cvtpk(sc_, sc_) & 0xffffu); \
            ((LAS float*)(P + Mp::EQ))[tid & 63] = re##S; } \
        { v2u o; o.x = rv##S.x; o.y = rv##S.y; *(LAS v2u*)(P + Mp::V + ((tid & 255) >> 2) * Mp::VP + (tid & 3) * 16) = o; o.x = rv##S.z; o.y = rv##S.w; *(LAS v2u*)(P + Mp::V + ((tid & 255) >> 2) * Mp::VP + (tid & 3) * 16 + 8) = o; } } while (0)
    RC_LOAD(0, A);
    RC_STAGE(0, A);
    RC_LOAD(1, B);
    RC_LOAD(2, A);
    f32x4 Sst[NEB][2];
#pragma unroll
    for (int eb = 0; eb < NEB; ++eb)
#pragma unroll
        for (int dbi = 0; dbi < 2; ++dbi) Sst[eb][dbi] = (f32x4){0.f, 0.f, 0.f, 0.f};
    __syncthreads();
    LAS unsigned char* P0 = L; LAS unsigned char* P1 = L + Mp::PAR; LAS unsigned char* S0 = L + Mp::SB; LAS unsigned char* S1 = L + Mp::SB + Mp::SBSZ;
    const int orow = 16 * (F.wave & 3) + (lane & 15);
    for (int c = 0; c < T / 64; c += 2) {
        RC_STAGE(1, B); RC_LOAD(c + 3, B);
        rec_compute<NEB>(F.wave, lane, P0, S0, S1, Sst, R.out + RC_TOK(c, orow) * 1024);
        __syncthreads();
        RC_STAGE(0, A); RC_LOAD(c + 4, A);
        rec_compute<NEB>(F.wave, lane, P1, S1, S0, Sst, R.out + RC_TOK(c + 1, orow) * 1024);
        __syncthreads();
    }
#undef RC_LOAD
#undef RC_STAGE
#undef RC_TOK
#undef RC_T
}
__device__ __forceinline__ void mlstm_chunk_unit(const Frame& F, const Args& A, int unit) {
    const int es = unit & 7, dir = (unit >> 3) & 1, h = (unit >> 4) & 3, b = unit >> 6;
    RecP R; const size_t chain = (size_t)((dir * 4 + b) * 4 + h) * T * 128;
    (void)chain; const bf16* Ub = (const bf16*)(A.ws + WS_U) + (size_t)b * T * UW + h * 128;
    R.qin = Ub + U_QA; R.kin = Ub + U_KA; R.qs = UW;
    R.eq = (const float*)(A.ws + WS_EQM) + (size_t)(((b * 4 + h) * 2 + dir) * 64) * 64; R.ek = (const float*)(A.ws + WS_EKM) + (size_t)(((b * 4 + h) * 2 + dir) * 64) * 64;
    R.vsrc = (const bf16*)(A.ws + WS_VINM) + (size_t)(((b * 4 + h) * 8 + es)) * T * 32; R.gtab = (const float*)(A.ws + WS_GTABM) + (size_t)((((b * 4 + h) * 2 + dir) * 64)) * 128;
    R.out = (bf16*)(A.ws + WS_HA) + (size_t)dir * M * 1024 + h * 256 + es * 32; R.b = b; R.dir = dir;
    rec_unit<3>(F, R);
}
__device__ __forceinline__ void hgrn_chunk_unit(const Frame& F, const Args& A, int unit) {
    const int es = unit & 3, dir = (unit >> 2) & 1, h = (unit >> 3) & 7, b = unit >> 6;
    RecP R; const size_t chain = (size_t)((dir * 4 + b) * 8 + h) * T * 128;
    R.qin = (const bf16*)(A.ws + WS_QIN) + chain; R.kin = (const bf16*)(A.ws + WS_KIN) + chain; R.qs = 128; R.eq = nullptr; R.ek = nullptr;
    R.vsrc = (const bf16*)(A.ws + WS_VINH) + (size_t)(((b * 8 + h) * 4 + es)) * T * 32; R.gtab = (const float*)(A.ws + WS_GTAB) + (size_t)((((b * 8 + h) * 2 + dir) * 64)) * 128;
    R.out = (bf16*)(A.ws + WS_HB) + (size_t)dir * M * 1024 + h * 128 + es * 32; R.b = b; R.dir = dir;
    rec_unit<2>(F, R);
}
#ifndef MK_ONE_LAUNCH
#define MK_ONE_LAUNCH 1
#endif
constexpr int N_PHASES = 21;
__global__ void __launch_bounds__(NWAVES * 64, 2) trunk_fwd(Args args) {
    extern __shared__ __attribute__((aligned(16))) unsigned char lds[];
    Frame F;
    F.lds = (LAS unsigned char*)lds;
    F.wave = __builtin_amdgcn_readfirstlane(threadIdx.x >> 6);
    F.G = gridDim.x;
    const Args& A = args;
    { const int tid0 = F.wave * 64 + lane_now(); for (int u = tid0; u < (LDS_BYTES - LDSCTL_OFF) / 4; u += NWAVES * 64) ((LAS unsigned*)(F.lds + LDSCTL_OFF))[u] = 0u; }
    __syncthreads();
    gu32* ctl = (gu32*)(args.ws + WS_CTL);
    const int lo = args.ph_lo, hi = args.ph_hi;
    XcdBarrier bar; bar.bar = (unsigned*)(ctl + CW_BAR); bar.x = 0; bar.st = nullptr;
    if (hi - lo > 1) bar = xcd_barrier_post((unsigned*)(ctl + CW_BAR), (volatile LAS unsigned*)(F.lds + MISC_OFF) + 8, F.wave);
#ifndef PROBE_MASK
#define PROBE_MASK 0u
#endif
#define IN(k) (lo <= (k) && (k) < hi)
#define REP(k) _Pragma("unroll") for (int rep_ = 0; rep_ < (((PROBE_MASK >> (k)) & 1u) ? 2 : 1); ++rep_)
#define RSEAM(k) do { if (((PROBE_MASK >> (k)) & 1u) && rep_ == 0) xcd_barrier(bar, F.wave); } while (0)
#ifndef TPROBE
#define TPROBE (-1)
#endif
#ifndef TPROBE_US
#define TPROBE_US 1000.0f
#endif
    unsigned long long tp_a = (TPROBE == 0) ? __builtin_amdgcn_s_memrealtime() : 0ull, tp_b = 0ull;
#define SEAM(k) do { if (IN(k) && IN((k) + 1)) xcd_barrier(bar, F.wave); if ((k) == TPROBE) tp_b = __builtin_amdgcn_s_memrealtime(); if ((k) + 1 == TPROBE) tp_a = __builtin_amdgcn_s_memrealtime(); } while (0)
    unsigned char* ws = args.ws;
    bf16* XB0 = (bf16*)(ws + WS_XB0); bf16* XB1 = (bf16*)(ws + WS_XB1); bf16* TBUF = (bf16*)A.out;
    const int bid = (int)blockIdx.x;
    const int kple = (args.ph_hi > 0) ? PLE_DIM : 0;

    REP(0) if (IN(0)) { p0_prologue(F, A); RSEAM(0); } SEAM(0);
    REP(1) if (IN(1)) {
        pg8::Gemm g{XB0, (const bf16*)(ws + WS_WRIN), M, UW, D}; pg8::StaticOrder S; S.init(M, UW, F.G, bid);
        pg8::EpiRecIn E{(bf16*)(ws + WS_U), UW, (bf16*)(ws + WS_VINM), (bf16*)(ws + WS_VINH), T};
        pg8::gemm_phase<pg8::EpiRecIn, pg8::StaticOrder, true, true>(F.lds + RING_OFF, g, S, E, F.wave);
        gates_mfma(F, A);
    RSEAM(1); } SEAM(1);
    REP(2) if (IN(2)) { rec_prep(F, A); xcd_barrier(bar, F.wave);
        for (int v = bid; v < 256; v += F.G) { const int x = v & 7, j = v >> 3; mlstm_chunk_unit(F, A, ((x + 8 * (j >> 3)) << 3) | (j & 7)); }
        for (int v = bid; v < 256; v += F.G) { const int x = v & 7, j = v >> 3; hgrn_chunk_unit(F, A, ((x + 8 * (j >> 2)) << 2) | (j & 3)); } RSEAM(2); } SEAM(2);
    REP(3) if (IN(3)) { p3_finalize(F, A); RSEAM(3); } SEAM(3);
    REP(4) if (IN(4)) {
        pg8::Gemm g{(const bf16*)(ws + WS_Y), (const bf16*)(ws + WS_WROUT), M, D, D}; pg8::StaticOrder S; S.init(M, D, F.G, bid);
        pg8::EpiResB E{nullptr, XB0, TBUF, D, ALPHA};
        pg8::gemm_phase<pg8::EpiResB, pg8::StaticOrder, true, true, true>(F.lds + RING_OFF, g, S, E, F.wave);
    RSEAM(4); } SEAM(4);
    REP(5) if (IN(5)) { ln_phase_b(F, A, A.in[I_LNW] + 0 * D, A.in[I_LNB] + 0 * D, TBUF, XB1); RSEAM(5); } SEAM(5);
    REP(6) if (IN(6)) {
        pg8::Gemm g{XB1, (const bf16*)(ws + WS_WFGU), M, 2 * FFN, D}; pg8::StaticOrder S; S.init(M, 2 * FFN, F.G, bid);
        pg8::EpiSwiglu E{(bf16*)(ws + WS_H), FFN, 2 * FFN / 256};
        pg8::gemm_phase<pg8::EpiSwiglu, pg8::StaticOrder, true, true>(F.lds + RING_OFF, g, S, E, F.wave);
    RSEAM(6); } SEAM(6);
    REP(7) if (IN(7)) {
        { pg8::Gemm g{(const bf16*)(ws + WS_H), (const bf16*)(ws + WS_WFDN), M, D, FFN}; pg8::StaticOrder S; S.init(M, D, F.G, bid);
          pg8::EpiResB E{nullptr, XB1, TBUF, D, ALPHA};
          pg8::gemm_phase<pg8::EpiResB, pg8::StaticOrder, true, true, true>(F.lds + RING_OFF, g, S, E, F.wave); }
        { pg8::Gemm g{(const bf16*)(ws + WS_PB), (const bf16*)(ws + WS_WPP0), M, D, kple}; pg8::StaticOrder S; S.init(M, D, F.G, bid);
          pg8::EpiStoreB E{(bf16*)(ws + WS_PP), D, D / 256};
          pg8::gemm_phase<pg8::EpiStoreB, pg8::StaticOrder, true, true, true>(F.lds + RING_OFF, g, S, E, F.wave); }
    RSEAM(7); } SEAM(7);
    REP(8) if (IN(8)) { ln_phase_b(F, A, A.in[I_LNW] + 1 * D, A.in[I_LNB] + 1 * D, TBUF, XB0); RSEAM(8); } SEAM(8);
    REP(10) if (IN(10)) {
        pg8::Gemm g{XB0, (const bf16*)(ws + WS_WPG0), M, D, D}; pg8::StaticOrder S; S.init(M, D, F.G, bid);
        pg8::EpiPleB E{XB0, (const bf16*)(ws + WS_PP), XB1, nullptr, D};
        pg8::gemm_phase<pg8::EpiPleB, pg8::StaticOrder, true, true>(F.lds + RING_OFF, g, S, E, F.wave);
    RSEAM(10); } SEAM(10);
#ifdef SLEEP_PROBE_US
    { const unsigned long long t0 = __builtin_amdgcn_s_memrealtime(); while (__builtin_amdgcn_s_memrealtime() - t0 < (unsigned long long)(SLEEP_PROBE_US * 100)) __builtin_amdgcn_s_sleep(32); }
#endif
    REP(11) if (IN(11)) {
        pg8::Gemm g{XB1, (const bf16*)(ws + WS_WQKV), M, NQKV, D}; pg8::StaticOrder S; S.init(M, NQKV, F.G, bid);
        pg8::EpiQKVHeads E{(bf16*)(ws + WS_QKV), T, 16};
        pg8::gemm_phase<pg8::EpiQKVHeads, pg8::StaticOrder, true, true>(F.lds + RING_OFF, g, S, E, F.wave);
    RSEAM(11); } SEAM(11);
    REP(12) if (IN(12)) { na_phase_mfma(F, A); RSEAM(12); } SEAM(12);
    REP(13) if (IN(13)) {
        pg8::Gemm g{(const bf16*)(ws + WS_AO), (const bf16*)(ws + WS_WNAO), M, D, D}; pg8::StaticOrder S; S.init(M, D, F.G, bid);
        pg8::EpiResBF E{XB1, A.out, D, ALPHA};
        pg8::gemm_phase<pg8::EpiResBF, pg8::StaticOrder, true, true, true>(F.lds + RING_OFF, g, S, E, F.wave);
    RSEAM(13); } SEAM(13);
    REP(14) if (IN(14)) { ln_router_phase(F, A, A.in[I_LNW] + 2 * D, A.in[I_LNB] + 2 * D, XB0); RSEAM(14); } SEAM(14);
    REP(15) if (IN(15)) { moe_route_phase(F, A); RSEAM(15); } SEAM(15);
    REP(16) if (IN(16)) {
        const int* TILEE = (const int*)(ws + WS_TILEE); const int nrt = __builtin_amdgcn_readfirstlane(TILEE[0]);
        pg8::Gemm g{XB0, (const bf16*)(ws + WS_WMGU), nrt * 256, 2 * MOE, D}; g.Ainv = (const int*)(ws + WS_INV);
        pg8::MoeOrder S; S.base.init(nrt * 256, 2 * MOE, F.G, bid); S.tile_e = TILEE + 1; S.nN = 2 * MOE / 256;
        pg8::EpiSwiglu E{(bf16*)(ws + WS_HM), MOE, 2 * MOE / 256};
        pg8::gemm_phase<pg8::EpiSwiglu, pg8::MoeOrder, true, true, false, true>(F.lds + RING_OFF, g, S, E, F.wave);
    RSEAM(16); } SEAM(16);
    REP(17) if (IN(17)) {
        { const int* TILEE = (const int*)(ws + WS_TILEE); const int nrt = __builtin_amdgcn_readfirstlane(TILEE[0]);
          const int nra = nrt < pg8::TAIL_PM0 ? nrt : pg8::TAIL_PM0;
          { pg8::Gemm g{(const bf16*)(ws + WS_HM), (const bf16*)(ws + WS_WMDN), nra * 256, D, MOE}; pg8::MoeOrder S; S.base.init(nra * 256, D, F.G, bid); S.tile_e = TILEE + 1; S.nN = D / 256;
            pg8::EpiStoreB E{(bf16*)(ws + WS_YS), D, D / 256};
            pg8::gemm_phase<pg8::EpiStoreB, pg8::MoeOrder, true, true, true>(F.lds + RING_OFF, g, S, E, F.wave); }
          if (nrt > pg8::TAIL_PM0) {
            pg8::Gemm g{(const bf16*)(ws + WS_HM), (const bf16*)(ws + WS_WMDN), nrt * 256, D, MOE, MOE / pg8::TAIL_KS}; pg8::MoeTailOrder S{TILEE + 1, nrt - pg8::TAIL_PM0, F.G, bid, D / 256, MOE / pg8::TAIL_KS / 64};
            pg8::EpiStorePart E{(bf16*)(ws + WS_PART), D, D / 256, MOE / pg8::TAIL_KS / 64};
            pg8::gemm_phase<pg8::EpiStorePart, pg8::MoeTailOrder, true, true, true>(F.lds + RING_OFF, g, S, E, F.wave); } }
        { pg8::Gemm g{(const bf16*)(ws + WS_PB) + (size_t)M * PLE_DIM, (const bf16*)(ws + WS_WPP1), M, D, kple}; pg8::StaticOrder S; S.init(M, D, F.G, bid);
          pg8::EpiStoreB E{(bf16*)(ws + WS_PP1), D, D / 256};
          pg8::gemm_phase<pg8::EpiStoreB, pg8::StaticOrder, true, true, true>(F.lds + RING_OFF, g, S, E, F.wave); }
    RSEAM(17); } SEAM(17);
    REP(18) if (IN(18)) { ln_moe_phase(F, A, A.in[I_LNW] + 3 * D, A.in[I_LNB] + 3 * D, XB0, XB1); RSEAM(18); } SEAM(18);
    REP(20) if (IN(20)) {
        pg8::Gemm g{XB1, (const bf16*)(ws + WS_WPG1), M, D, D}; pg8::StaticOrder S; S.init(M, D, F.G, bid);
        pg8::EpiPleB E{XB1, (const bf16*)(ws + WS_PP1), nullptr, A.out, D};
        pg8::gemm_phase<pg8::EpiPleB, pg8::StaticOrder, true, true>(F.lds + RING_OFF, g, S, E, F.wave);
    }
    if (TPROBE >= 0) {
        if (TPROBE == 20) tp_b = __builtin_amdgcn_s_memrealtime();
        float* dl = (float*)(ctl + 64);
        if (bid == 0 && F.wave == 0 && lane_now() == 0) *dl = (float)(long long)(tp_b - tp_a) * 0.01f / TPROBE_US;
        xcd_barrier(bar, F.wave);
        const float sc = 1.0f + __hip_atomic_load(dl, __ATOMIC_RELAXED, __HIP_MEMORY_SCOPE_AGENT);
        const size_t gt = (size_t)blockIdx.x * (NWAVES * 64) + F.wave * 64 + lane_now(), NGT = (size_t)F.G * NWAVES * 64;
        for (size_t i = gt; i < (size_t)M * D / 4; i += NGT) { f32x4 v = ((GAS f32x4*)A.out)[i]; ((GAS f32x4*)A.out)[i] = v * sc; }
    }
#undef IN
#undef SEAM
}

extern "C" void kernel_launch(void* const* d_in, const int* in_sizes, int n_in, void* d_out, int out_size, void* d_ws, size_t ws_size, hipStream_t stream) {
    static int grid = 0;
    if (grid == 0) {
        if (n_in != 23 || in_sizes[0] != M * D || out_size != M * D || ws_size < WS_END) { fprintf(stderr, "kernel_launch: unexpected shapes (n_in %d, in0 %d, out %d, ws %zu, need %zu)\n", n_in, n_in > 0 ? in_sizes[0] : -1, out_size, ws_size, (size_t)WS_END); grid = -1; return; }
        int dev = 0, cus = 0, per_cu = 0;
        if (hipGetDevice(&dev) != hipSuccess || hipDeviceGetAttribute(&cus, hipDeviceAttributeMultiprocessorCount, dev) != hipSuccess) { grid = -1; return; }
        if (hipFuncSetAttribute((const void*)trunk_fwd, hipFuncAttributeMaxDynamicSharedMemorySize, LDS_BYTES) != hipSuccess) { fprintf(stderr, "kernel_launch: hipFuncSetAttribute failed\n"); grid = -1; return; }
        if (hipOccupancyMaxActiveBlocksPerMultiprocessor(&per_cu, (const void*)trunk_fwd, NWAVES * 64, LDS_BYTES) != hipSuccess || per_cu < 1) { fprintf(stderr, "kernel_launch: occupancy query reports %d\n", per_cu); }
        (void)hipGetLastError();
        grid = cus;
    }
    if (grid < 0) return;
    (void)hipMemsetAsync((char*)d_ws + WS_CTL, 0, CTL_ZERO_BYTES, stream);
    Args a{};
    for (int i = 0; i < 23; ++i) a.in[i] = (const float*)d_in[i];
    a.out = (float*)d_out; a.ws = (unsigned char*)d_ws;
#if MK_ONE_LAUNCH
    a.ph_lo = 0; a.ph_hi = N_PHASES;
    hipLaunchKernelGGL(trunk_fwd, dim3(grid), dim3(NWAVES * 64), LDS_BYTES, stream, a);
#else
    for (int ph = 0; ph < N_PHASES; ++ph) { a.ph_lo = ph; a.ph_hi = ph + 1; hipLaunchKernelGGL(trunk_fwd, dim3(grid), dim3(NWAVES * 64), LDS_BYTES, stream, a); }
#endif
}
```

```cpp
#include <hip/hip_runtime.h>
#include <cstdio>
#include <cstdint>
__device__ __forceinline__ int lane_now() { int l; asm volatile("v_mbcnt_lo_u32_b32 %0, -1, 0\n\tv_mbcnt_hi_u32_b32 %0, -1, %0" : "=v"(l)); return l; }
namespace pg8 {
#define PG8_LAS __attribute__((address_space(3)))
typedef unsigned short bf16_t;
typedef short bf16x8 __attribute__((ext_vector_type(8)));
typedef float f32x4 __attribute__((ext_vector_type(4)));
typedef unsigned u32x4 __attribute__((ext_vector_type(4)));
constexpr int BM = 256, BK = 64, HALF = 128, HTB = HALF * BK * 2  , STAGE_BYTES = 8 * HTB, NXCD = 8, WGM = 8;

__host__ __device__ __forceinline__ int lds_byte(int r, int c) { const int st = (r >> 4) * 2 + (c >> 5), rr = r & 15, cc = c & 31, ob = rr * 64 + cc * 2; return st * 1024 + (ob ^ (((ob >> 9) & 1) << 5)); }
__host__ __device__ __forceinline__ void stage_rc(int b, int& R, int& C) { const int st = b / 1024, sb = b % 1024, swz = sb ^ (((sb >> 9) & 1) << 5); R = (st >> 1) * 16 + swz / 64; C = (st & 1) * 32 + (swz % 64) / 2; }
__host__ __device__ __forceinline__ int perm32(int rho) { const int n = rho >> 4, i = rho & 15; return 8 * (i >> 2) + 4 * n + (i & 3); }

__host__ __device__ __forceinline__ size_t bt_tiled_off(int n, int k, int K) {
    const int pn = n >> 8, hf = (n >> 7) & 1, nr = n & 127, v = nr & 31;
    const int R = (nr & ~31) + 16 * ((v >> 2) & 1) + 4 * (v >> 3) + (v & 3);
    return ((size_t)((pn * 2 + hf) * (K / 64) + (k >> 6))) * 16384 + (size_t)lds_byte(R, k & 63);
}
__host__ __device__ __forceinline__ size_t at_tiled_off(int m, int k, int K) {
    return ((size_t)(((m >> 8) * 2 + ((m >> 7) & 1)) * (K >> 6) + (k >> 6))) * 16384 + (size_t)lds_byte(m & 127, k & 63);
}
struct Unit { int pm, pn, koff; };
struct Gemm { const bf16_t* A; const bf16_t* Bt; int M, N, K; int Kloop = 0; const int* Ainv = nullptr; };

struct StaticOrder {
    int nM, nN, nwg, G, c;
    __host__ __device__ void init(int M, int N, int G_, int c_) { nM = M / BM; nN = N / BM; nwg = nM * nN; G = G_; c = c_; }
    __host__ __device__ bool next(int i, Unit& u) const {
        const long L = (long)i * G + c; if (L >= nwg) return false;
        int wgid = (int)L; { const int q = nwg / NXCD, r = nwg % NXCD, xcd = wgid % NXCD, off = wgid / NXCD; wgid = (xcd < r ? xcd * (q + 1) : r * (q + 1) + (xcd - r) * q) + off; }
        const int nig = WGM * nN, gid = wgid / nig, fm = gid * WGM, gsz = (nM - fm) < WGM ? (nM - fm) : WGM;
        u.pm = fm + ((wgid % nig) % gsz); u.pn = (wgid % nig) / gsz; u.koff = 0; return true;
    }
    __device__ __forceinline__ void a_ready(const Unit&) const {}
    __device__ __forceinline__ void done(const Unit&) const {}
};

typedef float f32x2c_t __attribute__((ext_vector_type(2))); typedef __bf16 bf16x2c_t __attribute__((ext_vector_type(2)));
__device__ __forceinline__ unsigned cvt_pk_bf16(float lo, float hi) { f32x2c_t v = {lo, hi}; bf16x2c_t b = __builtin_convertvector(v, bf16x2c_t); return __builtin_bit_cast(unsigned, b); }
__device__ __forceinline__ float fsigmoid(float x) { return __builtin_amdgcn_rcpf(1.0f + __expf(-x)); }
__device__ __forceinline__ float fsilu(float x) { return x * fsigmoid(x); }


struct EpiBf16G {
    static constexpr bool PERM = true, AFTER_DRAIN = false;
    bf16_t* O; int ldc; int gate_pn; float* Gt;
    __device__ __forceinline__ void operator()(const f32x4 (&acc)[2][2][4][2], const Unit& u, int wr, int wc, int fr, int fq) const {
        const int row0 = u.pm * BM + wr * 64 + fr;
        if (u.pn == gate_pn) {
            if (wc == 0 && fq < 2) {
#pragma unroll
                for (int ai = 0; ai < 2; ++ai)
#pragma unroll
                    for (int m = 0; m < 4; ++m) { float* gp = Gt + (size_t)(row0 + ai * HALF + m * 16) * 16 + 8 * fq;
                        *(f32x4*)(gp) = acc[ai][0][m][0]; *(f32x4*)(gp + 4) = acc[ai][0][m][1]; }
            }
            return;
        }
        const int col0 = u.pn * BM + wc * 32 + 8 * fq;
#pragma unroll
        for (int ai = 0; ai < 2; ++ai)
#pragma unroll
            for (int m = 0; m < 4; ++m) { bf16_t* rowp = O + (size_t)(row0 + ai * HALF + m * 16) * ldc + col0;
#pragma unroll
                for (int bj = 0; bj < 2; ++bj) { const f32x4 v0 = acc[ai][bj][m][0], v1 = acc[ai][bj][m][1];
                    u32x4 w; w.x = cvt_pk_bf16(v0[0], v0[1]); w.y = cvt_pk_bf16(v0[2], v0[3]); w.z = cvt_pk_bf16(v1[0], v1[1]); w.w = cvt_pk_bf16(v1[2], v1[3]);
                    *(u32x4*)(rowp + bj * HALF) = w; } }
    }
};

struct EpiQKVHeads {
    static constexpr bool PERM = true, AFTER_DRAIN = false;
    bf16_t* O; int Tlen, nheads;
    __device__ __forceinline__ void operator()(const f32x4 (&acc)[2][2][4][2], const Unit& u, int wr, int wc, int fr, int fq) const {
        const int which = u.pn >> 3, hp = u.pn & 7;
        const int row0 = u.pm * BM + wr * 64 + fr; const int b = (u.pm * BM) / Tlen; const int t0 = row0 - b * Tlen;
#pragma unroll
        for (int bj = 0; bj < 2; ++bj) { bf16_t* hb = O + ((size_t)which * 4 * nheads + (size_t)b * nheads + (2 * hp + bj)) * (size_t)Tlen * 128 + wc * 32 + 8 * fq;
#pragma unroll
            for (int ai = 0; ai < 2; ++ai)
#pragma unroll
                for (int m = 0; m < 4; ++m) { const f32x4 v0 = acc[ai][bj][m][0], v1 = acc[ai][bj][m][1];
                    u32x4 w; w.x = cvt_pk_bf16(v0[0], v0[1]); w.y = cvt_pk_bf16(v0[2], v0[3]); w.z = cvt_pk_bf16(v1[0], v1[1]); w.w = cvt_pk_bf16(v1[2], v1[3]);
                    *(u32x4*)(hb + (size_t)(t0 + ai * HALF + m * 16) * 128) = w; } }
    }
};

struct EpiRecIn {
    static constexpr bool PERM = true, AFTER_DRAIN = false;
    bf16_t* O; int ldc; bf16_t* VM; bf16_t* VH; int Tlen;
    __device__ __forceinline__ void operator()(const f32x4 (&acc)[2][2][4][2], const Unit& u, int wr, int wc, int fr, int fq) const {
        const int row0 = u.pm * BM + wr * 64 + fr;
        const bool isvm = (u.pn >= 4 && u.pn < 8), isvh = (u.pn >= 24 && u.pn < 28);
        if (isvm || isvh) {
            const int b = (u.pm * BM) / Tlen; const int t0 = row0 - b * Tlen;
#pragma unroll
            for (int bj = 0; bj < 2; ++bj) {
                bf16_t* base = isvm ? VM + ((size_t)((b * 4 + (u.pn - 4)) * 8 + 4 * bj + wc)) * (size_t)Tlen * 32 + 8 * fq
                                    : VH + ((size_t)((b * 8 + 2 * (u.pn - 24) + bj) * 4 + wc)) * (size_t)Tlen * 32 + 8 * fq;
#pragma unroll
                for (int ai = 0; ai < 2; ++ai)
#pragma unroll
                    for (int m = 0; m < 4; ++m) { const f32x4 v0 = acc[ai][bj][m][0], v1 = acc[ai][bj][m][1];
                        u32x4 w; w.x = cvt_pk_bf16(v0[0], v0[1]); w.y = cvt_pk_bf16(v0[2], v0[3]); w.z = cvt_pk_bf16(v1[0], v1[1]); w.w = cvt_pk_bf16(v1[2], v1[3]);
                        *(u32x4*)(base + (size_t)(t0 + ai * HALF + m * 16) * 32) = w; } }
            return;
        }
        const int col0 = u.pn * BM + wc * 32 + 8 * fq;
#pragma unroll
        for (int ai = 0; ai < 2; ++ai)
#pragma unroll
            for (int m = 0; m < 4; ++m) { bf16_t* rowp = O + (size_t)(row0 + ai * HALF + m * 16) * ldc + col0;
#pragma unroll
                for (int bj = 0; bj < 2; ++bj) { const f32x4 v0 = acc[ai][bj][m][0], v1 = acc[ai][bj][m][1];
                    u32x4 w; w.x = cvt_pk_bf16(v0[0], v0[1]); w.y = cvt_pk_bf16(v0[2], v0[3]); w.z = cvt_pk_bf16(v1[0], v1[1]); w.w = cvt_pk_bf16(v1[2], v1[3]);
                    *(u32x4*)(rowp + bj * HALF) = w; } }
    }
};
struct EpiSwiglu {
    static constexpr bool PERM = true, AFTER_DRAIN = false;
    bf16_t* H; int ldh; int npn;
    __device__ __forceinline__ void operator()(const f32x4 (&acc)[2][2][4][2], const Unit& u, int wr, int wc, int fr, int fq) const {
        const int row0 = u.pm * BM + wr * 64 + fr; const int pl = u.pn % npn; const int col0 = pl * HALF + wc * 32 + 8 * fq;
#pragma unroll
        for (int ai = 0; ai < 2; ++ai)
#pragma unroll
            for (int m = 0; m < 4; ++m) { bf16_t* rowp = (bf16_t*)((unsigned char*)H + at_tiled_off(row0 + ai * HALF + m * 16, col0, ldh));
                const f32x4 g0 = acc[ai][0][m][0], g1 = acc[ai][0][m][1], u0 = acc[ai][1][m][0], u1 = acc[ai][1][m][1];
                float o[8];
#pragma unroll
                for (int i = 0; i < 4; ++i) { o[i] = fsilu(g0[i]) * u0[i]; o[4 + i] = fsilu(g1[i]) * u1[i]; }
                u32x4 w; w.x = cvt_pk_bf16(o[0], o[1]); w.y = cvt_pk_bf16(o[2], o[3]); w.z = cvt_pk_bf16(o[4], o[5]); w.w = cvt_pk_bf16(o[6], o[7]);
                *(u32x4*)rowp = w; }
    }
};
struct EpiResF32 {
    static constexpr bool PERM = true, AFTER_DRAIN = false;
    const float* SRC; float* DST; int ldc; float alpha;
    __device__ __forceinline__ void operator()(const f32x4 (&acc)[2][2][4][2], const Unit& u, int wr, int wc, int fr, int fq) const {
        const int row0 = u.pm * BM + wr * 64 + fr; const int col0 = u.pn * BM + wc * 32 + 8 * fq;
#pragma unroll
        for (int ai = 0; ai < 2; ++ai)
#pragma unroll
            for (int m = 0; m < 4; ++m) { const size_t ro = (size_t)(row0 + ai * HALF + m * 16) * ldc + col0;
#pragma unroll
                for (int bj = 0; bj < 2; ++bj)
#pragma unroll
                    for (int n = 0; n < 2; ++n) { const size_t o = ro + bj * HALF + 4 * n; const f32x4 s = *(const f32x4*)(SRC + o); *(f32x4*)(DST + o) = s * alpha + acc[ai][bj][m][n]; } }
    }
};
struct EpiStoreF32 {
    static constexpr bool PERM = true, AFTER_DRAIN = false;
    float* O; int ldc; int npn;
    __device__ __forceinline__ void operator()(const f32x4 (&acc)[2][2][4][2], const Unit& u, int wr, int wc, int fr, int fq) const {
        const int row0 = u.pm * BM + wr * 64 + fr; const int col0 = (u.pn % npn) * BM + wc * 32 + 8 * fq;
#pragma unroll
        for (int ai = 0; ai < 2; ++ai)
#pragma unroll
            for (int m = 0; m < 4; ++m) { float* ro = O + (size_t)(row0 + ai * HALF + m * 16) * ldc + col0;
#pragma unroll
                for (int bj = 0; bj < 2; ++bj)
#pragma unroll
                    for (int n = 0; n < 2; ++n) *(f32x4*)(ro + bj * HALF + 4 * n) = acc[ai][bj][m][n]; }
    }
};
struct EpiPle {
    static constexpr bool PERM = true, AFTER_DRAIN = false;
    float* XF; const float* PP; bf16_t* XB; int ldc;
    __device__ __forceinline__ void operator()(const f32x4 (&acc)[2][2][4][2], const Unit& u, int wr, int wc, int fr, int fq) const {
        const int row0 = u.pm * BM + wr * 64 + fr; const int col0 = u.pn * BM + wc * 32 + 8 * fq;
#pragma unroll
        for (int ai = 0; ai < 2; ++ai)
#pragma unroll
            for (int m = 0; m < 4; ++m) { const size_t ro = (size_t)(row0 + ai * HALF + m * 16) * ldc + col0;
#pragma unroll
                for (int bj = 0; bj < 2; ++bj) { f32x4 o[2];
#pragma unroll
                    for (int n = 0; n < 2; ++n) { const size_t of = ro + bj * HALF + 4 * n; const f32x4 x = *(const f32x4*)(XF + of), pp = *(const f32x4*)(PP + of); const f32x4 a = acc[ai][bj][m][n];
                        f32x4 r; r[0] = x[0] + fsigmoid(a[0]) * pp[0]; r[1] = x[1] + fsigmoid(a[1]) * pp[1]; r[2] = x[2] + fsigmoid(a[2]) * pp[2]; r[3] = x[3] + fsigmoid(a[3]) * pp[3];
                        *(f32x4*)(XF + of) = r; o[n] = r; }
                    u32x4 w; w.x = cvt_pk_bf16(o[0][0], o[0][1]); w.y = cvt_pk_bf16(o[0][2], o[0][3]); w.z = cvt_pk_bf16(o[1][0], o[1][1]); w.w = cvt_pk_bf16(o[1][2], o[1][3]);
                    if (XB) *(u32x4*)(XB + ro + bj * HALF) = w; } }
    }
};

__device__ __forceinline__ float bf_lo(unsigned w) { return __builtin_bit_cast(float, w << 16); }
__device__ __forceinline__ float bf_hi(unsigned w) { return __builtin_bit_cast(float, w & 0xffff0000u); }
typedef unsigned u32x2 __attribute__((ext_vector_type(2)));
struct EpiResB {
    static constexpr bool PERM = true, AFTER_DRAIN = false;
    const float* SRCF_unused; const bf16_t* SRCB; bf16_t* DSTB; int ldc; float alpha;
    __device__ __forceinline__ void operator()(const f32x4 (&acc)[2][2][4][2], const Unit& u, int wr, int wc, int fr, int fq) const {
        const int row0 = u.pm * BM + wr * 64 + fr; const int col0 = u.pn * BM + wc * 32 + 8 * fq;
        u32x4 sv[2][4][2];
#pragma unroll
        for (int ai = 0; ai < 2; ++ai)
#pragma unroll
            for (int m = 0; m < 4; ++m)
#pragma unroll
                for (int bj = 0; bj < 2; ++bj) sv[ai][m][bj] = *(const u32x4*)(SRCB + (size_t)(row0 + ai * HALF + m * 16) * ldc + col0 + bj * HALF);
#pragma unroll
        for (int ai = 0; ai < 2; ++ai)
#pragma unroll
            for (int m = 0; m < 4; ++m)
#pragma unroll
                for (int bj = 0; bj < 2; ++bj) { const size_t o = (size_t)(row0 + ai * HALF + m * 16) * ldc + col0 + bj * HALF; const u32x4 w0 = sv[ai][m][bj];
                    const f32x4 s0 = (f32x4){bf_lo(w0.x), bf_hi(w0.x), bf_lo(w0.y), bf_hi(w0.y)}, s1 = (f32x4){bf_lo(w0.z), bf_hi(w0.z), bf_lo(w0.w), bf_hi(w0.w)};
                    const f32x4 v0 = s0 * alpha + acc[ai][bj][m][0], v1 = s1 * alpha + acc[ai][bj][m][1];
                    u32x4 w; w.x = cvt_pk_bf16(v0[0], v0[1]); w.y = cvt_pk_bf16(v0[2], v0[3]); w.z = cvt_pk_bf16(v1[0], v1[1]); w.w = cvt_pk_bf16(v1[2], v1[3]);
                    *(u32x4*)(DSTB + o) = w; }
    }
};
struct EpiResBF {
    static constexpr bool PERM = true, AFTER_DRAIN = false;
    const bf16_t* SRCB; float* DSTF; int ldc; float alpha;
    __device__ __forceinline__ void operator()(const f32x4 (&acc)[2][2][4][2], const Unit& u, int wr, int wc, int fr, int fq) const {
        const int row0 = u.pm * BM + wr * 64 + fr; const int col0 = u.pn * BM + wc * 32 + 8 * fq;
        u32x4 sv[2][4][2];
#pragma unroll
        for (int ai = 0; ai < 2; ++ai)
#pragma unroll
            for (int m = 0; m < 4; ++m)
#pragma unroll
                for (int bj = 0; bj < 2; ++bj) sv[ai][m][bj] = *(const u32x4*)(SRCB + (size_t)(row0 + ai * HALF + m * 16) * ldc + col0 + bj * HALF);
#pragma unroll
        for (int ai = 0; ai < 2; ++ai)
#pragma unroll
            for (int m = 0; m < 4; ++m)
#pragma unroll
                for (int bj = 0; bj < 2; ++bj) { const size_t o = (size_t)(row0 + ai * HALF + m * 16) * ldc + col0 + bj * HALF; const u32x4 w = sv[ai][m][bj];
                    const f32x4 s0 = (f32x4){bf_lo(w.x), bf_hi(w.x), bf_lo(w.y), bf_hi(w.y)}, s1 = (f32x4){bf_lo(w.z), bf_hi(w.z), bf_lo(w.w), bf_hi(w.w)};
                    *(f32x4*)(DSTF + o) = s0 * alpha + acc[ai][bj][m][0]; *(f32x4*)(DSTF + o + 4) = s1 * alpha + acc[ai][bj][m][1]; }
    }
};
struct EpiStoreB {
    static constexpr bool PERM = true, AFTER_DRAIN = false;
    bf16_t* O; int ldc; int npn;
    __device__ __forceinline__ void operator()(const f32x4 (&acc)[2][2][4][2], const Unit& u, int wr, int wc, int fr, int fq) const {
        const int row0 = u.pm * BM + wr * 64 + fr; const int col0 = (u.pn % npn) * BM + wc * 32 + 8 * fq;
#pragma unroll
        for (int ai = 0; ai < 2; ++ai)
#pragma unroll
            for (int m = 0; m < 4; ++m) { bf16_t* rowp = O + (size_t)(row0 + ai * HALF + m * 16) * ldc + col0;
#pragma unroll
                for (int bj = 0; bj < 2; ++bj) { const f32x4 v0 = acc[ai][bj][m][0], v1 = acc[ai][bj][m][1];
                    u32x4 w; w.x = cvt_pk_bf16(v0[0], v0[1]); w.y = cvt_pk_bf16(v0[2], v0[3]); w.z = cvt_pk_bf16(v1[0], v1[1]); w.w = cvt_pk_bf16(v1[2], v1[3]);
                    *(u32x4*)(rowp + bj * HALF) = w; } }
    }
};
struct EpiPleB {
    static constexpr bool PERM = true, AFTER_DRAIN = false;
    const bf16_t* XIN; const bf16_t* PP; bf16_t* XOUT; float* OUTF; int ldc;
    __device__ __forceinline__ void operator()(const f32x4 (&acc)[2][2][4][2], const Unit& u, int wr, int wc, int fr, int fq) const {
        const int row0 = u.pm * BM + wr * 64 + fr; const int col0 = u.pn * BM + wc * 32 + 8 * fq;
#pragma unroll
        for (int ai = 0; ai < 2; ++ai) {
            u32x4 xv[4][2], pv[4][2];
#pragma unroll
            for (int m = 0; m < 4; ++m)
#pragma unroll
                for (int bj = 0; bj < 2; ++bj) { const size_t o = (size_t)(row0 + ai * HALF + m * 16) * ldc + col0 + bj * HALF; xv[m][bj] = *(const u32x4*)(XIN + o); pv[m][bj] = *(const u32x4*)(PP + o); }
#pragma unroll
            for (int m = 0; m < 4; ++m)
#pragma unroll
                for (int bj = 0; bj < 2; ++bj) { const size_t o = (size_t)(row0 + ai * HALF + m * 16) * ldc + col0 + bj * HALF; const u32x4 xw = xv[m][bj], pw = pv[m][bj];
                    const float xs[8] = {bf_lo(xw.x), bf_hi(xw.x), bf_lo(xw.y), bf_hi(xw.y), bf_lo(xw.z), bf_hi(xw.z), bf_lo(xw.w), bf_hi(xw.w)};
                    const float ps[8] = {bf_lo(pw.x), bf_hi(pw.x), bf_lo(pw.y), bf_hi(pw.y), bf_lo(pw.z), bf_hi(pw.z), bf_lo(pw.w), bf_hi(pw.w)};
                    float r[8];
#pragma unroll
                    for (int i = 0; i < 4; ++i) { r[i] = xs[i] + fsigmoid(acc[ai][bj][m][0][i]) * ps[i]; r[4 + i] = xs[4 + i] + fsigmoid(acc[ai][bj][m][1][i]) * ps[4 + i]; }
                    if (XOUT) { u32x4 w; w.x = cvt_pk_bf16(r[0], r[1]); w.y = cvt_pk_bf16(r[2], r[3]); w.z = cvt_pk_bf16(r[4], r[5]); w.w = cvt_pk_bf16(r[6], r[7]); *(u32x4*)(XOUT + o) = w; }
                    if (OUTF) { *(f32x4*)(OUTF + o) = (f32x4){r[0], r[1], r[2], r[3]}; *(f32x4*)(OUTF + o + 4) = (f32x4){r[4], r[5], r[6], r[7]}; } }
        }
    }
};

constexpr int TAIL_PM0 = 128, TAIL_KS = 8, TAIL_ROWS = 8 * 256;
struct MoeTailOrder {
    const int* tile_e; int ntail, G, c, nN, ktiles;
    __device__ __forceinline__ bool next(int i, Unit& u) const {
        const int L = i * G + c; if (L >= ntail * nN * TAIL_KS) return false;
        const int ks = L & (TAIL_KS - 1), pn = (L >> 3) % nN, pm = TAIL_PM0 + (L >> 3) / nN;
        u.pm = pm; u.pn = tile_e[pm] * nN + pn; u.koff = ks * ktiles * 16384; return true; }
    __device__ __forceinline__ void a_ready(const Unit&) const {}
    __device__ __forceinline__ void done(const Unit&) const {}
};
struct EpiStorePart {
    static constexpr bool PERM = true, AFTER_DRAIN = false;
    bf16_t* O; int ldc; int npn; int ktiles;
    __device__ __forceinline__ void operator()(const f32x4 (&acc)[2][2][4][2], const Unit& u, int wr, int wc, int fr, int fq) const {
        const int ks = u.koff / (ktiles * 16384);
        const int row0 = (u.pm - TAIL_PM0) * BM + wr * 64 + fr; const int col0 = (u.pn % npn) * BM + wc * 32 + 8 * fq;
        bf16_t* base = O + (size_t)ks * TAIL_ROWS * ldc;
#pragma unroll
        for (int ai = 0; ai < 2; ++ai)
#pragma unroll
            for (int m = 0; m < 4; ++m) { bf16_t* ro = base + (size_t)(row0 + ai * HALF + m * 16) * ldc + col0;
#pragma unroll
                for (int bj = 0; bj < 2; ++bj) { const f32x4 v0 = acc[ai][bj][m][0], v1 = acc[ai][bj][m][1];
                    u32x4 w; w.x = cvt_pk_bf16(v0[0], v0[1]); w.y = cvt_pk_bf16(v0[2], v0[3]); w.z = cvt_pk_bf16(v1[0], v1[1]); w.w = cvt_pk_bf16(v1[2], v1[3]);
                    *(u32x4*)(ro + bj * HALF) = w; } }
    }
};
struct MoeOrder {
    StaticOrder base; const int* tile_e; int nN;
    __device__ __forceinline__ bool next(int i, Unit& u) const { if (!base.next(i, u)) return false; u.pn += tile_e[u.pm] * nN; return true; }
    __device__ __forceinline__ void a_ready(const Unit&) const {}
    __device__ __forceinline__ void done(const Unit&) const {}
};

template <class Epi, class Sched, bool ALIGN_EPI = false, bool SP2 = false, bool ATILED = false, bool AGATHER = false>
__device__ __forceinline__ void gemm_phase(PG8_LAS unsigned char* lds, const Gemm g, const Sched& S, const Epi& E, int wave_s) {
    const int lane = lane_now(), wid = wave_s, tid = wave_s * 64 + lane, wr = wid >> 2, wc = wid & 3, fr = lane & 15, fq = lane >> 4;
    const int K = g.K, nt = (g.Kloop ? g.Kloop : K) / BK;
    unsigned voffA[2], voffB[2];
    unsigned gP[2] = {0u, 0u}, gN[2] = {0u, 0u}, ridx2 = 0u, cC2 = 0u;
#pragma unroll
    for (int i = 0; i < 2; ++i) { int R, C; stage_rc(tid * 16 + i * 8192, R, C); const int Rb = Epi::PERM ? ((R & ~31) + perm32(R & 31)) : R;
        voffA[i] = ATILED ? (unsigned)(tid * 16 + i * 8192) : (unsigned)(R * K + C) * 2u;     voffB[i] = (unsigned)(tid * 16 + i * 8192); (void)Rb; if (i == 0) { ridx2 = (unsigned)R * 4u; cC2 = (unsigned)C * 2u; } }
    const size_t kstep = (size_t)(BK * 2);
    const size_t kstepB = (size_t)(HALF * BK * 2);
    const size_t kstepA = ATILED ? kstepB : kstep;
    const size_t hstep = (size_t)HALF * K * 2;
    const size_t tstep = 2 * hstep;
    const unsigned ldsw = (unsigned)wid * 1024u;
    const int aoff = lds_byte(wr * 64 + fr, fq * 8), boff = lds_byte(wc * 32 + fr, fq * 8);
#define PG8_SA(b, h) (((b) * 2 + (h)) * HTB)
#define PG8_SB(b, h) ((4 + (b) * 2 + (h)) * HTB)
#define PG8_STAGE(bufoff, gbase, voff) do { _Pragma("unroll") for (int _i = 0; _i < 2; ++_i) \
        __builtin_amdgcn_global_load_lds((const unsigned*)((const char*)(gbase) + (voff)[_i]), (PG8_LAS unsigned*)(lds + (bufoff) + ldsw + _i * 8192), 16, 0, 0); } while (0)
#define PG8_LDA(dst, b, h) do { _Pragma("unroll") for (int m = 0; m < 4; ++m) _Pragma("unroll") for (int k = 0; k < 2; ++k) dst[m][k] = *(const PG8_LAS bf16x8*)(lds + PG8_SA(b, h) + aoff + m * 2048 + k * 1024); } while (0)
#define PG8_LDB(dst, b, h) do { _Pragma("unroll") for (int n = 0; n < 2; ++n) _Pragma("unroll") for (int k = 0; k < 2; ++k) dst[n][k] = *(const PG8_LAS bf16x8*)(lds + PG8_SB(b, h) + boff + n * 2048 + k * 1024); } while (0)
#define PG8_GIDX(dst, pm_) do { const int* _ip = g.Ainv + (size_t)(pm_) * 128;        \
        asm volatile("global_load_dword %0, %1, %2" : "+v"(dst[0]) : "v"(ridx2), "s"(_ip) : "memory"); asm volatile("global_load_dword %0, %1, %2 offset:256" : "+v"(dst[1]) : "v"(ridx2), "s"(_ip) : "memory"); } while (0)
#define PG8_STA(bufoff, kptr, h_, nx_) do { if constexpr (AGATHER) { const unsigned _s = ((nx_) && last) ? gN[h_] : gP[h_]; unsigned _g[2] = { (_s & 0xffffu) * (unsigned)(K * 2) + cC2, (_s >> 16) * (unsigned)(K * 2) + cC2 }; PG8_STAGE(bufoff, kptr, _g); } \
        else PG8_STAGE(bufoff, (kptr) + (h_) * hstep, voffA); } while (0)
#define PG8_MMA(ai, bj, At, Bt) do { __builtin_amdgcn_s_setprio(1); _Pragma("unroll") for (int m = 0; m < 4; ++m) _Pragma("unroll") for (int n = 0; n < 2; ++n) _Pragma("unroll") for (int k = 0; k < 2; ++k) \
        acc[ai][bj][m][n] = __builtin_amdgcn_mfma_f32_16x16x32_bf16(Bt[n][k], At[m][k], acc[ai][bj][m][n], 0, 0, 0); __builtin_amdgcn_s_setprio(0); } while (0)
#define PG8_WAIT_V(n) asm volatile("s_waitcnt vmcnt(" #n ")" ::: "memory")
#define PG8_WAIT_L(n) asm volatile("s_waitcnt lgkmcnt(" #n ")" ::: "memory")
#define PG8_BAR __builtin_amdgcn_s_barrier()
#define PG8_SCHED __builtin_amdgcn_sched_barrier(0)
    Unit cur, nxt; int ui = 0;
    if (!S.next(0, cur)) return;
    f32x4 acc[2][2][4][2];
#pragma unroll
    for (int a = 0; a < 2; ++a)
#pragma unroll
        for (int b = 0; b < 2; ++b)
#pragma unroll
            for (int m = 0; m < 4; ++m)
#pragma unroll
                for (int n = 0; n < 2; ++n) acc[a][b][m][n] = (f32x4){0.f, 0.f, 0.f, 0.f};
    bf16x8 At[4][2], B0[2][2], B1[2][2];
    const char* cA = AGATHER ? (const char*)g.A : (const char*)g.A + (size_t)cur.pm * tstep + cur.koff; const char* cB = (const char*)g.Bt + (size_t)cur.pn * tstep + cur.koff;
    if constexpr (AGATHER) { static_assert(!AGATHER || (SP2 && !ATILED), "AGATHER: SP2, row-major A"); PG8_GIDX(gP, cur.pm); asm volatile("s_waitcnt vmcnt(0)" ::: "memory"); asm volatile("" : "+v"(gP[0]), "+v"(gP[1])); }
    S.a_ready(cur);
    if constexpr (SP2) {
        const bool last = false; (void)last;
        PG8_STAGE(PG8_SB(0, 0), cB, voffB); PG8_STAGE(PG8_SB(0, 1), cB + hstep, voffB); PG8_STA(PG8_SA(0, 0), cA, 0, false); PG8_STA(PG8_SA(0, 1), cA, 1, false);
        if (wr == 1) PG8_BAR;
        PG8_WAIT_V(2); PG8_BAR;
        PG8_STAGE(PG8_SB(1, 0), cB + kstepB, voffB); PG8_STA(PG8_SA(1, 0), cA + kstepA, 0, false); PG8_STAGE(PG8_SB(1, 1), cB + hstep + kstepB, voffB);
        PG8_WAIT_V(6); PG8_BAR;
    } else {
        PG8_STAGE(PG8_SB(0, 0), cB, voffB); PG8_STAGE(PG8_SA(0, 0), cA, voffA); PG8_STAGE(PG8_SB(0, 1), cB + hstep, voffB); PG8_STAGE(PG8_SA(0, 1), cA + hstep, voffA);
        if (wr == 1) PG8_BAR;
        PG8_WAIT_V(4); PG8_BAR;
        PG8_STAGE(PG8_SB(1, 0), cB + kstepB, voffB); PG8_STAGE(PG8_SA(1, 0), cA + kstepA, voffA); PG8_STAGE(PG8_SB(1, 1), cB + hstep + kstepB, voffB);
        PG8_WAIT_V(6); PG8_BAR;
    }
    for (;;) {
        const bool has_next = S.next(ui + 1, nxt);
        const char* nA = AGATHER ? cA : has_next ? (const char*)g.A + (size_t)nxt.pm * tstep + nxt.koff : cA; const char* nB = has_next ? (const char*)g.Bt + (size_t)nxt.pn * tstep + nxt.koff : cB;
        if constexpr (AGATHER) { if (!has_next) { gN[0] = gP[0]; gN[1] = gP[1]; } }
        for (int t = 0; t < nt; t += 2) {
            const bool last = (t == nt - 2);
            const bool gfetch = AGATHER && has_next && t == 2;
            if constexpr (AGATHER) { if (gfetch) PG8_GIDX(gN, nxt.pm); }
            const char* a1 = cA + (size_t)(t + 1) * kstepA;
            const char* a2 = last ? nA : cA + (size_t)(t + 2) * kstepA; const char* b2 = last ? nB : cB + (size_t)(t + 2) * kstepB;
            const char* a3 = a2 + kstepA; const char* b3 = b2 + kstepB;
            if (last && has_next) S.a_ready(nxt);
            if constexpr (SP2) {
            PG8_LDB(B0, 0, 0); PG8_LDB(B1, 0, 1); PG8_SCHED; PG8_LDA(At, 0, 0); PG8_STA(PG8_SA(1, 1), a1, 1, false);
            if (gfetch) PG8_WAIT_V(10); else PG8_WAIT_V(8);
            PG8_WAIT_L(0); PG8_BAR; PG8_MMA(0, 0, At, B0); PG8_MMA(0, 1, At, B1); PG8_BAR; PG8_SCHED;
            PG8_LDA(At, 0, 1); PG8_STAGE(PG8_SB(0, 0), b2, voffB); PG8_STAGE(PG8_SB(0, 1), b2 + hstep, voffB); PG8_STA(PG8_SA(0, 0), a2, 0, true);
            PG8_WAIT_V(8); PG8_WAIT_L(0); PG8_BAR; PG8_MMA(1, 0, At, B0); PG8_MMA(1, 1, At, B1); PG8_BAR; PG8_SCHED;
            PG8_LDB(B0, 1, 0); PG8_LDB(B1, 1, 1); PG8_SCHED; PG8_LDA(At, 1, 0); PG8_STA(PG8_SA(0, 1), a2, 1, true);
            PG8_WAIT_V(8); PG8_WAIT_L(0); PG8_BAR; PG8_MMA(0, 0, At, B0); PG8_MMA(0, 1, At, B1); PG8_BAR; PG8_SCHED;
            PG8_LDA(At, 1, 1); PG8_STAGE(PG8_SB(1, 0), b3, voffB); PG8_STAGE(PG8_SB(1, 1), b3 + hstep, voffB); PG8_STA(PG8_SA(1, 0), a3, 0, true);
            PG8_WAIT_V(8); PG8_WAIT_L(0); PG8_BAR; PG8_MMA(1, 0, At, B0); PG8_MMA(1, 1, At, B1); PG8_BAR; PG8_SCHED;
            } else {
            PG8_LDB(B0, 0, 0); PG8_SCHED; PG8_LDA(At, 0, 0); PG8_STAGE(PG8_SA(1, 1), a1 + hstep, voffA);
            PG8_WAIT_L(8); PG8_BAR; PG8_WAIT_L(0); PG8_MMA(0, 0, At, B0); PG8_BAR; PG8_SCHED;
            PG8_LDB(B1, 0, 1); PG8_STAGE(PG8_SB(0, 0), b2, voffB);
            PG8_BAR; PG8_WAIT_L(0); PG8_MMA(0, 1, At, B1); PG8_BAR;
            PG8_LDA(At, 0, 1); PG8_STAGE(PG8_SA(0, 0), a2, voffA);
            PG8_BAR; PG8_WAIT_L(0); PG8_MMA(1, 0, At, B0); PG8_BAR; PG8_SCHED;
            PG8_STAGE(PG8_SB(0, 1), b2 + hstep, voffB);
            PG8_WAIT_V(6); PG8_BAR; PG8_MMA(1, 1, At, B1); PG8_BAR;
            PG8_LDB(B0, 1, 0); PG8_SCHED; PG8_LDA(At, 1, 0); PG8_STAGE(PG8_SA(0, 1), a2 + hstep, voffA);
            PG8_WAIT_L(8); PG8_BAR; PG8_WAIT_L(0); PG8_MMA(0, 0, At, B0); PG8_BAR; PG8_SCHED;
            PG8_LDB(B1, 1, 1); PG8_STAGE(PG8_SB(1, 0), b3, voffB);
            PG8_BAR; PG8_WAIT_L(0); PG8_MMA(0, 1, At, B1); PG8_BAR;
            PG8_LDA(At, 1, 1); PG8_STAGE(PG8_SA(1, 0), a3, voffA);
            PG8_BAR; PG8_WAIT_L(0); PG8_MMA(1, 0, At, B0); PG8_BAR; PG8_SCHED;
            PG8_STAGE(PG8_SB(1, 1), b3 + hstep, voffB);
            PG8_WAIT_V(6); PG8_BAR; PG8_MMA(1, 1, At, B1); PG8_BAR;
            }
        }
        if constexpr (ALIGN_EPI) { if (wr == 0) PG8_BAR; }
        if constexpr (!Epi::AFTER_DRAIN) { E(acc, cur, wr, wc, fr, fq); S.done(cur); }
        if (!has_next) break;
#pragma unroll
        for (int a = 0; a < 2; ++a)
#pragma unroll
            for (int b = 0; b < 2; ++b)
#pragma unroll
                for (int m = 0; m < 4; ++m)
#pragma unroll
                    for (int n = 0; n < 2; ++n) acc[a][b][m][n] = (f32x4){0.f, 0.f, 0.f, 0.f};
        cur = nxt; cA = nA; cB = nB; ++ui;
        if constexpr (AGATHER) { gP[0] = gN[0]; gP[1] = gN[1]; }
        if constexpr (ALIGN_EPI) { if (wr == 1) PG8_BAR; }
    }
    PG8_WAIT_V(0);
    if constexpr (!ALIGN_EPI) { if (wr == 0) PG8_BAR; }
    PG8_BAR;
    if constexpr (Epi::AFTER_DRAIN) { E.fused(acc, cur, wr, wc, fr, fq, lds, wid, lane); S.done(cur); }
#undef PG8_SA
#undef PG8_SB
#undef PG8_STAGE
#undef PG8_LDA
#undef PG8_LDB
#undef PG8_GIDX
#undef PG8_STA
#undef PG8_MMA
#undef PG8_WAIT_V
#undef PG8_WAIT_L
#undef PG8_BAR
#undef PG8_SCHED
}
}
constexpr int NWAVES = 8;
constexpr int BATCH = 4, T = 4096, D = 2048, M = BATCH * T;
constexpr int PLE_DIM = 256, FFN = 5632, MOE = 7168, NE = 8;
constexpr int REC_IN = 8208, UW = 8192, NREC = 8448;
constexpr int U_QA = 0, U_KA = 512, U_VA = 1024, U_OA = 2048, U_QB = 3072, U_FF = 4096, U_FB = 5120, U_IB = 6144, U_GB = 7168;
constexpr int NQKV = 6144;
constexpr int XS_ROWS = 34816;
constexpr float LN_EPS = 1e-5f, RMS_EPS = 1e-6f, ALPHA = 1.41421356237f, GATE_CAP = 15.0f;

constexpr size_t MiB = 1u << 20;
constexpr size_t WS_CTL = 0, CTL_ZERO_BYTES = 1 * MiB;
constexpr size_t WS_INV = 2 * MiB;
constexpr size_t WS_TOKE = 1 * MiB, WS_TOKG = WS_TOKE + 256 * 1024, WS_DEST = WS_TOKG + 256 * 1024, WS_WGCNT = WS_DEST + 256 * 1024, WS_TILEE = WS_WGCNT + 64 * 1024;
constexpr size_t WS_WQKV = 4 * MiB, WS_WNAO = 28 * MiB, WS_WPG1 = 36 * MiB, WS_WPP1 = 44 * MiB, WS_WMGU = 48 * MiB, WS_WMDN = 496 * MiB;
constexpr size_t WS_XB0 = 720 * MiB, WS_XB1 = 784 * MiB, WS_PB = 848 * MiB, WS_G = 864 * MiB, WS_WGATE = 866 * MiB;
constexpr size_t WS_WRIN = 872 * MiB, WS_WROUT = 905 * MiB, WS_WFGU = 913 * MiB, WS_WFDN = 957 * MiB, WS_WPG0 = 979 * MiB, WS_WPP0 = 987 * MiB;
constexpr size_t WS_U = 992 * MiB, WS_HA = 1248 * MiB, WS_HB = 1376 * MiB, WS_Y = 1504 * MiB;
constexpr size_t WS_H = 992 * MiB;
constexpr size_t WS_PP = 1248 * MiB;
constexpr size_t WS_QKV = 992 * MiB;
constexpr size_t WS_AO = WS_Y;
constexpr size_t WS_HM = 872 * MiB;
constexpr size_t WS_YS = 1348 * MiB;
constexpr size_t WS_XS = 1348 * MiB;
constexpr size_t WS_PP1 = 1620 * MiB;
constexpr size_t WS_QIN = 1568 * MiB, WS_KIN = 1632 * MiB, WS_GTAB = 1696 * MiB, WS_GTABM = 1698 * MiB, WS_QINM = 1700 * MiB, WS_KINM = 1732 * MiB, WS_EQM = 1700 * MiB, WS_EKM = 1701 * MiB;
constexpr size_t WS_VINM = 1504 * MiB, WS_VINH = 1536 * MiB;
constexpr size_t WS_PART = 1484 * MiB;
constexpr size_t WS_END = 1764 * MiB;
static_assert(WS_WMGU + (size_t)NE * 2 * MOE * D * 2 <= WS_WMDN && WS_WMDN + (size_t)NE * D * MOE * 2 <= WS_XB0, "ws map 1");
static_assert(WS_WRIN + (size_t)NREC * D * 2 <= WS_WROUT && WS_WFGU + (size_t)2 * FFN * D * 2 <= WS_WFDN && WS_WFDN + (size_t)D * FFN * 2 <= WS_WPG0 && WS_WPP0 + (size_t)D * PLE_DIM * 2 <= WS_U, "ws map 2");
static_assert(WS_U + (size_t)M * UW * 2 <= WS_HA && WS_H + (size_t)M * FFN * 2 <= WS_HA && WS_QKV + (size_t)M * NQKV * 2 <= WS_HA, "ws map 3");
static_assert(WS_HM + (size_t)XS_ROWS * MOE * 2 <= WS_YS && WS_YS + (size_t)XS_ROWS * D * 4 <= WS_END && WS_XS + (size_t)XS_ROWS * D * 2 <= WS_Y, "ws map 4");
constexpr int CW_BAR = 4096;

constexpr int RING_OFF = 0, RING_BYTES = 131072;
constexpr int LDSCTL_OFF = RING_BYTES, MISC_OFF = LDSCTL_OFF + 320;
constexpr int LDS_BYTES = 147456;
static_assert(MISC_OFF + 128 <= LDS_BYTES, "LDS map");

#define GAS __attribute__((address_space(1)))
#define LAS __attribute__((address_space(3)))
typedef unsigned short bf16;
typedef unsigned v4u __attribute__((ext_vector_type(4)));
typedef unsigned v2u __attribute__((ext_vector_type(2)));
typedef float f32x4 __attribute__((ext_vector_type(4)));
typedef float f32x2 __attribute__((ext_vector_type(2)));
typedef GAS unsigned gu32;
#define RLX_AGENT __ATOMIC_RELAXED, __HIP_MEMORY_SCOPE_AGENT
#define LDS_WAIT() asm volatile("s_waitcnt lgkmcnt(0)" ::: "memory")
#define VM_WAIT() asm volatile("s_waitcnt vmcnt(0)" ::: "memory")
__device__ __forceinline__ unsigned f2bf(float f) { unsigned u = __builtin_bit_cast(unsigned, f); return (u + 0x7fffu + ((u >> 16) & 1u)) >> 16; }
typedef float f32x2_t __attribute__((ext_vector_type(2))); typedef __bf16 bf16x2_t __attribute__((ext_vector_type(2)));
__device__ __forceinline__ unsigned cvtpk(float lo, float hi) { f32x2_t v = {lo, hi}; bf16x2_t b = __builtin_convertvector(v, bf16x2_t); return __builtin_bit_cast(unsigned, b); }
__device__ __forceinline__ unsigned pk2(float lo, float hi) { return cvtpk(lo, hi); }
__device__ __forceinline__ float bflo(unsigned w) { return __builtin_bit_cast(float, w << 16); }
__device__ __forceinline__ float bfhi(unsigned w) { return __builtin_bit_cast(float, w & 0xffff0000u); }
__device__ __forceinline__ float bf1(bf16 h) { return __builtin_bit_cast(float, (unsigned)h << 16); }
typedef short bf16x8 __attribute__((ext_vector_type(8)));
typedef short s16x4 __attribute__((ext_vector_type(4)));
__device__ __forceinline__ s16x4 lds_tr(LAS unsigned char* p) { return __builtin_bit_cast(s16x4, __builtin_amdgcn_ds_read_tr16_b64_v4i16((LAS s16x4*)p)); }
__device__ __forceinline__ float sigm(float x) { return __builtin_amdgcn_rcpf(1.0f + __expf(-x)); }
#define AT(base, m, k, K) ((bf16*)((unsigned char*)(base) + pg8::at_tiled_off((int)(m), (int)(k), (K))))
#define XB_TMO      128
#define XB_XCNT(j)  (256  + 64 * (j))
#define XB_XSUB(j)  (1280 + 64 * (j))
#define XB_XGEN(j)  (2304 + 64 * (j))
#define XB_TOP      3328
#define XB_TOPGEN   3392
#define XCD_BAR_WORDS 3456
#define XB_SPIN_CAP (1u << 18)

__device__ __forceinline__ unsigned xb_ld(unsigned* p)              { return __hip_atomic_load(p, __ATOMIC_RELAXED, __HIP_MEMORY_SCOPE_AGENT); }
__device__ __forceinline__ unsigned xb_add(unsigned* p, unsigned v) { return __hip_atomic_fetch_add(p, v, __ATOMIC_RELAXED, __HIP_MEMORY_SCOPE_AGENT); }
__device__ __forceinline__ unsigned xb_xcc_id() { return (unsigned)__builtin_amdgcn_s_getreg((3 << 11) | 20) & 0xFu; }
#define XB_SPIN(cond, bar) do { unsigned _sp = 0; while (cond) { __builtin_amdgcn_s_sleep(1); \
    if ((++_sp & 255u) == 0u) { if (xb_ld(&(bar)[XB_TMO])) break; if (_sp > XB_SPIN_CAP) { atomicAdd(&(bar)[XB_TMO], 1u); break; } } } } while (0)

struct XcdBarrier {
    unsigned* bar; unsigned x;
    volatile LAS unsigned* st;
};

__device__ __forceinline__ XcdBarrier xcd_barrier_post(unsigned* bar, volatile LAS unsigned* st, int wave_s) {
    XcdBarrier b; b.bar = bar; b.x = xb_xcc_id(); b.st = st;
    if (wave_s == 0 && lane_now() == 0) (void)xb_add(&bar[XB_XCNT(b.x)], 1u);
    return b;
}
__device__ __forceinline__ void xcd_barrier_complete(unsigned* bar, unsigned x, unsigned& nloc, unsigned& nx) {
    const unsigned G = gridDim.x * gridDim.y * gridDim.z;
    unsigned sum, cnt, mine, sp = 0u;
    for (;;) {
        sum = 0u; cnt = 0u; mine = 0u;
#pragma unroll
        for (unsigned j = 0; j < 16; ++j) { const unsigned c = xb_ld(&bar[XB_XCNT(j)]); sum += c; cnt += (c > 0u) ? 1u : 0u; mine = (j == x) ? c : mine; }
        if (sum == G) break;
        __builtin_amdgcn_s_sleep(1);
        if ((++sp & 255u) == 0u) { if (xb_ld(&bar[XB_TMO])) break; if (sp > XB_SPIN_CAP) { atomicAdd(&bar[XB_TMO], 1u); break; } }
    }
    nloc = mine > 0u ? mine : 1u; nx = cnt > 0u ? cnt : 1u;
}

__device__ __forceinline__ void xcd_barrier(const XcdBarrier& b, int wave_s) {
    asm volatile("s_waitcnt vmcnt(0)" ::: "memory");
    __syncthreads();
    if (wave_s == 0 && lane_now() == 0) {
        unsigned* bar = b.bar;
        __builtin_amdgcn_s_waitcnt(0);
        unsigned nloc = b.st[0], nx = b.st[1];
        if (nloc == 0u) { xcd_barrier_complete(bar, b.x, nloc, nx); b.st[0] = nloc; b.st[1] = nx; }
        const unsigned old = xb_add(&bar[XB_XSUB(b.x)], 1u);
        const unsigned gen = old / nloc;
        if (old + 1u == (gen + 1u) * nloc) {
            __builtin_amdgcn_fence(__ATOMIC_RELEASE, "agent");
            asm volatile("s_waitcnt vmcnt(0)" ::: "memory");
            const unsigned og = xb_add(&bar[XB_TOP], 1u);
            const unsigned tg = og / nx;
            if (og + 1u == (tg + 1u) * nx) xb_add(&bar[XB_TOPGEN], 1u);
            else XB_SPIN(xb_ld(&bar[XB_TOPGEN]) == tg, bar);
            __builtin_amdgcn_fence(__ATOMIC_ACQUIRE, "agent");
            xb_add(&bar[XB_XGEN(b.x)], 1u);
            asm volatile("s_waitcnt vmcnt(0)" ::: "memory");
        } else {
            XB_SPIN(xb_ld(&bar[XB_XGEN(b.x)]) == gen, bar);
            __builtin_amdgcn_fence(__ATOMIC_ACQUIRE, "agent");
            asm volatile("s_waitcnt vmcnt(0)" ::: "memory");
        }
    }
    __syncthreads();
}

struct Frame {
    LAS unsigned char* lds;
    int wave, G;
};
struct Args { const float* in[23]; float* out; unsigned char* ws; int ph_lo, ph_hi; };
enum { I_X = 0, I_P, I_LNW, I_LNB, I_RECWIN, I_GBIAS, I_MNORM, I_LBLOG, I_HNORM, I_RECWOUT, I_FWG, I_FWU, I_FWD, I_NAQKV, I_RPB, I_NAOUT, I_WR, I_BR, I_MWG, I_MWU, I_MWD, I_PLEG, I_PLEP };

#define DPP_ADD(v, ctrl) ((v) + __builtin_bit_cast(float, __builtin_amdgcn_update_dpp(0, __builtin_bit_cast(int, (v)), (ctrl), 0xF, 0xF, true)))
__device__ __forceinline__ float row_sum16(float v) {
    v = DPP_ADD(v, 0xB1);
    v = DPP_ADD(v, 0x4E);
    v = DPP_ADD(v, 0x141);
    v = DPP_ADD(v, 0x140);
    return v;
}
__device__ __forceinline__ float wave_sum(float v) {
    v = row_sum16(v);
    const float r0 = __builtin_bit_cast(float, __builtin_amdgcn_readlane(__builtin_bit_cast(int, v), 0)), r1 = __builtin_bit_cast(float, __builtin_amdgcn_readlane(__builtin_bit_cast(int, v), 16));
    const float r2 = __builtin_bit_cast(float, __builtin_amdgcn_readlane(__builtin_bit_cast(int, v), 32)), r3 = __builtin_bit_cast(float, __builtin_amdgcn_readlane(__builtin_bit_cast(int, v), 48));
    return (r0 + r1) + (r2 + r3);
}
__device__ __forceinline__ float half_sum32(float v, int lane) {
    v = row_sum16(v);
    const float r0 = __builtin_bit_cast(float, __builtin_amdgcn_readlane(__builtin_bit_cast(int, v), 0)), r1 = __builtin_bit_cast(float, __builtin_amdgcn_readlane(__builtin_bit_cast(int, v), 16));
    const float r2 = __builtin_bit_cast(float, __builtin_amdgcn_readlane(__builtin_bit_cast(int, v), 32)), r3 = __builtin_bit_cast(float, __builtin_amdgcn_readlane(__builtin_bit_cast(int, v), 48));
    return (lane < 32) ? (r0 + r1) : (r2 + r3);
}
__device__ __forceinline__ float wave_max(float v) {
#pragma unroll
    for (int o = 1; o < 64; o <<= 1) v = fmaxf(v, __shfl_xor(v, o));
    return v;
}

__device__ __forceinline__ void tr_item(const float* W, int ldn, int K, int srcc, int nvalid, bf16* WT, size_t drow, int k0, LAS float* scr, int lane, bool tiled) {
    const int c = lane & 31;
    {   float tmp[32]; const float* wp = W + (size_t)(k0 + (lane >> 5)) * ldn + srcc + c; const bool ok = c < nvalid;
#pragma unroll
        for (int i = 0; i < 32; ++i) tmp[i] = ok ? __builtin_nontemporal_load(wp + (size_t)(2 * i) * ldn) : 0.f;
#pragma unroll
        for (int i = 0; i < 32; ++i) scr[(2 * i + (lane >> 5)) * 33 + c] = tmp[i]; }
    LDS_WAIT(); asm volatile("" ::: "memory");
    const int c8 = lane & 7;
#pragma unroll
    for (int j = 0; j < 4; ++j) { const int n = (lane >> 3) + 8 * j; const LAS float* s = scr + (8 * c8) * 33 + n;
        v4u o; o.x = pk2(s[0 * 33], s[1 * 33]); o.y = pk2(s[2 * 33], s[3 * 33]); o.z = pk2(s[4 * 33], s[5 * 33]); o.w = pk2(s[6 * 33], s[7 * 33]);
        if (tiled) *(GAS v4u*)((GAS unsigned char*)WT + pg8::bt_tiled_off((int)drow + n, k0 + 8 * c8, K)) = o; else *(GAS v4u*)(WT + (drow + n) * (size_t)K + k0 + 8 * c8) = o; }
    LDS_WAIT(); asm volatile("" ::: "memory");
}
constexpr int TR2_P = 288;
struct Tr2D { const float* W; unsigned char* WT; int ldn, K, srcc, drow, k0; };
__device__ __forceinline__ void tr2_load(f32x2 (&tmp)[32], const Tr2D& t, int lane) {
    const float* wp = t.W + (size_t)t.k0 * t.ldn + t.srcc + 2 * lane;
#pragma unroll
    for (int i = 0; i < 32; ++i) tmp[i] = __builtin_nontemporal_load((const GAS f32x2*)(wp + (size_t)i * t.ldn));
}
__device__ __forceinline__ void tr2_store(const f32x2 (&tmp)[32], const Tr2D& t, LAS unsigned char* scr, int lane) {
    {   const int n = 2 * lane, v = n & 31, slot = (n & ~31) + 16 * ((v >> 2) & 1) + 4 * (v >> 3) + (v & 3);
#pragma unroll
        for (int i = 0; i < 32; ++i) *(LAS unsigned*)(scr + i * TR2_P + slot * 2) = cvtpk(tmp[i][0], tmp[i][1]); }
    LDS_WAIT(); asm volatile("" ::: "memory");
    const int g = lane >> 4, i16 = lane & 15, q = i16 >> 2, p4 = lane & 3;
    unsigned char* blk = t.WT + ((size_t)(((t.drow >> 8) * 2 + ((t.drow >> 7) & 1)) * (t.K >> 6) + (t.k0 >> 6))) * 16384;
    const int C = (t.k0 & 63) + 8 * g;
#pragma unroll
    for (int s = 0; s < 8; ++s) { LAS unsigned char* tp = scr + (8 * g + q) * TR2_P + (16 * s + 4 * p4) * 2;
        const s16x4 x0 = lds_tr(tp), x1 = lds_tr(tp + 4 * TR2_P);
        v4u o = __builtin_bit_cast(v4u, (bf16x8){x0[0], x0[1], x0[2], x0[3], x1[0], x1[1], x1[2], x1[3]});
        *(GAS v4u*)(blk + pg8::lds_byte(16 * s + i16, C)) = o; }
    LDS_WAIT(); asm volatile("" ::: "memory");
}
constexpr int N2_RIN = 64 * (UW / 128), N2_ROUT = 64 * 16, N2_FGU = 64 * (2 * FFN / 128), N2_FDN = (FFN / 32) * 16, N2_PG = 64 * 16, N2_PP = 8 * 16, N2_QKV = 64 * (NQKV / 128), N2_NAO = 64 * 16;
constexpr int N2_MGU = 64 * (NE * 2 * MOE / 128), N2_MDN = (MOE / 32) * (NE * D / 128);
constexpr int N2_ITEMS = N2_RIN + N2_ROUT + N2_FGU + N2_FDN + 2 * N2_PG + 2 * N2_PP + N2_QKV + N2_NAO + N2_MGU + N2_MDN;
__device__ __forceinline__ Tr2D tr2_decode(const Args& A, int r) {
    unsigned char* ws = A.ws; const float* W; unsigned char* WT; int ldn, K; int srcc, kb, nb;
#define TR_KN() { const int nk2_ = K / 64, g8_ = r >> 3, w8_ = r & 7; kb = (g8_ % nk2_) * 2 + (w8_ & 1); nb = (g8_ / nk2_) * 4 + (w8_ >> 1); }
    if (r < N2_RIN) { W = A.in[I_RECWIN]; WT = ws + WS_WRIN; ldn = REC_IN; K = D; TR_KN(); srcc = (nb < 24) ? nb * 128 : nb * 128 + 16; }
    else if ((r -= N2_RIN) < N2_ROUT) { W = A.in[I_RECWOUT]; WT = ws + WS_WROUT; ldn = D; K = D; TR_KN(); srcc = nb * 128; }
    else if ((r -= N2_ROUT) < N2_FGU) { WT = ws + WS_WFGU; ldn = FFN; K = D; TR_KN(); W = (nb & 1) ? A.in[I_FWU] : A.in[I_FWG]; srcc = (nb >> 1) * 128; }
    else if ((r -= N2_FGU) < N2_FDN) { W = A.in[I_FWD]; WT = ws + WS_WFDN; ldn = D; K = FFN; TR_KN(); srcc = nb * 128; }
    else if ((r -= N2_FDN) < 2 * N2_PG) { const int l = r / N2_PG; r -= l * N2_PG; W = A.in[I_PLEG] + (size_t)l * D * D; WT = ws + (l ? WS_WPG1 : WS_WPG0); ldn = D; K = D; TR_KN(); srcc = nb * 128; }
    else if ((r -= 2 * N2_PG) < 2 * N2_PP) { const int l = r / N2_PP; r -= l * N2_PP; W = A.in[I_PLEP] + (size_t)l * PLE_DIM * D; WT = ws + (l ? WS_WPP1 : WS_WPP0); ldn = D; K = PLE_DIM; TR_KN(); srcc = nb * 128; }
    else if ((r -= 2 * N2_PP) < N2_QKV) { W = A.in[I_NAQKV]; WT = ws + WS_WQKV; ldn = NQKV; K = D; TR_KN(); srcc = nb * 128; }
    else if ((r -= N2_QKV) < N2_NAO) { W = A.in[I_NAOUT]; WT = ws + WS_WNAO; ldn = D; K = D; TR_KN(); srcc = nb * 128; }
    else if ((r -= N2_NAO) < N2_MGU) { WT = ws + WS_WMGU; ldn = MOE; K = D; TR_KN(); const int e = nb / (2 * MOE / 128), nl = nb % (2 * MOE / 128); W = ((nl & 1) ? A.in[I_MWU] : A.in[I_MWG]) + (size_t)e * D * MOE; srcc = (nl >> 1) * 128; }
    else { r -= N2_MGU; WT = ws + WS_WMDN; ldn = D; K = MOE; TR_KN(); const int e = nb / (D / 128), nl = nb % (D / 128); W = A.in[I_MWD] + (size_t)e * MOE * D; srcc = nl * 128; }
#undef TR_KN
    Tr2D t; t.W = W; t.WT = WT; t.ldn = ldn; t.K = K; t.srcc = srcc; t.drow = nb * 128; t.k0 = kb * 32; return t;
}
__device__ __forceinline__ void p0_prologue(const Frame& F, const Args& A) {
    const int lane = lane_now(), tid = F.wave * 64 + lane; (void)tid;
    LAS float* scr = (LAS float*)(F.lds + RING_OFF + F.wave * 16384);
    const int gw = blockIdx.x * NWAVES + F.wave, NGW = F.G * NWAVES;
    unsigned char* ws = A.ws;
    {
        f32x2 ra[32], rb[32]; Tr2D da, db; int it = gw;
        if (it < N2_ITEMS) { da = tr2_decode(A, it); tr2_load(ra, da, lane); }
        while (it < N2_ITEMS) {
            int nx = it + NGW; if (nx < N2_ITEMS) { db = tr2_decode(A, nx); tr2_load(rb, db, lane); }
            tr2_store(ra, da, (LAS unsigned char*)scr, lane);
            it = nx; if (it >= N2_ITEMS) break;
            nx = it + NGW; if (nx < N2_ITEMS) { da = tr2_decode(A, nx); tr2_load(ra, da, lane); }
            tr2_store(rb, db, (LAS unsigned char*)scr, lane);
            it = nx;
        }
    }
    for (int it = gw; it < 32 * 8; it += NGW) { const int kb = it >> 3, nb = it & 7; tr_item(A.in[I_RECWIN], REC_IN, D, 3072, (nb == 0) ? 16 : 0, (bf16*)(ws + WS_WGATE), (size_t)nb * 32, kb * 64, scr, lane, false); }
    const size_t gt = (size_t)blockIdx.x * (NWAVES * 64) + tid, NGT = (size_t)F.G * NWAVES * 64;
    { const GAS f32x4* src = (const GAS f32x4*)A.in[I_X]; GAS v4u* dst = (GAS v4u*)(ws + WS_XB0); const size_t NCH = (size_t)M * D / 8;
      for (size_t i = gt; i < NCH; i += 4 * NGT) { f32x4 a[4], b[4];
#pragma unroll
          for (int u = 0; u < 4; ++u) { const size_t iu = i + u * NGT; if (iu < NCH) { a[u] = __builtin_nontemporal_load(src + 2 * iu); b[u] = __builtin_nontemporal_load(src + 2 * iu + 1); } }
#pragma unroll
          for (int u = 0; u < 4; ++u) { const size_t iu = i + u * NGT; if (iu < NCH) { v4u o; o.x = pk2(a[u][0], a[u][1]); o.y = pk2(a[u][2], a[u][3]); o.z = pk2(b[u][0], b[u][1]); o.w = pk2(b[u][2], b[u][3]); dst[iu] = o; } } } }
    { const GAS f32x4* src = (const GAS f32x4*)A.in[I_P]; GAS v4u* dst = (GAS v4u*)(ws + WS_PB); const size_t NCH = (size_t)2 * M * PLE_DIM / 8;
      for (size_t i = gt; i < NCH; i += 4 * NGT) { f32x4 a[4], b[4];
#pragma unroll
          for (int u = 0; u < 4; ++u) { const size_t iu = i + u * NGT; if (iu < NCH) { a[u] = __builtin_nontemporal_load(src + 2 * iu); b[u] = __builtin_nontemporal_load(src + 2 * iu + 1); } }
#pragma unroll
          for (int u = 0; u < 4; ++u) { const size_t iu = i + u * NGT; if (iu < NCH) { v4u o; o.x = pk2(a[u][0], a[u][1]); o.y = pk2(a[u][2], a[u][3]); o.z = pk2(b[u][0], b[u][1]); o.w = pk2(b[u][2], b[u][3]);
              *(GAS v4u*)AT(dst, (iu * 8) / PLE_DIM, (iu * 8) % PLE_DIM, PLE_DIM) = o; } } } }
}

constexpr int RB = 32;
#define T0_OF(blk) (dir ? (T - RB - (blk) * RB) : (blk) * RB)
__device__ __forceinline__ void mlstm_unit(const Frame& F, const Args& A, int unit) {
    const int lane = lane_now(), tid = F.wave * 64 + lane; (void)tid;
    const int cg = unit & 3, dir = (unit >> 2) & 1, h = (unit >> 3) & 3, b = unit >> 5;
    LAS float* qs = (LAS float*)(F.lds + RING_OFF);
    LAS float* ks = qs + RB * 128;
    LAS float* vs = ks + RB * 128;
    LAS float* fi = vs + RB * 64;
    LAS float* ob = fi + RB * 2;
    const bf16* U = (const bf16*)(A.ws + WS_U); const float* Gt = (const float*)(A.ws + WS_G);
    float* HA = (float*)(A.ws + WS_HA) + (size_t)dir * M * 1024;
    const int e = lane & 7, dg = lane >> 3, colw = F.wave * 8 + e;
    const int srow = tid >> 4, sc = tid & 15;
    const float bias_i = A.in[I_GBIAS][(dir ? 2 : 0) * 4 + h], bias_f = A.in[I_GBIAS][(dir ? 3 : 1) * 4 + h];
    float C[16], n[16];
#pragma unroll
    for (int j = 0; j < 16; ++j) { C[j] = 0.f; n[j] = 0.f; }
    v4u rq, rk; v2u rv; float rgi = 0.f, rgf = 0.f;
    {   const size_t row = (size_t)b * T + T0_OF(0) + srow; const bf16* ur = U + row * UW;
        rq = *(const GAS v4u*)(ur + U_QA + h * 128 + sc * 8); rk = *(const GAS v4u*)(ur + U_KA + h * 128 + sc * 8); rv = *(const GAS v2u*)(ur + U_VA + h * 256 + cg * 64 + sc * 4);
        if (tid < RB) { const size_t r2 = (size_t)b * T + T0_OF(0) + tid; rgi = Gt[r2 * 16 + (dir ? 2 : 0) * 4 + h]; rgf = Gt[r2 * 16 + (dir ? 3 : 1) * 4 + h]; } }
    for (int blk = 0; blk < T / RB; ++blk) {
        const int t0 = T0_OF(blk);
        {   const float qsc = 0.08838834764831845f;
            LAS float* qd = qs + srow * 128 + sc * 8; LAS float* kd = ks + srow * 128 + sc * 8;
            *(LAS f32x4*)qd = (f32x4){bflo(rq.x) * qsc, bfhi(rq.x) * qsc, bflo(rq.y) * qsc, bfhi(rq.y) * qsc}; *(LAS f32x4*)(qd + 4) = (f32x4){bflo(rq.z) * qsc, bfhi(rq.z) * qsc, bflo(rq.w) * qsc, bfhi(rq.w) * qsc};
            *(LAS f32x4*)kd = (f32x4){bflo(rk.x), bfhi(rk.x), bflo(rk.y), bfhi(rk.y)}; *(LAS f32x4*)(kd + 4) = (f32x4){bflo(rk.z), bfhi(rk.z), bflo(rk.w), bfhi(rk.w)};
            *(LAS f32x4*)(vs + srow * 64 + sc * 4) = (f32x4){bflo(rv.x), bfhi(rv.x), bflo(rv.y), bfhi(rv.y)};
            if (tid < RB) { const float gi = GATE_CAP * tanhf((rgi + bias_i) * (1.0f / GATE_CAP)), gf = GATE_CAP * tanhf((rgf + bias_f) * (1.0f / GATE_CAP));
                fi[tid * 2] = sigm(gf); fi[tid * 2 + 1] = __expf(gi); } }
        __syncthreads();
        if (blk + 1 < T / RB) { const size_t row = (size_t)b * T + T0_OF(blk + 1) + srow; const bf16* ur = U + row * UW;
            rq = *(const GAS v4u*)(ur + U_QA + h * 128 + sc * 8); rk = *(const GAS v4u*)(ur + U_KA + h * 128 + sc * 8); rv = *(const GAS v2u*)(ur + U_VA + h * 256 + cg * 64 + sc * 4);
            if (tid < RB) { const size_t r2 = (size_t)b * T + T0_OF(blk + 1) + tid; rgi = Gt[r2 * 16 + (dir ? 2 : 0) * 4 + h]; rgf = Gt[r2 * 16 + (dir ? 3 : 1) * 4 + h]; } }
        for (int s = 0; s < RB; ++s) {
            const int tl = dir ? (RB - 1 - s) : s;
            const float f = fi[tl * 2], ii = fi[tl * 2 + 1], v = vs[tl * 64 + colw];
            const LAS f32x4* qp = (const LAS f32x4*)(qs + tl * 128 + dg * 16); const LAS f32x4* kp = (const LAS f32x4*)(ks + tl * 128 + dg * 16);
            float num = 0.f, den = 0.f;
#pragma unroll
            for (int j4 = 0; j4 < 4; ++j4) { const f32x4 q4 = qp[j4], k4 = kp[j4];
#pragma unroll
                for (int i = 0; i < 4; ++i) { const int j = j4 * 4 + i; const float kk = ii * k4[i]; C[j] = f * C[j] + kk * v; n[j] = f * n[j] + kk; num += C[j] * q4[i]; den += n[j] * q4[i]; } }
            num += __shfl_xor(num, 8); den += __shfl_xor(den, 8); num += __shfl_xor(num, 16); den += __shfl_xor(den, 16); num += __shfl_xor(num, 32); den += __shfl_xor(den, 32);
            if (dg == 0) ob[tl * 64 + colw] = num / fmaxf(fabsf(den), 1.0f);
        }
        __syncthreads();
        *(GAS f32x4*)(HA + ((size_t)b * T + t0 + srow) * 1024 + h * 256 + cg * 64 + sc * 4) = *(const LAS f32x4*)(ob + srow * 64 + sc * 4);
    }
    __syncthreads();
}
__device__ __forceinline__ void hgrn_unit(const Frame& F, const Args& A, int unit) {
    const int lane = lane_now(), tid = F.wave * 64 + lane; (void)tid;
    const int cg = unit & 1, dir = (unit >> 1) & 1, h = (unit >> 2) & 7, b = unit >> 5;
    LAS float* qs = (LAS float*)(F.lds + RING_OFF);
    LAS float* fs = qs + RB * 128;
    LAS float* vs = fs + RB * 128;
    LAS float* ob = vs + RB * 64;
    const bf16* U = (const bf16*)(A.ws + WS_U);
    float* HB = (float*)(A.ws + WS_HB) + (size_t)dir * M * 1024;
    const int e = lane & 7, dg = lane >> 3, colw = F.wave * 8 + e;
    const int srow = tid >> 4, sc = tid & 15;
    float lb[8];
#pragma unroll
    for (int i = 0; i < 8; ++i) { const float l0 = A.in[I_LBLOG][(dir * 2 + 0) * 1024 + h * 128 + sc * 8 + i], l1 = A.in[I_LBLOG][(dir * 2 + 1) * 1024 + h * 128 + sc * 8 + i]; lb[i] = 1.0f / (1.0f + __expf(l1 - l0)); }
    float S[16];
#pragma unroll
    for (int j = 0; j < 16; ++j) S[j] = 0.f;
    v4u rq, rf; v2u rv;
    {   const size_t row = (size_t)b * T + T0_OF(0) + srow; const bf16* ur = U + row * UW;
        rq = *(const GAS v4u*)(ur + U_QB + h * 128 + sc * 8); rf = *(const GAS v4u*)(ur + (dir ? U_FB : U_FF) + h * 128 + sc * 8); rv = *(const GAS v2u*)(ur + U_IB + h * 128 + cg * 64 + sc * 4); }
    for (int blk = 0; blk < T / RB; ++blk) {
        const int t0 = T0_OF(blk);
        {   LAS float* qd = qs + srow * 128 + sc * 8; LAS float* fd = fs + srow * 128 + sc * 8;
            float qv[8] = {bflo(rq.x), bfhi(rq.x), bflo(rq.y), bfhi(rq.y), bflo(rq.z), bfhi(rq.z), bflo(rq.w), bfhi(rq.w)};
            float fv[8] = {bflo(rf.x), bfhi(rf.x), bflo(rf.y), bfhi(rf.y), bflo(rf.z), bfhi(rf.z), bflo(rf.w), bfhi(rf.w)};
#pragma unroll
            for (int i = 0; i < 8; ++i) { qv[i] = qv[i] * sigm(qv[i]); fv[i] = lb[i] + (1.0f - lb[i]) * sigm(fv[i]); }
            *(LAS f32x4*)qd = (f32x4){qv[0], qv[1], qv[2], qv[3]}; *(LAS f32x4*)(qd + 4) = (f32x4){qv[4], qv[5], qv[6], qv[7]};
            *(LAS f32x4*)fd = (f32x4){fv[0], fv[1], fv[2], fv[3]}; *(LAS f32x4*)(fd + 4) = (f32x4){fv[4], fv[5], fv[6], fv[7]};
            *(LAS f32x4*)(vs + srow * 64 + sc * 4) = (f32x4){bflo(rv.x), bfhi(rv.x), bflo(rv.y), bfhi(rv.y)}; }
        __syncthreads();
        if (blk + 1 < T / RB) { const size_t row = (size_t)b * T + T0_OF(blk + 1) + srow; const bf16* ur = U + row * UW;
            rq = *(const GAS v4u*)(ur + U_QB + h * 128 + sc * 8); rf = *(const GAS v4u*)(ur + (dir ? U_FB : U_FF) + h * 128 + sc * 8); rv = *(const GAS v2u*)(ur + U_IB + h * 128 + cg * 64 + sc * 4); }
        for (int s = 0; s < RB; ++s) {
            const int tl = dir ? (RB - 1 - s) : s;
            const float v = vs[tl * 64 + colw];
            const LAS f32x4* qp = (const LAS f32x4*)(qs + tl * 128 + dg * 16); const LAS f32x4* fp = (const LAS f32x4*)(fs + tl * 128 + dg * 16);
            float o = 0.f;
#pragma unroll
            for (int j4 = 0; j4 < 4; ++j4) { const f32x4 q4 = qp[j4], f4 = fp[j4];
#pragma unroll
                for (int i = 0; i < 4; ++i) { const int j = j4 * 4 + i; S[j] = f4[i] * S[j] + (1.0f - f4[i]) * v; o += S[j] * q4[i]; } }
            o += __shfl_xor(o, 8); o += __shfl_xor(o, 16); o += __shfl_xor(o, 32);
            if (dg == 0) ob[tl * 64 + colw] = o;
        }
        __syncthreads();
        *(GAS f32x4*)(HB + ((size_t)b * T + t0 + srow) * 1024 + h * 128 + cg * 64 + sc * 4) = *(const LAS f32x4*)(ob + srow * 64 + sc * 4);
    }
    __syncthreads();
}
__device__ __forceinline__ void p3_finalize(const Frame& F, const Args& A) {
    const int lane = lane_now(), tid = F.wave * 64 + lane; (void)tid;
    const int gw = blockIdx.x * NWAVES + F.wave, NGW = F.G * NWAVES;
    const bf16* U = (const bf16*)(A.ws + WS_U); bf16* Y = (bf16*)(A.ws + WS_Y);
    const bf16* HA = (const bf16*)(A.ws + WS_HA); const bf16* HB = (const bf16*)(A.ws + WS_HB);
    f32x4 nw[8];
#pragma unroll
    for (int ps = 0; ps < 8; ++ps) nw[ps] = *(const GAS f32x4*)((ps < 4 ? A.in[I_MNORM] : A.in[I_HNORM]) + (ps & 3) * 256 + lane * 4);
    v2u ra[8], rb[8], rg[8];
#define P3_LOAD(row_) do { const size_t ro_ = (size_t)(row_) * 1024; const bf16* ur_ = U + (size_t)(row_) * UW; \
        _Pragma("unroll") for (int ps = 0; ps < 8; ++ps) { const int c = (ps & 3) * 256 + lane * 4; const bf16* hb_ = (ps < 4) ? HA : HB; \
            ra[ps] = *(const GAS v2u*)(hb_ + ro_ + c); rb[ps] = *(const GAS v2u*)(hb_ + (size_t)M * 1024 + ro_ + c); rg[ps] = *(const GAS v2u*)(ur_ + (ps < 4 ? U_OA : U_GB) + c); } } while (0)
    int row = gw; if (row < M) P3_LOAD(row);
    for (; row < M; row += NGW) {
        v2u out[8];
#pragma unroll
        for (int ps = 0; ps < 8; ++ps) { const v2u a2 = ra[ps], b2 = rb[ps], gg = rg[ps];
            const f32x4 s = (f32x4){bflo(a2.x) + bflo(b2.x), bfhi(a2.x) + bfhi(b2.x), bflo(a2.y) + bflo(b2.y), bfhi(a2.y) + bfhi(b2.y)}; float ss = (s[0] * s[0] + s[1] * s[1]) + (s[2] * s[2] + s[3] * s[3]);
            ss = (ps < 4) ? wave_sum(ss) : half_sum32(ss, lane);
            const float r = __builtin_amdgcn_rsqf(ss * (ps < 4 ? (1.0f / 256.0f) : (1.0f / 128.0f)) + RMS_EPS);
            const float g0 = bflo(gg.x), g1 = bfhi(gg.x), g2 = bflo(gg.y), g3 = bfhi(gg.y);
            float m0, m1, m2, m3;
            if (ps < 4) { m0 = sigm(g0); m1 = sigm(g1); m2 = sigm(g2); m3 = sigm(g3); } else { m0 = g0 * sigm(g0); m1 = g1 * sigm(g1); m2 = g2 * sigm(g2); m3 = g3 * sigm(g3); }
            out[ps].x = pk2(s[0] * r * nw[ps][0] * m0, s[1] * r * nw[ps][1] * m1); out[ps].y = pk2(s[2] * r * nw[ps][2] * m2, s[3] * r * nw[ps][3] * m3); }
        const int rown = row + NGW; if (rown < M) P3_LOAD(rown);
#pragma unroll
        for (int ps = 0; ps < 8; ++ps) *(GAS v2u*)AT(Y, row, ps * 256 + lane * 4, D) = out[ps];
    }
#undef P3_LOAD
}

struct LnAff { f32x4 w[8], b[8]; };
__device__ __forceinline__ LnAff ln_aff_load(const float* w, const float* bvec, int lane) { LnAff a;
#pragma unroll
    for (int j = 0; j < 8; ++j) { a.w[j] = *(const GAS f32x4*)(w + 256 * j + 4 * lane); a.b[j] = *(const GAS f32x4*)(bvec + 256 * j + 4 * lane); }
    return a; }
__device__ __forceinline__ void ln_row_regs(f32x4 (&v)[8], const LnAff& af, int lane) {
    float s = 0.f;
#pragma unroll
    for (int j = 0; j < 8; ++j) s += (v[j][0] + v[j][1]) + (v[j][2] + v[j][3]);
    const float mean = wave_sum(s) * (1.0f / D); float s2 = 0.f;
#pragma unroll
    for (int j = 0; j < 8; ++j) { v[j] = v[j] - mean; s2 += (v[j][0] * v[j][0] + v[j][1] * v[j][1]) + (v[j][2] * v[j][2] + v[j][3] * v[j][3]); }
    const float rstd = 1.0f / sqrtf(wave_sum(s2) * (1.0f / D) + LN_EPS);
#pragma unroll
    for (int j = 0; j < 8; ++j) v[j] = v[j] * rstd * af.w[j] + af.b[j];
}
__device__ __forceinline__ void store_row(const f32x4 (&v)[8], float* xf, bf16* xb, int lane) {
#pragma unroll
    for (int j = 0; j < 8; ++j) { *(GAS f32x4*)(xf + 256 * j + 4 * lane) = v[j]; v2u o; o.x = pk2(v[j][0], v[j][1]); o.y = pk2(v[j][2], v[j][3]); *(GAS v2u*)(xb + 256 * j + 4 * lane) = o; }
}

__device__ __forceinline__ void load_row_b(f32x4 (&v)[8], const bf16* xb, int lane) {
#pragma unroll
    for (int j = 0; j < 8; ++j) { const v2u w = *(const GAS v2u*)(xb + 256 * j + 4 * lane); v[j] = (f32x4){bflo(w.x), bfhi(w.x), bflo(w.y), bfhi(w.y)}; }
}
__device__ __forceinline__ void store_row_b(const f32x4 (&v)[8], bf16* xb, int lane) {
#pragma unroll
    for (int j = 0; j < 8; ++j) { v2u o; o.x = pk2(v[j][0], v[j][1]); o.y = pk2(v[j][2], v[j][3]); *(GAS v2u*)(xb + 256 * j + 4 * lane) = o; }
}
__device__ __forceinline__ void load_row_bt(f32x4 (&v)[8], const bf16* base, int row, int lane) {
#pragma unroll
    for (int j = 0; j < 8; ++j) { const v2u w = *(const GAS v2u*)AT(base, row, 256 * j + 4 * lane, D); v[j] = (f32x4){bflo(w.x), bfhi(w.x), bflo(w.y), bfhi(w.y)}; }
}
__device__ __forceinline__ void store_row_bt(const f32x4 (&v)[8], bf16* base, int row, int lane) {
#pragma unroll
    for (int j = 0; j < 8; ++j) { v2u o; o.x = pk2(v[j][0], v[j][1]); o.y = pk2(v[j][2], v[j][3]); *(GAS v2u*)AT(base, row, 256 * j + 4 * lane, D) = o; }
}
__device__ __forceinline__ void ln_phase_b(const Frame& F, const Args& A, const float* w, const float* bvec, const bf16* TB, bf16* XB) {
    const int lane = lane_now(); const int gw = blockIdx.x * NWAVES + F.wave, NGW = F.G * NWAVES;
    const LnAff af = ln_aff_load(w, bvec, lane);
    f32x4 v[8], vn[8]; int row = gw; if (row < M) load_row_b(v, TB + (size_t)row * D, lane);
    for (; row < M; row += NGW) {
        const int rn = row + NGW; if (rn < M) load_row_b(vn, TB + (size_t)rn * D, lane);
        ln_row_regs(v, af, lane); store_row_b(v, XB + (size_t)row * D, lane);
#pragma unroll
        for (int j = 0; j < 8; ++j) v[j] = vn[j]; }
}
__device__ __forceinline__ void ln_phase(const Frame& F, const Args& A, const float* w, const float* bvec, bf16* XB) {
    const int lane = lane_now(), tid = F.wave * 64 + lane; (void)tid;
    const LnAff af = ln_aff_load(w, bvec, lane);
    const int gw = blockIdx.x * NWAVES + F.wave, NGW = F.G * NWAVES;
    for (int row = gw; row < M; row += NGW) { float* xr = A.out + (size_t)row * D; f32x4 v[8];
#pragma unroll
        for (int j = 0; j < 8; ++j) v[j] = *(const GAS f32x4*)(xr + 256 * j + 4 * lane);
        ln_row_regs(v, af, lane); store_row(v, xr, XB + (size_t)row * D, lane); }
}
__device__ __forceinline__ void ln_router_phase(const Frame& F, const Args& A, const float* w, const float* bvec, bf16* XB) {
    const int lane = lane_now(), tid = F.wave * 64 + lane; (void)tid;
    const LnAff af = ln_aff_load(w, bvec, lane);
    LAS int* cnt = (LAS int*)(F.lds + RING_OFF);
    int* TOKE = (int*)(A.ws + WS_TOKE); float* TOKG = (float*)(A.ws + WS_TOKG); int* WGCNT = (int*)(A.ws + WS_WGCNT);
    const float* wr = A.in[I_WR]; const float* br = A.in[I_BR];
    LAS f32x4* wt = (LAS f32x4*)(F.lds + RING_OFF + 1024);
    for (int x = tid; x < 2048 * 2; x += NWAVES * 64) { const int col = x >> 1, half = x & 1; const int j = col >> 8, ln = (col & 255) >> 2, i = col & 3;
        wt[((j * 4 + i) * 2 + half) * 64 + ln] = *(const GAS f32x4*)(wr + (size_t)col * NE + 4 * half); }
    for (int vb = blockIdx.x; vb < M / 64; vb += F.G) {
        if (tid < 8) cnt[tid] = 0;
        __syncthreads();
        f32x4 v[8], vn[8];
        { const float* xr0 = A.out + (size_t)(vb * 64 + F.wave * 8) * D;
#pragma unroll
          for (int j = 0; j < 8; ++j) v[j] = *(const GAS f32x4*)(xr0 + 256 * j + 4 * lane); }
        for (int k = 0; k < 8; ++k) { const int row = vb * 64 + F.wave * 8 + k;
            if (k + 1 < 8) { const float* xn = A.out + (size_t)(row + 1) * D;
#pragma unroll
                for (int j = 0; j < 8; ++j) vn[j] = *(const GAS f32x4*)(xn + 256 * j + 4 * lane); }
            ln_row_regs(v, af, lane); store_row_b(v, XB + (size_t)row * D, lane);
            float lg[8];
#pragma unroll
            for (int e = 0; e < 8; ++e) lg[e] = 0.f;
#pragma unroll
            for (int j = 0; j < 8; ++j)
#pragma unroll
                for (int i = 0; i < 4; ++i) { const f32x4 w0 = wt[((j * 4 + i) * 2 + 0) * 64 + lane], w1 = wt[((j * 4 + i) * 2 + 1) * 64 + lane]; const float xv = v[j][i];
                    lg[0] += xv * w0[0]; lg[1] += xv * w0[1]; lg[2] += xv * w0[2]; lg[3] += xv * w0[3]; lg[4] += xv * w1[0]; lg[5] += xv * w1[1]; lg[6] += xv * w1[2]; lg[7] += xv * w1[3]; }
#pragma unroll
            for (int e = 0; e < 8; ++e) lg[e] = wave_sum(lg[e]) + br[e];
            int e1 = 0; float l1 = lg[0];
#pragma unroll
            for (int e = 1; e < 8; ++e) if (lg[e] > l1) { l1 = lg[e]; e1 = e; }
            int e2 = -1; float l2 = -3.0e38f;
#pragma unroll
            for (int e = 0; e < 8; ++e) if (e != e1 && lg[e] > l2) { l2 = lg[e]; e2 = e; }
            const float g2 = 1.0f / (1.0f + __expf(l1 - l2)), g1 = 1.0f - g2;
            if (lane == 0) { TOKE[2 * row] = e1; TOKE[2 * row + 1] = e2; TOKG[2 * row] = g1; TOKG[2 * row + 1] = g2; __hip_atomic_fetch_add(&cnt[e1], 1, __ATOMIC_RELAXED, __HIP_MEMORY_SCOPE_WORKGROUP); __hip_atomic_fetch_add(&cnt[e2], 1, __ATOMIC_RELAXED, __HIP_MEMORY_SCOPE_WORKGROUP); }
#pragma unroll
            for (int j = 0; j < 8; ++j) v[j] = vn[j];
        }
        __syncthreads();
        if (tid < 8) WGCNT[vb * 8 + tid] = cnt[tid];
        __syncthreads();
    }
}
__device__ __forceinline__ int inv_slot(int d) { const int rr = d & 127; return (((d >> 7) * 64 + (rr & 63)) << 1) + (rr >> 6); }
__device__ __forceinline__ void moe_route_phase(const Frame& F, const Args& A) {
    const int lane = lane_now(), tid = F.wave * 64 + lane; (void)lane;
    LAS int* sm = (LAS int*)(F.lds + RING_OFF);
    const int* TOKE = (const int*)(A.ws + WS_TOKE); int* DEST = (int*)(A.ws + WS_DEST); const int* WGCNT = (const int*)(A.ws + WS_WGCNT); int* TILEE = (int*)(A.ws + WS_TILEE); unsigned short* INV = (unsigned short*)(A.ws + WS_INV);
    for (int vb = blockIdx.x; vb < M / 64; vb += F.G) {
        if (tid < 16) sm[tid] = 0;
        if (tid >= 64 && tid < 192) sm[32 + tid - 64] = TOKE[vb * 128 + tid - 64];
        __syncthreads();
        {   const int e = tid & 7, wq = tid >> 3; int tot = 0, pre = 0;
#pragma unroll
            for (int i = 0; i < 4; ++i) { const int w = wq * 4 + i; const int c = WGCNT[w * 8 + e]; tot += c; pre += (w < vb) ? c : 0; }
            __hip_atomic_fetch_add(&sm[e], tot, __ATOMIC_RELAXED, __HIP_MEMORY_SCOPE_WORKGROUP); __hip_atomic_fetch_add(&sm[8 + e], pre, __ATOMIC_RELAXED, __HIP_MEMORY_SCOPE_WORKGROUP); }
        __syncthreads();
        if (tid == 0) { int base = 0; for (int e = 0; e < 8; ++e) { sm[16 + e] = base; base += ((sm[e] + 255) >> 8) << 8; }
            if (vb == 0) { int rt = 0; for (int e = 0; e < 8; ++e) { const int nt = (sm[e] + 255) >> 8; for (int i = 0; i < nt; ++i) TILEE[1 + rt++] = e; } TILEE[0] = rt; } }
        __syncthreads();
        if (tid < 128) { const int e = sm[32 + tid]; int rank = 0; for (int s = 0; s < tid; ++s) rank += (sm[32 + s] == e) ? 1 : 0; const int d = sm[16 + e] + sm[8 + e] + rank; DEST[vb * 128 + tid] = d; INV[inv_slot(d)] = (unsigned short)(vb * 64 + (tid >> 1)); }
        if (vb == 0) { for (int e = 0; e < 8; ++e) { const int tot = sm[e], pad = ((tot + 255) >> 8) << 8, base = sm[16 + e]; for (int i = tot + tid; i < pad; i += NWAVES * 64) INV[inv_slot(base + i)] = 0; } }
        __syncthreads();
    }
}
__device__ __forceinline__ void ln_moe_phase(const Frame& F, const Args& A, const float* w, const float* bvec, const bf16* XBin, bf16* XBout) {
    const int lane = lane_now(); const int gw = blockIdx.x * NWAVES + F.wave, NGW = F.G * NWAVES;
    const LnAff af = ln_aff_load(w, bvec, lane);
    const float* TOKG = (const float*)(A.ws + WS_TOKG); const int* DEST = (const int*)(A.ws + WS_DEST); const bf16* YS = (const bf16*)(A.ws + WS_YS);
    const bf16* PARTB = (const bf16*)(A.ws + WS_PART);
    f32x4 v[8], y1[8], y2[8]; int row = gw; int d1 = 0, d2 = 0; float g1 = 0.f, g2 = 0.f;
    if (row < M) { d1 = DEST[2 * row]; d2 = DEST[2 * row + 1]; g1 = TOKG[2 * row]; g2 = TOKG[2 * row + 1]; }
#define LD_YROW(dst, d_) do { if ((d_) < pg8::TAIL_PM0 * 256) load_row_b(dst, YS + (size_t)(d_) * D, lane); else { const bf16* pb_ = PARTB + (size_t)((d_) - pg8::TAIL_PM0 * 256) * D; \
          \
        _Pragma("unroll") for (int hb_ = 0; hb_ < 2; ++hb_) { v2u r_[4][8]; \
            _Pragma("unroll") for (int q_ = 0; q_ < 4; ++q_) _Pragma("unroll") for (int j = 0; j < 8; ++j) r_[q_][j] = *(const GAS v2u*)(pb_ + (size_t)(4 * hb_ + q_) * pg8::TAIL_ROWS * D + 256 * j + 4 * lane); \
            _Pragma("unroll") for (int q_ = 0; q_ < 4; ++q_) _Pragma("unroll") for (int j = 0; j < 8; ++j) { const f32x4 t_ = (f32x4){bflo(r_[q_][j].x), bfhi(r_[q_][j].x), bflo(r_[q_][j].y), bfhi(r_[q_][j].y)}; \
                dst[j] = (hb_ == 0 && q_ == 0) ? t_ : dst[j] + t_; } } } } while (0)
    for (; row < M; row += NGW) {
        load_row_b(v, XBin + (size_t)row * D, lane); LD_YROW(y1, d1); LD_YROW(y2, d2);
        const float cg1 = g1, cg2 = g2; const int rn = row + NGW;
        if (rn < M) { d1 = DEST[2 * rn]; d2 = DEST[2 * rn + 1]; g1 = TOKG[2 * rn]; g2 = TOKG[2 * rn + 1]; }
#pragma unroll
        for (int j = 0; j < 8; ++j) v[j] = v[j] * ALPHA + y1[j] * cg1 + y2[j] * cg2;
        ln_row_regs(v, af, lane); store_row_b(v, XBout + (size_t)row * D, lane); }
#undef LD_YROW
}

__device__ __forceinline__ void na_phase_simple(const Frame& F, const Args& A) {
    const int lane = lane_now(), tid = F.wave * 64 + lane; (void)tid;
    const int gw = blockIdx.x * NWAVES + F.wave, NGW = F.G * NWAVES;
    const bf16* QKV = (const bf16*)(A.ws + WS_QKV); bf16* AO = (bf16*)(A.ws + WS_AO); const float* rpb = A.in[I_RPB];
    const float scale = 0.08838834764831845f;
    for (int task = gw; task < M * 16; task += NGW) {
        const int tok = task >> 4, h = task & 15, b = tok >> 12, r = (tok >> 6) & 63, c = tok & 63;
        const int rs = min(max(r - 4, 0), 56), cs = min(max(c - 8, 0), 48);
        const GAS v4u* qp = (const GAS v4u*)(QKV + (size_t)tok * NQKV + h * 128);
        float sc[2];
#pragma unroll
        for (int i = 0; i < 2; ++i) { const int kk = lane + 64 * i, jr = kk >> 4, jc = kk & 15; const int ktok = b * T + (rs + jr) * 64 + cs + jc;
            const GAS v4u* kp = (const GAS v4u*)(QKV + (size_t)ktok * NQKV + D + h * 128); float acc = 0.f;
#pragma unroll 4
            for (int j = 0; j < 16; ++j) { const v4u q = qp[j], k = kp[j];
                acc += bflo(q.x) * bflo(k.x) + bfhi(q.x) * bfhi(k.x) + bflo(q.y) * bflo(k.y) + bfhi(q.y) * bfhi(k.y) + bflo(q.z) * bflo(k.z) + bfhi(q.z) * bfhi(k.z) + bflo(q.w) * bflo(k.w) + bfhi(q.w) * bfhi(k.w); }
            sc[i] = acc * scale + rpb[(h * 15 + (rs + jr - r + 7)) * 31 + (cs + jc - c + 15)]; }
        const float mx = wave_max(fmaxf(sc[0], sc[1]));
        const float p0 = __expf(sc[0] - mx), p1 = __expf(sc[1] - mx);
        const float inv = 1.0f / wave_sum(p0 + p1);
        float a0 = 0.f, a1 = 0.f;
        const bf16* vbase = QKV + 2 * D + h * 128 + 2 * lane;
#pragma unroll
        for (int i = 0; i < 2; ++i) { const float pi = i ? p1 : p0;
#pragma unroll 8
            for (int l = 0; l < 64; ++l) { const int kk = l + 64 * i, jr = kk >> 4, jc = kk & 15; const int ktok = b * T + (rs + jr) * 64 + cs + jc;
                const float pk = __builtin_bit_cast(float, __builtin_amdgcn_readlane(__builtin_bit_cast(int, pi), l));
                const unsigned vv = *(const GAS unsigned*)(vbase + (size_t)ktok * NQKV); a0 += pk * bflo(vv); a1 += pk * bfhi(vv); } }
        *(GAS unsigned*)(AO + (size_t)tok * D + h * 128 + 2 * lane) = pk2(a0 * inv, a1 * inv);
    }
}
constexpr int NA_VP = 288, NA_KP = 272;
__device__ __forceinline__ void na_phase_mfma(const Frame& F, const Args& A) {
    const int lane = lane_now(), tid = F.wave * 64 + lane, i = lane & 15, fq = lane >> 4;
    const bf16* QKV = (const bf16*)(A.ws + WS_QKV); bf16* AO = (bf16*)(A.ws + WS_AO); const float* rpb = A.in[I_RPB];
    LAS unsigned char* vl = F.lds + RING_OFF;
    LAS float* rp = (LAS float*)(F.lds + RING_OFF + 5 * 64 * NA_VP);
    const int qsel = F.wave >> 2, qi = F.wave & 3, wc = min(max(16 * qi - 8, 0), 32);
    const int qc = 16 * qi + i, cs = min(max(qc - 8, 0), 48);
    const float scale = 0.08838834764831845f;
    const int q4 = (lane & 15) >> 2, p4 = lane & 3;
    v4u vreg[10];
#define NA_LOAD(NR, row0, moff, tokb_, h_) do { _Pragma("unroll") for (int k = 0; k < 2 * (NR); ++k) { const int ch = tid + 512 * k, row = ch >> 10, key = (ch >> 4) & 63, c16 = ch & 15; const int vr = min((row0) + row, 63); \
        vreg[k] = *(const GAS v4u*)(QKV + (size_t)(moff) * ((size_t)M * D) + ((tokb_) + vr * 64 + key) * 128 + c16 * 8); } } while (0)
#define NA_STORE(NR, pitch) do { _Pragma("unroll") for (int k = 0; k < 2 * (NR); ++k) { const int ch = tid + 512 * k, row = ch >> 10, key = (ch >> 4) & 63, c16 = ch & 15; *(LAS v4u*)(vl + (row * 64 + key) * (pitch) + c16 * 16) = vreg[k]; } } while (0)
    const int upw = (64 * 32 + F.G - 1) / F.G; int unit = blockIdx.x * upw; const int unit_end = min(unit + upw, 64 * 32);
    if (unit < 64 * 32) { const int rpi = unit & 31, bh = unit >> 5, h = bh & 15, b = bh >> 4; const int R0 = min(max(2 * rpi - 4, 0), 56); NA_LOAD(5, R0, 1, (size_t)(b * 16 + h) * T, h); }
    int hprev = -1;
    for (; unit < unit_end; unit += 1) {
        const int rpi = unit & 31, bh = unit >> 5, h = bh & 15, b = bh >> 4;
        const int r0 = 2 * rpi, qrow = r0 + qsel, R0 = min(max(r0 - 4, 0), 56), rsw = min(max(qrow - 4, 0), 56);
        const size_t tokb = (size_t)b * T, hrow = (size_t)(b * 16 + h) * T;
        bf16x8 bq[4];
        { const bf16* qp = QKV + (hrow + qrow * 64 + qc) * 128 + 8 * fq;
#pragma unroll
          for (int kk = 0; kk < 4; ++kk) bq[kk] = *(const GAS bf16x8*)(qp + 32 * kk); }
        __syncthreads();
        if (h != hprev) { if (tid < 465) rp[tid] = rpb[h * 465 + tid]; hprev = h; }
        NA_STORE(5, NA_KP); NA_LOAD(4, R0 + 5, 1, hrow, h);
        __syncthreads();
        f32x4 acc[16];
#pragma unroll
        for (int kt = 0; kt < 16; ++kt) acc[kt] = (f32x4){0.f, 0.f, 0.f, 0.f};
        LAS unsigned char* kb0 = vl + (wc + i) * NA_KP + 16 * fq;
#pragma unroll
        for (int jr = 0; jr < 8; ++jr) { const int la = rsw + jr - R0;
            if (la <= 4) { LAS unsigned char* kp = kb0 + la * 64 * NA_KP;
                bf16x8 ka[2][4];
#pragma unroll
                for (int kb2 = 0; kb2 < 2; ++kb2)
#pragma unroll
                    for (int kk = 0; kk < 4; ++kk) ka[kb2][kk] = *(const LAS bf16x8*)(kp + 16 * kb2 * NA_KP + 64 * kk);
#pragma unroll
                for (int kb2 = 0; kb2 < 2; ++kb2)
#pragma unroll
                    for (int kk = 0; kk < 4; ++kk) acc[2 * jr + kb2] = __builtin_amdgcn_mfma_f32_16x16x32_bf16(ka[kb2][kk], bq[kk], acc[2 * jr + kb2], 0, 0, 0); } }
        __syncthreads();
        NA_STORE(4, NA_KP); NA_LOAD(5, R0, 2, hrow, h);
        __syncthreads();
#pragma unroll
        for (int jr = 0; jr < 8; ++jr) { const int la = rsw + jr - R0 - 5;
            if (la >= 0) { LAS unsigned char* kp = kb0 + la * 64 * NA_KP;
                bf16x8 ka[2][4];
#pragma unroll
                for (int kb2 = 0; kb2 < 2; ++kb2)
#pragma unroll
                    for (int kk = 0; kk < 4; ++kk) ka[kb2][kk] = *(const LAS bf16x8*)(kp + 16 * kb2 * NA_KP + 64 * kk);
#pragma unroll
                for (int kb2 = 0; kb2 < 2; ++kb2)
#pragma unroll
                    for (int kk = 0; kk < 4; ++kk) acc[2 * jr + kb2] = __builtin_amdgcn_mfma_f32_16x16x32_bf16(ka[kb2][kk], bq[kk], acc[2 * jr + kb2], 0, 0, 0); } }
        float mx = -3.0e38f;
#pragma unroll
        for (int kt = 0; kt < 16; ++kt) { const int jr = kt >> 1, kb2 = kt & 1; const int dr = rsw + jr - qrow + 7;
#pragma unroll
            for (int r = 0; r < 4; ++r) { const int kc = wc + 16 * kb2 + 4 * fq + r; const int dc = min(max(kc - qc + 15, 0), 30); const bool ok = (kc >= cs) && (kc < cs + 16);
                const float s = ok ? acc[kt][r] * scale + rp[dr * 31 + dc] : -3.0e38f; acc[kt][r] = s; mx = fmaxf(mx, s); } }
        mx = fmaxf(mx, __shfl_xor(mx, 16)); mx = fmaxf(mx, __shfl_xor(mx, 32));
        float sum = 0.f;
#pragma unroll
        for (int kt = 0; kt < 16; ++kt)
#pragma unroll
            for (int r = 0; r < 4; ++r) { const float p = __expf(acc[kt][r] - mx); acc[kt][r] = p; sum += p; }
        sum += __shfl_xor(sum, 16); sum += __shfl_xor(sum, 32);
        const float inv = 1.0f / sum;
        bf16x8 pb[8];
#pragma unroll
        for (int ks = 0; ks < 8; ++ks) { v4u w; w.x = cvtpk(acc[2 * ks][0], acc[2 * ks][1]); w.y = cvtpk(acc[2 * ks][2], acc[2 * ks][3]); w.z = cvtpk(acc[2 * ks + 1][0], acc[2 * ks + 1][1]); w.w = cvtpk(acc[2 * ks + 1][2], acc[2 * ks + 1][3]);
            pb[ks] = __builtin_bit_cast(bf16x8, w); }
        __syncthreads();
        NA_STORE(5, NA_VP); NA_LOAD(4, R0 + 5, 2, hrow, h);
        __syncthreads();
        f32x4 o[8];
#pragma unroll
        for (int db = 0; db < 8; ++db) o[db] = (f32x4){0.f, 0.f, 0.f, 0.f};
        LAS unsigned char* vb0 = vl + (wc + 4 * fq + q4) * NA_VP + 8 * p4;
#pragma unroll
        for (int jr = 0; jr < 8; ++jr) { const int la = rsw + jr - R0;
            if (la <= 4) { LAS unsigned char* vp = vb0 + la * 64 * NA_VP;
                s16x4 x0[8], x1[8];
#pragma unroll
                for (int db = 0; db < 8; ++db) { x0[db] = lds_tr(vp + 32 * db); x1[db] = lds_tr(vp + 16 * NA_VP + 32 * db); }
#pragma unroll
                for (int db = 0; db < 8; ++db) { const bf16x8 a = (bf16x8){x0[db][0], x0[db][1], x0[db][2], x0[db][3], x1[db][0], x1[db][1], x1[db][2], x1[db][3]};
                    o[db] = __builtin_amdgcn_mfma_f32_16x16x32_bf16(a, pb[jr], o[db], 0, 0, 0); } } }
        __syncthreads();
        NA_STORE(4, NA_VP);
        { const int un = unit + 1; if (un < unit_end) { const int rpn = un & 31, bhn = un >> 5, hn = bhn & 15, bn = bhn >> 4; const int R0n = min(max(2 * rpn - 4, 0), 56); NA_LOAD(5, R0n, 1, (size_t)(bn * 16 + hn) * T, hn); } }
        __syncthreads();
#pragma unroll
        for (int jr = 0; jr < 8; ++jr) { const int la = rsw + jr - R0 - 5;
            if (la >= 0) { LAS unsigned char* vp = vb0 + la * 64 * NA_VP;
                s16x4 x0[8], x1[8];
#pragma unroll
                for (int db = 0; db < 8; ++db) { x0[db] = lds_tr(vp + 32 * db); x1[db] = lds_tr(vp + 16 * NA_VP + 32 * db); }
#pragma unroll
                for (int db = 0; db < 8; ++db) { const bf16x8 a = (bf16x8){x0[db][0], x0[db][1], x0[db][2], x0[db][3], x1[db][0], x1[db][1], x1[db][2], x1[db][3]};
                    o[db] = __builtin_amdgcn_mfma_f32_16x16x32_bf16(a, pb[jr], o[db], 0, 0, 0); } } }
        const int orow = (int)(tokb + qrow * 64 + qc);
#pragma unroll
        for (int db = 0; db < 8; ++db) { v2u w; w.x = cvtpk(o[db][0] * inv, o[db][1] * inv); w.y = cvtpk(o[db][2] * inv, o[db][3] * inv); *(GAS v2u*)AT(AO, orow, h * 128 + 16 * db + 4 * fq, D) = w; }
    }
#undef NA_LOAD
#undef NA_STORE
    __syncthreads();
}
__device__ __forceinline__ float wave_scan_incl(float v, int lane) {
#pragma unroll
    for (int off = 1; off < 64; off <<= 1) { const float t = __shfl_up(v, off); if (lane >= off) v += t; }
    return v;
}
__device__ __forceinline__ void rec_prep(const Frame& F, const Args& A) {
    const int lane = lane_now(); const int gw = blockIdx.x * NWAVES + F.wave, NGW = F.G * NWAVES;
    const bf16* U = (const bf16*)(A.ws + WS_U); const float* Gt = (const float*)(A.ws + WS_G);
    bf16* QIN = (bf16*)(A.ws + WS_QIN); bf16* KIN = (bf16*)(A.ws + WS_KIN); float* GTAB = (float*)(A.ws + WS_GTAB);
    float* EQM = (float*)(A.ws + WS_EQM); float* EKM = (float*)(A.ws + WS_EKM); float* GTABM = (float*)(A.ws + WS_GTABM);
    for (int item = gw; item < 2048; item += NGW) {
        const int c = item & 63, dir = (item >> 6) & 1, h = (item >> 7) & 3, b = item >> 9;
        const size_t tk = (size_t)b * T + (dir ? (T - 1 - (64 * c + lane)) : (64 * c + lane));
        const float bias_i = A.in[I_GBIAS][(dir ? 2 : 0) * 4 + h], bias_f = A.in[I_GBIAS][(dir ? 3 : 1) * 4 + h];
        const float pi_ = Gt[tk * 16 + (dir ? 2 : 0) * 4 + h] + Gt[(size_t)M * 16 + tk * 16 + (dir ? 2 : 0) * 4 + h], pf_ = Gt[tk * 16 + (dir ? 3 : 1) * 4 + h] + Gt[(size_t)M * 16 + tk * 16 + (dir ? 3 : 1) * 4 + h];
        const float gi = GATE_CAP * tanhf((pi_ + bias_i) * (1.0f / GATE_CAP)), gf = GATE_CAP * tanhf((pf_ + bias_f) * (1.0f / GATE_CAP));
        const float lf = -log1pf(__expf(-gf)); const float bb = wave_scan_incl(lf, lane);
        const float gg = __builtin_bit_cast(float, __builtin_amdgcn_readlane(__builtin_bit_cast(int, bb), 63));
        const float eq = 0.08838834764831845f * __expf(bb), ek = __expf(gi - bb);
        GTABM[(size_t)item * 128 + lane] = gg; GTABM[(size_t)item * 128 + 64 + lane] = gg;
        EQM[(size_t)item * 64 + lane] = eq; EKM[(size_t)item * 64 + lane] = ek;
    }
    for (int item = gw; item < 4096; item += NGW) {
        const int c = item & 63, dir = (item >> 6) & 1, h = (item >> 7) & 7, b = item >> 10;
        const int ch = h * 128 + 2 * lane;
        const float l00 = A.in[I_LBLOG][(dir * 2 + 0) * 1024 + ch], l01 = A.in[I_LBLOG][(dir * 2 + 1) * 1024 + ch], l10 = A.in[I_LBLOG][(dir * 2 + 0) * 1024 + ch + 1], l11 = A.in[I_LBLOG][(dir * 2 + 1) * 1024 + ch + 1];
        const float lb0 = 1.0f / (1.0f + __expf(l01 - l00)), lb1 = 1.0f / (1.0f + __expf(l11 - l10));
        float pr0 = 1.f, pr1 = 1.f;
        for (int tb = 0; tb < 64; tb += 16) {
            unsigned qw[16], fw[16];
#pragma unroll
            for (int u = 0; u < 16; ++u) { const int tau = tb + u; const size_t tk = (size_t)b * T + (dir ? (T - 1 - (64 * c + tau)) : (64 * c + tau));
                qw[u] = *(const GAS unsigned*)(U + tk * UW + U_QB + ch); fw[u] = *(const GAS unsigned*)(U + tk * UW + (dir ? U_FB : U_FF) + ch); }
#pragma unroll
            for (int u = 0; u < 16; ++u) { const int tau = tb + u; const int tl = dir ? (T - 1 - (64 * c + tau)) : (64 * c + tau);
                const float q0 = bflo(qw[u]), q1 = bfhi(qw[u]);
                const float f0 = lb0 + (1.0f - lb0) * sigm(bflo(fw[u])), f1 = lb1 + (1.0f - lb1) * sigm(bfhi(fw[u]));
                pr0 *= f0; pr1 *= f1;
                const size_t o = ((size_t)(((dir * 4 + b) * 8 + h)) * T + tl) * 128 + 2 * lane;
                *(GAS unsigned*)(QIN + o) = cvtpk(q0 * sigm(q0) * pr0, q1 * sigm(q1) * pr1);
                *(GAS unsigned*)(KIN + o) = cvtpk((1.0f - f0) * __builtin_amdgcn_rcpf(pr0), (1.0f - f1) * __builtin_amdgcn_rcpf(pr1)); }
        }
        *(GAS f32x2*)(GTAB + (size_t)item * 128 + 2 * lane) = (f32x2){__logf(pr0), __logf(pr1)};
    }
}

__device__ __forceinline__ void gates_mfma(const Frame& F, const Args& A) {
    const int lane = lane_now(), i = lane & 15, fq = lane >> 4; const int gw = blockIdx.x * NWAVES + F.wave, NGW = F.G * NWAVES;
    const bf16* X = (const bf16*)(A.ws + WS_XB0); const bf16* Wg = (const bf16*)(A.ws + WS_WGATE);
    float* Gt = (float*)(A.ws + WS_G);
    for (int it = gw; it < 2 * (M / 16); it += NGW) { const int blk = it % (M / 16), kh = it / (M / 16);
        const bf16* wp = Wg + (size_t)i * D + 8 * fq; const int xrow = 16 * blk + i;
        f32x4 acc0 = (f32x4){0.f, 0.f, 0.f, 0.f}, acc1 = (f32x4){0.f, 0.f, 0.f, 0.f};
#pragma unroll 8
        for (int kk = kh * (D / 64); kk < (kh + 1) * (D / 64); kk += 2) {
            const bf16x8 a0 = *(const GAS bf16x8*)(wp + 32 * kk), b0 = *(const GAS bf16x8*)(X + (size_t)xrow * D + 32 * kk + 8 * fq), a1 = *(const GAS bf16x8*)(wp + 32 * kk + 32), b1 = *(const GAS bf16x8*)(X + (size_t)xrow * D + 32 * kk + 32 + 8 * fq);
            acc0 = __builtin_amdgcn_mfma_f32_16x16x32_bf16(a0, b0, acc0, 0, 0, 0); acc1 = __builtin_amdgcn_mfma_f32_16x16x32_bf16(a1, b1, acc1, 0, 0, 0);
        }
        *(GAS f32x4*)(Gt + (size_t)kh * M * 16 + (size_t)(16 * blk + i) * 16 + 4 * fq) = acc0 + acc1;
    }
}
constexpr int RQ_P = 272;
template <int NEB> struct RecMap {
    static constexpr int VP = NEB * 32 + 8, Q = 0, K = 17408, V = 34816, TB = V + 64 * VP, EQ = TB + 512, PAR = EQ + 256, SB = 2 * PAR, SBSZ = 128 * VP;
    static_assert(TB % 16 == 0 && PAR % 16 == 0 && SB + 2 * SBSZ <= RING_BYTES, "recurrence LDS map");
};
struct RecP { const bf16* qin; const bf16* kin;
              const bf16* vsrc;
              const float* gtab;
              bf16* out;
              int b, dir;
              int qs;
              const float* eq; const float* ek; };

template <int NEB>
__device__ __forceinline__ void rec_compute(int wave, int lane, LAS unsigned char* P, LAS unsigned char* SBc, LAS unsigned char* SBn, f32x4 (&Sst)[NEB][2], bf16* outrow  ) {
    typedef RecMap<NEB> Mp;
    const int i = lane & 15, fq = lane >> 4, q4 = i >> 2, p4 = lane & 3;
#define RC_TR2(dst, ptr, step) do { const s16x4 x0_ = lds_tr(ptr), x1_ = lds_tr((ptr) + (step)); dst = (bf16x8){x0_[0], x0_[1], x0_[2], x0_[3], x1_[0], x1_[1], x1_[2], x1_[3]}; } while (0)
    if (wave < 4) {
        __builtin_amdgcn_s_setprio(2);
        const int tbk = wave;
        bf16x8 qf[4], sf[4][NEB], kf[4][4], vf[2][NEB];
#pragma unroll
        for (int kk = 0; kk < 4; ++kk) qf[kk] = *(const LAS bf16x8*)(P + Mp::Q + (16 * tbk + i) * RQ_P + (32 * kk + 8 * fq) * 2);
#pragma unroll
        for (int kk = 0; kk < 4; ++kk)
#pragma unroll
            for (int eb = 0; eb < NEB; ++eb) RC_TR2(sf[kk][eb], SBc + (32 * kk + 8 * fq + q4) * Mp::VP + (16 * eb + 4 * p4) * 2, 4 * Mp::VP);
#pragma unroll
        for (int sb = 0; sb < 2; ++sb) if (sb <= tbk) {
#pragma unroll
            for (int kk = 0; kk < 4; ++kk) kf[sb][kk] = *(const LAS bf16x8*)(P + Mp::K + (16 * sb + i) * RQ_P + (32 * kk + 8 * fq) * 2); }
        f32x4 o[NEB];
#pragma unroll
        for (int eb = 0; eb < NEB; ++eb) o[eb] = (f32x4){0.f, 0.f, 0.f, 0.f};
#pragma unroll
        for (int kk = 0; kk < 4; ++kk)
#pragma unroll
            for (int eb = 0; eb < NEB; ++eb) o[eb] = __builtin_amdgcn_mfma_f32_16x16x32_bf16(sf[kk][eb], qf[kk], o[eb], 0, 0, 0);
        asm volatile("" ::: "memory");
#pragma unroll
        for (int sb = 2; sb < 4; ++sb) if (sb <= tbk) {
#pragma unroll
            for (int kk = 0; kk < 4; ++kk) kf[sb][kk] = *(const LAS bf16x8*)(P + Mp::K + (16 * sb + i) * RQ_P + (32 * kk + 8 * fq) * 2); }
#pragma unroll
        for (int ks = 0; ks < 2; ++ks) if (2 * ks <= tbk) {
#pragma unroll
            for (int eb = 0; eb < NEB; ++eb) RC_TR2(vf[ks][eb], P + Mp::V + (32 * ks + 4 * fq + q4) * Mp::VP + (16 * eb + 4 * p4) * 2, 16 * Mp::VP); }
        f32x4 pt[4];
#pragma unroll
        for (int sb = 0; sb < 4; ++sb) { pt[sb] = (f32x4){0.f, 0.f, 0.f, 0.f};
            if (sb <= tbk) { f32x4 acc = (f32x4){0.f, 0.f, 0.f, 0.f};
#pragma unroll
                for (int kk = 0; kk < 4; ++kk) acc = __builtin_amdgcn_mfma_f32_16x16x32_bf16(kf[sb][kk], qf[kk], acc, 0, 0, 0);
#pragma unroll
                for (int r = 0; r < 4; ++r) { const bool ok = (sb < tbk) || (4 * fq + r <= i); pt[sb][r] = ok ? acc[r] : 0.f; } } }
#pragma unroll
        for (int ks = 0; ks < 2; ++ks) if (2 * ks <= tbk) {
            v4u w; w.x = cvtpk(pt[2 * ks][0], pt[2 * ks][1]); w.y = cvtpk(pt[2 * ks][2], pt[2 * ks][3]); w.z = cvtpk(pt[2 * ks + 1][0], pt[2 * ks + 1][1]); w.w = cvtpk(pt[2 * ks + 1][2], pt[2 * ks + 1][3]);
            const bf16x8 pf = __builtin_bit_cast(bf16x8, w);
#pragma unroll
            for (int eb = 0; eb < NEB; ++eb) o[eb] = __builtin_amdgcn_mfma_f32_16x16x32_bf16(vf[ks][eb], pf, o[eb], 0, 0, 0); }
        bf16* hp = outrow + 4 * fq; float rden = 1.0f;
        if (NEB == 3) { const float eqt = ((const LAS float*)(P + Mp::EQ))[16 * tbk + i]; const float den = __shfl(o[NEB - 1][0], i) * eqt; rden = __builtin_amdgcn_rcpf(fmaxf(fabsf(den), 1.0f)) * eqt; }
        { v2u w; w.x = cvtpk(o[0][0] * rden, o[0][1] * rden); w.y = cvtpk(o[0][2] * rden, o[0][3] * rden); *(GAS v2u*)(hp) = w; w.x = cvtpk(o[1][0] * rden, o[1][1] * rden); w.y = cvtpk(o[1][2] * rden, o[1][3] * rden); *(GAS v2u*)(hp + 16) = w; }
        __builtin_amdgcn_s_setprio(0);
    } else {
        const int wq = wave - 4;
        bf16x8 af[2][NEB], bfr[2][2];
#pragma unroll
        for (int ks = 0; ks < 2; ++ks) {
#pragma unroll
            for (int eb = 0; eb < NEB; ++eb) RC_TR2(af[ks][eb], P + Mp::V + (32 * ks + 8 * fq + q4) * Mp::VP + (16 * eb + 4 * p4) * 2, 4 * Mp::VP);
#pragma unroll
            for (int dbi = 0; dbi < 2; ++dbi) RC_TR2(bfr[ks][dbi], P + Mp::K + (32 * ks + 8 * fq + q4) * RQ_P + (16 * (2 * wq + dbi) + 4 * p4) * 2, 4 * RQ_P); }
        float eg[2];
#pragma unroll
        for (int dbi = 0; dbi < 2; ++dbi) eg[dbi] = __expf(((const LAS float*)(P + Mp::TB))[16 * (2 * wq + dbi) + i]);
#pragma unroll
        for (int ks = 0; ks < 2; ++ks)
#pragma unroll
            for (int eb = 0; eb < NEB; ++eb)
#pragma unroll
                for (int dbi = 0; dbi < 2; ++dbi) Sst[eb][dbi] = __builtin_amdgcn_mfma_f32_16x16x32_bf16(af[ks][eb], bfr[ks][dbi], Sst[eb][dbi], 0, 0, 0);
#pragma unroll
        for (int dbi = 0; dbi < 2; ++dbi)
#pragma unroll
            for (int eb = 0; eb < NEB; ++eb) { Sst[eb][dbi] = Sst[eb][dbi] * eg[dbi]; v2u o; o.x = cvtpk(Sst[eb][dbi][0], Sst[eb][dbi][1]); o.y = cvtpk(Sst[eb][dbi][2], Sst[eb][dbi][3]);
                *(LAS v2u*)(SBn + (16 * (2 * wq + dbi) + i) * Mp::VP + (16 * eb + 4 * fq) * 2) = o; }
    }
#undef RC_TR2
}
template <int NEB>
__device__ __forceinline__ void rec_unit(const Frame& F, const RecP R) {
    typedef RecMap<NEB> Mp;
    const int lane = lane_now(), tid = F.wave * 64 + lane;
    LAS unsigned char* L = F.lds + RING_OFF;
    const int b = R.b, dir = R.dir;
#define RC_T(c, tau) (dir ? (T - 1 - (64 * (c) + (tau))) : (64 * (c) + (tau)))
#define RC_TOK(c, tau) ((size_t)b * T + RC_T(c, tau))
    for (int x = tid; x < Mp::SBSZ / 4; x += NWAVES * 64) ((LAS unsigned*)(L + Mp::SB))[x] = 0u;
    if (NEB == 3 && tid < 128) { LAS unsigned char* vr = L + (tid >> 6) * Mp::PAR + Mp::V + (tid & 63) * Mp::VP + 64;
        *(LAS unsigned short*)(vr + 2) = (unsigned short)0; *(LAS unsigned*)(vr + 4) = 0u; v2u o; o.x = 0u; o.y = 0u; *(LAS v2u*)(vr + 8) = o; *(LAS v2u*)(vr + 16) = o; *(LAS v2u*)(vr + 24) = o; }
    v4u rqA[2], rkA[2], rvA, rqB[2], rkB[2], rvB; float rgA, rgB, reA = 0.f, rsA = 0.f, reB = 0.f, rsB = 0.f;
#define RC_LOAD(cc, S) do { const int c_ = (cc) < T / 64 ? (cc) : T / 64 - 1; \
        _Pragma("unroll") for (int k = 0; k < 2; ++k) { const int ch = tid + 512 * k, row = ch >> 4, c16 = ch & 15; const size_t o = (size_t)RC_T(c_, row) * R.qs + c16 * 8; \
            rq##S[k] = *(const GAS v4u*)(R.qin + o); rk##S[k] = *(const GAS v4u*)(R.kin + o); } \
        rv##S = *(const GAS v4u*)(R.vsrc + (size_t)RC_T(c_, (tid & 255) >> 2) * 32 + (tid & 3) * 8); \
        rg##S = R.gtab[(size_t)c_ * 128 + (tid & 127)]; \
        if (NEB == 3) { re##S = R.eq[(size_t)c_ * 64 + (tid & 63)]; rs##S = R.ek[(size_t)c_ * 64 + ((tid & 255) >> 2)]; } } while (0)
#define RC_STAGE(par, S) do { LAS unsigned char* P = L + (par) * Mp::PAR; \
        _Pragma("unroll") for (int k = 0; k < 2; ++k) { const int ch = tid + 512 * k, row = ch >> 4, c16 = ch & 15; \
            *(LAS v4u*)(P + Mp::Q + row * RQ_P + c16 * 16) = rq##S[k]; *(LAS v4u*)(P + Mp::K + row * RQ_P + c16 * 16) = rk##S[k]; } \
        ((LAS float*)(P + Mp::TB))[tid & 127] = rg##S;     \
        if (NEB == 3) { const float sc_ = rs##S;       \
            rv##S.x = cvtpk(bflo(rv##S.x) * sc_, bfhi(rv##S.x) * sc_); rv##S.y = cvtpk(bflo(rv##S.y) * sc_, bfhi(rv##S.y) * sc_); rv##S.z = cvtpk(bflo(rv##S.z) * sc_, bfhi(rv##S.z) * sc_); rv##S.w = cvtpk(bflo(rv##S.w) * sc_, bfhi(rv##S.w) * sc_); \
            *(LAS unsigned short*)(P + Mp::V + ((tid & 255) >> 2) * Mp::VP + 64) = (unsigned short)(cvtpk(sc_, sc_) & 0xffffu); \
            ((LAS float*)(P + Mp::EQ))[tid & 63] = re##S; } \
        { v2u o; o.x = rv##S.x; o.y = rv##S.y; *(LAS v2u*)(P + Mp::V + ((tid & 255) >> 2) * Mp::VP + (tid & 3) * 16) = o; o.x = rv##S.z; o.y = rv##S.w; *(LAS v2u*)(P + Mp::V + ((tid & 255) >> 2) * Mp::VP + (tid & 3) * 16 + 8) = o; } } while (0)
    RC_LOAD(0, A);
    RC_STAGE(0, A);
    RC_LOAD(1, B);
    RC_LOAD(2, A);
    f32x4 Sst[NEB][2];
#pragma unroll
    for (int eb = 0; eb < NEB; ++eb)
#pragma unroll
        for (int dbi = 0; dbi < 2; ++dbi) Sst[eb][dbi] = (f32x4){0.f, 0.f, 0.f, 0.f};
    __syncthreads();
    LAS unsigned char* P0 = L; LAS unsigned char* P1 = L + Mp::PAR; LAS unsigned char* S0 = L + Mp::SB; LAS unsigned char* S1 = L + Mp::SB + Mp::SBSZ;
    const int orow = 16 * (F.wave & 3) + (lane & 15);
    for (int c = 0; c < T / 64; c += 2) {
        RC_STAGE(1, B); RC_LOAD(c + 3, B);
        rec_compute<NEB>(F.wave, lane, P0, S0, S1, Sst, R.out + RC_TOK(c, orow) * 1024);
        __syncthreads();
        RC_STAGE(0, A); RC_LOAD(c + 4, A);
        rec_compute<NEB>(F.wave, lane, P1, S1, S0, Sst, R.out + RC_TOK(c + 1, orow) * 1024);
        __syncthreads();
    }
#undef RC_LOAD
#undef RC_STAGE
#undef RC_TOK
#undef RC_T
}
__device__ __forceinline__ void mlstm_chunk_unit(const Frame& F, const Args& A, int unit) {
    const int es = unit & 7, dir = (unit >> 3) & 1, h = (unit >> 4) & 3, b = unit >> 6;
    RecP R; const size_t chain = (size_t)((dir * 4 + b) * 4 + h) * T * 128;
    (void)chain; const bf16* Ub = (const bf16*)(A.ws + WS_U) + (size_t)b * T * UW + h * 128;
    R.qin = Ub + U_QA; R.kin = Ub + U_KA; R.qs = UW;
    R.eq = (const float*)(A.ws + WS_EQM) + (size_t)(((b * 4 + h) * 2 + dir) * 64) * 64; R.ek = (const float*)(A.ws + WS_EKM) + (size_t)(((b * 4 + h) * 2 + dir) * 64) * 64;
    R.vsrc = (const bf16*)(A.ws + WS_VINM) + (size_t)(((b * 4 + h) * 8 + es)) * T * 32; R.gtab = (const float*)(A.ws + WS_GTABM) + (size_t)((((b * 4 + h) * 2 + dir) * 64)) * 128;
    R.out = (bf16*)(A.ws + WS_HA) + (size_t)dir * M * 1024 + h * 256 + es * 32; R.b = b; R.dir = dir;
    rec_unit<3>(F, R);
}
__device__ __forceinline__ void hgrn_chunk_unit(const Frame& F, const Args& A, int unit) {
    const int es = unit & 3, dir = (unit >> 2) & 1, h = (unit >> 3) & 7, b = unit >> 6;
    RecP R; const size_t chain = (size_t)((dir * 4 + b) * 8 + h) * T * 128;
    R.qin = (const bf16*)(A.ws + WS_QIN) + chain; R.kin = (const bf16*)(A.ws + WS_KIN) + chain; R.qs = 128; R.eq = nullptr; R.ek = nullptr;
    R.vsrc = (const bf16*)(A.ws + WS_VINH) + (size_t)(((b * 8 + h) * 4 + es)) * T * 32; R.gtab = (const float*)(A.ws + WS_GTAB) + (size_t)((((b * 8 + h) * 2 + dir) * 64)) * 128;
    R.out = (bf16*)(A.ws + WS_HB) + (size_t)dir * M * 1024 + h * 128 + es * 32; R.b = b; R.dir = dir;
    rec_unit<2>(F, R);
}
#ifndef MK_ONE_LAUNCH
#define MK_ONE_LAUNCH 1
#endif
constexpr int N_PHASES = 21;
__global__ void __launch_bounds__(NWAVES * 64, 2) trunk_fwd(Args args) {
    extern __shared__ __attribute__((aligned(16))) unsigned char lds[];
    Frame F;
    F.lds = (LAS unsigned char*)lds;
    F.wave = __builtin_amdgcn_readfirstlane(threadIdx.x >> 6);
    F.G = gridDim.x;
    const Args& A = args;
    { const int tid0 = F.wave * 64 + lane_now(); for (int u = tid0; u < (LDS_BYTES - LDSCTL_OFF) / 4; u += NWAVES * 64) ((LAS unsigned*)(F.lds + LDSCTL_OFF))[u] = 0u; }
    __syncthreads();
    gu32* ctl = (gu32*)(args.ws + WS_CTL);
    const int lo = args.ph_lo, hi = args.ph_hi;
    XcdBarrier bar; bar.bar = (unsigned*)(ctl + CW_BAR); bar.x = 0; bar.st = nullptr;
    if (hi - lo > 1) bar = xcd_barrier_post((unsigned*)(ctl + CW_BAR), (volatile LAS unsigned*)(F.lds + MISC_OFF) + 8, F.wave);
#ifndef PROBE_MASK
#define PROBE_MASK 0u
#endif
#define IN(k) (lo <= (k) && (k) < hi)
#define REP(k) _Pragma("unroll") for (int rep_ = 0; rep_ < (((PROBE_MASK >> (k)) & 1u) ? 2 : 1); ++rep_)
#define RSEAM(k) do { if (((PROBE_MASK >> (k)) & 1u) && rep_ == 0) xcd_barrier(bar, F.wave); } while (0)
#ifndef TPROBE
#define TPROBE (-1)
#endif
#ifndef TPROBE_US
#define TPROBE_US 1000.0f
#endif
    unsigned long long tp_a = (TPROBE == 0) ? __builtin_amdgcn_s_memrealtime() : 0ull, tp_b = 0ull;
#define SEAM(k) do { if (IN(k) && IN((k) + 1)) xcd_barrier(bar, F.wave); if ((k) == TPROBE) tp_b = __builtin_amdgcn_s_memrealtime(); if ((k) + 1 == TPROBE) tp_a = __builtin_amdgcn_s_memrealtime(); } while (0)
    unsigned char* ws = args.ws;
    bf16* XB0 = (bf16*)(ws + WS_XB0); bf16* XB1 = (bf16*)(ws + WS_XB1); bf16* TBUF = (bf16*)A.out;
    const int bid = (int)blockIdx.x;
    const int kple = (args.ph_hi > 0) ? PLE_DIM : 0;

    REP(0) if (IN(0)) { p0_prologue(F, A); RSEAM(0); } SEAM(0);
    REP(1) if (IN(1)) {
        pg8::Gemm g{XB0, (const bf16*)(ws + WS_WRIN), M, UW, D}; pg8::StaticOrder S; S.init(M, UW, F.G, bid);
        pg8::EpiRecIn E{(bf16*)(ws + WS_U), UW, (bf16*)(ws + WS_VINM), (bf16*)(ws + WS_VINH), T};
        pg8::gemm_phase<pg8::EpiRecIn, pg8::StaticOrder, true, true>(F.lds + RING_OFF, g, S, E, F.wave);
        gates_mfma(F, A);
    RSEAM(1); } SEAM(1);
    REP(2) if (IN(2)) { rec_prep(F, A); xcd_barrier(bar, F.wave);
        for (int v = bid; v < 256; v += F.G) { const int x = v & 7, j = v >> 3; mlstm_chunk_unit(F, A, ((x + 8 * (j >> 3)) << 3) | (j & 7)); }
        for (int v = bid; v < 256; v += F.G) { const int x = v & 7, j = v >> 3; hgrn_chunk_unit(F, A, ((x + 8 * (j >> 2)) << 2) | (j & 3)); } RSEAM(2); } SEAM(2);
    REP(3) if (IN(3)) { p3_finalize(F, A); RSEAM(3); } SEAM(3);
    REP(4) if (IN(4)) {
        pg8::Gemm g{(const bf16*)(ws + WS_Y), (const bf16*)(ws + WS_WROUT), M, D, D}; pg8::StaticOrder S; S.init(M, D, F.G, bid);
        pg8::EpiResB E{nullptr, XB0, TBUF, D, ALPHA};
        pg8::gemm_phase<pg8::EpiResB, pg8::StaticOrder, true, true, true>(F.lds + RING_OFF, g, S, E, F.wave);
    RSEAM(4); } SEAM(4);
    REP(5) if (IN(5)) { ln_phase_b(F, A, A.in[I_LNW] + 0 * D, A.in[I_LNB] + 0 * D, TBUF, XB1); RSEAM(5); } SEAM(5);
    REP(6) if (IN(6)) {
        pg8::Gemm g{XB1, (const bf16*)(ws + WS_WFGU), M, 2 * FFN, D}; pg8::StaticOrder S; S.init(M, 2 * FFN, F.G, bid);
        pg8::EpiSwiglu E{(bf16*)(ws + WS_H), FFN, 2 * FFN / 256};
        pg8::gemm_phase<pg8::EpiSwiglu, pg8::StaticOrder, true, true>(F.lds + RING_OFF, g, S, E, F.wave);
    RSEAM(6); } SEAM(6);
    REP(7) if (IN(7)) {
        { pg8::Gemm g{(const bf16*)(ws + WS_H), (const bf16*)(ws + WS_WFDN), M, D, FFN}; pg8::StaticOrder S; S.init(M, D, F.G, bid);
          pg8::EpiResB E{nullptr, XB1, TBUF, D, ALPHA};
          pg8::gemm_phase<pg8::EpiResB, pg8::StaticOrder, true, true, true>(F.lds + RING_OFF, g, S, E, F.wave); }
        { pg8::Gemm g{(const bf16*)(ws + WS_PB), (const bf16*)(ws + WS_WPP0), M, D, kple}; pg8::StaticOrder S; S.init(M, D, F.G, bid);
          pg8::EpiStoreB E{(bf16*)(ws + WS_PP), D, D / 256};
          pg8::gemm_phase<pg8::EpiStoreB, pg8::StaticOrder, true, true, true>(F.lds + RING_OFF, g, S, E, F.wave); }
    RSEAM(7); } SEAM(7);
    REP(8) if (IN(8)) { ln_phase_b(F, A, A.in[I_LNW] + 1 * D, A.in[I_LNB] + 1 * D, TBUF, XB0); RSEAM(8); } SEAM(8);
    REP(10) if (IN(10)) {
        pg8::Gemm g{XB0, (const bf16*)(ws + WS_WPG0), M, D, D}; pg8::StaticOrder S; S.init(M, D, F.G, bid);
        pg8::EpiPleB E{XB0, (const bf16*)(ws + WS_PP), XB1, nullptr, D};
        pg8::gemm_phase<pg8::EpiPleB, pg8::StaticOrder, true, true>(F.lds + RING_OFF, g, S, E, F.wave);
    RSEAM(10); } SEAM(10);
#ifdef SLEEP_PROBE_US
    { const unsigned long long t0 = __builtin_amdgcn_s_memrealtime(); while (__builtin_amdgcn_s_memrealtime() - t0 < (unsigned long long)(SLEEP_PROBE_US * 100)) __builtin_amdgcn_s_sleep(32); }
#endif
    REP(11) if (IN(11)) {
        pg8::Gemm g{XB1, (const bf16*)(ws + WS_WQKV), M, NQKV, D}; pg8::StaticOrder S; S.init(M, NQKV, F.G, bid);
        pg8::EpiQKVHeads E{(bf16*)(ws + WS_QKV), T, 16};
        pg8::gemm_phase<pg8::EpiQKVHeads, pg8::StaticOrder, true, true>(F.lds + RING_OFF, g, S, E, F.wave);
    RSEAM(11); } SEAM(11);
    REP(12) if (IN(12)) { na_phase_mfma(F, A); RSEAM(12); } SEAM(12);
    REP(13) if (IN(13)) {
        pg8::Gemm g{(const bf16*)(ws + WS_AO), (const bf16*)(ws + WS_WNAO), M, D, D}; pg8::StaticOrder S; S.init(M, D, F.G, bid);
        pg8::EpiResBF E{XB1, A.out, D, ALPHA};
        pg8::gemm_phase<pg8::EpiResBF, pg8::StaticOrder, true, true, true>(F.lds + RING_OFF, g, S, E, F.wave);
    RSEAM(13); } SEAM(13);
    REP(14) if (IN(14)) { ln_router_phase(F, A, A.in[I_LNW] + 2 * D, A.in[I_LNB] + 2 * D, XB0); RSEAM(14); } SEAM(14);
    REP(15) if (IN(15)) { moe_route_phase(F, A); RSEAM(15); } SEAM(15);
    REP(16) if (IN(16)) {
        const int* TILEE = (const int*)(ws + WS_TILEE); const int nrt = __builtin_amdgcn_readfirstlane(TILEE[0]);
        pg8::Gemm g{XB0, (const bf16*)(ws + WS_WMGU), nrt * 256, 2 * MOE, D}; g.Ainv = (const int*)(ws + WS_INV);
        pg8::MoeOrder S; S.base.init(nrt * 256, 2 * MOE, F.G, bid); S.tile_e = TILEE + 1; S.nN = 2 * MOE / 256;
        pg8::EpiSwiglu E{(bf16*)(ws + WS_HM), MOE, 2 * MOE / 256};
        pg8::gemm_phase<pg8::EpiSwiglu, pg8::MoeOrder, true, true, false, true>(F.lds + RING_OFF, g, S, E, F.wave);
    RSEAM(16); } SEAM(16);
    REP(17) if (IN(17)) {
        { const int* TILEE = (const int*)(ws + WS_TILEE); const int nrt = __builtin_amdgcn_readfirstlane(TILEE[0]);
          const int nra = nrt < pg8::TAIL_PM0 ? nrt : pg8::TAIL_PM0;
          { pg8::Gemm g{(const bf16*)(ws + WS_HM), (const bf16*)(ws + WS_WMDN), nra * 256, D, MOE}; pg8::MoeOrder S; S.base.init(nra * 256, D, F.G, bid); S.tile_e = TILEE + 1; S.nN = D / 256;
            pg8::EpiStoreB E{(bf16*)(ws + WS_YS), D, D / 256};
            pg8::gemm_phase<pg8::EpiStoreB, pg8::MoeOrder, true, true, true>(F.lds + RING_OFF, g, S, E, F.wave); }
          if (nrt > pg8::TAIL_PM0) {
            pg8::Gemm g{(const bf16*)(ws + WS_HM), (const bf16*)(ws + WS_WMDN), nrt * 256, D, MOE, MOE / pg8::TAIL_KS}; pg8::MoeTailOrder S{TILEE + 1, nrt - pg8::TAIL_PM0, F.G, bid, D / 256, MOE / pg8::TAIL_KS / 64};
            pg8::EpiStorePart E{(bf16*)(ws + WS_PART), D, D / 256, MOE / pg8::TAIL_KS / 64};
            pg8::gemm_phase<pg8::EpiStorePart, pg8::MoeTailOrder, true, true, true>(F.lds + RING_OFF, g, S, E, F.wave); } }
        { pg8::Gemm g{(const bf16*)(ws + WS_PB) + (size_t)M * PLE_DIM, (const bf16*)(ws + WS_WPP1), M, D, kple}; pg8::StaticOrder S; S.init(M, D, F.G, bid);
          pg8::EpiStoreB E{(bf16*)(ws + WS_PP1), D, D / 256};
          pg8::gemm_phase<pg8::EpiStoreB, pg8::StaticOrder, true, true, true>(F.lds + RING_OFF, g, S, E, F.wave); }
    RSEAM(17); } SEAM(17);
    REP(18) if (IN(18)) { ln_moe_phase(F, A, A.in[I_LNW] + 3 * D, A.in[I_LNB] + 3 * D, XB0, XB1); RSEAM(18); } SEAM(18);
    REP(20) if (IN(20)) {
        pg8::Gemm g{XB1, (const bf16*)(ws + WS_WPG1), M, D, D}; pg8::StaticOrder S; S.init(M, D, F.G, bid);
        pg8::EpiPleB E{XB1, (const bf16*)(ws + WS_PP1), nullptr, A.out, D};
        pg8::gemm_phase<pg8::EpiPleB, pg8::StaticOrder, true, true>(F.lds + RING_OFF, g, S, E, F.wave);
    }
    if (TPROBE >= 0) {
        if (TPROBE == 20) tp_b = __builtin_amdgcn_s_memrealtime();
        float* dl = (float*)(ctl + 64);
        if (bid == 0 && F.wave == 0 && lane_now() == 0) *dl = (float)(long long)(tp_b - tp_a) * 0.01f / TPROBE_US;
        xcd_barrier(bar, F.wave);
        const float sc = 1.0f + __hip_atomic_load(dl, __ATOMIC_RELAXED, __HIP_MEMORY_SCOPE_AGENT);
        const size_t gt = (size_t)blockIdx.x * (NWAVES * 64) + F.wave * 64 + lane_now(), NGT = (size_t)F.G * NWAVES * 64;
        for (size_t i = gt; i < (size_t)M * D / 4; i += NGT) { f32x4 v = ((GAS f32x4*)A.out)[i]; ((GAS f32x4*)A.out)[i] = v * sc; }
    }
#undef IN
#undef SEAM
}

extern "C" void kernel_launch(void* const* d_in, const int* in_sizes, int n_in, void* d_out, int out_size, void* d_ws, size_t ws_size, hipStream_t stream) {
    static int grid = 0;
    if (grid == 0) {
        if (n_in != 23 || in_sizes[0] != M * D || out_size != M * D || ws_size < WS_END) { fprintf(stderr, "kernel_launch: unexpected shapes (n_in %d, in0 %d, out %d, ws %zu, need %zu)\n", n_in, n_in > 0 ? in_sizes[0] : -1, out_size, ws_size, (size_t)WS_END); grid = -1; return; }
        int dev = 0, cus = 0, per_cu = 0;
        if (hipGetDevice(&dev) != hipSuccess || hipDeviceGetAttribute(&cus, hipDeviceAttributeMultiprocessorCount, dev) != hipSuccess) { grid = -1; return; }
        if (hipFuncSetAttribute((const void*)trunk_fwd, hipFuncAttributeMaxDynamicSharedMemorySize, LDS_BYTES) != hipSuccess) { fprintf(stderr, "kernel_launch: hipFuncSetAttribute failed\n"); grid = -1; return; }
        if (hipOccupancyMaxActiveBlocksPerMultiprocessor(&per_cu, (const void*)trunk_fwd, NWAVES * 64, LDS_BYTES) != hipSuccess || per_cu < 1) { fprintf(stderr, "kernel_launch: occupancy query reports %d\n", per_cu); }
        (void)hipGetLastError();
        grid = cus;
    }
    if (grid < 0) return;
    (void)hipMemsetAsync((char*)d_ws + WS_CTL, 0, CTL_ZERO_BYTES, stream);
    Args a{};
    for (int i = 0; i < 23; ++i) a.in[i] = (const float*)d_in[i];
    a.out = (float*)d_out; a.ws = (unsigned char*)d_ws;
#if MK_ONE_LAUNCH
    a.ph_lo = 0; a.ph_hi = N_PHASES;
    hipLaunchKernelGGL(trunk_fwd, dim3(grid), dim3(NWAVES * 64), LDS_BYTES, stream, a);
#else
    for (int ph = 0; ph < N_PHASES; ++ph) { a.ph_lo = ph; a.ph_hi = ph + 1; hipLaunchKernelGGL(trunk_fwd, dim3(grid), dim3(NWAVES * 64), LDS_BYTES, stream, a); }
#endif
}
```
